# Optimizing an MI355X kernel written in HIP

```python
import math
import jax
import jax.numpy as jnp
from jax import lax
import numpy as np

D_MODEL = 1024
BATCH = 8
SEQ = 4096
DEPTH = 2

HEAD_DIM = 64
N_HEADS = D_MODEL // HEAD_DIM
N_HEADS_FOX = N_HEADS // 2
N_HEADS_MOBA = N_HEADS - N_HEADS_FOX
N_HEADS_DIL = N_HEADS
ATTN_SCALE = HEAD_DIM ** -0.5
Q_BLOCK = 128
MOBA_BLOCK = 256
MOBA_TOPK = 3
MOBA_QCHUNK = 16
DIL_PATTERNS = ((128, 1), (512, 4), (2048, 16))
NUM_BUCKETS = 32
MAX_DISTANCE = 2048
D_FF = 2816
N_EXPERTS = 8
TOP_K = 2
D_FF_EXPERT = 3584
NORM_EPS = 1e-6
NEG_INF = float("-inf")

kernel_name = "hybrid_fox_moba_dilated_moe_trunk"


def rms_norm(x, g):
    xf = x.astype(jnp.float32)
    y = xf * lax.rsqrt(jnp.mean(xf * xf, axis=-1, keepdims=True) + NORM_EPS)
    return (y * g.astype(jnp.float32)).astype(x.dtype)


def modulate(h, g, shift, scale):
    return rms_norm(h, g) * (1 + scale[:, None, :]) + shift[:, None, :]


def to_heads(t, n_heads):
    b, s, _ = t.shape
    return t.reshape(b, s, n_heads, HEAD_DIM).transpose(0, 2, 1, 3)


def from_heads(t):
    b, h, s, dh = t.shape
    return t.transpose(0, 2, 1, 3).reshape(b, s, h * dh)


def t5_bucket(dist):
    n = jnp.maximum(dist, 0)
    max_exact = NUM_BUCKETS // 2
    nf = jnp.maximum(n, 1).astype(jnp.float32)
    log_ratio = jnp.log(nf / max_exact) / math.log(MAX_DISTANCE / max_exact)
    large = max_exact + (log_ratio * (NUM_BUCKETS - max_exact)).astype(jnp.int32)
    large = jnp.minimum(large, NUM_BUCKETS - 1)
    return jnp.where(n < max_exact, n, large)


def fox_attention(q, k, v, log_f):
    b, h, s, dh = q.shape
    n_blk = s // Q_BLOCK
    cum = jnp.cumsum(log_f, axis=-1)
    q_blocks = jnp.moveaxis(q.reshape(b, h, n_blk, Q_BLOCK, dh), 2, 0)
    c_blocks = jnp.moveaxis(cum.reshape(b, h, n_blk, Q_BLOCK), 2, 0)
    k_pos = jnp.arange(s)

    def one_block(args):
        qi, ci, bi = args
        q_pos = bi * Q_BLOCK + jnp.arange(Q_BLOCK)
        sc = jnp.einsum("bhqd,bhkd->bhqk", qi, k).astype(jnp.float32) * ATTN_SCALE
        sc = sc + ci[..., None] - cum[:, :, None, :]
        sc = jnp.where(k_pos[None, :] <= q_pos[:, None], sc, NEG_INF)
        p = jax.nn.softmax(sc, axis=-1)
        return jnp.einsum("bhqk,bhkd->bhqd", p.astype(v.dtype), v)

    out = lax.map(one_block, (q_blocks, c_blocks, jnp.arange(n_blk)))
    return jnp.moveaxis(out, 0, 2).reshape(b, h, s, dh)


def moba_attention(q, k, v, bias_t):
    b, h, s, dh = q.shape
    n_blk = -(-s // MOBA_BLOCK)
    s_pad = n_blk * MOBA_BLOCK
    pad = ((0, 0), (0, 0), (0, s_pad - s), (0, 0))
    k_blocks = jnp.pad(k, pad).reshape(b, h, n_blk, MOBA_BLOCK, dh)
    v_blocks = jnp.pad(v, pad).reshape(b, h, n_blk, MOBA_BLOCK, dh)
    k_mean = jnp.mean(k_blocks.astype(jnp.float32), axis=3)
    gate = jnp.einsum("bhsd,bhnd->bhsn", q.astype(jnp.float32), k_mean)
    q_blk = jnp.arange(s) // MOBA_BLOCK
    fully_past = jnp.arange(n_blk)[None, :] < q_blk[:, None]
    gate = jnp.where(fully_past, gate, NEG_INF)
    if n_blk < MOBA_TOPK:
        gate = jnp.pad(gate, ((0, 0), (0, 0), (0, 0), (0, MOBA_TOPK - n_blk)), constant_values=NEG_INF)
    top_val, top_idx = lax.top_k(gate, MOBA_TOPK)
    sel_valid = jnp.isfinite(top_val)
    top_idx = jnp.minimum(top_idx, n_blk - 1)

    n_qc = s // MOBA_QCHUNK

    def chunks(t):
        return jnp.moveaxis(t.reshape(b, h, n_qc, MOBA_QCHUNK, *t.shape[3:]), 2, 0)

    b_ix = jnp.arange(b)[:, None, None, None]
    h_ix = jnp.arange(h)[None, :, None, None]
    blk_off = jnp.arange(MOBA_BLOCK)
    n_sel = MOBA_TOPK * MOBA_BLOCK

    def one_chunk(args):
        qc, idx, valid, ci = args
        t_pos = ci * MOBA_QCHUNK + jnp.arange(MOBA_QCHUNK)
        k_sel = k_blocks[b_ix, h_ix, idx]
        v_sel = v_blocks[b_ix, h_ix, idx]
        s_sel = jnp.einsum("bhqd,bhqjnd->bhqjn", qc, k_sel).astype(jnp.float32) * ATTN_SCALE
        dist_sel = t_pos[None, None, :, None, None] - (idx[..., None] * MOBA_BLOCK + blk_off)
        s_sel = s_sel + bias_t[h_ix[..., None], t5_bucket(dist_sel)]
        s_sel = jnp.where(valid[..., None], s_sel, NEG_INF)
        own = (ci * MOBA_QCHUNK) // MOBA_BLOCK
        k_own = lax.dynamic_index_in_dim(k_blocks, own, axis=2, keepdims=False)
        v_own = lax.dynamic_index_in_dim(v_blocks, own, axis=2, keepdims=False)
        s_own = jnp.einsum("bhqd,bhnd->bhqn", qc, k_own).astype(jnp.float32) * ATTN_SCALE
        dist_own = t_pos[:, None] - (own * MOBA_BLOCK + blk_off)[None, :]
        s_own = s_own + bias_t[:, t5_bucket(dist_own)][None]
        s_own = jnp.where(dist_own >= 0, s_own, NEG_INF)
        p = jax.nn.softmax(jnp.concatenate([s_sel.reshape(b, h, MOBA_QCHUNK, n_sel), s_own], axis=-1), axis=-1)
        p_sel = p[..., :n_sel].reshape(b, h, MOBA_QCHUNK, MOBA_TOPK, MOBA_BLOCK)
        p_own = p[..., n_sel:]
        return (jnp.einsum("bhqjn,bhqjnd->bhqd", p_sel.astype(v.dtype), v_sel)
                + jnp.einsum("bhqn,bhnd->bhqd", p_own.astype(v.dtype), v_own))

    out = lax.map(one_chunk, (chunks(q), chunks(top_idx), chunks(sel_valid), jnp.arange(n_qc)))
    return jnp.moveaxis(out, 0, 2).reshape(b, h, s, dh)


def dilated_branch(q, k, v, bias_t, span, dil):
    b, h, s, dh = q.shape
    unit = span * dil
    s_pad = -(-s // unit) * unit
    sub_len = s_pad // dil
    nc = sub_len // span
    pad = ((0, 0), (0, 0), (0, s_pad - s), (0, 0))

    def split(t):
        t = jnp.pad(t, pad).reshape(b, h, sub_len, dil, dh).transpose(0, 1, 3, 2, 4)
        return t.reshape(b, h, dil, nc, span, dh)

    def band(t):
        prev = jnp.pad(t, ((0, 0), (0, 0), (0, 0), (1, 0), (0, 0), (0, 0)))[:, :, :, :-1]
        return jnp.concatenate([prev, t], axis=4)

    def unsplit(t):
        rest = t.shape[5:]
        t = t.reshape(b, h, dil, sub_len, *rest)
        t = jnp.swapaxes(t, 2, 3).reshape(b, h, s_pad, *rest)
        return t[:, :, :s]

    qc = split(q)
    k_band = band(split(k))
    v_band = band(split(v))
    rel = jnp.arange(span)[:, None] + span - jnp.arange(2 * span)[None, :]
    in_band = (rel >= 0) & (rel <= span)
    not_before_start = (jnp.arange(nc)[:, None, None] > 0) | (jnp.arange(2 * span)[None, None, :] >= span)
    mask = in_band[None] & not_before_start
    bias = bias_t[:, t5_bucket(rel * dil)]
    sc = jnp.einsum("bhrcqd,bhrckd->bhrcqk", qc, k_band).astype(jnp.float32) * ATTN_SCALE
    sc = jnp.where(mask, sc + bias[None, :, None, None], NEG_INF)
    m = jnp.max(sc, axis=-1)
    e = jnp.exp(sc - m[..., None])
    l = jnp.sum(e, axis=-1)
    o = jnp.einsum("bhrcqk,bhrckd->bhrcqd", e, v_band.astype(jnp.float32)) / l[..., None]
    return unsplit(m), unsplit(l), unsplit(o)


def dilated_attention(q, k, v, bias_t):
    ms, ls, os_ = [], [], []
    for window, dil in DIL_PATTERNS:
        m, l, o = dilated_branch(q, k, v, bias_t, window // dil, dil)
        ms.append(m)
        ls.append(l)
        os_.append(o)
    m_all = jnp.stack(ms)
    w = jnp.stack(ls) * jnp.exp(m_all - jnp.max(m_all, axis=0))
    o = jnp.sum(w[..., None] * jnp.stack(os_), axis=0) / jnp.sum(w, axis=0)[..., None]
    return o.astype(q.dtype)


def even_mixer(u, w_in, gate_bias, w_out, rel_bias_table):
    d_a = N_HEADS_FOX * HEAD_DIM
    d_b = N_HEADS_MOBA * HEAD_DIM
    cuts = np.cumsum([d_a, d_a, d_a, N_HEADS_FOX, d_b, d_b]).tolist()
    q_a, k_a, v_a, f_a, q_b, k_b, v_b = jnp.split(u @ w_in, cuts, axis=-1)
    log_f = jax.nn.log_sigmoid(f_a.astype(jnp.float32) + gate_bias.astype(jnp.float32)).transpose(0, 2, 1)
    o_fox = fox_attention(to_heads(q_a, N_HEADS_FOX), to_heads(k_a, N_HEADS_FOX),
                          to_heads(v_a, N_HEADS_FOX), log_f)
    bias_moba = rel_bias_table.T[N_HEADS_FOX:]
    o_moba = moba_attention(to_heads(q_b, N_HEADS_MOBA), to_heads(k_b, N_HEADS_MOBA),
                            to_heads(v_b, N_HEADS_MOBA), bias_moba)
    o = from_heads(jnp.concatenate([o_fox, o_moba.astype(o_fox.dtype)], axis=1))
    return o @ w_out


def odd_mixer(u, w_in, w_out, rel_bias_table):
    q, k, v = jnp.split(u @ w_in, 3, axis=-1)
    o = dilated_attention(to_heads(q, N_HEADS_DIL), to_heads(k, N_HEADS_DIL),
                          to_heads(v, N_HEADS_DIL), rel_bias_table.T)
    return from_heads(o) @ w_out


def swiglu(u, w_gate, w_up, w_down):
    return (jax.nn.silu(u @ w_gate) * (u @ w_up)) @ w_down


def moe_swiglu(u, router_w, w_gate, w_up, w_down):
    b, s, d = u.shape
    t = u.reshape(b * s, d)
    logits = (t @ router_w).astype(jnp.float32)
    top_v, top_i = lax.top_k(logits, TOP_K)
    top_p = jax.nn.softmax(top_v, axis=-1)
    gates = jnp.einsum("nk,nke->ne", top_p, jax.nn.one_hot(top_i, N_EXPERTS, dtype=jnp.float32))
    out = jnp.zeros_like(t)
    for e in range(N_EXPERTS):
        out = out + gates[:, e:e + 1].astype(t.dtype) * swiglu(t, w_gate[e], w_up[e], w_down[e])
    return out.reshape(b, s, d)


def setup_inputs(seed: int = 0) -> dict:
    key = jax.random.key(seed)
    ks = jax.random.split(key, 18)
    D = D_MODEL
    n_even = (DEPTH + 1) // 2
    n_odd = DEPTH // 2
    d_attn = N_HEADS * HEAD_DIM
    d_in_even = 3 * N_HEADS_FOX * HEAD_DIM + N_HEADS_FOX + 3 * N_HEADS_MOBA * HEAD_DIM

    def rn(k, shape):
        return jax.random.normal(k, shape, jnp.float32)

    def w(k, shape, fan_in, gain=1.0):
        return (gain * fan_in ** -0.5) * rn(k, shape)

    return {
        "x": rn(ks[0], (BATCH, SEQ, D)),
        "c": rn(ks[1], (BATCH, D)),
        "mod_w": w(ks[2], (DEPTH, D, 6 * D), D, 0.5),
        "mod_b": 0.02 * rn(ks[3], (DEPTH, 6 * D)),
        "norm_g": 1.0 + 0.1 * rn(ks[4], (DEPTH, 4, D)),
        "attn_in_w_even": w(ks[5], (n_even, D, d_in_even), D),
        "fox_gate_bias": 1.0 + 0.5 * rn(ks[6], (n_even, N_HEADS_FOX)),
        "attn_out_w_even": w(ks[7], (n_even, d_attn, D), d_attn),
        "attn_in_w_odd": w(ks[8], (n_odd, D, 3 * N_HEADS_DIL * HEAD_DIM), D),
        "attn_out_w_odd": w(ks[9], (n_odd, N_HEADS_DIL * HEAD_DIM, D), N_HEADS_DIL * HEAD_DIM),
        "rel_bias_table": 0.5 * rn(ks[10], (NUM_BUCKETS, N_HEADS)),
        "ffn_w_gate": w(ks[11], (n_even, D, D_FF), D),
        "ffn_w_up": w(ks[12], (n_even, D, D_FF), D),
        "ffn_w_down": w(ks[13], (n_even, D_FF, D), D_FF),
        "router_w": w(ks[14], (n_odd, D, N_EXPERTS), D),
        "exp_w_gate": w(ks[15], (n_odd, N_EXPERTS, D, D_FF_EXPERT), D),
        "exp_w_up": w(ks[16], (n_odd, N_EXPERTS, D, D_FF_EXPERT), D),
        "exp_w_down": w(ks[17], (n_odd, N_EXPERTS, D_FF_EXPERT, D), D_FF_EXPERT),
    }


def reference(x, c, mod_w, mod_b, norm_g, attn_in_w_even, fox_gate_bias, attn_out_w_even,
              attn_in_w_odd, attn_out_w_odd, rel_bias_table, ffn_w_gate, ffn_w_up, ffn_w_down,
              router_w, exp_w_gate, exp_w_up, exp_w_down):
    mods = jnp.einsum("bd,lde->lbe", jax.nn.silu(c), mod_w) + mod_b[:, None, :]
    h = x
    for layer in range(DEPTH):
        j = layer // 2
        sh1, sc1, g1, sh2, sc2, g2 = jnp.split(mods[layer], 6, axis=-1)
        gains = norm_g[layer]
        u = modulate(h, gains[0], sh1, sc1)
        if layer % 2 == 0:
            y = even_mixer(u, attn_in_w_even[j], fox_gate_bias[j], attn_out_w_even[j], rel_bias_table)
        else:
            y = odd_mixer(u, attn_in_w_odd[j], attn_out_w_odd[j], rel_bias_table)
        h = h + g1[:, None, :] * rms_norm(y, gains[1])
        u = modulate(h, gains[2], sh2, sc2)
        if layer % 2 == 0:
            y = swiglu(u, ffn_w_gate[j], ffn_w_up[j], ffn_w_down[j])
        else:
            y = moe_swiglu(u, router_w[j], exp_w_gate[j], exp_w_up[j], exp_w_down[j])
        h = h + g2[:, None, :] * rms_norm(y, gains[3])
    return h
```

```cpp
#include <hip/hip_runtime.h>
#include <cstdio>
#include <cstdint>

#ifndef MK_ONE_LAUNCH
#define MK_ONE_LAUNCH 1
#endif
#ifndef MK_DUP
#define MK_DUP 0
#endif
#ifndef MK_LAST_PHASE
#define MK_LAST_PHASE 21
#endif

#define GAS __attribute__((address_space(1)))
#define LAS __attribute__((address_space(3)))
typedef unsigned short bf16;
typedef unsigned u32x4 __attribute__((ext_vector_type(4)));
typedef unsigned u32x2 __attribute__((ext_vector_type(2)));
typedef float f32x4 __attribute__((ext_vector_type(4)));
typedef float f32x2 __attribute__((ext_vector_type(2)));
typedef float f32x16 __attribute__((ext_vector_type(16)));
typedef short bf16x8 __attribute__((ext_vector_type(8)));
typedef short s16x4 __attribute__((ext_vector_type(4)));
typedef GAS unsigned gu32;

constexpr int NB = 8, SEQ = 4096, DM = 1024, NTOK = NB * SEQ, NH = 16, HD = 64;
constexpr int DFF = 2816, NEXP = 8, DFE = 3584;
constexpr int QKVP = 3072;
constexpr int DIN0 = 3080;
constexpr float NORM_EPS = 1e-6f;
constexpr float LOG2E = 1.4426950408889634f;
constexpr int NWAVES = 8;
constexpr int MAXTILES = 264;
constexpr int PASS0_TILES = 128, PASS1_MAXTILES = MAXTILES - PASS0_TILES;

constexpr size_t MiB = 1u << 20;
constexpr size_t WS_CTL = 0, CTL_ZERO_BYTES = 1 * MiB;
constexpr size_t WS_MODS = 1 * MiB;
constexpr size_t WS_LOGF = 2 * MiB;
constexpr size_t WS_CUM = 3 * MiB;
constexpr size_t WS_KMEAN = 4 * MiB;
constexpr size_t WS_TOKE = 5 * MiB;
constexpr size_t WS_TOKP = WS_TOKE + 256 * 1024;
constexpr size_t WS_TOKR = WS_TOKP + 256 * 1024;
constexpr size_t WS_TOKS = WS_TOKR + 256 * 1024;
constexpr size_t WS_TILEE = 6 * MiB;
constexpr size_t WS_ML = 8 * MiB;
constexpr size_t WS_RA = 24 * MiB;
constexpr size_t WS_RC = 88 * MiB;
constexpr size_t WS_WOTHER = 152 * MiB;
constexpr size_t WS_RB = 185 * MiB;
constexpr size_t WS_RD = 377 * MiB;
constexpr size_t WS_HID = 24 * MiB;
constexpr size_t WS_USORT = 262 * MiB;
constexpr size_t WS_YSLOT = 328 * MiB;
constexpr size_t WS_WEXP = 460 * MiB;
constexpr size_t WS_END = 544 * MiB;
constexpr size_t WEXP_STRIDE = 10 * MiB + 512 * 1024, WEXP_DN_OFF = 7 * MiB;
constexpr float FP8_SW = 64.f, FP8_SU = 4.f, FP8_SH = 8.f;
constexpr size_t WO_IN0 = 0, WO_OUT0 = 6 * MiB, WO_IN1 = 8 * MiB, WO_OUT1 = 14 * MiB, WO_FGU = 16 * MiB, WO_FDN = 27 * MiB;
static_assert(WS_RB + (size_t)NTOK * QKVP * 2 <= WS_RD && WS_HID + (size_t)MAXTILES * 256 * DFE <= WS_USORT && WS_USORT + (size_t)MAXTILES * 256 * DM <= WS_YSLOT && WS_YSLOT + (size_t)MAXTILES * 256 * DM * 2 <= WS_WEXP && WS_WEXP + 8 * WEXP_STRIDE <= WS_END, "d_ws map");
constexpr int CW_GCNT = 1024;
constexpr int CW_QKN = 2048;
constexpr int CW_KN1 = 3072;
constexpr int CW_BAR = 4096;

constexpr int RING_BYTES = 131072;
constexpr int MISC_OFF = RING_BYTES + 320;
constexpr int LDS_BYTES = 147456;

__device__ __forceinline__ unsigned f2bf(float f) { unsigned u = __builtin_bit_cast(unsigned, f); return (u + 0x7fffu + ((u >> 16) & 1u)) >> 16; }
__device__ __forceinline__ unsigned pk2(float lo, float hi) { return f2bf(lo) | (f2bf(hi) << 16); }
__device__ __forceinline__ float bf2f(unsigned short b) { return __builtin_bit_cast(float, (unsigned)b << 16); }
__device__ __forceinline__ float bflo(unsigned w) { return __builtin_bit_cast(float, w << 16); }
__device__ __forceinline__ float bfhi(unsigned w) { return __builtin_bit_cast(float, w & 0xffff0000u); }
__device__ __forceinline__ float wave_sum(float v) {
#pragma unroll
    for (int o = 1; o < 64; o <<= 1) v += __shfl_xor(v, o);
    return v;
}
__device__ __forceinline__ unsigned pk4_fp8(float a, float b, float c, float d) { unsigned w = __builtin_amdgcn_cvt_pk_fp8_f32(a, b, 0u, false); return __builtin_amdgcn_cvt_pk_fp8_f32(c, d, w, true); }
__device__ __forceinline__ float clamp448(float v) { return __builtin_amdgcn_fmed3f(v, -448.f, 448.f); }
#define LDS_WAIT() asm volatile("s_waitcnt lgkmcnt(0)" ::: "memory")
#define VM_WAIT() asm volatile("s_waitcnt vmcnt(0)" ::: "memory")

namespace pg8 {
typedef unsigned short bf16_t;
typedef int v8i_t __attribute__((ext_vector_type(8)));
constexpr int BM = 256, BK = 64, HALF = 128, HTB = HALF * BK * 2, STAGE_BYTES = 8 * HTB, NXCD = 8, WGM = 8;
__host__ __device__ __forceinline__ int lds_byte(int r, int c) { const int st = (r >> 4) * 2 + (c >> 5), rr = r & 15, cc = c & 31, ob = rr * 64 + cc * 2; return st * 1024 + (ob ^ (((ob >> 9) & 1) << 5)); }
__host__ __device__ __forceinline__ void stage_rc(int b, int& R, int& C) { const int st = b / 1024, sb = b % 1024, swz = sb ^ (((sb >> 9) & 1) << 5); R = (st >> 1) * 16 + swz / 64; C = (st & 1) * 32 + (swz % 64) / 2; }
__host__ __device__ __forceinline__ int perm32(int rho) { const int n = rho >> 4, i = rho & 15; return 8 * (i >> 2) + 4 * n + (i & 3); }

struct Unit { int pm, pn; };
struct Gemm { const bf16_t* A; const bf16_t* Bt; int M, N, K; };

struct StaticOrder {
    int nM, nN, nwg, G, c;
    __device__ void init(int M, int N, int G_, int c_) { nM = M / BM; nN = N / BM; nwg = nM * nN; G = G_; c = c_; }
    __device__ bool next(int i, Unit& u) const {
        const long L = (long)i * G + c; if (L >= nwg) return false;
        int wgid = (int)L; { const int q = nwg / NXCD, r = nwg % NXCD, xcd = wgid % NXCD, off = wgid / NXCD; wgid = (xcd < r ? xcd * (q + 1) : r * (q + 1) + (xcd - r) * q) + off; }
        const int nig = WGM * nN, gid = wgid / nig, fm = gid * WGM, gsz = (nM - fm) < WGM ? (nM - fm) : WGM;
        u.pm = fm + ((wgid % nig) % gsz); u.pn = (wgid % nig) / gsz; return true;
    }
    __device__ __forceinline__ const char* abase(const Gemm& g, const Unit& u) const { return (const char*)g.A + (size_t)u.pm * ((size_t)BM * g.K * 2); }
    __device__ __forceinline__ const char* bbase(const Gemm& g, const Unit& u) const { return (const char*)g.Bt + (size_t)u.pn * ((size_t)BM * g.K * 2); }
};
struct MoeOrder {
    StaticOrder so; const int* tile_e; size_t estride;
    __device__ bool next(int i, Unit& u) const { return so.next(i, u); }
    __device__ __forceinline__ const char* abase(const Gemm& g, const Unit& u) const { return (const char*)g.A + (size_t)u.pm * ((size_t)BM * g.K * 2); }
    __device__ __forceinline__ const char* bbase(const Gemm& g, const Unit& u) const { const int e = __builtin_amdgcn_readfirstlane(tile_e[u.pm]); return (const char*)g.Bt + (size_t)e * estride + (size_t)u.pn * ((size_t)BM * g.K * 2); }
};

typedef float f32x2_t __attribute__((ext_vector_type(2))); typedef __bf16 bf16x2_t __attribute__((ext_vector_type(2)));
__device__ __forceinline__ unsigned cvt_pk_bf16(float lo, float hi) { f32x2_t v = {lo, hi}; bf16x2_t b = __builtin_convertvector(v, bf16x2_t); return __builtin_bit_cast(unsigned, b); }

struct EpiBf16 {
    static constexpr bool PERM = true;
    bf16_t* O; int ldc;
    __device__ __forceinline__ void operator()(const f32x4 (&acc)[2][2][4][2], const Unit& u, int wr, int wc, int fr, int fq) const {
        const int row0 = u.pm * BM + wr * 64 + fr; const int col0 = u.pn * BM + wc * 32 + 8 * fq;
#pragma unroll
        for (int ai = 0; ai < 2; ++ai)
#pragma unroll
            for (int m = 0; m < 4; ++m) { bf16_t* rowp = O + (size_t)(row0 + ai * HALF + m * 16) * ldc + col0;
#pragma unroll
                for (int bj = 0; bj < 2; ++bj) { const f32x4 v0 = acc[ai][bj][m][0], v1 = acc[ai][bj][m][1];
                    u32x4 w; w.x = cvt_pk_bf16(v0[0], v0[1]); w.y = cvt_pk_bf16(v0[2], v0[3]); w.z = cvt_pk_bf16(v1[0], v1[1]); w.w = cvt_pk_bf16(v1[2], v1[3]);
                    *(u32x4*)(rowp + bj * HALF) = w; } }
    }
};
struct EpiHeadMajor {
    static constexpr bool PERM = true;
    bf16_t* O; int M; unsigned long long qmask; float qscale;
    __device__ __forceinline__ void operator()(const f32x4 (&acc)[2][2][4][2], const Unit& u, int wr, int wc, int fr, int fq) const {
        const int row0 = u.pm * BM + wr * 64 + fr; const int col0 = u.pn * BM + wc * 32 + 8 * fq;
#pragma unroll
        for (int ai = 0; ai < 2; ++ai)
#pragma unroll
            for (int m = 0; m < 4; ++m) { const int row = row0 + ai * HALF + m * 16;
#pragma unroll
                for (int bj = 0; bj < 2; ++bj) { const int col = col0 + bj * HALF; const float sc = ((qmask >> (col >> 6)) & 1ull) ? qscale : 1.f; const f32x4 v0 = acc[ai][bj][m][0] * sc, v1 = acc[ai][bj][m][1] * sc;
                    u32x4 w; w.x = cvt_pk_bf16(v0[0], v0[1]); w.y = cvt_pk_bf16(v0[2], v0[3]); w.z = cvt_pk_bf16(v1[0], v1[1]); w.w = cvt_pk_bf16(v1[2], v1[3]);
                    *(u32x4*)(O + ((size_t)(col >> 6) * M + row) * 64 + (col & 63)) = w; } }
    }
};
__device__ __forceinline__ float silu_mul(float g, float u) { return g * u * __builtin_amdgcn_rcpf(1.f + __builtin_amdgcn_exp2f(-g * LOG2E)); }
struct EpiBf16Scaled {
    static constexpr bool PERM = true;
    bf16_t* O; int ldc; float scale;
    __device__ __forceinline__ void operator()(const f32x4 (&acc)[2][2][4][2], const Unit& u, int wr, int wc, int fr, int fq) const {
        const int row0 = u.pm * BM + wr * 64 + fr; const int col0 = u.pn * BM + wc * 32 + 8 * fq;
#pragma unroll
        for (int ai = 0; ai < 2; ++ai)
#pragma unroll
            for (int m = 0; m < 4; ++m) { bf16_t* rowp = O + (size_t)(row0 + ai * HALF + m * 16) * ldc + col0;
#pragma unroll
                for (int bj = 0; bj < 2; ++bj) { const f32x4 v0 = acc[ai][bj][m][0] * scale, v1 = acc[ai][bj][m][1] * scale;
                    u32x4 w; w.x = cvt_pk_bf16(v0[0], v0[1]); w.y = cvt_pk_bf16(v0[2], v0[3]); w.z = cvt_pk_bf16(v1[0], v1[1]); w.w = cvt_pk_bf16(v1[2], v1[3]);
                    *(u32x4*)(rowp + bj * HALF) = w; } }
    }
};
struct EpiSwigluFp8 {
    static constexpr bool PERM = true;
    unsigned char* O; int ldc; float sin, sout;
    __device__ __forceinline__ void operator()(const f32x4 (&acc)[2][2][4][2], const Unit& u, int wr, int wc, int fr, int fq) const {
        const int row0 = u.pm * BM + wr * 64 + fr; const int col0 = u.pn * HALF + wc * 32 + 8 * fq;
#pragma unroll
        for (int ai = 0; ai < 2; ++ai)
#pragma unroll
            for (int m = 0; m < 4; ++m) { unsigned char* rowp = O + (size_t)(row0 + ai * HALF + m * 16) * ldc + col0;
                const f32x4 ag0 = acc[ai][0][m][0], ag1 = acc[ai][0][m][1];
                const f32x4 t0 = ag0 * (-sin * LOG2E), t1 = ag1 * (-sin * LOG2E);
                f32x4 d0, d1;
#pragma unroll
                for (int e = 0; e < 4; ++e) { d0[e] = __builtin_amdgcn_exp2f(t0[e]); d1[e] = __builtin_amdgcn_exp2f(t1[e]); }
                d0 = d0 + 1.f; d1 = d1 + 1.f;
                f32x4 r0, r1;
#pragma unroll
                for (int e = 0; e < 4; ++e) { r0[e] = __builtin_amdgcn_rcpf(d0[e]); r1[e] = __builtin_amdgcn_rcpf(d1[e]); }
                const f32x4 v0 = (ag0 * acc[ai][1][m][0]) * (sin * sin * sout) * r0, v1 = (ag1 * acc[ai][1][m][1]) * (sin * sin * sout) * r1;
                u32x2 w; w.x = pk4_fp8(clamp448(v0[0]), clamp448(v0[1]), clamp448(v0[2]), clamp448(v0[3]));
                w.y = pk4_fp8(clamp448(v1[0]), clamp448(v1[1]), clamp448(v1[2]), clamp448(v1[3]));
                *(u32x2*)rowp = w; __builtin_amdgcn_sched_barrier(0); }
    }
};
struct EpiSwiglu {
    static constexpr bool PERM = true;
    bf16_t* O; int ldc;
    __device__ __forceinline__ void operator()(const f32x4 (&acc)[2][2][4][2], const Unit& u, int wr, int wc, int fr, int fq) const {
        const int row0 = u.pm * BM + wr * 64 + fr; const int col0 = u.pn * HALF + wc * 32 + 8 * fq;
#pragma unroll
        for (int ai = 0; ai < 2; ++ai)
#pragma unroll
            for (int m = 0; m < 4; ++m) { bf16_t* rowp = O + (size_t)(row0 + ai * HALF + m * 16) * ldc + col0;
                const f32x4 g0 = acc[ai][0][m][0], g1 = acc[ai][0][m][1], u0 = acc[ai][1][m][0], u1 = acc[ai][1][m][1];
                u32x4 w; w.x = cvt_pk_bf16(silu_mul(g0[0], u0[0]), silu_mul(g0[1], u0[1])); w.y = cvt_pk_bf16(silu_mul(g0[2], u0[2]), silu_mul(g0[3], u0[3]));
                w.z = cvt_pk_bf16(silu_mul(g1[0], u1[0]), silu_mul(g1[1], u1[1])); w.w = cvt_pk_bf16(silu_mul(g1[2], u1[2]), silu_mul(g1[3], u1[3]));
                *(u32x4*)rowp = w; }
    }
};

__device__ __forceinline__ void glds16s(const void* sbase, unsigned voff, unsigned lds_dst) { unsigned keep;
    asm volatile("s_mov_b32 %0, m0\n\ts_mov_b32 m0, %3\n\ts_nop 0\n\tglobal_load_lds_dwordx4 %2, %1\n\ts_mov_b32 m0, %0" : "=&s"(keep) : "s"(sbase), "v"(voff), "s"(lds_dst) : "memory"); }
template <class Epi, class Sched, bool ALIGN_EPI = true, bool FP8 = false, int KC = 0>
__device__ __forceinline__ void gemm_phase(LAS unsigned char* lds, const Gemm g, const Sched& S, const Epi& E) {
    const int tid = threadIdx.x, wid = __builtin_amdgcn_readfirstlane(tid >> 6), lane = tid & 63, wr = wid >> 2, wc = wid & 3, fr = lane & 15, fq = lane >> 4;
    const int K = KC > 0 ? KC : g.K, nt = K / BK;
    unsigned voffA[2], voffB[2];
#pragma unroll
    for (int i = 0; i < 2; ++i) { int R, C; stage_rc(tid * 16 + i * 8192, R, C); const int Rb = Epi::PERM ? ((R & ~31) + perm32(R & 31)) : R;
        voffA[i] = (unsigned)(R * K + C) * 2u; voffB[i] = (unsigned)(Rb * K + C) * 2u; }
    const size_t kstep = (size_t)(BK * 2);
    const size_t hstep = (size_t)HALF * K * 2;
    const unsigned ldsw = (unsigned)wid * 1024u;
    const unsigned lds_u32 = (unsigned)(unsigned long long)lds;
    const int aoff = lds_byte(wr * 64 + fr, fq * 8), boff = lds_byte(wc * 32 + fr, fq * 8);
    const int aoff8 = lds_byte(wr * 64 + fr, (fq & 1) * 16) + (fq >> 1) * 1024, boff8 = lds_byte(wc * 32 + fr, (fq & 1) * 16) + (fq >> 1) * 1024;
#define PG8_SA(b, h) (((b) * 2 + (h)) * HTB)
#define PG8_SB(b, h) ((4 + (b) * 2 + (h)) * HTB)
#define PG8_STAGE(bufoff, gbase, voff) do { _Pragma("unroll") for (int _i = 0; _i < 2; ++_i) \
        glds16s((const void*)(gbase), (voff)[_i], lds_u32 + (unsigned)(bufoff) + ldsw + (unsigned)(_i * 8192)); } while (0)
#define PG8_LD8(p_) (*(const LAS v8i_t*)(p_))
#define PG8_LDA(dst, b, h) do { if constexpr (FP8) { _Pragma("unroll") for (int m = 0; m < 4; ++m) dst##8[m] = PG8_LD8(lds + PG8_SA(b, h) + aoff8 + m * 2048); } \
        else { _Pragma("unroll") for (int m = 0; m < 4; ++m) _Pragma("unroll") for (int k = 0; k < 2; ++k) dst[m][k] = *(const LAS bf16x8*)(lds + PG8_SA(b, h) + aoff + m * 2048 + k * 1024); } } while (0)
#define PG8_LDB(dst, b, h) do { if constexpr (FP8) { _Pragma("unroll") for (int n = 0; n < 2; ++n) dst##8[n] = PG8_LD8(lds + PG8_SB(b, h) + boff8 + n * 2048); } \
        else { _Pragma("unroll") for (int n = 0; n < 2; ++n) _Pragma("unroll") for (int k = 0; k < 2; ++k) dst[n][k] = *(const LAS bf16x8*)(lds + PG8_SB(b, h) + boff + n * 2048 + k * 1024); } } while (0)
#define PG8_MMA(ai, bj, At, Bt) do { __builtin_amdgcn_s_setprio(1); if constexpr (FP8) { _Pragma("unroll") for (int m = 0; m < 4; ++m) _Pragma("unroll") for (int n = 0; n < 2; ++n) \
            asm volatile("v_mfma_f32_16x16x128_f8f6f4 %0, %1, %2, %0" : "+v"(acc[ai][bj][m][n]) : "v"(Bt##8[n]), "v"(At##8[m])); } \
        else { _Pragma("unroll") for (int m = 0; m < 4; ++m) _Pragma("unroll") for (int n = 0; n < 2; ++n) _Pragma("unroll") for (int k = 0; k < 2; ++k) \
        acc[ai][bj][m][n] = __builtin_amdgcn_mfma_f32_16x16x32_bf16(Bt[n][k], At[m][k], acc[ai][bj][m][n], 0, 0, 0); } __builtin_amdgcn_s_setprio(0); } while (0)
#define PG8_WAIT_V(n) asm volatile("s_waitcnt vmcnt(" #n ")" ::: "memory")
#define PG8_WAIT_L(n) asm volatile("s_waitcnt lgkmcnt(" #n ")" ::: "memory")
#define PG8_BAR __builtin_amdgcn_s_barrier()
#define PG8_SCHED __builtin_amdgcn_sched_barrier(0)
    Unit cur, nxt; int ui = 0;
    if (!S.next(0, cur)) return;
    f32x4 acc[2][2][4][2];
#pragma unroll
    for (int a = 0; a < 2; ++a)
#pragma unroll
        for (int b = 0; b < 2; ++b)
#pragma unroll
            for (int m = 0; m < 4; ++m)
#pragma unroll
                for (int n = 0; n < 2; ++n) acc[a][b][m][n] = (f32x4){0.f, 0.f, 0.f, 0.f};
    bf16x8 At[4][2], B0[2][2], B1[2][2]; v8i_t At8[4], B08[2], B18[2];
    const char* cA = S.abase(g, cur); const char* cB = S.bbase(g, cur);
    PG8_STAGE(PG8_SB(0, 0), cB, voffB); PG8_STAGE(PG8_SB(0, 1), cB + hstep, voffB); PG8_STAGE(PG8_SA(0, 0), cA, voffA); PG8_STAGE(PG8_SA(0, 1), cA + hstep, voffA);
    if (wr == 1) PG8_BAR;
    PG8_WAIT_V(2); PG8_BAR;
    PG8_STAGE(PG8_SB(1, 0), cB + kstep, voffB); PG8_STAGE(PG8_SA(1, 0), cA + kstep, voffA); PG8_STAGE(PG8_SB(1, 1), cB + hstep + kstep, voffB);
    PG8_WAIT_V(6); PG8_BAR;
    for (;;) {
        const bool has_next = S.next(ui + 1, nxt);
        const char* nA = cA; const char* nB = cB;
        if (has_next) { nA = S.abase(g, nxt); nB = S.bbase(g, nxt); }
        for (int t = 0; t < nt; t += 2) {
            const bool last = (t == nt - 2);
            const char* a1 = cA + (size_t)(t + 1) * kstep;
            const char* a2 = last ? nA : cA + (size_t)(t + 2) * kstep; const char* b2 = last ? nB : cB + (size_t)(t + 2) * kstep;
            const char* a3 = a2 + kstep; const char* b3 = b2 + kstep;
            PG8_LDB(B0, 0, 0); PG8_LDB(B1, 0, 1); PG8_SCHED; PG8_LDA(At, 0, 0); PG8_STAGE(PG8_SA(1, 1), a1 + hstep, voffA);
            PG8_WAIT_V(8); PG8_WAIT_L(0); PG8_BAR; PG8_MMA(0, 0, At, B0); PG8_MMA(0, 1, At, B1); PG8_BAR; PG8_SCHED;
            PG8_LDA(At, 0, 1); PG8_STAGE(PG8_SB(0, 0), b2, voffB); PG8_STAGE(PG8_SB(0, 1), b2 + hstep, voffB); PG8_STAGE(PG8_SA(0, 0), a2, voffA);
            PG8_WAIT_V(8); PG8_WAIT_L(0); PG8_BAR; PG8_MMA(1, 0, At, B0); PG8_MMA(1, 1, At, B1); PG8_BAR; PG8_SCHED;
            PG8_LDB(B0, 1, 0); PG8_LDB(B1, 1, 1); PG8_SCHED; PG8_LDA(At, 1, 0); PG8_STAGE(PG8_SA(0, 1), a2 + hstep, voffA);
            PG8_WAIT_V(8); PG8_WAIT_L(0); PG8_BAR; PG8_MMA(0, 0, At, B0); PG8_MMA(0, 1, At, B1); PG8_BAR; PG8_SCHED;
            PG8_LDA(At, 1, 1); PG8_STAGE(PG8_SB(1, 0), b3, voffB); PG8_STAGE(PG8_SB(1, 1), b3 + hstep, voffB); PG8_STAGE(PG8_SA(1, 0), a3, voffA);
            PG8_WAIT_V(8); PG8_WAIT_L(0); PG8_BAR; PG8_MMA(1, 0, At, B0); PG8_MMA(1, 1, At, B1); PG8_BAR; PG8_SCHED;
        }
        if constexpr (ALIGN_EPI) { if (wr == 0) PG8_BAR; }
        if constexpr (FP8) asm volatile("s_nop 15\n\ts_nop 15" ::: "memory");
        E(acc, cur, wr, wc, fr, fq);
#if MK_DUP == 116
        if constexpr (FP8) { asm volatile("" ::: "memory"); E(acc, cur, wr, wc, fr, fq); }
#endif
        if (!has_next) break;
#pragma unroll
        for (int a = 0; a < 2; ++a)
#pragma unroll
            for (int b = 0; b < 2; ++b)
#pragma unroll
                for (int m = 0; m < 4; ++m)
#pragma unroll
                    for (int n = 0; n < 2; ++n) acc[a][b][m][n] = (f32x4){0.f, 0.f, 0.f, 0.f};
        cur = nxt; cA = nA; cB = nB; ++ui;
        if constexpr (ALIGN_EPI) { if (wr == 1) PG8_BAR; }
    }
    PG8_WAIT_V(0);
    if constexpr (!ALIGN_EPI) { if (wr == 0) PG8_BAR; }
    PG8_BAR;
#undef PG8_SA
#undef PG8_SB
#undef PG8_STAGE
#undef PG8_LDA
#undef PG8_LDB
#undef PG8_MMA
#undef PG8_WAIT_V
#undef PG8_WAIT_L
#undef PG8_BAR
#undef PG8_SCHED
}
}

namespace att {
constexpr int KS = 0, VS = 16384, TAB = 32768, KM = TAB + 4224 * 4, LDS_END = KM + 4096;
constexpr float C2 = 0.125f * LOG2E;
constexpr float NEG = -1e30f;
__device__ __forceinline__ int crow(int r, int hi) { return (r & 3) + 8 * (r >> 2) + 4 * hi; }
__device__ __forceinline__ int t5_bucket(int d) {
    if (d < 16) return d < 0 ? 0 : d;
    int b = 16;
    b += (d >= 22); b += (d >= 30); b += (d >= 40); b += (d >= 54); b += (d >= 73); b += (d >= 99); b += (d >= 134); b += (d >= 182);
    b += (d >= 246); b += (d >= 332); b += (d >= 450); b += (d >= 609); b += (d >= 825); b += (d >= 1117); b += (d >= 1513);
    return b;
}
__device__ __forceinline__ float swapmax(float m) { return fmaxf(m, __shfl_xor(m, 32)); }
__device__ __forceinline__ float swapsum(float m) { return m + __shfl_xor(m, 32); }
typedef short v4i16_t __attribute__((ext_vector_type(4)));
__device__ __forceinline__ s16x4 vtr(const LAS unsigned char* p) { return __builtin_bit_cast(s16x4, __builtin_amdgcn_ds_read_tr16_b64_v4i16((LAS v4i16_t*)p)); }

template <int MODE>
__device__ __forceinline__ void attn_unit(LAS unsigned char* lds, const bf16* __restrict__ qkv, int b, int h, int qt, int dil, int cls,
                                          const float* __restrict__ cum, const float* __restrict__ kmean, const float* __restrict__ relb,
                                          bf16* __restrict__ O, float* __restrict__ ml, const unsigned* __restrict__ qkn = nullptr) {
    const int tid = threadIdx.x, lane = tid & 63, r32 = lane & 31, hi = lane >> 5; const int wid = __builtin_amdgcn_readfirstlane(tid >> 6);
    int qcol, kcol, vcol;
    if (MODE == 0) { qcol = h * 64; kcol = 512 + h * 64; vcol = 1024 + h * 64; }
    else if (MODE == 1) { const int hh = h - 8; qcol = 1536 + hh * 64; kcol = 2048 + hh * 64; vcol = 2560 + hh * 64; }
    else { qcol = h * 64; kcol = 1024 + h * 64; vcol = 2048 + h * 64; }
    const bf16* base = qkv + (size_t)b * SEQ * QKVP;
    const int pw = 256 * qt + 32 * wid;
    const int myq = pw + r32;
    const int mytok = myq * dil + cls;
    bf16x8 qr[4];
    { const bf16* qrow = base + (size_t)mytok * QKVP + qcol + hi * 8;
#pragma unroll
      for (int d0 = 0; d0 < 4; ++d0) qr[d0] = *(const bf16x8*)(qrow + d0 * 16); }
    LAS float* tab = (LAS float*)(lds + TAB);
    LAS float* kml = (LAS float*)(lds + KM);
    if (MODE == 0) {
        const float* cp = cum + (size_t)(b * 8 + h) * SEQ; const int nk = 256 * (qt + 1);
        for (int s = tid; s < nk; s += 512) tab[s] = -cp[s] * LOG2E;
    } else if (MODE == 1) {
        for (int j = tid; j < 4224; j += 512) { const int rel = 4095 - j; tab[j] = rel >= 0 ? relb[t5_bucket(rel) * 16 + h] * LOG2E : 0.f; }
        const float* kp = kmean + (size_t)(b * 8 + (h - 8)) * 16 * 64;
        for (int j = tid; j < qt * 64; j += 512) kml[j] = kp[j];
    } else {
        for (int j = tid; j < 384; j += 512) { const int rel = 255 - j; tab[j] = (rel >= 0 && rel <= 128) ? relb[t5_bucket(rel * dil) * 16 + h] * LOG2E : 0.f; }
    }
    const int vrow = 16 * (wid & 3) + (lane >> 2);
    const bf16* ksrc0 = base + kcol + wid * 8;
    const bf16* vsrc0 = base + vcol + (wid >> 2) * 32 + (lane & 3) * 8;
    int tlo = (MODE == 2) ? (4 * qt - 2 > 0 ? 4 * qt - 2 : 0) : 0; const int thi = 4 * qt + 3;
    if (MODE == 0) {
        LAS int* tsl = (LAS int*)(lds + KM);
        if (tid == 0) tsl[0] = 4 * qt;
        __syncthreads();
        if (tid < 4 * qt) { const float* cp = cum + (size_t)(b * 8 + h) * SEQ;
            const float qn = __builtin_bit_cast(float, qkn[2 * (b * 8 + h)]), kn = __builtin_bit_cast(float, qkn[2 * (b * 8 + h) + 1]);
            const float bound = 2.f * qn * kn * C2 + (cp[256 * qt] - cp[64 * tid + 63]) * LOG2E;
            if (bound >= -64.f) __hip_atomic_fetch_min(&tsl[0], tid, __ATOMIC_RELAXED, __HIP_MEMORY_SCOPE_WORKGROUP); }
        __syncthreads();
        tlo = __builtin_amdgcn_readfirstlane(tsl[0]);
    }
    u32x4 kreg, vreg;
#define ATT_LOAD(t) do { const int kt_ = ((64 * (t) + lane) * dil + cls), vt_ = ((64 * (t) + vrow) * dil + cls); \
        kreg = *(const u32x4*)(ksrc0 + (size_t)kt_ * QKVP); vreg = *(const u32x4*)(vsrc0 + (size_t)vt_ * QKVP); } while (0)
#define ATT_STORE(buf) do { *(LAS u32x4*)(lds + KS + (buf) * 8192 + wid * 1024 + lane * 16) = kreg; *(LAS u32x4*)(lds + VS + (buf) * 8192 + wid * 1024 + lane * 16) = vreg; } while (0)
    ATT_LOAD(tlo); ATT_STORE(0);
    __syncthreads();
    unsigned sel = 0u;
    if (MODE == 1) {
        float v1 = -INFINITY, v2 = -INFINITY, v3 = -INFINITY; int i1 = -1, i2 = -1, i3 = -1;
        for (int n = 0; n < qt; ++n) {
            float part = 0.f;
#pragma unroll
            for (int d0 = 0; d0 < 4; ++d0) { const f32x4 ka = *(const LAS f32x4*)(kml + n * 64 + d0 * 16 + hi * 8), kb = *(const LAS f32x4*)(kml + n * 64 + d0 * 16 + hi * 8 + 4);
                part += bf2f((unsigned short)qr[d0][0]) * ka[0] + bf2f((unsigned short)qr[d0][1]) * ka[1] + bf2f((unsigned short)qr[d0][2]) * ka[2] + bf2f((unsigned short)qr[d0][3]) * ka[3];
                part += bf2f((unsigned short)qr[d0][4]) * kb[0] + bf2f((unsigned short)qr[d0][5]) * kb[1] + bf2f((unsigned short)qr[d0][6]) * kb[2] + bf2f((unsigned short)qr[d0][7]) * kb[3]; }
            const float gt = swapsum(part);
            if (gt > v1) { v3 = v2; i3 = i2; v2 = v1; i2 = i1; v1 = gt; i1 = n; }
            else if (gt > v2) { v3 = v2; i3 = i2; v2 = gt; i2 = n; }
            else if (gt > v3) { v3 = gt; i3 = n; }
        }
        if (i1 >= 0) sel |= 1u << i1; if (i2 >= 0) sel |= 1u << i2; if (i3 >= 0) sel |= 1u << i3;
    }
    float m = NEG, l = 0.f; f32x16 o0 = {}, o1 = {};
    const LAS unsigned char* vp0 = lds + VS + ((lane >> 4) & 1) * 32 + (lane & 3) * 8 + (4 * hi + ((lane & 15) >> 2)) * 64;
    int buf = 0;
    for (int t = tlo; t <= thi; ++t, buf ^= 1) {
        if (t < thi) ATT_LOAD(t + 1);
        bool active;
        if (MODE == 2) active = (64 * t + 63 >= pw - 128) && (64 * t <= pw + 31);
        else active = (64 * t <= pw + 31);
        if (MODE == 1) { if (t < 4 * qt) active = (__ballot((sel >> (t >> 2)) & 1u) != 0ull); }
        if (active) {
            const LAS unsigned char* Ks = lds + KS + buf * 8192 + hi * 1024 + r32 * 16;
            f32x16 p0 = {}, p1 = {};
#pragma unroll
            for (int d0 = 0; d0 < 4; ++d0) { const bf16x8 k0 = *(const LAS bf16x8*)(Ks + d0 * 2048), k1 = *(const LAS bf16x8*)(Ks + d0 * 2048 + 512);
                p0 = __builtin_amdgcn_mfma_f32_32x32x16_bf16(k0, qr[d0], p0, 0, 0, 0); p1 = __builtin_amdgcn_mfma_f32_32x32x16_bf16(k1, qr[d0], p1, 0, 0, 0); }
            if (MODE == 0) {
                const LAS float* cn = tab + 64 * t + 4 * hi;
#pragma unroll
                for (int a = 0; a < 4; ++a) { const f32x4 c0 = *(const LAS f32x4*)(cn + 8 * a), c1 = *(const LAS f32x4*)(cn + 32 + 8 * a);
#pragma unroll
                    for (int e = 0; e < 4; ++e) { p0[4 * a + e] = __builtin_fmaf(p0[4 * a + e], C2, c0[e]); p1[4 * a + e] = __builtin_fmaf(p1[4 * a + e], C2, c1[e]); } }
                if (t >= 4 * qt) {
#pragma unroll
                    for (int r = 0; r < 16; ++r) { const int kp = 64 * t + crow(r, hi); if (kp > myq) p0[r] = NEG; if (kp + 32 > myq) p1[r] = NEG; }
                }
            } else {
                const int relbase = myq - 64 * t - 4 * hi;
                const LAS float* tj = tab + ((MODE == 1 ? 4095 : 255) - relbase);
#pragma unroll
                for (int r = 0; r < 16; ++r) { const int cr = (r & 3) + 8 * (r >> 2);
                    p0[r] = __builtin_fmaf(p0[r], C2, tj[cr]); p1[r] = __builtin_fmaf(p1[r], C2, tj[cr + 32]); }
                if (MODE == 1) {
                    if (t < 4 * qt) { if (!((sel >> (t >> 2)) & 1u)) {
#pragma unroll
                            for (int r = 0; r < 16; ++r) { p0[r] = NEG; p1[r] = NEG; } } }
                    else {
#pragma unroll
                        for (int r = 0; r < 16; ++r) { const int cr = (r & 3) + 8 * (r >> 2); if (relbase - cr < 0) p0[r] = NEG; if (relbase - cr - 32 < 0) p1[r] = NEG; }
                    }
                } else {
#pragma unroll
                    for (int r = 0; r < 16; ++r) { const int cr = (r & 3) + 8 * (r >> 2); const int e0 = relbase - cr, e1 = e0 - 32;
                        if (e0 < 0 || e0 > 128) p0[r] = NEG; if (e1 < 0 || e1 > 128) p1[r] = NEG; }
                }
            }
            float mx = fmaxf(p0[0], p1[0]);
#pragma unroll
            for (int r = 1; r < 16; ++r) mx = fmaxf(mx, fmaxf(p0[r], p1[r]));
            mx = swapmax(mx);
            const float mn = fmaxf(m, mx), alpha = __builtin_amdgcn_exp2f(m - mn); m = mn;
            float rs = 0.f;
#pragma unroll
            for (int r = 0; r < 16; ++r) { p0[r] = __builtin_amdgcn_exp2f(p0[r] - mn); p1[r] = __builtin_amdgcn_exp2f(p1[r] - mn); rs += p0[r] + p1[r]; }
            l = l * alpha + rs;
#pragma unroll
            for (int r = 0; r < 16; ++r) { o0[r] *= alpha; o1[r] *= alpha; }
            bf16x8 pa[4];
#pragma unroll
            for (int ks = 0; ks < 4; ++ks) { u32x4 w;
#pragma unroll
                for (int e = 0; e < 4; ++e) { const int r = 8 * (ks & 1) + 2 * e; w[e] = (ks < 2) ? pg8::cvt_pk_bf16(p0[r], p0[r + 1]) : pg8::cvt_pk_bf16(p1[r], p1[r + 1]); }
                pa[ks] = __builtin_bit_cast(bf16x8, w); }
            const LAS unsigned char* vp = vp0 + buf * 8192;
#pragma unroll
            for (int ks = 0; ks < 4; ++ks) {
                const s16x4 a0 = vtr(vp + ks * 1024), a1 = vtr(vp + ks * 1024 + 512), b0 = vtr(vp + 4096 + ks * 1024), b1 = vtr(vp + 4096 + ks * 1024 + 512);
                const bf16x8 va = (bf16x8){a0[0], a0[1], a0[2], a0[3], a1[0], a1[1], a1[2], a1[3]}, vb = (bf16x8){b0[0], b0[1], b0[2], b0[3], b1[0], b1[1], b1[2], b1[3]};
                o0 = __builtin_amdgcn_mfma_f32_32x32x16_bf16(va, pa[ks], o0, 0, 0, 0);
                o1 = __builtin_amdgcn_mfma_f32_32x32x16_bf16(vb, pa[ks], o1, 0, 0, 0);
            }
        }
        if (t < thi) ATT_STORE(buf ^ 1);
        __syncthreads();
    }
#undef ATT_LOAD
#undef ATT_STORE
    const float lt = swapsum(l), inv = 1.f / lt;
    bf16* orow = O + ((size_t)b * SEQ + mytok) * DM + h * 64 + 4 * hi;
#pragma unroll
    for (int a = 0; a < 4; ++a) {
        u32x2 w0, w1; w0.x = pk2(o0[4 * a] * inv, o0[4 * a + 1] * inv); w0.y = pk2(o0[4 * a + 2] * inv, o0[4 * a + 3] * inv);
        w1.x = pk2(o1[4 * a] * inv, o1[4 * a + 1] * inv); w1.y = pk2(o1[4 * a + 2] * inv, o1[4 * a + 3] * inv);
        *(u32x2*)(orow + 8 * a) = w0; *(u32x2*)(orow + 32 + 8 * a) = w1;
    }
    if (MODE == 2) { if (hi == 0) { f32x2 v; v.x = m; v.y = lt; *(f32x2*)(ml + (((size_t)b * SEQ + mytok) * NH + h) * 2) = v; } }
}

constexpr int R_K = 0, R_V = 32768, R_TAB = 65536, R_KM = R_TAB + 4288 * 4, R_TS = R_KM + 4096, R_END = R_TS + 64;
#define ATT_WAITBAR(N) asm volatile("s_waitcnt vmcnt(" #N ") lgkmcnt(0)\n\ts_barrier" ::: "memory")
__device__ __forceinline__ bf16x8 scale_q(bf16x8 q) { bf16x8 r;
#pragma unroll
    for (int e = 0; e < 8; ++e) r[e] = (short)f2bf(bf2f((unsigned short)q[e]) * C2);
    return r; }

#define ATT_QK(Ks) do { _Pragma("unroll") for (int d0 = 0; d0 < 4; ++d0) { const bf16x8 k0_ = *(const LAS bf16x8*)((Ks) + koff[d0]), k1_ = *(const LAS bf16x8*)((Ks) + koff[d0] + 4096); \
        p0 = __builtin_amdgcn_mfma_f32_32x32x16_bf16(k0_, qr[d0], p0, 0, 0, 0); p1 = __builtin_amdgcn_mfma_f32_32x32x16_bf16(k1_, qr[d0], p1, 0, 0, 0); } } while (0)
#define ATT_SOFTMAX_PV(vp) do { \
        float mx_ = fmaxf(p0[0], p1[0]); \
        _Pragma("unroll") for (int r = 1; r < 16; ++r) mx_ = fmaxf(mx_, fmaxf(p0[r], p1[r])); \
        mx_ = swapmax(mx_); \
        const float mn_ = fmaxf(m, mx_); \
        if (__any(mn_ > m)) { const float alpha_ = __builtin_amdgcn_exp2f(m - mn_); l *= alpha_; \
            _Pragma("unroll") for (int r = 0; r < 16; ++r) { o0[r] *= alpha_; o1[r] *= alpha_; } } \
        m = mn_; float rs_ = 0.f; \
        _Pragma("unroll") for (int r = 0; r < 16; ++r) { p0[r] = __builtin_amdgcn_exp2f(p0[r] - mn_); p1[r] = __builtin_amdgcn_exp2f(p1[r] - mn_); rs_ += p0[r] + p1[r]; } \
        l += rs_; \
        bf16x8 pa_[4]; \
        _Pragma("unroll") for (int ks = 0; ks < 4; ++ks) { u32x4 w_; \
            _Pragma("unroll") for (int e = 0; e < 4; ++e) { const int r = 8 * (ks & 1) + 2 * e; w_[e] = (ks < 2) ? pg8::cvt_pk_bf16(p0[r], p0[r + 1]) : pg8::cvt_pk_bf16(p1[r], p1[r + 1]); } \
            pa_[ks] = __builtin_bit_cast(bf16x8, w_); } \
        _Pragma("unroll") for (int ks = 0; ks < 4; ++ks) { \
            const s16x4 a0_ = vtr((vp) + ks * 1024), a1_ = vtr((vp) + ks * 1024 + 512), b0_ = vtr((vp) + 4096 + ks * 1024), b1_ = vtr((vp) + 4096 + ks * 1024 + 512); \
            const bf16x8 va_ = (bf16x8){a0_[0], a0_[1], a0_[2], a0_[3], a1_[0], a1_[1], a1_[2], a1_[3]}, vb_ = (bf16x8){b0_[0], b0_[1], b0_[2], b0_[3], b1_[0], b1_[1], b1_[2], b1_[3]}; \
            o0 = __builtin_amdgcn_mfma_f32_32x32x16_bf16(va_, pa_[ks], o0, 0, 0, 0); o1 = __builtin_amdgcn_mfma_f32_32x32x16_bf16(vb_, pa_[ks], o1, 0, 0, 0); } \
    } while (0)
#define ATT_FAST_PV(vp) do { \
        _Pragma("unroll") for (int r = 0; r < 16; ++r) { p0[r] = __builtin_amdgcn_exp2f(p0[r]); p1[r] = __builtin_amdgcn_exp2f(p1[r]); } \
        bf16x8 pa_[4]; \
        _Pragma("unroll") for (int ks = 0; ks < 4; ++ks) { u32x4 w_; \
            _Pragma("unroll") for (int e = 0; e < 4; ++e) { const int r = 8 * (ks & 1) + 2 * e; w_[e] = (ks < 2) ? pg8::cvt_pk_bf16(p0[r], p0[r + 1]) : pg8::cvt_pk_bf16(p1[r], p1[r + 1]); } \
            pa_[ks] = __builtin_bit_cast(bf16x8, w_); } \
        _Pragma("unroll") for (int ks = 0; ks < 4; ++ks) { \
            const s16x4 a0_ = vtr((vp) + ks * 1024), a1_ = vtr((vp) + ks * 1024 + 512), b0_ = vtr((vp) + 4096 + ks * 1024), b1_ = vtr((vp) + 4096 + ks * 1024 + 512); \
            const bf16x8 va_ = (bf16x8){a0_[0], a0_[1], a0_[2], a0_[3], a1_[0], a1_[1], a1_[2], a1_[3]}, vb_ = (bf16x8){b0_[0], b0_[1], b0_[2], b0_[3], b1_[0], b1_[1], b1_[2], b1_[3]}; \
            o0 = __builtin_amdgcn_mfma_f32_32x32x16_bf16(va_, pa_[ks], o0, 0, 0, 0); o1 = __builtin_amdgcn_mfma_f32_32x32x16_bf16(vb_, pa_[ks], o1, 0, 0, 0); \
            o2 = __builtin_amdgcn_mfma_f32_32x32x16_bf16(ones8, pa_[ks], o2, 0, 0, 0); } \
    } while (0)
#define ATT_STORE_O(orow, inv) do { _Pragma("unroll") for (int a = 0; a < 4; ++a) { \
        u32x2 w0_, w1_; w0_.x = pg8::cvt_pk_bf16(o0[4 * a] * (inv), o0[4 * a + 1] * (inv)); w0_.y = pg8::cvt_pk_bf16(o0[4 * a + 2] * (inv), o0[4 * a + 3] * (inv)); \
        w1_.x = pg8::cvt_pk_bf16(o1[4 * a] * (inv), o1[4 * a + 1] * (inv)); w1_.y = pg8::cvt_pk_bf16(o1[4 * a + 2] * (inv), o1[4 * a + 3] * (inv)); \
        *(u32x2*)((orow) + 8 * a) = w0_; *(u32x2*)((orow) + 32 + 8 * a) = w1_; } } while (0)

template <int MODE>
__device__ __forceinline__ void attn_unit_v2(LAS unsigned char* lds, const bf16* __restrict__ qkv, int b, int h, int qt,
                                             const float* __restrict__ cum, const float* __restrict__ kmean, const float* __restrict__ relb,
                                             bf16* __restrict__ O, const unsigned* __restrict__ qkn) {
    const int tid = threadIdx.x, lane = tid & 63, r32 = lane & 31, hi = lane >> 5; const int wid = __builtin_amdgcn_readfirstlane(tid >> 6);
    const int qs = (MODE == 0) ? h : 24 + (h - 8), ks = qs + 8, vs = qs + 16;
    const bf16* qb = qkv + ((size_t)qs * NTOK + (size_t)b * SEQ) * 64; const bf16* kb = qkv + ((size_t)ks * NTOK + (size_t)b * SEQ) * 64; const bf16* vb = qkv + ((size_t)vs * NTOK + (size_t)b * SEQ) * 64;
    const int pw = 256 * qt + 32 * wid, myq = pw + r32;
    bf16x8 qr[4];
    { const bf16* qrow = qb + (size_t)myq * 64 + hi * 8;
#pragma unroll
      for (int d0 = 0; d0 < 4; ++d0) qr[d0] = *(const bf16x8*)(qrow + d0 * 16); }
    LAS float* tab = (LAS float*)(lds + R_TAB); LAS float* kml = (LAS float*)(lds + R_KM); LAS int* tsl = (LAS int*)(lds + R_TS);
    const int thi = 4 * qt + 3; int tlo = 0; float fox_b2 = 0.f;
    if (MODE == 0) {
        fox_b2 = 2.f * __builtin_bit_cast(float, qkn[2 * (b * 16 + h)]) * __builtin_bit_cast(float, qkn[2 * (b * 16 + h) + 1]);
        const float* cp = cum + (size_t)(b * 8 + h) * SEQ; const int nk = 256 * (qt + 1);
        for (int s = tid; s < nk; s += 512) tab[s] = -cp[s] * LOG2E;
        if (tid == 0) tsl[0] = 4 * qt;
        __syncthreads();
        if (tid < 4 * qt) { const float qn = __builtin_bit_cast(float, qkn[2 * (b * 16 + h)]), kn = __builtin_bit_cast(float, qkn[2 * (b * 16 + h) + 1]);
            const float bound = 2.f * qn * kn + (cp[256 * qt] - cp[64 * tid + 63]) * LOG2E;
            if (bound >= -64.f) __hip_atomic_fetch_min(&tsl[0], tid, __ATOMIC_RELAXED, __HIP_MEMORY_SCOPE_WORKGROUP); }
        __syncthreads();
        tlo = __builtin_amdgcn_readfirstlane(tsl[0]);
    } else {
        for (int j = tid; j < 4288; j += 512) { const int rel = 4095 - j; tab[j] = rel >= 0 ? relb[t5_bucket(rel) * 16 + h] * LOG2E : NEG; }
        const float* kp = kmean + (size_t)(b * 8 + (h - 8)) * 16 * 64;
        for (int j = tid; j < qt * 64; j += 512) kml[j] = kp[j];
        __syncthreads();
    }
    unsigned sel = 0u;
    if (MODE == 1) {
        float v1 = -INFINITY, v2 = -INFINITY, v3 = -INFINITY; int i1 = -1, i2 = -1, i3 = -1;
        for (int n = 0; n < qt; ++n) {
            float part = 0.f;
#pragma unroll
            for (int d0 = 0; d0 < 4; ++d0) { const f32x4 ka = *(const LAS f32x4*)(kml + n * 64 + d0 * 16 + hi * 8), kb = *(const LAS f32x4*)(kml + n * 64 + d0 * 16 + hi * 8 + 4);
                part += bf2f((unsigned short)qr[d0][0]) * ka[0] + bf2f((unsigned short)qr[d0][1]) * ka[1] + bf2f((unsigned short)qr[d0][2]) * ka[2] + bf2f((unsigned short)qr[d0][3]) * ka[3];
                part += bf2f((unsigned short)qr[d0][4]) * kb[0] + bf2f((unsigned short)qr[d0][5]) * kb[1] + bf2f((unsigned short)qr[d0][6]) * kb[2] + bf2f((unsigned short)qr[d0][7]) * kb[3]; }
            const float gt = swapsum(part);
            if (gt > v1) { v3 = v2; i3 = i2; v2 = v1; i2 = i1; v1 = gt; i1 = n; }
            else if (gt > v2) { v3 = v2; i3 = i2; v2 = gt; i2 = n; }
            else if (gt > v3) { v3 = gt; i3 = n; }
        }
        if (i1 >= 0) sel |= 1u << i1; if (i2 >= 0) sel |= 1u << i2; if (i3 >= 0) sel |= 1u << i3;
    }
    bool fast = false; f32x16 o2 = {}; bf16x8 ones8;
#pragma unroll
    for (int e = 0; e < 8; ++e) ones8[e] = (short)0x3F80;
    if (MODE == 1) fast = true;
    const int vrow = 16 * (wid & 3) + (lane >> 2);
    const int krow = 8 * wid + (lane >> 3);
    const bf16* ksrc0 = kb + (size_t)krow * 64 + (((lane & 7) ^ ((krow >> 1) & 7)) * 8);
    const bf16* vsrc0 = vb + (size_t)vrow * 64 + (wid >> 2) * 32 + (lane & 3) * 8;
    int koff[4];
#pragma unroll
    for (int d0 = 0; d0 < 4; ++d0) koff[d0] = r32 * 128 + (((2 * d0 + hi) ^ ((r32 >> 1) & 7)) << 4);
#define ATT_DMA(t) do { const unsigned so_ = (unsigned)((((t) & 3) * 8192) + wid * 1024); \
        __builtin_amdgcn_global_load_lds((const unsigned*)(ksrc0 + (size_t)(t) * 4096), (LAS unsigned*)(lds + R_K + so_), 16, 0, 0); \
        __builtin_amdgcn_global_load_lds((const unsigned*)(vsrc0 + (size_t)(t) * 4096), (LAS unsigned*)(lds + R_V + so_), 16, 0, 0); } while (0)
    const LAS unsigned char* vp0 = lds + R_V + ((lane >> 4) & 1) * 32 + (lane & 3) * 8 + (4 * hi + ((lane & 15) >> 2)) * 64;
    float m = NEG, l = 0.f; f32x16 o0 = {}, o1 = {};
#pragma unroll 1
  for (int attempt = 0; attempt < (MODE == 1 ? 2 : 1); ++attempt) {
    if (attempt == 1) { fast = false; m = NEG; l = 0.f; o0 = f32x16{}; o1 = f32x16{}; }
    asm volatile("s_waitcnt vmcnt(0)" ::: "memory");
    ATT_DMA(tlo); ATT_DMA(tlo + 1); ATT_DMA(tlo + 2);
    ATT_WAITBAR(4);
    for (int t = tlo; t <= thi; ++t) {
        if (t + 3 <= thi) ATT_DMA(t + 3);
        bool active = (64 * t <= pw + 31);
        if (MODE == 1) { if (t < 4 * qt) active = (__ballot((sel >> (t >> 2)) & 1u) != 0ull); }
        if (MODE == 0) { if (64 * t + 63 < pw) active = active && !((fox_b2 + tab[64 * t + 63] - tab[pw]) < -64.f); }
        if (active) {
            const LAS unsigned char* Ks = lds + R_K + (t & 3) * 8192;
            f32x16 p0, p1;
            if (MODE == 0) {
                const LAS float* cn = tab + 64 * t + 4 * hi;
#pragma unroll
                for (int a = 0; a < 4; ++a) { const f32x4 c0 = *(const LAS f32x4*)(cn + 8 * a), c1 = *(const LAS f32x4*)(cn + 32 + 8 * a);
#pragma unroll
                    for (int e = 0; e < 4; ++e) { p0[4 * a + e] = c0[e]; p1[4 * a + e] = c1[e]; } }
            } else {
                const int relbase = myq - 64 * t - 4 * hi;
                const LAS float* tj = tab + (4095 - relbase);
                if (t < 4 * qt) { if (!((sel >> (t >> 2)) & 1u)) tj = tab + 4224; }
#pragma unroll
                for (int r = 0; r < 16; ++r) { const int cr = (r & 3) + 8 * (r >> 2); p0[r] = tj[cr]; p1[r] = tj[cr + 32]; }
            }
            ATT_QK(Ks);
            if (MODE == 0) { if (t >= 4 * qt) {
#pragma unroll
                    for (int r = 0; r < 16; ++r) { const int kp = 64 * t + crow(r, hi); if (kp > myq) p0[r] = NEG; if (kp + 32 > myq) p1[r] = NEG; } } }
            const LAS unsigned char* vp = vp0 + (t & 3) * 8192;
            if (MODE == 1 && fast) { ATT_FAST_PV(vp); } else { ATT_SOFTMAX_PV(vp); }
        }
        if (t + 3 <= thi) ATT_WAITBAR(4); else if (t + 2 <= thi) ATT_WAITBAR(2); else ATT_WAITBAR(0);
    }
    if (MODE == 1 && attempt == 0) {
        const float l0 = o2[0]; const bool bad = __any(!(l0 > 7.9e-31f && l0 < 1.3e36f));
        if (tid == 0) tsl[1] = 0;
        __syncthreads();
        if (bad && lane == 0) tsl[1] = 1;
        __syncthreads();
        const int redo = __builtin_amdgcn_readfirstlane(tsl[1]);
        __syncthreads();
        if (!redo) break;
    }
  }
#undef ATT_DMA
    const float lt = (MODE == 1 && fast) ? o2[0] : swapsum(l), inv = 1.f / lt;
    bf16* orow = O + ((size_t)b * SEQ + myq) * DM + h * 64 + 4 * hi;
    ATT_STORE_O(orow, inv);
}

constexpr int DL_K = 0, DL_V = 49152, DL_TAB = 98304, DL_END = DL_TAB + 1536 + 128 + 2048;
__device__ __forceinline__ void dil_params(int i, int j, int& h, int& gp, int& dil, int& cls, int& qt) { const int hp = i / 3, idx = j + 32 * (i % 3), h2 = idx / 48, rem = idx % 48, x = rem & 15;
    h = 2 * hp + h2; gp = rem >> 4; dil = gp == 0 ? 1 : (gp == 1 ? 4 : 16); qt = gp == 0 ? x : (gp == 1 ? (x >> 2) : 0); cls = gp == 0 ? 0 : (gp == 1 ? (x & 3) : x); }
__device__ __forceinline__ void dilated_phase(LAS unsigned char* lds, const bf16* __restrict__ qkv, int b, int j, const float* __restrict__ relb,
                                              bf16* O0, bf16* O1, bf16* O2, float* __restrict__ ml, const unsigned* __restrict__ knw  ) {
    const int tid = threadIdx.x, lane = tid & 63, r32 = lane & 31, hi = lane >> 5; const int wid = __builtin_amdgcn_readfirstlane(tid >> 6);
    const int vrow = 16 * (wid & 3) + (lane >> 2), krow = 8 * wid + (lane >> 3);
    int koff[4];
#pragma unroll
    for (int d0 = 0; d0 < 4; ++d0) koff[d0] = r32 * 128 + (((2 * d0 + hi) ^ ((r32 >> 1) & 7)) << 4);
    LAS float* tab = (LAS float*)(lds + DL_TAB);
    LAS float* rbl = (LAS float*)(lds + DL_TAB + 1536 + 128);
    if (tid < 512) rbl[tid] = relb[tid] * LOG2E;
    __syncthreads();
    u32x4 kv[12]; bf16x8 qn[4], qn2[4];
#define DIL_PREFETCH(h_, qt_, dil_, cls_) do { const int T0_ = 4 * (qt_) - 2; \
        const bf16* ksrc0 = qkv + ((size_t)(16 + (h_)) * NTOK + (size_t)b * SEQ) * 64 + (((lane & 7) ^ ((krow >> 1) & 7)) * 8); \
        const bf16* vsrc0 = qkv + ((size_t)(32 + (h_)) * NTOK + (size_t)b * SEQ) * 64 + (wid >> 2) * 32 + (lane & 3) * 8; \
        _Pragma("unroll") for (int s_ = 0; s_ < 6; ++s_) { int kp_ = 64 * (T0_ + s_) + krow, vq_ = 64 * (T0_ + s_) + vrow; kp_ = kp_ < 0 ? 0 : kp_; vq_ = vq_ < 0 ? 0 : vq_; \
            kv[2 * s_] = *(const u32x4*)(ksrc0 + (size_t)(kp_ * (dil_) + (cls_)) * 64); kv[2 * s_ + 1] = *(const u32x4*)(vsrc0 + (size_t)(vq_ * (dil_) + (cls_)) * 64); } \
        } while (0)
#define DIL_PREFETCH_Q2(h_, qt_, dil_, cls_) do { const bf16* qrow_ = qkv + ((size_t)(h_) * NTOK + (size_t)b * SEQ) * 64 + (size_t)((256 * (qt_) + 32 * wid + r32) * (dil_) + (cls_)) * 64 + hi * 8; \
          _Pragma("unroll") for (int d0 = 0; d0 < 4; ++d0) qn2[d0] = *(const bf16x8*)(qrow_ + d0 * 16); } while (0)
#define DIL_PREFETCH_Q(h_, qt_, dil_, cls_) do { const bf16* qrow_ = qkv + ((size_t)(h_) * NTOK + (size_t)b * SEQ) * 64 + (size_t)((256 * (qt_) + 32 * wid + r32) * (dil_) + (cls_)) * 64 + hi * 8; \
          _Pragma("unroll") for (int d0 = 0; d0 < 4; ++d0) qn[d0] = *(const bf16x8*)(qrow_ + d0 * 16); } while (0)
    bf16x8 ones8;
#pragma unroll
    for (int e = 0; e < 8; ++e) ones8[e] = (short)0x3F80;
    int h, gp, dil, cls, qt;
    const LAS unsigned char* vp0 = lds + DL_V + ((lane >> 4) & 1) * 32 + (lane & 3) * 8 + (4 * hi + ((lane & 15) >> 2)) * 64;
    dil_params(0, j, h, gp, dil, cls, qt);
    DIL_PREFETCH(h, qt, dil, cls); DIL_PREFETCH_Q(h, qt, dil, cls);
    constexpr int NIT = (MK_DUP == 113) ? 48 : 24;
#pragma unroll 1
    for (int i = 0; i < NIT; ++i) {
        dil_params(i % 24, j, h, gp, dil, cls, qt);
        if (i > 0) {
#pragma unroll
            for (int d0 = 0; d0 < 4; ++d0) qn[d0] = qn2[d0]; }
#pragma unroll
        for (int s_ = 0; s_ < 6; ++s_) { *(LAS u32x4*)(lds + DL_K + s_ * 8192 + wid * 1024 + lane * 16) = kv[2 * s_]; *(LAS u32x4*)(lds + DL_V + s_ * 8192 + wid * 1024 + lane * 16) = kv[2 * s_ + 1]; }
        { for (int j = tid; j < 384; j += 512) { const int rel = 255 - j; tab[j] = (rel >= 0 && rel <= 128) ? rbl[t5_bucket(rel * dil) * 16 + h] : NEG; } }
        __syncthreads();
        if (i + 1 < NIT) { int h2_, g2_, d2, c2, q2; dil_params((i + 1) % 24, j, h2_, g2_, d2, c2, q2); DIL_PREFETCH(h2_, q2, d2, c2); DIL_PREFETCH_Q2(h2_, q2, d2, c2); }
        f32x16 o0 = {}, o1 = {}, o2 = {};
        float cshift = 0.f;
#pragma unroll 1
        for (int attempt = 0; attempt < 2; ++attempt) {
            if (attempt == 1) { float mx = NEG; o0 = f32x16{}; o1 = f32x16{}; o2 = f32x16{};
#pragma unroll
                for (int jj = 0; jj < 3; ++jj) { const int slot = (wid >> 1) + jj;
                    if (4 * qt - 2 + slot >= 0) { const int relbase = 32 * (wid & 1) + r32 + 128 - 64 * jj - 4 * hi; const LAS float* tj = tab + (255 - relbase);
                        f32x16 p0, p1;
#pragma unroll
                        for (int r = 0; r < 16; ++r) { const int cr = (r & 3) + 8 * (r >> 2); p0[r] = tj[cr]; p1[r] = tj[cr + 32]; }
                        const LAS unsigned char* Ks = lds + DL_K + slot * 8192;
                        { bf16x8 (&qr)[4] = qn; ATT_QK(Ks); }
#pragma unroll
                        for (int r = 0; r < 16; ++r) mx = fmaxf(mx, fmaxf(p0[r], p1[r])); } }
                cshift = swapmax(mx); }
#pragma unroll
            for (int jj = 0; jj < 3; ++jj) { const int slot = (wid >> 1) + jj;
                if (4 * qt - 2 + slot >= 0) { const int relbase = 32 * (wid & 1) + r32 + 128 - 64 * jj - 4 * hi; const LAS float* tj = tab + (255 - relbase);
                    f32x16 p0, p1;
                    if (attempt == 0) {
#pragma unroll
                        for (int r = 0; r < 16; ++r) { const int cr = (r & 3) + 8 * (r >> 2); p0[r] = tj[cr]; p1[r] = tj[cr + 32]; } }
                    else {
#pragma unroll
                        for (int r = 0; r < 16; ++r) { const int cr = (r & 3) + 8 * (r >> 2); p0[r] = tj[cr] - cshift; p1[r] = tj[cr + 32] - cshift; } }
                    const LAS unsigned char* Ks = lds + DL_K + slot * 8192;
                    { bf16x8 (&qr)[4] = qn; ATT_QK(Ks); }
                    const LAS unsigned char* vp = vp0 + slot * 8192;
                    ATT_FAST_PV(vp); } }
            if (attempt == 0) { const float l0 = o2[0]; if (!__any(!(l0 > 7.9e-31f && l0 < 1.3e36f))) break; }
        }
        const float m = cshift;
        const float lt = o2[0], inv = 1.f / lt;
        bf16* Op = gp == 0 ? O0 : (gp == 1 ? O1 : O2);
        const int mytok = (256 * qt + 32 * wid + r32) * dil + cls;
        bf16* orow = Op + ((size_t)b * SEQ + mytok) * DM + h * 64 + 4 * hi;
        ATT_STORE_O(orow, inv);
        if (hi == 0) { f32x2 v; v.x = m; v.y = lt; *(f32x2*)(ml + (size_t)gp * NTOK * NH * 2 + (((size_t)b * SEQ + mytok) * NH + h) * 2) = v; }
        __syncthreads();
    }
#undef DIL_PREFETCH
#undef DIL_PREFETCH_Q
}
}

#define XB_TMO      128
#define XB_XCNT(j)  (256  + 64 * (j))
#define XB_XSUB(j)  (1280 + 64 * (j))
#define XB_XGEN(j)  (2304 + 64 * (j))
#define XB_TOP      3328
#define XB_TOPGEN   3392
#define XCD_BAR_WORDS 3456
#define XB_SPIN_CAP (1u << 18)
__device__ __forceinline__ unsigned xb_ld(unsigned* p)              { return __hip_atomic_load(p, __ATOMIC_RELAXED, __HIP_MEMORY_SCOPE_AGENT); }
__device__ __forceinline__ unsigned xb_add(unsigned* p, unsigned v) { return __hip_atomic_fetch_add(p, v, __ATOMIC_RELAXED, __HIP_MEMORY_SCOPE_AGENT); }
__device__ __forceinline__ unsigned xb_xcc_id() { return (unsigned)__builtin_amdgcn_s_getreg((3 << 11) | 20) & 0xFu; }
#define XB_SPIN(cond, bar) do { unsigned _sp = 0; while (cond) { __builtin_amdgcn_s_sleep(1); \
    if ((++_sp & 255u) == 0u) { if (xb_ld(&(bar)[XB_TMO])) break; if (_sp > XB_SPIN_CAP) { atomicAdd(&(bar)[XB_TMO], 1u); break; } } } } while (0)
struct XcdBarrier { unsigned* bar; unsigned x; volatile LAS unsigned* st; };
__device__ __forceinline__ XcdBarrier xcd_barrier_post(unsigned* bar, volatile LAS unsigned* st) {
    XcdBarrier b; b.bar = bar; b.x = xb_xcc_id(); b.st = st;
    if (threadIdx.x == 0) (void)xb_add(&bar[XB_XCNT(b.x)], 1u);
    return b;
}
__device__ __forceinline__ void xcd_barrier_complete(unsigned* bar, unsigned x, unsigned& nloc, unsigned& nx) {
    const unsigned G = gridDim.x * gridDim.y * gridDim.z;
    unsigned sum, cnt, mine, sp = 0u;
    for (;;) {
        sum = 0u; cnt = 0u; mine = 0u;
#pragma unroll
        for (unsigned j = 0; j < 16; ++j) { const unsigned c = xb_ld(&bar[XB_XCNT(j)]); sum += c; cnt += (c > 0u) ? 1u : 0u; mine = (j == x) ? c : mine; }
        if (sum == G) break;
        __builtin_amdgcn_s_sleep(1);
        if ((++sp & 255u) == 0u) { if (xb_ld(&bar[XB_TMO])) break; if (sp > XB_SPIN_CAP) { atomicAdd(&bar[XB_TMO], 1u); break; } }
    }
    nloc = mine > 0u ? mine : 1u; nx = cnt > 0u ? cnt : 1u;
}
__device__ __forceinline__ void xcd_barrier(const XcdBarrier& b) {
    asm volatile("s_waitcnt vmcnt(0)" ::: "memory");
    __syncthreads();
    if (threadIdx.x == 0) {
        unsigned* bar = b.bar;
        __builtin_amdgcn_s_waitcnt(0);
        unsigned nloc = b.st[0], nx = b.st[1];
        if (nloc == 0u) { xcd_barrier_complete(bar, b.x, nloc, nx); b.st[0] = nloc; b.st[1] = nx; }
        const unsigned old = xb_add(&bar[XB_XSUB(b.x)], 1u);
        const unsigned gen = old / nloc;
        if (old + 1u == (gen + 1u) * nloc) {
            __builtin_amdgcn_fence(__ATOMIC_RELEASE, "agent");
            asm volatile("s_waitcnt vmcnt(0)" ::: "memory");
            const unsigned og = xb_add(&bar[XB_TOP], 1u);
            const unsigned tg = og / nx;
            if (og + 1u == (tg + 1u) * nx) xb_add(&bar[XB_TOPGEN], 1u);
            else XB_SPIN(xb_ld(&bar[XB_TOPGEN]) == tg, bar);
            __builtin_amdgcn_fence(__ATOMIC_ACQUIRE, "agent");
            xb_add(&bar[XB_XGEN(b.x)], 1u);
            asm volatile("s_waitcnt vmcnt(0)" ::: "memory");
        } else {
            XB_SPIN(xb_ld(&bar[XB_XGEN(b.x)]) == gen, bar);
            __builtin_amdgcn_fence(__ATOMIC_ACQUIRE, "agent");
            asm volatile("s_waitcnt vmcnt(0)" ::: "memory");
        }
    }
    __syncthreads();
}

struct Args { const float* in[18]; float* out; unsigned char* ws; int ph_lo, ph_hi; };
struct Frame {
    LAS unsigned char* lds; int tid, lane, wave, vcu, G;
    const float *x, *c, *mod_w, *mod_b, *norm_g, *w_in0, *fox_bias, *w_out0, *w_in1, *w_out1, *relb, *ffn_g, *ffn_u, *ffn_d, *router_w, *ex_g, *ex_u, *ex_d;
    float* out; unsigned char* ws;
};

template <int MODE> __device__ __forceinline__ int dest_row(int n) {
    if (MODE == 0) return n;
    if (MODE == 1) return ((n >> 7) << 8) + (n & 127);
    return n < 1536 ? n : (n >= 1544 ? n - 8 : -1);
}
template <int MODE, bool FP8 = false>
__device__ __forceinline__ void transpose_item(const float* __restrict__ W, int K, int N, bf16* __restrict__ WT, int row_off, LAS float* scr, int item, int lane) {
    const int nblk = (N + 31) / 32, kb = item / nblk, nb = item % nblk, k0 = 64 * kb, n0 = 32 * nb;
    const int nc = n0 + (lane & 31); const bool okc = nc < N;
#pragma unroll 8
    for (int i = 0; i < 32; ++i) { const int kk = 2 * i + (lane >> 5); scr[kk * 33 + (lane & 31)] = okc ? W[(size_t)(k0 + kk) * N + nc] : 0.f; }
    LDS_WAIT(); asm volatile("" ::: "memory");
    const int c = lane & 7;
#pragma unroll
    for (int j = 0; j < 4; ++j) { const int n = (lane >> 3) + 8 * j; const int dr = dest_row<MODE>(n0 + n); const LAS float* s = scr + (8 * c) * 33 + n;
        if constexpr (FP8) { u32x2 o; o.x = pk4_fp8(s[0 * 33] * FP8_SW, s[1 * 33] * FP8_SW, s[2 * 33] * FP8_SW, s[3 * 33] * FP8_SW); o.y = pk4_fp8(s[4 * 33] * FP8_SW, s[5 * 33] * FP8_SW, s[6 * 33] * FP8_SW, s[7 * 33] * FP8_SW);
            if (n0 + n < N && dr >= 0) *(u32x2*)((unsigned char*)WT + (size_t)(row_off + dr) * K + k0 + 8 * c) = o; }
        else { u32x4 o; o.x = pk2(s[0 * 33], s[1 * 33]); o.y = pk2(s[2 * 33], s[3 * 33]); o.z = pk2(s[4 * 33], s[5 * 33]); o.w = pk2(s[6 * 33], s[7 * 33]);
        if (n0 + n < N && dr >= 0) *(u32x4*)(WT + (size_t)(row_off + dr) * K + k0 + 8 * c) = o; } }
    LDS_WAIT(); asm volatile("" ::: "memory");
}

__device__ __forceinline__ void weight_copies(Frame& F) {
    LAS float* scr = (LAS float*)(F.lds + F.wave * 16384);
    const int gw = F.vcu * NWAVES + F.wave, NGW = F.G * NWAVES;
    bf16* wo = (bf16*)(F.ws + WS_WOTHER);
    constexpr int I_IN0 = 16 * 97, I_OUT = 16 * 32, I_IN1 = 16 * 96, I_FG = 16 * 88, I_FD = 44 * 32;
    constexpr int NITEMS = I_IN0 + I_OUT + I_IN1 + I_OUT + 2 * I_FG + I_FD;
    for (int it = gw; it < NITEMS; it += NGW) {
        int r = it;
        if (r < I_IN0) { transpose_item<2>(F.w_in0, DM, DIN0, wo + WO_IN0 / 2, 0, scr, r, F.lane); continue; } r -= I_IN0;
        if (r < I_OUT) { transpose_item<0>(F.w_out0, DM, DM, wo + WO_OUT0 / 2, 0, scr, r, F.lane); continue; } r -= I_OUT;
        if (r < I_IN1) { transpose_item<0>(F.w_in1, DM, 3 * DM, wo + WO_IN1 / 2, 0, scr, r, F.lane); continue; } r -= I_IN1;
        if (r < I_OUT) { transpose_item<0>(F.w_out1, DM, DM, wo + WO_OUT1 / 2, 0, scr, r, F.lane); continue; } r -= I_OUT;
        if (r < I_FG) { transpose_item<1>(F.ffn_g, DM, DFF, wo + WO_FGU / 2, 0, scr, r, F.lane); continue; } r -= I_FG;
        if (r < I_FG) { transpose_item<1>(F.ffn_u, DM, DFF, wo + WO_FGU / 2, 128, scr, r, F.lane); continue; } r -= I_FG;
        transpose_item<0, true>(F.ffn_d, DFF, DM, wo + WO_FDN / 2, 0, scr, r, F.lane);
    }
    __syncthreads();
}

__device__ __forceinline__ void phase_prologue(Frame& F) {
    if (F.vcu < 192) {
        LAS float* sc = (LAS float*)F.lds;
        LAS float* red = (LAS float*)(F.lds + 32768);
        for (int i = F.tid; i < NB * DM; i += 512) { const float v = F.c[i]; sc[i] = v / (1.f + expf(-v)); }
        __syncthreads();
        const int l = F.vcu / 96, e0 = (F.vcu % 96) * 64, col = F.lane, kq = F.wave;
        float acc[8];
#pragma unroll
        for (int b = 0; b < 8; ++b) acc[b] = 0.f;
        const float* wp = F.mod_w + ((size_t)l * DM + kq * 128) * 6144 + e0 + col;
#pragma unroll 32
        for (int k = 0; k < 128; ++k) { const float w = wp[(size_t)k * 6144];
#pragma unroll
            for (int b = 0; b < 8; ++b) acc[b] += sc[b * DM + kq * 128 + k] * w; }
#pragma unroll
        for (int b = 0; b < 8; ++b) red[(kq * 8 + b) * 64 + col] = acc[b];
        __syncthreads();
        { const int b = F.tid >> 6; float s = 0.f;
#pragma unroll
          for (int q = 0; q < 8; ++q) s += red[(q * 8 + b) * 64 + col];
          ((float*)(F.ws + WS_MODS))[((size_t)l * NB + b) * 6144 + e0 + col] = s + F.mod_b[l * 6144 + e0 + col]; }
        __syncthreads();
    }
}

__device__ __forceinline__ void expert_weight_copies(Frame& F) {
    LAS float* scr = (LAS float*)(F.lds + F.wave * 16384);
    const int gw = F.vcu * NWAVES + F.wave, NGW = F.G * NWAVES;
    constexpr int I_GU = 16 * 112, I_DN = 56 * 32, PER_E = 2 * I_GU + I_DN;
    for (int it = gw; it < NEXP * PER_E; it += NGW) {
        const int e = it / PER_E; int r = it % PER_E;
        bf16* we = (bf16*)(F.ws + WS_WEXP + (size_t)e * WEXP_STRIDE);
        if (r < I_GU) { transpose_item<1, true>(F.ex_g + (size_t)e * DM * DFE, DM, DFE, we, 0, scr, r, F.lane); continue; } r -= I_GU;
        if (r < I_GU) { transpose_item<1, true>(F.ex_u + (size_t)e * DM * DFE, DM, DFE, we, 128, scr, r, F.lane); continue; } r -= I_GU;
        transpose_item<0, true>(F.ex_d + (size_t)e * DFE * DM, DFE, DM, (bf16*)((unsigned char*)we + WEXP_DN_OFF), 0, scr, r, F.lane);
    }
}

template <bool RES, int EXTRA>
__device__ __forceinline__ void thin_phase(Frame& F, const float* hin, const bf16* y, const float* gy, const float* gatev  ,
                                           const float* gu, const float* shv, const float* scv, bf16* uout) {
    const int gw = F.vcu * NWAVES + F.wave;
    const int row0 = gw * 16, b = row0 >> 12;
    LAS float* w8 = (LAS float*)F.lds;
    LAS int* lcnt = (LAS int*)(F.lds + 32768);
    if (EXTRA == 1) { for (int i = F.tid; i < 8 * DM; i += 512) { const int k = i >> 3, j = i & 7; w8[j * DM + k] = F.w_in0[(size_t)k * DIN0 + 1536 + j]; } }
    if (EXTRA == 2) { for (int i = F.tid; i < 8 * DM; i += 512) { const int k = i >> 3, j = i & 7; w8[j * DM + k] = F.router_w[(size_t)k * NEXP + j]; }
        if (F.tid < 16) lcnt[F.tid] = 0; }
    if (EXTRA != 0) __syncthreads();
    f32x4 Gv[4], Av[4], Bv[4];
#pragma unroll
    for (int j = 0; j < 4; ++j) { const int c = 256 * j + 4 * F.lane;
        const f32x4 g = *(const f32x4*)(gu + c), s1 = *(const f32x4*)(scv + (size_t)b * 6144 + c); Av[j] = g * (s1 + 1.f); Bv[j] = *(const f32x4*)(shv + (size_t)b * 6144 + c);
        if (RES) Gv[j] = *(const f32x4*)(gatev + (size_t)b * 6144 + c) * *(const f32x4*)(gy + c); }
    for (int i = 0; i < 16; ++i) {
        const int row = row0 + i;
        f32x4 hv[4];
#pragma unroll
        for (int j = 0; j < 4; ++j) hv[j] = *(const f32x4*)(hin + (size_t)row * DM + 256 * j + 4 * F.lane);
        if (RES) {
            f32x4 yv[4]; float ss = 0.f;
#pragma unroll
            for (int j = 0; j < 4; ++j) { const u32x2 w = *(const u32x2*)(y + (size_t)row * DM + 256 * j + 4 * F.lane); yv[j] = (f32x4){bflo(w.x), bfhi(w.x), bflo(w.y), bfhi(w.y)};
#ifdef DBG_SANITIZE
                for (int e_ = 0; e_ < 4; ++e_) if (!(fabsf(yv[j][e_]) < 1e30f)) yv[j][e_] = 0.f;
#endif
                ss += (yv[j].x * yv[j].x + yv[j].y * yv[j].y) + (yv[j].z * yv[j].z + yv[j].w * yv[j].w); }
            const float rstd = 1.f / sqrtf(wave_sum(ss) * (1.f / DM) + NORM_EPS);
#pragma unroll
            for (int j = 0; j < 4; ++j) { hv[j] = hv[j] + Gv[j] * (yv[j] * rstd); *(f32x4*)(F.out + (size_t)row * DM + 256 * j + 4 * F.lane) = hv[j]; }
        }
        float s2 = 0.f;
#pragma unroll
        for (int j = 0; j < 4; ++j) s2 += (hv[j].x * hv[j].x + hv[j].y * hv[j].y) + (hv[j].z * hv[j].z + hv[j].w * hv[j].w);
        const float rs = 1.f / sqrtf(wave_sum(s2) * (1.f / DM) + NORM_EPS);
        f32x4 uv[4];
#pragma unroll
        for (int j = 0; j < 4; ++j) { uv[j] = hv[j] * rs * Av[j] + Bv[j];
            u32x2 w; w.x = pk2(uv[j].x, uv[j].y); w.y = pk2(uv[j].z, uv[j].w); *(u32x2*)(uout + (size_t)row * DM + 256 * j + 4 * F.lane) = w; }
        if (EXTRA != 0) {
            float d[8];
#pragma unroll
            for (int q = 0; q < 8; ++q) { float s = 0.f;
#pragma unroll
                for (int j = 0; j < 4; ++j) { const f32x4 w = *(const LAS f32x4*)(w8 + q * DM + 256 * j + 4 * F.lane); s += (uv[j].x * w.x + uv[j].y * w.y) + (uv[j].z * w.z + uv[j].w * w.w); }
                d[q] = wave_sum(s); }
            if (EXTRA == 1) {
                float z = d[0];
#pragma unroll
                for (int q = 1; q < 8; ++q) z = (F.lane == q) ? d[q] : z;
                if (F.lane < 8) { z += F.fox_bias[F.lane]; const float ls = fminf(z, 0.f) - log1pf(expf(-fabsf(z)));
                    ((float*)(F.ws + WS_LOGF))[((size_t)b * 8 + F.lane) * SEQ + (row & (SEQ - 1))] = ls; }
            } else {
                int i1 = 0; float v1 = d[0];
#pragma unroll
                for (int q = 1; q < 8; ++q) if (d[q] > v1) { v1 = d[q]; i1 = q; }
                int i2 = -1; float v2 = -INFINITY;
#pragma unroll
                for (int q = 0; q < 8; ++q) if (q != i1 && d[q] > v2) { v2 = d[q]; i2 = q; }
                if (i2 < 0) { i2 = (i1 + 1) & 7; v2 = v1; }
                const float p1 = 1.f / (1.f + expf(v2 - v1)), p2 = 1.f - p1;
                if (F.lane == 0) {
                    const int rl = row - F.vcu * 128;
                    const int k1 = __hip_atomic_fetch_add(&lcnt[i1], 1, __ATOMIC_RELAXED, __HIP_MEMORY_SCOPE_WORKGROUP);
                    const int k2 = __hip_atomic_fetch_add(&lcnt[i2], 1, __ATOMIC_RELAXED, __HIP_MEMORY_SCOPE_WORKGROUP);
                    lcnt[16 + rl * 2] = i1; lcnt[16 + rl * 2 + 1] = i2; lcnt[16 + 256 + rl * 2] = k1; lcnt[16 + 256 + rl * 2 + 1] = k2;
                    f32x2 pv; pv.x = p1; pv.y = p2; *(f32x2*)((float*)(F.ws + WS_TOKP) + (size_t)row * 2) = pv;
                }
            }
        }
    }
    if (EXTRA == 2) {
        __syncthreads();
        if (F.tid < 8) lcnt[8 + F.tid] = (int)__hip_atomic_fetch_add((unsigned*)(F.ws + WS_CTL) + CW_GCNT + 64 * F.tid, (unsigned)lcnt[F.tid], __ATOMIC_RELAXED, __HIP_MEMORY_SCOPE_AGENT);
        __syncthreads();
        if (F.tid < 256) { const int rl = F.tid >> 1, k = F.tid & 1, e = lcnt[16 + F.tid], rk = lcnt[16 + 256 + F.tid]; const size_t row = (size_t)F.vcu * 128 + rl;
            ((int*)(F.ws + WS_TOKE))[row * 2 + k] = e; ((int*)(F.ws + WS_TOKR))[row * 2 + k] = lcnt[8 + e] + rk; }
        __syncthreads();
    }
}

__device__ __forceinline__ void phase_cum_kmean(Frame& F) {
    if (F.vcu < 64) {
        const float* lf = (const float*)(F.ws + WS_LOGF) + (size_t)F.vcu * SEQ; float* cu = (float*)(F.ws + WS_CUM) + (size_t)F.vcu * SEQ;
        LAS float* wt = (LAS float*)F.lds;
        f32x4 a = *(const f32x4*)(lf + F.tid * 8), c = *(const f32x4*)(lf + F.tid * 8 + 4);
        float v[8] = {a.x, a.y, a.z, a.w, c.x, c.y, c.z, c.w};
#pragma unroll
        for (int i = 1; i < 8; ++i) v[i] += v[i - 1];
        float run = v[7];
#pragma unroll
        for (int o = 1; o < 64; o <<= 1) { const float t = __shfl_up(run, o); if (F.lane >= o) run += t; }
        if (F.lane == 63) wt[F.wave] = run;
        __syncthreads();
        float off = run - v[7];
        for (int w = 0; w < F.wave; ++w) off += wt[w];
        f32x4 o0 = {v[0] + off, v[1] + off, v[2] + off, v[3] + off}, o1 = {v[4] + off, v[5] + off, v[6] + off, v[7] + off};
        *(f32x4*)(cu + F.tid * 8) = o0; *(f32x4*)(cu + F.tid * 8 + 4) = o1;
        __syncthreads();
    }
    const int gw = F.vcu * NWAVES + F.wave, NGW = F.G * NWAVES;
    const bf16* qkv = (const bf16*)(F.ws + WS_RB);
    for (int it = gw; it < NB * 8 * 16; it += NGW) {
        const int blk = it & 15, hh = (it >> 4) & 7, b = it >> 7;
        const bf16* kp = qkv + ((size_t)(32 + hh) * NTOK + (size_t)b * SEQ + blk * 256) * 64 + (F.lane & 7) * 8;
        float s[8] = {0.f, 0.f, 0.f, 0.f, 0.f, 0.f, 0.f, 0.f};
#pragma unroll 8
        for (int i = 0; i < 32; ++i) { const u32x4 w = *(const u32x4*)(kp + (size_t)((F.lane >> 3) + 8 * i) * 64);
            s[0] += bflo(w.x); s[1] += bfhi(w.x); s[2] += bflo(w.y); s[3] += bfhi(w.y); s[4] += bflo(w.z); s[5] += bfhi(w.z); s[6] += bflo(w.w); s[7] += bfhi(w.w); }
#pragma unroll
        for (int q = 0; q < 8; ++q) { s[q] += __shfl_xor(s[q], 8); s[q] += __shfl_xor(s[q], 16); s[q] += __shfl_xor(s[q], 32); }
        if (F.lane < 8) { float* o = (float*)(F.ws + WS_KMEAN) + (size_t)it * 64 + F.lane * 8;
            f32x4 o0 = {s[0], s[1], s[2], s[3]}, o1 = {s[4], s[5], s[6], s[7]}; *(f32x4*)o = o0 * (1.f / 256.f); *(f32x4*)(o + 4) = o1 * (1.f / 256.f); }
    }
    for (int it = gw; it < NB * 8 * 16; it += NGW) {
        const int blk = it & 15, hx = (it >> 4) & 7, b = it >> 7; const int qs = hx;
        const bf16* qp = qkv + ((size_t)qs * NTOK + (size_t)b * SEQ + blk * 256) * 64 + (F.lane & 7) * 8;
        float mq = 0.f, mk = 0.f;
        for (int i0 = 0; i0 < 32; i0 += 8) {
            u32x4 wq[8], wk[8];
#pragma unroll
            for (int i = 0; i < 8; ++i) { wq[i] = *(const u32x4*)(qp + (size_t)((F.lane >> 3) + 8 * (i0 + i)) * 64); wk[i] = *(const u32x4*)(qp + (size_t)8 * NTOK * 64 + (size_t)((F.lane >> 3) + 8 * (i0 + i)) * 64); }
#pragma unroll
            for (int i = 0; i < 8; ++i) { float sq = 0.f, sk = 0.f;
#pragma unroll
                for (int e = 0; e < 4; ++e) { sq += bflo(wq[i][e]) * bflo(wq[i][e]) + bfhi(wq[i][e]) * bfhi(wq[i][e]); sk += bflo(wk[i][e]) * bflo(wk[i][e]) + bfhi(wk[i][e]) * bfhi(wk[i][e]); }
                sq += __shfl_xor(sq, 1); sq += __shfl_xor(sq, 2); sq += __shfl_xor(sq, 4); sk += __shfl_xor(sk, 1); sk += __shfl_xor(sk, 2); sk += __shfl_xor(sk, 4);
                mq = fmaxf(mq, sq); mk = fmaxf(mk, sk); } }
#pragma unroll
        for (int o = 8; o < 64; o <<= 1) { mq = fmaxf(mq, __shfl_xor(mq, o)); mk = fmaxf(mk, __shfl_xor(mk, o)); }
        if (F.lane == 0) { unsigned* w = (unsigned*)(F.ws + WS_CTL) + CW_QKN + 2 * (b * 16 + hx);
            __hip_atomic_fetch_max(w, __builtin_bit_cast(unsigned, sqrtf(mq)), __ATOMIC_RELAXED, __HIP_MEMORY_SCOPE_AGENT);
            __hip_atomic_fetch_max(w + 1, __builtin_bit_cast(unsigned, sqrtf(mk)), __ATOMIC_RELAXED, __HIP_MEMORY_SCOPE_AGENT); }
    }
}

__device__ __forceinline__ void phase_merge(Frame& F) {
    const int gw = F.vcu * NWAVES + F.wave;
    bf16* p0 = (bf16*)(F.ws + WS_RA); const bf16* p1 = (const bf16*)(F.ws + WS_RC); const bf16* p2 = (const bf16*)(F.ws + WS_RD);
    const float* ml = (const float*)(F.ws + WS_ML);
    for (int i = 0; i < 16; ++i) { const size_t row = (size_t)gw * 16 + i;
#pragma unroll
        for (int j = 0; j < 4; ++j) { const int head = 4 * j + (F.lane >> 4); const size_t mi = (row * NH + head) * 2;
            const f32x2 a = *(const f32x2*)(ml + mi), b = *(const f32x2*)(ml + (size_t)NTOK * NH * 2 + mi), c = *(const f32x2*)(ml + (size_t)2 * NTOK * NH * 2 + mi);
            const float M = fmaxf(a.x, fmaxf(b.x, c.x));
            float wa = a.y * __builtin_amdgcn_exp2f(a.x - M), wb = b.y * __builtin_amdgcn_exp2f(b.x - M), wc = c.y * __builtin_amdgcn_exp2f(c.x - M);
            const float inv = 1.f / (wa + wb + wc); wa *= inv; wb *= inv; wc *= inv;
            const size_t off = row * DM + 256 * j + 4 * F.lane;
            const u32x2 xa = *(const u32x2*)(p0 + off), xb = *(const u32x2*)(p1 + off), xc = *(const u32x2*)(p2 + off);
            u32x2 w; w.x = pk2(wa * bflo(xa.x) + wb * bflo(xb.x) + wc * bflo(xc.x), wa * bfhi(xa.x) + wb * bfhi(xb.x) + wc * bfhi(xc.x));
            w.y = pk2(wa * bflo(xa.y) + wb * bflo(xb.y) + wc * bflo(xc.y), wa * bfhi(xa.y) + wb * bfhi(xb.y) + wc * bfhi(xc.y));
            *(u32x2*)(p0 + off) = w; }
    }
}

__device__ __forceinline__ void phase_gather(Frame& F) {
    LAS int* so = (LAS int*)F.lds;
    if (F.tid == 0) { int acc = 0; for (int e = 0; e < 8; ++e) { so[e] = acc; const int c = (int)__hip_atomic_load((unsigned*)(F.ws + WS_CTL) + CW_GCNT + 64 * e, __ATOMIC_RELAXED, __HIP_MEMORY_SCOPE_AGENT); acc += (c + 255) & ~255; } so[8] = acc; }
    __syncthreads();
    if (F.vcu == 0) { int* te = (int*)(F.ws + WS_TILEE); const int nt = so[8] >> 8;
        for (int t = F.tid; t < MAXTILES; t += 512) { int e = 0; for (int q = 1; q < 8; ++q) if (t * 256 >= so[q]) e = q; te[t] = e; }
        if (F.tid == 0) te[MAXTILES] = nt < MAXTILES ? nt : MAXTILES; }
    const int gw = F.vcu * NWAVES + F.wave;
    const bf16* u = (const bf16*)(F.ws + WS_RA); unsigned char* us = F.ws + WS_USORT;
    const int* te = (const int*)(F.ws + WS_TOKE); const int* tr = (const int*)(F.ws + WS_TOKR); int* ts = (int*)(F.ws + WS_TOKS);
    int d_l = 0;
    if (F.lane < 32) { const int e = te[gw * 32 + F.lane] & 7; d_l = so[e] + tr[gw * 32 + F.lane]; d_l = d_l < 0 ? 0 : (d_l >= MAXTILES * 256 ? MAXTILES * 256 - 1 : d_l); ts[gw * 32 + F.lane] = d_l; }
#pragma unroll 1
    for (int i0 = 0; i0 < 16; i0 += 4) {
        u32x4 a[4], b[4];
#pragma unroll
        for (int r = 0; r < 4; ++r) { const size_t row = (size_t)gw * 16 + i0 + r; a[r] = *(const u32x4*)(u + row * DM + F.lane * 8); b[r] = *(const u32x4*)(u + row * DM + 512 + F.lane * 8); }
#pragma unroll
        for (int r = 0; r < 4; ++r) { u32x2 fa, fb;
            fa.x = pk4_fp8(bflo(a[r].x) * FP8_SU, bfhi(a[r].x) * FP8_SU, bflo(a[r].y) * FP8_SU, bfhi(a[r].y) * FP8_SU); fa.y = pk4_fp8(bflo(a[r].z) * FP8_SU, bfhi(a[r].z) * FP8_SU, bflo(a[r].w) * FP8_SU, bfhi(a[r].w) * FP8_SU);
            fb.x = pk4_fp8(bflo(b[r].x) * FP8_SU, bfhi(b[r].x) * FP8_SU, bflo(b[r].y) * FP8_SU, bfhi(b[r].y) * FP8_SU); fb.y = pk4_fp8(bflo(b[r].z) * FP8_SU, bfhi(b[r].z) * FP8_SU, bflo(b[r].w) * FP8_SU, bfhi(b[r].w) * FP8_SU);
#pragma unroll
            for (int k = 0; k < 2; ++k) { const int dst = __builtin_amdgcn_readlane(d_l, 2 * (i0 + r) + k);
                *(u32x2*)(us + (size_t)dst * DM + F.lane * 8) = fa; *(u32x2*)(us + (size_t)dst * DM + 512 + F.lane * 8) = fb; } }
    }
}

__device__ __forceinline__ void phase_final(Frame& F, const float* __restrict__ gy, const float* __restrict__ gatev) {
    const int gw = F.vcu * NWAVES + F.wave; const int row0 = gw * 16, b = row0 >> 12;
    const bf16* ys = (const bf16*)(F.ws + WS_YSLOT); const int* ts = (const int*)(F.ws + WS_TOKS); const float* tp = (const float*)(F.ws + WS_TOKP);
    f32x4 Gv[4];
#pragma unroll
    for (int j = 0; j < 4; ++j) { const int c = 256 * j + 4 * F.lane; Gv[j] = *(const f32x4*)(gatev + (size_t)b * 6144 + c) * *(const f32x4*)(gy + c); }
    for (int i = 0; i < 16; ++i) { const size_t row = (size_t)row0 + i;
        int s1 = ts[row * 2], s2 = ts[row * 2 + 1]; const float p1 = tp[row * 2], p2 = tp[row * 2 + 1];
        s1 = s1 < 0 ? 0 : (s1 >= MAXTILES * 256 ? MAXTILES * 256 - 1 : s1); s2 = s2 < 0 ? 0 : (s2 >= MAXTILES * 256 ? MAXTILES * 256 - 1 : s2);
        f32x4 yv[4]; float ss = 0.f;
#pragma unroll
        for (int j = 0; j < 4; ++j) { const u32x2 wa = *(const u32x2*)(ys + (size_t)s1 * DM + 256 * j + 4 * F.lane), wb = *(const u32x2*)(ys + (size_t)s2 * DM + 256 * j + 4 * F.lane);
            yv[j] = (f32x4){p1 * bflo(wa.x) + p2 * bflo(wb.x), p1 * bfhi(wa.x) + p2 * bfhi(wb.x), p1 * bflo(wa.y) + p2 * bflo(wb.y), p1 * bfhi(wa.y) + p2 * bfhi(wb.y)};
            ss += (yv[j].x * yv[j].x + yv[j].y * yv[j].y) + (yv[j].z * yv[j].z + yv[j].w * yv[j].w); }
        const float rstd = 1.f / sqrtf(wave_sum(ss) * (1.f / DM) + NORM_EPS);
#pragma unroll
        for (int j = 0; j < 4; ++j) { float* op = F.out + row * DM + 256 * j + 4 * F.lane; const f32x4 hv = *(const f32x4*)op; *(f32x4*)op = hv + Gv[j] * (yv[j] * rstd); }
    }
}

constexpr int NPHASES = 21;
__global__ void __launch_bounds__(NWAVES * 64, 2) trunk_fwd(Args args) {
    extern __shared__ __attribute__((aligned(16))) unsigned char lds_raw[];
    Frame F;
    F.lds = (LAS unsigned char*)lds_raw;
    volatile LAS unsigned* MISC = (volatile LAS unsigned*)(F.lds + MISC_OFF);
    F.tid = threadIdx.x; F.lane = F.tid & 63; F.wave = __builtin_amdgcn_readfirstlane(F.tid >> 6);
    F.G = gridDim.x; { const int bx = blockIdx.x; F.vcu = (F.G % 8 == 0) ? (bx % 8) * (F.G / 8) + bx / 8 : bx; }
    F.x = args.in[0]; F.c = args.in[1]; F.mod_w = args.in[2]; F.mod_b = args.in[3]; F.norm_g = args.in[4]; F.w_in0 = args.in[5]; F.fox_bias = args.in[6]; F.w_out0 = args.in[7];
    F.w_in1 = args.in[8]; F.w_out1 = args.in[9]; F.relb = args.in[10]; F.ffn_g = args.in[11]; F.ffn_u = args.in[12]; F.ffn_d = args.in[13]; F.router_w = args.in[14];
    F.ex_g = args.in[15]; F.ex_u = args.in[16]; F.ex_d = args.in[17]; F.out = args.out; F.ws = args.ws;
    for (int u = F.tid; u < (LDS_BYTES - RING_BYTES) / 4; u += NWAVES * 64) ((LAS unsigned*)(F.lds + RING_BYTES))[u] = 0u;
    __syncthreads();
    const int lo = args.ph_lo, hi = args.ph_hi;
    XcdBarrier bar; bar.bar = (unsigned*)(F.ws + WS_CTL) + CW_BAR; bar.x = 0; bar.st = nullptr;
    if (hi - lo > 1) bar = xcd_barrier_post((unsigned*)(F.ws + WS_CTL) + CW_BAR, MISC + 8);
#define IN(k) (lo <= (k) && (k) < hi)
#define SEAM(k) do { if (IN(k) && IN((k) + 1)) xcd_barrier(bar); } while (0)
    const float* mods = (const float*)(F.ws + WS_MODS);
    const float* mods0 = mods, * mods1 = mods + (size_t)NB * 6144;
    const float* ng0 = F.norm_g, * ng1 = F.norm_g + 4 * DM;
    bf16* RA = (bf16*)(F.ws + WS_RA); bf16* RB = (bf16*)(F.ws + WS_RB); bf16* RC = (bf16*)(F.ws + WS_RC); bf16* RD = (bf16*)(F.ws + WS_RD);
    const bf16* wo = (const bf16*)(F.ws + WS_WOTHER);

    if (IN(0)) { phase_prologue(F); } SEAM(0);
    if (IN(1)) { thin_phase<false, 1>(F, F.x, nullptr, nullptr, nullptr, ng0, mods0 + 0, mods0 + 1024, RA); __syncthreads(); weight_copies(F); } SEAM(1);
    if (IN(2)) { pg8::Gemm g{RA, wo + WO_IN0 / 2, NTOK, 3072, DM}; pg8::StaticOrder S; S.init(NTOK, 3072, F.G, (int)blockIdx.x); pg8::EpiHeadMajor E{RB, NTOK, 0xFFull | (0xFFull << 24), att::C2};
        pg8::gemm_phase<pg8::EpiHeadMajor, pg8::StaticOrder>(F.lds, g, S, E); } SEAM(2);
    if (IN(3)) { phase_cum_kmean(F); } SEAM(3);
    if (IN(4)) {
        const int b = F.vcu >> 5, j = F.vcu & 31, a = j & 15;
        const float* cum = (const float*)(F.ws + WS_CUM); const float* km = (const float*)(F.ws + WS_KMEAN); const unsigned* qkn = (const unsigned*)(F.ws + WS_CTL) + CW_QKN;
        for (int r = 0; r < (MK_DUP == 41 ? 8 : 4); ++r) { const int r4 = r & 3; const int a8 = (a + 8) & 15; const int qt = (r4 == 0) ? a : (r4 == 1) ? 15 - a : (r4 == 2) ? a8 : 15 - a8;
            att::attn_unit_v2<1>(F.lds, RB, b, 8 + 2 * r4 + (j >> 4), qt, nullptr, km, F.relb, RA, qkn); }
        { const int hf = j >> 2, qq = j & 3;
          for (int i = 0; i < (MK_DUP == 40 ? 8 : 4); ++i) { const int i4 = i & 3; const int qt = (i4 == 0) ? 15 - qq : (i4 == 1) ? 8 + qq : (i4 == 2) ? 7 - qq : qq;
            att::attn_unit_v2<0>(F.lds, RB, b, hf, qt, cum, nullptr, nullptr, RA, qkn); } }
    } SEAM(4);
    if (IN(5)) { pg8::Gemm g{RA, wo + WO_OUT0 / 2, NTOK, DM, DM}; pg8::StaticOrder S; S.init(NTOK, DM, F.G, (int)blockIdx.x); pg8::EpiBf16 E{RC, DM};
        pg8::gemm_phase<pg8::EpiBf16, pg8::StaticOrder>(F.lds, g, S, E); } SEAM(5);
    if (IN(6)) { thin_phase<true, 0>(F, F.x, RC, ng0 + 1 * DM, mods0 + 2048, ng0 + 2 * DM, mods0 + 3072, mods0 + 4096, RA);
#if MK_DUP == 6
        xcd_barrier(bar); thin_phase<true, 0>(F, F.x, RC, ng0 + 1 * DM, mods0 + 2048, ng0 + 2 * DM, mods0 + 3072, mods0 + 4096, RA);
#endif
    } SEAM(6);
    if (IN(7)) { { pg8::Gemm g{RA, wo + WO_FGU / 2, NTOK, 2 * DFF, DM}; pg8::StaticOrder S; S.init(NTOK, 2 * DFF, F.G, (int)blockIdx.x); pg8::EpiSwigluFp8 E{(unsigned char*)RB, DFF, 1.f, FP8_SH};
        pg8::gemm_phase<pg8::EpiSwigluFp8, pg8::StaticOrder>(F.lds, g, S, E); }
#if MK_DUP == 7
        xcd_barrier(bar); { pg8::Gemm g{RA, wo + WO_FGU / 2, NTOK, 2 * DFF, DM}; pg8::StaticOrder S; S.init(NTOK, 2 * DFF, F.G, (int)blockIdx.x); pg8::EpiSwigluFp8 E{(unsigned char*)RB, DFF, 1.f, FP8_SH};
        pg8::gemm_phase<pg8::EpiSwigluFp8, pg8::StaticOrder>(F.lds, g, S, E); }
#endif
    } SEAM(7);
    if (IN(8)) { pg8::Gemm g{RB, wo + WO_FDN / 2, NTOK, DM, DFF / 2}; pg8::StaticOrder S; S.init(NTOK, DM, F.G, (int)blockIdx.x); pg8::EpiBf16Scaled E{RC, DM, 1.f / (FP8_SH * FP8_SW)};
        pg8::gemm_phase<pg8::EpiBf16Scaled, pg8::StaticOrder, true, true, DFF / 2>(F.lds, g, S, E); } SEAM(8);
    if (IN(9)) { thin_phase<true, 0>(F, F.out, RC, ng0 + 3 * DM, mods0 + 5120, ng1 + 0, mods1 + 0, mods1 + 1024, RA); } SEAM(9);
    if (IN(10)) { pg8::Gemm g{RA, wo + WO_IN1 / 2, NTOK, 3072, DM}; pg8::StaticOrder S; S.init(NTOK, 3072, F.G, (int)blockIdx.x); pg8::EpiHeadMajor E{RB, NTOK, 0xFFFFull, att::C2};
        pg8::gemm_phase<pg8::EpiHeadMajor, pg8::StaticOrder>(F.lds, g, S, E); } SEAM(10);
    if (IN(11)) {
        float* ml = (float*)(F.ws + WS_ML);
        att::dilated_phase(F.lds, RB, F.vcu >> 5, F.vcu & 31, F.relb, RA, RC, RD, ml, (const unsigned*)(F.ws + WS_CTL) + CW_KN1);
    } SEAM(11);
    if (IN(12)) { phase_merge(F); } SEAM(12);
    if (IN(13)) { pg8::Gemm g{RA, wo + WO_OUT1 / 2, NTOK, DM, DM}; pg8::StaticOrder S; S.init(NTOK, DM, F.G, (int)blockIdx.x); pg8::EpiBf16 E{RC, DM};
        pg8::gemm_phase<pg8::EpiBf16, pg8::StaticOrder>(F.lds, g, S, E); } SEAM(13);
    if (IN(14)) { thin_phase<true, 2>(F, F.out, RC, ng1 + 1 * DM, mods1 + 2048, ng1 + 2 * DM, mods1 + 3072, mods1 + 4096, RA); expert_weight_copies(F); } SEAM(14);
    if (IN(15)) { phase_gather(F); } SEAM(15);
    { int t_ = F.tid; asm volatile("" : "+v"(t_)); F.tid = t_; F.lane = t_ & 63; }
    {
        const int* te = (const int*)(F.ws + WS_TILEE);
        const unsigned char* us = F.ws + WS_USORT; unsigned char* hid = F.ws + WS_HID; bf16* ysl = (bf16*)(F.ws + WS_YSLOT);
        const unsigned char* wexp = F.ws + WS_WEXP;
        if (IN(16) || IN(17)) {
            int n = __builtin_amdgcn_readfirstlane(te[MAXTILES]); if (n > MAXTILES) n = MAXTILES;
            if (IN(16) && n > 0) { pg8::Gemm g{(const bf16*)us, (const bf16*)wexp, n * 256, 2 * DFE, DM / 2}; pg8::MoeOrder S; S.so.init(n * 256, 2 * DFE, F.G, (int)blockIdx.x); S.tile_e = te; S.estride = WEXP_STRIDE;
                pg8::EpiSwigluFp8 E{hid, DFE, 1.f / (FP8_SU * FP8_SW), FP8_SH}; pg8::gemm_phase<pg8::EpiSwigluFp8, pg8::MoeOrder, true, true, DM / 2>(F.lds, g, S, E); }
            SEAM(16);
            if (IN(17) && n > 0) { pg8::Gemm g{(const bf16*)hid, (const bf16*)(wexp + WEXP_DN_OFF), n * 256, DM, DFE / 2}; pg8::MoeOrder S; S.so.init(n * 256, DM, F.G, (int)blockIdx.x); S.tile_e = te; S.estride = WEXP_STRIDE;
                pg8::EpiBf16Scaled E{ysl, DM, 1.f / (FP8_SH * FP8_SW)}; pg8::gemm_phase<pg8::EpiBf16Scaled, pg8::MoeOrder, true, true, DFE / 2>(F.lds, g, S, E); }
            SEAM(17);
        }
    }
    { int t_ = F.tid; asm volatile("" : "+v"(t_)); F.tid = t_; F.lane = t_ & 63; }
    if (IN(20)) { phase_final(F, ng1 + 3 * DM, mods1 + 5120); }
#undef IN
#undef SEAM
}

extern "C" void kernel_launch(void* const* d_in, const int* in_sizes, int n_in, void* d_out, int out_size, void* d_ws, size_t ws_size, hipStream_t stream) {
    static int grid = 0;
    if (grid == 0) {
        if (n_in != 18 || in_sizes[0] != NTOK * DM || out_size != NTOK * DM || ws_size < WS_END) { fprintf(stderr, "kernel_launch: unexpected shapes / workspace (%d inputs, ws %zu, need %zu); nothing launched\n", n_in, ws_size, (size_t)WS_END); grid = -1; return; }
        int dev = 0, cus = 0, per_cu = 0;
        if (hipGetDevice(&dev) != hipSuccess || hipDeviceGetAttribute(&cus, hipDeviceAttributeMultiprocessorCount, dev) != hipSuccess) { grid = -1; return; }
        if (hipFuncSetAttribute((const void*)trunk_fwd, hipFuncAttributeMaxDynamicSharedMemorySize, LDS_BYTES) != hipSuccess) { fprintf(stderr, "kernel_launch: hipFuncSetAttribute failed\n"); grid = -1; return; }
        if (hipOccupancyMaxActiveBlocksPerMultiprocessor(&per_cu, (const void*)trunk_fwd, NWAVES * 64, LDS_BYTES) != hipSuccess || per_cu < 1) { fprintf(stderr, "kernel_launch: occupancy query reports %d\n", per_cu); }
        (void)hipGetLastError();
        grid = cus;
        if (grid != 256) { fprintf(stderr, "kernel_launch: built for 256 CUs, found %d; nothing launched\n", grid); grid = -1; return; }
    }
    if (grid < 0) return;
    if (hipMemsetAsync((char*)d_ws + WS_CTL, 0, CTL_ZERO_BYTES, stream) != hipSuccess) return;
    Args a{};
    for (int i = 0; i < 18; ++i) a.in[i] = (const float*)d_in[i];
    a.out = (float*)d_out; a.ws = (unsigned char*)d_ws;
#if MK_ONE_LAUNCH
    a.ph_lo = 0; a.ph_hi = MK_LAST_PHASE;
    hipLaunchKernelGGL(trunk_fwd, dim3(grid), dim3(NWAVES * 64), LDS_BYTES, stream, a);
#else
    for (int p = 0; p < MK_LAST_PHASE; ++p) { a.ph_lo = p; a.ph_hi = p + 1; hipLaunchKernelGGL(trunk_fwd, dim3(grid), dim3(NWAVES * 64), LDS_BYTES, stream, a); }
#endif
}
```

```cpp
#include <hip/hip_runtime.h>
#include <cstdio>
#include <cstdint>

#ifndef MK_ONE_LAUNCH
#define MK_ONE_LAUNCH 1
#endif
#ifndef MK_DUP
#define MK_DUP 0
#endif
#ifndef MK_LAST_PHASE
#define MK_LAST_PHASE 21
#endif

#define GAS __attribute__((address_space(1)))
#define LAS __attribute__((address_space(3)))
typedef unsigned short bf16;
typedef unsigned u32x4 __attribute__((ext_vector_type(4)));
typedef unsigned u32x2 __attribute__((ext_vector_type(2)));
typedef float f32x4 __attribute__((ext_vector_type(4)));
typedef float f32x2 __attribute__((ext_vector_type(2)));
typedef float f32x16 __attribute__((ext_vector_type(16)));
typedef short bf16x8 __attribute__((ext_vector_type(8)));
typedef short s16x4 __attribute__((ext_vector_type(4)));
typedef GAS unsigned gu32;

constexpr int NB = 8, SEQ = 4096, DM = 1024, NTOK = NB * SEQ, NH = 16, HD = 64;
constexpr int DFF = 2816, NEXP = 8, DFE = 3584;
constexpr int QKVP = 3072;
constexpr int DIN0 = 3080;
constexpr float NORM_EPS = 1e-6f;
constexpr float LOG2E = 1.4426950408889634f;
constexpr int NWAVES = 8;
constexpr int MAXTILES = 264;
constexpr int PASS0_TILES = 128, PASS1_MAXTILES = MAXTILES - PASS0_TILES;

constexpr size_t MiB = 1u << 20;
constexpr size_t WS_CTL = 0, CTL_ZERO_BYTES = 1 * MiB;
constexpr size_t WS_MODS = 1 * MiB;
constexpr size_t WS_LOGF = 2 * MiB;
constexpr size_t WS_CUM = 3 * MiB;
constexpr size_t WS_KMEAN = 4 * MiB;
constexpr size_t WS_TOKE = 5 * MiB;
constexpr size_t WS_TOKP = WS_TOKE + 256 * 1024;
constexpr size_t WS_TOKR = WS_TOKP + 256 * 1024;
constexpr size_t WS_TOKS = WS_TOKR + 256 * 1024;
constexpr size_t WS_TILEE = 6 * MiB;
constexpr size_t WS_ML = 8 * MiB;
constexpr size_t WS_RA = 24 * MiB;
constexpr size_t WS_RC = 88 * MiB;
constexpr size_t WS_WOTHER = 152 * MiB;
constexpr size_t WS_RB = 185 * MiB;
constexpr size_t WS_RD = 377 * MiB;
constexpr size_t WS_HID = 24 * MiB;
constexpr size_t WS_USORT = 262 * MiB;
constexpr size_t WS_YSLOT = 328 * MiB;
constexpr size_t WS_WEXP = 460 * MiB;
constexpr size_t WS_END = 544 * MiB;
constexpr size_t WEXP_STRIDE = 10 * MiB + 512 * 1024, WEXP_DN_OFF = 7 * MiB;
constexpr float FP8_SW = 64.f, FP8_SU = 4.f, FP8_SH = 8.f;
constexpr size_t WO_IN0 = 0, WO_OUT0 = 6 * MiB, WO_IN1 = 8 * MiB, WO_OUT1 = 14 * MiB, WO_FGU = 16 * MiB, WO_FDN = 27 * MiB;
static_assert(WS_RB + (size_t)NTOK * QKVP * 2 <= WS_RD && WS_HID + (size_t)MAXTILES * 256 * DFE <= WS_USORT && WS_USORT + (size_t)MAXTILES * 256 * DM <= WS_YSLOT && WS_YSLOT + (size_t)MAXTILES * 256 * DM * 2 <= WS_WEXP && WS_WEXP + 8 * WEXP_STRIDE <= WS_END, "d_ws map");
constexpr int CW_GCNT = 1024;
constexpr int CW_QKN = 2048;
constexpr int CW_KN1 = 3072;
constexpr int CW_BAR = 4096;

constexpr int RING_BYTES = 131072;
constexpr int MISC_OFF = RING_BYTES + 320;
constexpr int LDS_BYTES = 147456;

__device__ __forceinline__ unsigned f2bf(float f) { unsigned u = __builtin_bit_cast(unsigned, f); return (u + 0x7fffu + ((u >> 16) & 1u)) >> 16; }
__device__ __forceinline__ unsigned pk2(float lo, float hi) { return f2bf(lo) | (f2bf(hi) << 16); }
__device__ __forceinline__ float bf2f(unsigned short b) { return __builtin_bit_cast(float, (unsigned)b << 16); }
__device__ __forceinline__ float bflo(unsigned w) { return __builtin_bit_cast(float, w << 16); }
__device__ __forceinline__ float bfhi(unsigned w) { return __builtin_bit_cast(float, w & 0xffff0000u); }
__device__ __forceinline__ float wave_sum(float v) {
#pragma unroll
    for (int o = 1; o < 64; o <<= 1) v += __shfl_xor(v, o);
    return v;
}
__device__ __forceinline__ unsigned pk4_fp8(float a, float b, float c, float d) { unsigned w = __builtin_amdgcn_cvt_pk_fp8_f32(a, b, 0u, false); return __builtin_amdgcn_cvt_pk_fp8_f32(c, d, w, true); }
__device__ __forceinline__ float clamp448(float v) { return __builtin_amdgcn_fmed3f(v, -448.f, 448.f); }
#define LDS_WAIT() asm volatile("s_waitcnt lgkmcnt(0)" ::: "memory")
#define VM_WAIT() asm volatile("s_waitcnt vmcnt(0)" ::: "memory")

namespace pg8 {
typedef unsigned short bf16_t;
typedef int v8i_t __attribute__((ext_vector_type(8)));
constexpr int BM = 256, BK = 64, HALF = 128, HTB = HALF * BK * 2, STAGE_BYTES = 8 * HTB, NXCD = 8, WGM = 8;
__host__ __device__ __forceinline__ int lds_byte(int r, int c) { const int st = (r >> 4) * 2 + (c >> 5), rr = r & 15, cc = c & 31, ob = rr * 64 + cc * 2; return st * 1024 + (ob ^ (((ob >> 9) & 1) << 5)); }
__host__ __device__ __forceinline__ void stage_rc(int b, int& R, int& C) { const int st = b / 1024, sb = b % 1024, swz = sb ^ (((sb >> 9) & 1) << 5); R = (st >> 1) * 16 + swz / 64; C = (st & 1) * 32 + (swz % 64) / 2; }
__host__ __device__ __forceinline__ int perm32(int rho) { const int n = rho >> 4, i = rho & 15; return 8 * (i >> 2) + 4 * n + (i & 3); }

struct Unit { int pm, pn; };
struct Gemm { const bf16_t* A; const bf16_t* Bt; int M, N, K; };

struct StaticOrder {
    int nM, nN, nwg, G, c;
    __device__ void init(int M, int N, int G_, int c_) { nM = M / BM; nN = N / BM; nwg = nM * nN; G = G_; c = c_; }
    __device__ bool next(int i, Unit& u) const {
        const long L = (long)i * G + c; if (L >= nwg) return false;
        int wgid = (int)L; { const int q = nwg / NXCD, r = nwg % NXCD, xcd = wgid % NXCD, off = wgid / NXCD; wgid = (xcd < r ? xcd * (q + 1) : r * (q + 1) + (xcd - r) * q) + off; }
        const int nig = WGM * nN, gid = wgid / nig, fm = gid * WGM, gsz = (nM - fm) < WGM ? (nM - fm) : WGM;
        u.pm = fm + ((wgid % nig) % gsz); u.pn = (wgid % nig) / gsz; return true;
    }
    __device__ __forceinline__ const char* abase(const Gemm& g, const Unit& u) const { return (const char*)g.A + (size_t)u.pm * ((size_t)BM * g.K * 2); }
    __device__ __forceinline__ const char* bbase(const Gemm& g, const Unit& u) const { return (const char*)g.Bt + (size_t)u.pn * ((size_t)BM * g.K * 2); }
};
struct MoeOrder {
    StaticOrder so; const int* tile_e; size_t estride;
    __device__ bool next(int i, Unit& u) const { return so.next(i, u); }
    __device__ __forceinline__ const char* abase(const Gemm& g, const Unit& u) const { return (const char*)g.A + (size_t)u.pm * ((size_t)BM * g.K * 2); }
    __device__ __forceinline__ const char* bbase(const Gemm& g, const Unit& u) const { const int e = __builtin_amdgcn_readfirstlane(tile_e[u.pm]); return (const char*)g.Bt + (size_t)e * estride + (size_t)u.pn * ((size_t)BM * g.K * 2); }
};

typedef float f32x2_t __attribute__((ext_vector_type(2))); typedef __bf16 bf16x2_t __attribute__((ext_vector_type(2)));
__device__ __forceinline__ unsigned cvt_pk_bf16(float lo, float hi) { f32x2_t v = {lo, hi}; bf16x2_t b = __builtin_convertvector(v, bf16x2_t); return __builtin_bit_cast(unsigned, b); }

struct EpiBf16 {
    static constexpr bool PERM = true;
    bf16_t* O; int ldc;
    __device__ __forceinline__ void operator()(const f32x4 (&acc)[2][2][4][2], const Unit& u, int wr, int wc, int fr, int fq) const {
        const int row0 = u.pm * BM + wr * 64 + fr; const int col0 = u.pn * BM + wc * 32 + 8 * fq;
#pragma unroll
        for (int ai = 0; ai < 2; ++ai)
#pragma unroll
            for (int m = 0; m < 4; ++m) { bf16_t* rowp = O + (size_t)(row0 + ai * HALF + m * 16) * ldc + col0;
#pragma unroll
                for (int bj = 0; bj < 2; ++bj) { const f32x4 v0 = acc[ai][bj][m][0], v1 = acc[ai][bj][m][1];
                    u32x4 w; w.x = cvt_pk_bf16(v0[0], v0[1]); w.y = cvt_pk_bf16(v0[2], v0[3]); w.z = cvt_pk_bf16(v1[0], v1[1]); w.w = cvt_pk_bf16(v1[2], v1[3]);
                    *(u32x4*)(rowp + bj * HALF) = w; } }
    }
};
struct EpiHeadMajor {
    static constexpr bool PERM = true;
    bf16_t* O; int M; unsigned long long qmask; float qscale;
    __device__ __forceinline__ void operator()(const f32x4 (&acc)[2][2][4][2], const Unit& u, int wr, int wc, int fr, int fq) const {
        const int row0 = u.pm * BM + wr * 64 + fr; const int col0 = u.pn * BM + wc * 32 + 8 * fq;
#pragma unroll
        for (int ai = 0; ai < 2; ++ai)
#pragma unroll
            for (int m = 0; m < 4; ++m) { const int row = row0 + ai * HALF + m * 16;
#pragma unroll
                for (int bj = 0; bj < 2; ++bj) { const int col = col0 + bj * HALF; const float sc = ((qmask >> (col >> 6)) & 1ull) ? qscale : 1.f; const f32x4 v0 = acc[ai][bj][m][0] * sc, v1 = acc[ai][bj][m][1] * sc;
                    u32x4 w; w.x = cvt_pk_bf16(v0[0], v0[1]); w.y = cvt_pk_bf16(v0[2], v0[3]); w.z = cvt_pk_bf16(v1[0], v1[1]); w.w = cvt_pk_bf16(v1[2], v1[3]);
                    *(u32x4*)(O + ((size_t)(col >> 6) * M + row) * 64 + (col & 63)) = w; } }
    }
};
__device__ __forceinline__ float silu_mul(float g, float u) { return g * u * __builtin_amdgcn_rcpf(1.f + __builtin_amdgcn_exp2f(-g * LOG2E)); }
struct EpiBf16Scaled {
    static constexpr bool PERM = true;
    bf16_t* O; int ldc; float scale;
    __device__ __forceinline__ void operator()(const f32x4 (&acc)[2][2][4][2], const Unit& u, int wr, int wc, int fr, int fq) const {
        const int row0 = u.pm * BM + wr * 64 + fr; const int col0 = u.pn * BM + wc * 32 + 8 * fq;
#pragma unroll
        for (int ai = 0; ai < 2; ++ai)
#pragma unroll
            for (int m = 0; m < 4; ++m) { bf16_t* rowp = O + (size_t)(row0 + ai * HALF + m * 16) * ldc + col0;
#pragma unroll
                for (int bj = 0; bj < 2; ++bj) { const f32x4 v0 = acc[ai][bj][m][0] * scale, v1 = acc[ai][bj][m][1] * scale;
                    u32x4 w; w.x = cvt_pk_bf16(v0[0], v0[1]); w.y = cvt_pk_bf16(v0[2], v0[3]); w.z = cvt_pk_bf16(v1[0], v1[1]); w.w = cvt_pk_bf16(v1[2], v1[3]);
                    *(u32x4*)(rowp + bj * HALF) = w; } }
    }
};
struct EpiSwigluFp8 {
    static constexpr bool PERM = true;
    unsigned char* O; int ldc; float sin, sout;
    __device__ __forceinline__ void operator()(const f32x4 (&acc)[2][2][4][2], const Unit& u, int wr, int wc, int fr, int fq) const {
        const int row0 = u.pm * BM + wr * 64 + fr; const int col0 = u.pn * HALF + wc * 32 + 8 * fq;
#pragma unroll
        for (int ai = 0; ai < 2; ++ai)
#pragma unroll
            for (int m = 0; m < 4; ++m) { unsigned char* rowp = O + (size_t)(row0 + ai * HALF + m * 16) * ldc + col0;
                const f32x4 ag0 = acc[ai][0][m][0], ag1 = acc[ai][0][m][1];
                const f32x4 t0 = ag0 * (-sin * LOG2E), t1 = ag1 * (-sin * LOG2E);
                f32x4 d0, d1;
#pragma unroll
                for (int e = 0; e < 4; ++e) { d0[e] = __builtin_amdgcn_exp2f(t0[e]); d1[e] = __builtin_amdgcn_exp2f(t1[e]); }
                d0 = d0 + 1.f; d1 = d1 + 1.f;
                f32x4 r0, r1;
#pragma unroll
                for (int e = 0; e < 4; ++e) { r0[e] = __builtin_amdgcn_rcpf(d0[e]); r1[e] = __builtin_amdgcn_rcpf(d1[e]); }
                const f32x4 v0 = (ag0 * acc[ai][1][m][0]) * (sin * sin * sout) * r0, v1 = (ag1 * acc[ai][1][m][1]) * (sin * sin * sout) * r1;
                u32x2 w; w.x = pk4_fp8(clamp448(v0[0]), clamp448(v0[1]), clamp448(v0[2]), clamp448(v0[3]));
                w.y = pk4_fp8(clamp448(v1[0]), clamp448(v1[1]), clamp448(v1[2]), clamp448(v1[3]));
                *(u32x2*)rowp = w; __builtin_amdgcn_sched_barrier(0); }
    }
};
struct EpiSwiglu {
    static constexpr bool PERM = true;
    bf16_t* O; int ldc;
    __device__ __forceinline__ void operator()(const f32x4 (&acc)[2][2][4][2], const Unit& u, int wr, int wc, int fr, int fq) const {
        const int row0 = u.pm * BM + wr * 64 + fr; const int col0 = u.pn * HALF + wc * 32 + 8 * fq;
#pragma unroll
        for (int ai = 0; ai < 2; ++ai)
#pragma unroll
            for (int m = 0; m < 4; ++m) { bf16_t* rowp = O + (size_t)(row0 + ai * HALF + m * 16) * ldc + col0;
                const f32x4 g0 = acc[ai][0][m][0], g1 = acc[ai][0][m][1], u0 = acc[ai][1][m][0], u1 = acc[ai][1][m][1];
                u32x4 w; w.x = cvt_pk_bf16(silu_mul(g0[0], u0[0]), silu_mul(g0[1], u0[1])); w.y = cvt_pk_bf16(silu_mul(g0[2], u0[2]), silu_mul(g0[3], u0[3]));
                w.z = cvt_pk_bf16(silu_mul(g1[0], u1[0]), silu_mul(g1[1], u1[1])); w.w = cvt_pk_bf16(silu_mul(g1[2], u1[2]), silu_mul(g1[3], u1[3]));
                *(u32x4*)rowp = w; }
    }
};

__device__ __forceinline__ void glds16s(const void* sbase, unsigned voff, unsigned lds_dst) { unsigned keep;
    asm volatile("s_mov_b32 %0, m0\n\ts_mov_b32 m0, %3\n\ts_nop 0\n\tglobal_load_lds_dwordx4 %2, %1\n\ts_mov_b32 m0, %0" : "=&s"(keep) : "s"(sbase), "v"(voff), "s"(lds_dst) : "memory"); }
template <class Epi, class Sched, bool ALIGN_EPI = true, bool FP8 = false, int KC = 0>
__device__ __forceinline__ void gemm_phase(LAS unsigned char* lds, const Gemm g, const Sched& S, const Epi& E) {
    const int tid = threadIdx.x, wid = __builtin_amdgcn_readfirstlane(tid >> 6), lane = tid & 63, wr = wid >> 2, wc = wid & 3, fr = lane & 15, fq = lane >> 4;
    const int K = KC > 0 ? KC : g.K, nt = K / BK;
    unsigned voffA[2], voffB[2];
#pragma unroll
    for (int i = 0; i < 2; ++i) { int R, C; stage_rc(tid * 16 + i * 8192, R, C); const int Rb = Epi::PERM ? ((R & ~31) + perm32(R & 31)) : R;
        voffA[i] = (unsigned)(R * K + C) * 2u; voffB[i] = (unsigned)(Rb * K + C) * 2u; }
    const size_t kstep = (size_t)(BK * 2);
    const size_t hstep = (size_t)HALF * K * 2;
    const unsigned ldsw = (unsigned)wid * 1024u;
    const unsigned lds_u32 = (unsigned)(unsigned long long)lds;
    const int aoff = lds_byte(wr * 64 + fr, fq * 8), boff = lds_byte(wc * 32 + fr, fq * 8);
    const int aoff8 = lds_byte(wr * 64 + fr, (fq & 1) * 16) + (fq >> 1) * 1024, boff8 = lds_byte(wc * 32 + fr, (fq & 1) * 16) + (fq >> 1) * 1024;
#define PG8_SA(b, h) (((b) * 2 + (h)) * HTB)
#define PG8_SB(b, h) ((4 + (b) * 2 + (h)) * HTB)
#define PG8_STAGE(bufoff, gbase, voff) do { _Pragma("unroll") for (int _i = 0; _i < 2; ++_i) \
        glds16s((const void*)(gbase), (voff)[_i], lds_u32 + (unsigned)(bufoff) + ldsw + (unsigned)(_i * 8192)); } while (0)
#define PG8_LD8(p_) (*(const LAS v8i_t*)(p_))
#define PG8_LDA(dst, b, h) do { if constexpr (FP8) { _Pragma("unroll") for (int m = 0; m < 4; ++m) dst##8[m] = PG8_LD8(lds + PG8_SA(b, h) + aoff8 + m * 2048); } \
        else { _Pragma("unroll") for (int m = 0; m < 4; ++m) _Pragma("unroll") for (int k = 0; k < 2; ++k) dst[m][k] = *(const LAS bf16x8*)(lds + PG8_SA(b, h) + aoff + m * 2048 + k * 1024); } } while (0)
#define PG8_LDB(dst, b, h) do { if constexpr (FP8) { _Pragma("unroll") for (int n = 0; n < 2; ++n) dst##8[n] = PG8_LD8(lds + PG8_SB(b, h) + boff8 + n * 2048); } \
        else { _Pragma("unroll") for (int n = 0; n < 2; ++n) _Pragma("unroll") for (int k = 0; k < 2; ++k) dst[n][k] = *(const LAS bf16x8*)(lds + PG8_SB(b, h) + boff + n * 2048 + k * 1024); } } while (0)
#define PG8_MMA(ai, bj, At, Bt) do { __builtin_amdgcn_s_setprio(1); if constexpr (FP8) { _Pragma("unroll") for (int m = 0; m < 4; ++m) _Pragma("unroll") for (int n = 0; n < 2; ++n) \
            asm volatile("v_mfma_f32_16x16x128_f8f6f4 %0, %1, %2, %0" : "+v"(acc[ai][bj][m][n]) : "v"(Bt##8[n]), "v"(At##8[m])); } \
        else { _Pragma("unroll") for (int m = 0; m < 4; ++m) _Pragma("unroll") for (int n = 0; n < 2; ++n) _Pragma("unroll") for (int k = 0; k < 2; ++k) \
        acc[ai][bj][m][n] = __builtin_amdgcn_mfma_f32_16x16x32_bf16(Bt[n][k], At[m][k], acc[ai][bj][m][n], 0, 0, 0); } __builtin_amdgcn_s_setprio(0); } while (0)
#define PG8_WAIT_V(n) asm volatile("s_waitcnt vmcnt(" #n ")" ::: "memory")
#define PG8_WAIT_L(n) asm volatile("s_waitcnt lgkmcnt(" #n ")" ::: "memory")
#define PG8_BAR __builtin_amdgcn_s_barrier()
#define PG8_SCHED __builtin_amdgcn_sched_barrier(0)
    Unit cur, nxt; int ui = 0;
    if (!S.next(0, cur)) return;
    f32x4 acc[2][2][4][2];
#pragma unroll
    for (int a = 0; a < 2; ++a)
#pragma unroll
        for (int b = 0; b < 2; ++b)
#pragma unroll
            for (int m = 0; m < 4; ++m)
#pragma unroll
                for (int n = 0; n < 2; ++n) acc[a][b][m][n] = (f32x4){0.f, 0.f, 0.f, 0.f};
    bf16x8 At[4][2], B0[2][2], B1[2][2]; v8i_t At8[4], B08[2], B18[2];
    const char* cA = S.abase(g, cur); const char* cB = S.bbase(g, cur);
    PG8_STAGE(PG8_SB(0, 0), cB, voffB); PG8_STAGE(PG8_SB(0, 1), cB + hstep, voffB); PG8_STAGE(PG8_SA(0, 0), cA, voffA); PG8_STAGE(PG8_SA(0, 1), cA + hstep, voffA);
    if (wr == 1) PG8_BAR;
    PG8_WAIT_V(2); PG8_BAR;
    PG8_STAGE(PG8_SB(1, 0), cB + kstep, voffB); PG8_STAGE(PG8_SA(1, 0), cA + kstep, voffA); PG8_STAGE(PG8_SB(1, 1), cB + hstep + kstep, voffB);
    PG8_WAIT_V(6); PG8_BAR;
    for (;;) {
        const bool has_next = S.next(ui + 1, nxt);
        const char* nA = cA; const char* nB = cB;
        if (has_next) { nA = S.abase(g, nxt); nB = S.bbase(g, nxt); }
        for (int t = 0; t < nt; t += 2) {
            const bool last = (t == nt - 2);
            const char* a1 = cA + (size_t)(t + 1) * kstep;
            const char* a2 = last ? nA : cA + (size_t)(t + 2) * kstep; const char* b2 = last ? nB : cB + (size_t)(t + 2) * kstep;
            const char* a3 = a2 + kstep; const char* b3 = b2 + kstep;
            PG8_LDB(B0, 0, 0); PG8_LDB(B1, 0, 1); PG8_SCHED; PG8_LDA(At, 0, 0); PG8_STAGE(PG8_SA(1, 1), a1 + hstep, voffA);
            PG8_WAIT_V(8); PG8_WAIT_L(0); PG8_BAR; PG8_MMA(0, 0, At, B0); PG8_MMA(0, 1, At, B1); PG8_BAR; PG8_SCHED;
            PG8_LDA(At, 0, 1); PG8_STAGE(PG8_SB(0, 0), b2, voffB); PG8_STAGE(PG8_SB(0, 1), b2 + hstep, voffB); PG8_STAGE(PG8_SA(0, 0), a2, voffA);
            PG8_WAIT_V(8); PG8_WAIT_L(0); PG8_BAR; PG8_MMA(1, 0, At, B0); PG8_MMA(1, 1, At, B1); PG8_BAR; PG8_SCHED;
            PG8_LDB(B0, 1, 0); PG8_LDB(B1, 1, 1); PG8_SCHED; PG8_LDA(At, 1, 0); PG8_STAGE(PG8_SA(0, 1), a2 + hstep, voffA);
            PG8_WAIT_V(8); PG8_WAIT_L(0); PG8_BAR; PG8_MMA(0, 0, At, B0); PG8_MMA(0, 1, At, B1); PG8_BAR; PG8_SCHED;
            PG8_LDA(At, 1, 1); PG8_STAGE(PG8_SB(1, 0), b3, voffB); PG8_STAGE(PG8_SB(1, 1), b3 + hstep, voffB); PG8_STAGE(PG8_SA(1, 0), a3, voffA);
            PG8_WAIT_V(8); PG8_WAIT_L(0); PG8_BAR; PG8_MMA(1, 0, At, B0); PG8_MMA(1, 1, At, B1); PG8_BAR; PG8_SCHED;
        }
        if constexpr (ALIGN_EPI) { if (wr == 0) PG8_BAR; }
        if constexpr (FP8) asm volatile("s_nop 15\n\ts_nop 15" ::: "memory");
        E(acc, cur, wr, wc, fr, fq);
#if MK_DUP == 116
        if constexpr (FP8) { asm volatile("" ::: "memory"); E(acc, cur, wr, wc, fr, fq); }
#endif
        if (!has_next) break;
#pragma unroll
        for (int a = 0; a < 2; ++a)
#pragma unroll
            for (int b = 0; b < 2; ++b)
#pragma unroll
                for (int m = 0; m < 4; ++m)
#pragma unroll
                    for (int n = 0; n < 2; ++n) acc[a][b][m][n] = (f32x4){0.f, 0.f, 0.f, 0.f};
        cur = nxt; cA = nA; cB = nB; ++ui;
        if constexpr (ALIGN_EPI) { if (wr == 1) PG8_BAR; }
    }
    PG8_WAIT_V(0);
    if constexpr (!ALIGN_EPI) { if (wr == 0) PG8_BAR; }
    PG8_BAR;
#undef PG8_SA
#undef PG8_SB
#undef PG8_STAGE
#undef PG8_LDA
#undef PG8_LDB
#undef PG8_MMA
#undef PG8_WAIT_V
#undef PG8_WAIT_L
#undef PG8_BAR
#undef PG8_SCHED
}
}

namespace att {
constexpr int KS = 0, VS = 16384, TAB = 32768, KM = TAB + 4224 * 4, LDS_END = KM + 4096;
constexpr float C2 = 0.125f * LOG2E;
constexpr float NEG = -1e30f;
__device__ __forceinline__ int crow(int r, int hi) { return (r & 3) + 8 * (r >> 2) + 4 * hi; }
__device__ __forceinline__ int t5_bucket(int d) {
    if (d < 16) return d < 0 ? 0 : d;
    int b = 16;
    b += (d >= 22); b += (d >= 30); b += (d >= 40); b += (d >= 54); b += (d >= 73); b += (d >= 99); b += (d >= 134); b += (d >= 182);
    b += (d >= 246); b += (d >= 332); b += (d >= 450); b += (d >= 609); b += (d >= 825); b += (d >= 1117); b += (d >= 1513);
    return b;
}
__device__ __forceinline__ float swapmax(float m) { return fmaxf(m, __shfl_xor(m, 32)); }
__device__ __forceinline__ float swapsum(float m) { return m + __shfl_xor(m, 32); }
typedef short v4i16_t __attribute__((ext_vector_type(4)));
__device__ __forceinline__ s16x4 vtr(const LAS unsigned char* p) { return __builtin_bit_cast(s16x4, __builtin_amdgcn_ds_read_tr16_b64_v4i16((LAS v4i16_t*)p)); }

template <int MODE>
__device__ __forceinline__ void attn_unit(LAS unsigned char* lds, const bf16* __restrict__ qkv, int b, int h, int qt, int dil, int cls,
                                          const float* __restrict__ cum, const float* __restrict__ kmean, const float* __restrict__ relb,
                                          bf16* __restrict__ O, float* __restrict__ ml, const unsigned* __restrict__ qkn = nullptr) {
    const int tid = threadIdx.x, lane = tid & 63, r32 = lane & 31, hi = lane >> 5; const int wid = __builtin_amdgcn_readfirstlane(tid >> 6);
    int qcol, kcol, vcol;
    if (MODE == 0) { qcol = h * 64; kcol = 512 + h * 64; vcol = 1024 + h * 64; }
    else if (MODE == 1) { const int hh = h - 8; qcol = 1536 + hh * 64; kcol = 2048 + hh * 64; vcol = 2560 + hh * 64; }
    else { qcol = h * 64; kcol = 1024 + h * 64; vcol = 2048 + h * 64; }
    const bf16* base = qkv + (size_t)b * SEQ * QKVP;
    const int pw = 256 * qt + 32 * wid;
    const int myq = pw + r32;
    const int mytok = myq * dil + cls;
    bf16x8 qr[4];
    { const bf16* qrow = base + (size_t)mytok * QKVP + qcol + hi * 8;
#pragma unroll
      for (int d0 = 0; d0 < 4; ++d0) qr[d0] = *(const bf16x8*)(qrow + d0 * 16); }
    LAS float* tab = (LAS float*)(lds + TAB);
    LAS float* kml = (LAS float*)(lds + KM);
    if (MODE == 0) {
        const float* cp = cum + (size_t)(b * 8 + h) * SEQ; const int nk = 256 * (qt + 1);
        for (int s = tid; s < nk; s += 512) tab[s] = -cp[s] * LOG2E;
    } else if (MODE == 1) {
        for (int j = tid; j < 4224; j += 512) { const int rel = 4095 - j; tab[j] = rel >= 0 ? relb[t5_bucket(rel) * 16 + h] * LOG2E : 0.f; }
        const float* kp = kmean + (size_t)(b * 8 + (h - 8)) * 16 * 64;
        for (int j = tid; j < qt * 64; j += 512) kml[j] = kp[j];
    } else {
        for (int j = tid; j < 384; j += 512) { const int rel = 255 - j; tab[j] = (rel >= 0 && rel <= 128) ? relb[t5_bucket(rel * dil) * 16 + h] * LOG2E : 0.f; }
    }
    const int vrow = 16 * (wid & 3) + (lane >> 2);
    const bf16* ksrc0 = base + kcol + wid * 8;
    const bf16* vsrc0 = base + vcol + (wid >> 2) * 32 + (lane & 3) * 8;
    int tlo = (MODE == 2) ? (4 * qt - 2 > 0 ? 4 * qt - 2 : 0) : 0; const int thi = 4 * qt + 3;
    if (MODE == 0) {
        LAS int* tsl = (LAS int*)(lds + KM);
        if (tid == 0) tsl[0] = 4 * qt;
        __syncthreads();
        if (tid < 4 * qt) { const float* cp = cum + (size_t)(b * 8 + h) * SEQ;
            const float qn = __builtin_bit_cast(float, qkn[2 * (b * 8 + h)]), kn = __builtin_bit_cast(float, qkn[2 * (b * 8 + h) + 1]);
            const float bound = 2.f * qn * kn * C2 + (cp[256 * qt] - cp[64 * tid + 63]) * LOG2E;
            if (bound >= -64.f) __hip_atomic_fetch_min(&tsl[0], tid, __ATOMIC_RELAXED, __HIP_MEMORY_SCOPE_WORKGROUP); }
        __syncthreads();
        tlo = __builtin_amdgcn_readfirstlane(tsl[0]);
    }
    u32x4 kreg, vreg;
#define ATT_LOAD(t) do { const int kt_ = ((64 * (t) + lane) * dil + cls), vt_ = ((64 * (t) + vrow) * dil + cls); \
        kreg = *(const u32x4*)(ksrc0 + (size_t)kt_ * QKVP); vreg = *(const u32x4*)(vsrc0 + (size_t)vt_ * QKVP); } while (0)
#define ATT_STORE(buf) do { *(LAS u32x4*)(lds + KS + (buf) * 8192 + wid * 1024 + lane * 16) = kreg; *(LAS u32x4*)(lds + VS + (buf) * 8192 + wid * 1024 + lane * 16) = vreg; } while (0)
    ATT_LOAD(tlo); ATT_STORE(0);
    __syncthreads();
    unsigned sel = 0u;
    if (MODE == 1) {
        float v1 = -INFINITY, v2 = -INFINITY, v3 = -INFINITY; int i1 = -1, i2 = -1, i3 = -1;
        for (int n = 0; n < qt; ++n) {
            float part = 0.f;
#pragma unroll
            for (int d0 = 0; d0 < 4; ++d0) { const f32x4 ka = *(const LAS f32x4*)(kml + n * 64 + d0 * 16 + hi * 8), kb = *(const LAS f32x4*)(kml + n * 64 + d0 * 16 + hi * 8 + 4);
                part += bf2f((unsigned short)qr[d0][0]) * ka[0] + bf2f((unsigned short)qr[d0][1]) * ka[1] + bf2f((unsigned short)qr[d0][2]) * ka[2] + bf2f((unsigned short)qr[d0][3]) * ka[3];
                part += bf2f((unsigned short)qr[d0][4]) * kb[0] + bf2f((unsigned short)qr[d0][5]) * kb[1] + bf2f((unsigned short)qr[d0][6]) * kb[2] + bf2f((unsigned short)qr[d0][7]) * kb[3]; }
            const float gt = swapsum(part);
            if (gt > v1) { v3 = v2; i3 = i2; v2 = v1; i2 = i1; v1 = gt; i1 = n; }
            else if (gt > v2) { v3 = v2; i3 = i2; v2 = gt; i2 = n; }
            else if (gt > v3) { v3 = gt; i3 = n; }
        }
        if (i1 >= 0) sel |= 1u << i1; if (i2 >= 0) sel |= 1u << i2; if (i3 >= 0) sel |= 1u << i3;
    }
    float m = NEG, l = 0.f; f32x16 o0 = {}, o1 = {};
    const LAS unsigned char* vp0 = lds + VS + ((lane >> 4) & 1) * 32 + (lane & 3) * 8 + (4 * hi + ((lane & 15) >> 2)) * 64;
    int buf = 0;
    for (int t = tlo; t <= thi; ++t, buf ^= 1) {
        if (t < thi) ATT_LOAD(t + 1);
        bool active;
        if (MODE == 2) active = (64 * t + 63 >= pw - 128) && (64 * t <= pw + 31);
        else active = (64 * t <= pw + 31);
        if (MODE == 1) { if (t < 4 * qt) active = (__ballot((sel >> (t >> 2)) & 1u) != 0ull); }
        if (active) {
            const LAS unsigned char* Ks = lds + KS + buf * 8192 + hi * 1024 + r32 * 16;
            f32x16 p0 = {}, p1 = {};
#pragma unroll
            for (int d0 = 0; d0 < 4; ++d0) { const bf16x8 k0 = *(const LAS bf16x8*)(Ks + d0 * 2048), k1 = *(const LAS bf16x8*)(Ks + d0 * 2048 + 512);
                p0 = __builtin_amdgcn_mfma_f32_32x32x16_bf16(k0, qr[d0], p0, 0, 0, 0); p1 = __builtin_amdgcn_mfma_f32_32x32x16_bf16(k1, qr[d0], p1, 0, 0, 0); }
            if (MODE == 0) {
                const LAS float* cn = tab + 64 * t + 4 * hi;
#pragma unroll
                for (int a = 0; a < 4; ++a) { const f32x4 c0 = *(const LAS f32x4*)(cn + 8 * a), c1 = *(const LAS f32x4*)(cn + 32 + 8 * a);
#pragma unroll
                    for (int e = 0; e < 4; ++e) { p0[4 * a + e] = __builtin_fmaf(p0[4 * a + e], C2, c0[e]); p1[4 * a + e] = __builtin_fmaf(p1[4 * a + e], C2, c1[e]); } }
                if (t >= 4 * qt) {
#pragma unroll
                    for (int r = 0; r < 16; ++r) { const int kp = 64 * t + crow(r, hi); if (kp > myq) p0[r] = NEG; if (kp + 32 > myq) p1[r] = NEG; }
                }
            } else {
                const int relbase = myq - 64 * t - 4 * hi;
                const LAS float* tj = tab + ((MODE == 1 ? 4095 : 255) - relbase);
#pragma unroll
                for (int r = 0; r < 16; ++r) { const int cr = (r & 3) + 8 * (r >> 2);
                    p0[r] = __builtin_fmaf(p0[r], C2, tj[cr]); p1[r] = __builtin_fmaf(p1[r], C2, tj[cr + 32]); }
                if (MODE == 1) {
                    if (t < 4 * qt) { if (!((sel >> (t >> 2)) & 1u)) {
#pragma unroll
                            for (int r = 0; r < 16; ++r) { p0[r] = NEG; p1[r] = NEG; } } }
                    else {
#pragma unroll
                        for (int r = 0; r < 16; ++r) { const int cr = (r & 3) + 8 * (r >> 2); if (relbase - cr < 0) p0[r] = NEG; if (relbase - cr - 32 < 0) p1[r] = NEG; }
                    }
                } else {
#pragma unroll
                    for (int r = 0; r < 16; ++r) { const int cr = (r & 3) + 8 * (r >> 2); const int e0 = relbase - cr, e1 = e0 - 32;
                        if (e0 < 0 || e0 > 128) p0[r] = NEG; if (e1 < 0 || e1 > 128) p1[r] = NEG; }
                }
            }
            float mx = fmaxf(p0[0], p1[0]);
#pragma unroll
            for (int r = 1; r < 16; ++r) mx = fmaxf(mx, fmaxf(p0[r], p1[r]));
            mx = swapmax(mx);
            const float mn = fmaxf(m, mx), alpha = __builtin_amdgcn_exp2f(m - mn); m = mn;
            float rs = 0.f;
#pragma unroll
            for (int r = 0; r < 16; ++r) { p0[r] = __builtin_amdgcn_exp2f(p0[r] - mn); p1[r] = __builtin_amdgcn_exp2f(p1[r] - mn); rs += p0[r] + p1[r]; }
            l = l * alpha + rs;
#pragma unroll
            for (int r = 0; r < 16; ++r) { o0[r] *= alpha; o1[r] *= alpha; }
            bf16x8 pa[4];
#pragma unroll
            for (int ks = 0; ks < 4; ++ks) { u32x4 w;
#pragma unroll
                for (int e = 0; e < 4; ++e) { const int r = 8 * (ks & 1) + 2 * e; w[e] = (ks < 2) ? pg8::cvt_pk_bf16(p0[r], p0[r + 1]) : pg8::cvt_pk_bf16(p1[r], p1[r + 1]); }
                pa[ks] = __builtin_bit_cast(bf16x8, w); }
            const LAS unsigned char* vp = vp0 + buf * 8192;
#pragma unroll
            for (int ks = 0; ks < 4; ++ks) {
                const s16x4 a0 = vtr(vp + ks * 1024), a1 = vtr(vp + ks * 1024 + 512), b0 = vtr(vp + 4096 + ks * 1024), b1 = vtr(vp + 4096 + ks * 1024 + 512);
                const bf16x8 va = (bf16x8){a0[0], a0[1], a0[2], a0[3], a1[0], a1[1], a1[2], a1[3]}, vb = (bf16x8){b0[0], b0[1], b0[2], b0[3], b1[0], b1[1], b1[2], b1[3]};
                o0 = __builtin_amdgcn_mfma_f32_32x32x16_bf16(va, pa[ks], o0, 0, 0, 0);
                o1 = __builtin_amdgcn_mfma_f32_32x32x16_bf16(vb, pa[ks], o1, 0, 0, 0);
            }
        }
        if (t < thi) ATT_STORE(buf ^ 1);
        __syncthreads();
    }
#undef ATT_LOAD
#undef ATT_STORE
    const float lt = swapsum(l), inv = 1.f / lt;
    bf16* orow = O + ((size_t)b * SEQ + mytok) * DM + h * 64 + 4 * hi;
#pragma unroll
    for (int a = 0; a < 4; ++a) {
        u32x2 w0, w1; w0.x = pk2(o0[4 * a] * inv, o0[4 * a + 1] * inv); w0.y = pk2(o0[4 * a + 2] * inv, o0[4 * a + 3] * inv);
        w1.x = pk2(o1[4 * a] * inv, o1[4 * a + 1] * inv); w1.y = pk2(o1[4 * a + 2] * inv, o1[4 * a + 3] * inv);
        *(u32x2*)(orow + 8 * a) = w0; *(u32x2*)(orow + 32 + 8 * a) = w1;
    }
    if (MODE == 2) { if (hi == 0) { f32x2 v; v.x = m; v.y = lt; *(f32x2*)(ml + (((size_t)b * SEQ + mytok) * NH + h) * 2) = v; } }
}

constexpr int R_K = 0, R_V = 32768, R_TAB = 65536, R_KM = R_TAB + 4288 * 4, R_TS = R_KM + 4096, R_END = R_TS + 64;
#define ATT_WAITBAR(N) asm volatile("s_waitcnt vmcnt(" #N ") lgkmcnt(0)\n\ts_barrier" ::: "memory")
__device__ __forceinline__ bf16x8 scale_q(bf16x8 q) { bf16x8 r;
#pragma unroll
    for (int e = 0; e < 8; ++e) r[e] = (short)f2bf(bf2f((unsigned short)q[e]) * C2);
    return r; }

#define ATT_QK(Ks) do { _Pragma("unroll") for (int d0 = 0; d0 < 4; ++d0) { const bf16x8 k0_ = *(const LAS bf16x8*)((Ks) + koff[d0]), k1_ = *(const LAS bf16x8*)((Ks) + koff[d0] + 4096); \
        p0 = __builtin_amdgcn_mfma_f32_32x32x16_bf16(k0_, qr[d0], p0, 0, 0, 0); p1 = __builtin_amdgcn_mfma_f32_32x32x16_bf16(k1_, qr[d0], p1, 0, 0, 0); } } while (0)
#define ATT_SOFTMAX_PV(vp) do { \
        float mx_ = fmaxf(p0[0], p1[0]); \
        _Pragma("unroll") for (int r = 1; r < 16; ++r) mx_ = fmaxf(mx_, fmaxf(p0[r], p1[r])); \
        mx_ = swapmax(mx_); \
        const float mn_ = fmaxf(m, mx_); \
        if (__any(mn_ > m)) { const float alpha_ = __builtin_amdgcn_exp2f(m - mn_); l *= alpha_; \
            _Pragma("unroll") for (int r = 0; r < 16; ++r) { o0[r] *= alpha_; o1[r] *= alpha_; } } \
        m = mn_; float rs_ = 0.f; \
        _Pragma("unroll") for (int r = 0; r < 16; ++r) { p0[r] = __builtin_amdgcn_exp2f(p0[r] - mn_); p1[r] = __builtin_amdgcn_exp2f(p1[r] - mn_); rs_ += p0[r] + p1[r]; } \
        l += rs_; \
        bf16x8 pa_[4]; \
        _Pragma("unroll") for (int ks = 0; ks < 4; ++ks) { u32x4 w_; \
            _Pragma("unroll") for (int e = 0; e < 4; ++e) { const int r = 8 * (ks & 1) + 2 * e; w_[e] = (ks < 2) ? pg8::cvt_pk_bf16(p0[r], p0[r + 1]) : pg8::cvt_pk_bf16(p1[r], p1[r + 1]); } \
            pa_[ks] = __builtin_bit_cast(bf16x8, w_); } \
        _Pragma("unroll") for (int ks = 0; ks < 4; ++ks) { \
            const s16x4 a0_ = vtr((vp) + ks * 1024), a1_ = vtr((vp) + ks * 1024 + 512), b0_ = vtr((vp) + 4096 + ks * 1024), b1_ = vtr((vp) + 4096 + ks * 1024 + 512); \
            const bf16x8 va_ = (bf16x8){a0_[0], a0_[1], a0_[2], a0_[3], a1_[0], a1_[1], a1_[2], a1_[3]}, vb_ = (bf16x8){b0_[0], b0_[1], b0_[2], b0_[3], b1_[0], b1_[1], b1_[2], b1_[3]}; \
            o0 = __builtin_amdgcn_mfma_f32_32x32x16_bf16(va_, pa_[ks], o0, 0, 0, 0); o1 = __builtin_amdgcn_mfma_f32_32x32x16_bf16(vb_, pa_[ks], o1, 0, 0, 0); } \
    } while (0)
#define ATT_FAST_PV(vp) do { \
        _Pragma("unroll") for (int r = 0; r < 16; ++r) { p0[r] = __builtin_amdgcn_exp2f(p0[r]); p1[r] = __builtin_amdgcn_exp2f(p1[r]); } \
        bf16x8 pa_[4]; \
        _Pragma("unroll") for (int ks = 0; ks < 4; ++ks) { u32x4 w_; \
            _Pragma("unroll") for (int e = 0; e < 4; ++e) { const int r = 8 * (ks & 1) + 2 * e; w_[e] = (ks < 2) ? pg8::cvt_pk_bf16(p0[r], p0[r + 1]) : pg8::cvt_pk_bf16(p1[r], p1[r + 1]); } \
            pa_[ks] = __builtin_bit_cast(bf16x8, w_); } \
        _Pragma("unroll") for (int ks = 0; ks < 4; ++ks) { \
            const s16x4 a0_ = vtr((vp) + ks * 1024), a1_ = vtr((vp) + ks * 1024 + 512), b0_ = vtr((vp) + 4096 + ks * 1024), b1_ = vtr((vp) + 4096 + ks * 1024 + 512); \
            const bf16x8 va_ = (bf16x8){a0_[0], a0_[1], a0_[2], a0_[3], a1_[0], a1_[1], a1_[2], a1_[3]}, vb_ = (bf16x8){b0_[0], b0_[1], b0_[2], b0_[3], b1_[0], b1_[1], b1_[2], b1_[3]}; \
            o0 = __builtin_amdgcn_mfma_f32_32x32x16_bf16(va_, pa_[ks], o0, 0, 0, 0); o1 = __builtin_amdgcn_mfma_f32_32x32x16_bf16(vb_, pa_[ks], o1, 0, 0, 0); \
            o2 = __builtin_amdgcn_mfma_f32_32x32x16_bf16(ones8, pa_[ks], o2, 0, 0, 0); } \
    } while (0)
#define ATT_STORE_O(orow, inv) do { _Pragma("unroll") for (int a = 0; a < 4; ++a) { \
        u32x2 w0_, w1_; w0_.x = pg8::cvt_pk_bf16(o0[4 * a] * (inv), o0[4 * a + 1] * (inv)); w0_.y = pg8::cvt_pk_bf16(o0[4 * a + 2] * (inv), o0[4 * a + 3] * (inv)); \
        w1_.x = pg8::cvt_pk_bf16(o1[4 * a] * (inv), o1[4 * a + 1] * (inv)); w1_.y = pg8::cvt_pk_bf16(o1[4 * a + 2] * (inv), o1[4 * a + 3] * (inv)); \
        *(u32x2*)((orow) + 8 * a) = w0_; *(u32x2*)((orow) + 32 + 8 * a) = w1_; } } while (0)

template <int MODE>
__device__ __forceinline__ void attn_unit_v2(LAS unsigned char* lds, const bf16* __restrict__ qkv, int b, int h, int qt,
                                             const float* __restrict__ cum, const float* __restrict__ kmean, const float* __restrict__ relb,
                                             bf16* __restrict__ O, const unsigned* __restrict__ qkn) {
    const int tid = threadIdx.x, lane = tid & 63, r32 = lane & 31, hi = lane >> 5; const int wid = __builtin_amdgcn_readfirstlane(tid >> 6);
    const int qs = (MODE == 0) ? h : 24 + (h - 8), ks = qs + 8, vs = qs + 16;
    const bf16* qb = qkv + ((size_t)qs * NTOK + (size_t)b * SEQ) * 64; const bf16* kb = qkv + ((size_t)ks * NTOK + (size_t)b * SEQ) * 64; const bf16* vb = qkv + ((size_t)vs * NTOK + (size_t)b * SEQ) * 64;
    const int pw = 256 * qt + 32 * wid, myq = pw + r32;
    bf16x8 qr[4];
    { const bf16* qrow = qb + (size_t)myq * 64 + hi * 8;
#pragma unroll
      for (int d0 = 0; d0 < 4; ++d0) qr[d0] = *(const bf16x8*)(qrow + d0 * 16); }
    LAS float* tab = (LAS float*)(lds + R_TAB); LAS float* kml = (LAS float*)(lds + R_KM); LAS int* tsl = (LAS int*)(lds + R_TS);
    const int thi = 4 * qt + 3; int tlo = 0; float fox_b2 = 0.f;
    if (MODE == 0) {
        fox_b2 = 2.f * __builtin_bit_cast(float, qkn[2 * (b * 16 + h)]) * __builtin_bit_cast(float, qkn[2 * (b * 16 + h) + 1]);
        const float* cp = cum + (size_t)(b * 8 + h) * SEQ; const int nk = 256 * (qt + 1);
        for (int s = tid; s < nk; s += 512) tab[s] = -cp[s] * LOG2E;
        if (tid == 0) tsl[0] = 4 * qt;
        __syncthreads();
        if (tid < 4 * qt) { const float qn = __builtin_bit_cast(float, qkn[2 * (b * 16 + h)]), kn = __builtin_bit_cast(float, qkn[2 * (b * 16 + h) + 1]);
            const float bound = 2.f * qn * kn + (cp[256 * qt] - cp[64 * tid + 63]) * LOG2E;
            if (bound >= -64.f) __hip_atomic_fetch_min(&tsl[0], tid, __ATOMIC_RELAXED, __HIP_MEMORY_SCOPE_WORKGROUP); }
        __syncthreads();
        tlo = __builtin_amdgcn_readfirstlane(tsl[0]);
    } else {
        for (int j = tid; j < 4288; j += 512) { const int rel = 4095 - j; tab[j] = rel >= 0 ? relb[t5_bucket(rel) * 16 + h] * LOG2E : NEG; }
        const float* kp = kmean + (size_t)(b * 8 + (h - 8)) * 16 * 64;
        for (int j = tid; j < qt * 64; j += 512) kml[j] = kp[j];
        __syncthreads();
    }
    unsigned sel = 0u;
    if (MODE == 1) {
        float v1 = -INFINITY, v2 = -INFINITY, v3 = -INFINITY; int i1 = -1, i2 = -1, i3 = -1;
        for (int n = 0; n < qt; ++n) {
            float part = 0.f;
#pragma unroll
            for (int d0 = 0; d0 < 4; ++d0) { const f32x4 ka = *(const LAS f32x4*)(kml + n * 64 + d0 * 16 + hi * 8), kb = *(const LAS f32x4*)(kml + n * 64 + d0 * 16 + hi * 8 + 4);
                part += bf2f((unsigned short)qr[d0][0]) * ka[0] + bf2f((unsigned short)qr[d0][1]) * ka[1] + bf2f((unsigned short)qr[d0][2]) * ka[2] + bf2f((unsigned short)qr[d0][3]) * ka[3];
                part += bf2f((unsigned short)qr[d0][4]) * kb[0] + bf2f((unsigned short)qr[d0][5]) * kb[1] + bf2f((unsigned short)qr[d0][6]) * kb[2] + bf2f((unsigned short)qr[d0][7]) * kb[3]; }
            const float gt = swapsum(part);
            if (gt > v1) { v3 = v2; i3 = i2; v2 = v1; i2 = i1; v1 = gt; i1 = n; }
            else if (gt > v2) { v3 = v2; i3 = i2; v2 = gt; i2 = n; }
            else if (gt > v3) { v3 = gt; i3 = n; }
        }
        if (i1 >= 0) sel |= 1u << i1; if (i2 >= 0) sel |= 1u << i2; if (i3 >= 0) sel |= 1u << i3;
    }
    bool fast = false; f32x16 o2 = {}; bf16x8 ones8;
#pragma unroll
    for (int e = 0; e < 8; ++e) ones8[e] = (short)0x3F80;
    if (MODE == 1) fast = true;
    const int vrow = 16 * (wid & 3) + (lane >> 2);
    const int krow = 8 * wid + (lane >> 3);
    const bf16* ksrc0 = kb + (size_t)krow * 64 + (((lane & 7) ^ ((krow >> 1) & 7)) * 8);
    const bf16* vsrc0 = vb + (size_t)vrow * 64 + (wid >> 2) * 32 + (lane & 3) * 8;
    int koff[4];
#pragma unroll
    for (int d0 = 0; d0 < 4; ++d0) koff[d0] = r32 * 128 + (((2 * d0 + hi) ^ ((r32 >> 1) & 7)) << 4);
#define ATT_DMA(t) do { const unsigned so_ = (unsigned)((((t) & 3) * 8192) + wid * 1024); \
        __builtin_amdgcn_global_load_lds((const unsigned*)(ksrc0 + (size_t)(t) * 4096), (LAS unsigned*)(lds + R_K + so_), 16, 0, 0); \
        __builtin_amdgcn_global_load_lds((const unsigned*)(vsrc0 + (size_t)(t) * 4096), (LAS unsigned*)(lds + R_V + so_), 16, 0, 0); } while (0)
    const LAS unsigned char* vp0 = lds + R_V + ((lane >> 4) & 1) * 32 + (lane & 3) * 8 + (4 * hi + ((lane & 15) >> 2)) * 64;
    float m = NEG, l = 0.f; f32x16 o0 = {}, o1 = {};
#pragma unroll 1
  for (int attempt = 0; attempt < (MODE == 1 ? 2 : 1); ++attempt) {
    if (attempt == 1) { fast = false; m = NEG; l = 0.f; o0 = f32x16{}; o1 = f32x16{}; }
    asm volatile("s_waitcnt vmcnt(0)" ::: "memory");
    ATT_DMA(tlo); ATT_DMA(tlo + 1); ATT_DMA(tlo + 2);
    ATT_WAITBAR(4);
    for (int t = tlo; t <= thi; ++t) {
        if (t + 3 <= thi) ATT_DMA(t + 3);
        bool active = (64 * t <= pw + 31);
        if (MODE == 1) { if (t < 4 * qt) active = (__ballot((sel >> (t >> 2)) & 1u) != 0ull); }
        if (MODE == 0) { if (64 * t + 63 < pw) active = active && !((fox_b2 + tab[64 * t + 63] - tab[pw]) < -64.f); }
        if (active) {
            const LAS unsigned char* Ks = lds + R_K + (t & 3) * 8192;
            f32x16 p0, p1;
            if (MODE == 0) {
                const LAS float* cn = tab + 64 * t + 4 * hi;
#pragma unroll
                for (int a = 0; a < 4; ++a) { const f32x4 c0 = *(const LAS f32x4*)(cn + 8 * a), c1 = *(const LAS f32x4*)(cn + 32 + 8 * a);
#pragma unroll
                    for (int e = 0; e < 4; ++e) { p0[4 * a + e] = c0[e]; p1[4 * a + e] = c1[e]; } }
            } else {
                const int relbase = myq - 64 * t - 4 * hi;
                const LAS float* tj = tab + (4095 - relbase);
                if (t < 4 * qt) { if (!((sel >> (t >> 2)) & 1u)) tj = tab + 4224; }
#pragma unroll
                for (int r = 0; r < 16; ++r) { const int cr = (r & 3) + 8 * (r >> 2); p0[r] = tj[cr]; p1[r] = tj[cr + 32]; }
            }
            ATT_QK(Ks);
            if (MODE == 0) { if (t >= 4 * qt) {
#pragma unroll
                    for (int r = 0; r < 16; ++r) { const int kp = 64 * t + crow(r, hi); if (kp > myq) p0[r] = NEG; if (kp + 32 > myq) p1[r] = NEG; } } }
            const LAS unsigned char* vp = vp0 + (t & 3) * 8192;
            if (MODE == 1 && fast) { ATT_FAST_PV(vp); } else { ATT_SOFTMAX_PV(vp); }
        }
        if (t + 3 <= thi) ATT_WAITBAR(4); else if (t + 2 <= thi) ATT_WAITBAR(2); else ATT_WAITBAR(0);
    }
    if (MODE == 1 && attempt == 0) {
        const float l0 = o2[0]; const bool bad = __any(!(l0 > 7.9e-31f && l0 < 1.3e36f));
        if (tid == 0) tsl[1] = 0;
        __syncthreads();
        if (bad && lane == 0) tsl[1] = 1;
        __syncthreads();
        const int redo = __builtin_amdgcn_readfirstlane(tsl[1]);
        __syncthreads();
        if (!redo) break;
    }
  }
#undef ATT_DMA
    const float lt = (MODE == 1 && fast) ? o2[0] : swapsum(l), inv = 1.f / lt;
    bf16* orow = O + ((size_t)b * SEQ + myq) * DM + h * 64 + 4 * hi;
    ATT_STORE_O(orow, inv);
}

constexpr int DL_K = 0, DL_V = 49152, DL_TAB = 98304, DL_END = DL_TAB + 1536 + 128 + 2048;
__device__ __forceinline__ void dil_params(int i, int j, int& h, int& gp, int& dil, int& cls, int& qt) { const int hp = i / 3, idx = j + 32 * (i % 3), h2 = idx / 48, rem = idx % 48, x = rem & 15;
    h = 2 * hp + h2; gp = rem >> 4; dil = gp == 0 ? 1 : (gp == 1 ? 4 : 16); qt = gp == 0 ? x : (gp == 1 ? (x >> 2) : 0); cls = gp == 0 ? 0 : (gp == 1 ? (x & 3) : x); }
__device__ __forceinline__ void dilated_phase(LAS unsigned char* lds, const bf16* __restrict__ qkv, int b, int j, const float* __restrict__ relb,
                                              bf16* O0, bf16* O1, bf16* O2, float* __restrict__ ml, const unsigned* __restrict__ knw  ) {
    const int tid = threadIdx.x, lane = tid & 63, r32 = lane & 31, hi = lane >> 5; const int wid = __builtin_amdgcn_readfirstlane(tid >> 6);
    const int vrow = 16 * (wid & 3) + (lane >> 2), krow = 8 * wid + (lane >> 3);
    int koff[4];
#pragma unroll
    for (int d0 = 0; d0 < 4; ++d0) koff[d0] = r32 * 128 + (((2 * d0 + hi) ^ ((r32 >> 1) & 7)) << 4);
    LAS float* tab = (LAS float*)(lds + DL_TAB);
    LAS float* rbl = (LAS float*)(lds + DL_TAB + 1536 + 128);
    if (tid < 512) rbl[tid] = relb[tid] * LOG2E;
    __syncthreads();
    u32x4 kv[12]; bf16x8 qn[4], qn2[4];
#define DIL_PREFETCH(h_, qt_, dil_, cls_) do { const int T0_ = 4 * (qt_) - 2; \
        const bf16* ksrc0 = qkv + ((size_t)(16 + (h_)) * NTOK + (size_t)b * SEQ) * 64 + (((lane & 7) ^ ((krow >> 1) & 7)) * 8); \
        const bf16* vsrc0 = qkv + ((size_t)(32 + (h_)) * NTOK + (size_t)b * SEQ) * 64 + (wid >> 2) * 32 + (lane & 3) * 8; \
        _Pragma("unroll") for (int s_ = 0; s_ < 6; ++s_) { int kp_ = 64 * (T0_ + s_) + krow, vq_ = 64 * (T0_ + s_) + vrow; kp_ = kp_ < 0 ? 0 : kp_; vq_ = vq_ < 0 ? 0 : vq_; \
            kv[2 * s_] = *(const u32x4*)(ksrc0 + (size_t)(kp_ * (dil_) + (cls_)) * 64); kv[2 * s_ + 1] = *(const u32x4*)(vsrc0 + (size_t)(vq_ * (dil_) + (cls_)) * 64); } \
        } while (0)
#define DIL_PREFETCH_Q2(h_, qt_, dil_, cls_) do { const bf16* qrow_ = qkv + ((size_t)(h_) * NTOK + (size_t)b * SEQ) * 64 + (size_t)((256 * (qt_) + 32 * wid + r32) * (dil_) + (cls_)) * 64 + hi * 8; \
          _Pragma("unroll") for (int d0 = 0; d0 < 4; ++d0) qn2[d0] = *(const bf16x8*)(qrow_ + d0 * 16); } while (0)
#define DIL_PREFETCH_Q(h_, qt_, dil_, cls_) do { const bf16* qrow_ = qkv + ((size_t)(h_) * NTOK + (size_t)b * SEQ) * 64 + (size_t)((256 * (qt_) + 32 * wid + r32) * (dil_) + (cls_)) * 64 + hi * 8; \
          _Pragma("unroll") for (int d0 = 0; d0 < 4; ++d0) qn[d0] = *(const bf16x8*)(qrow_ + d0 * 16); } while (0)
    bf16x8 ones8;
#pragma unroll
    for (int e = 0; e < 8; ++e) ones8[e] = (short)0x3F80;
    int h, gp, dil, cls, qt;
    const LAS unsigned char* vp0 = lds + DL_V + ((lane >> 4) & 1) * 32 + (lane & 3) * 8 + (4 * hi + ((lane & 15) >> 2)) * 64;
    dil_params(0, j, h, gp, dil, cls, qt);
    DIL_PREFETCH(h, qt, dil, cls); DIL_PREFETCH_Q(h, qt, dil, cls);
    constexpr int NIT = (MK_DUP == 113) ? 48 : 24;
#pragma unroll 1
    for (int i = 0; i < NIT; ++i) {
        dil_params(i % 24, j, h, gp, dil, cls, qt);
        if (i > 0) {
#pragma unroll
            for (int d0 = 0; d0 < 4; ++d0) qn[d0] = qn2[d0]; }
#pragma unroll
        for (int s_ = 0; s_ < 6; ++s_) { *(LAS u32x4*)(lds + DL_K + s_ * 8192 + wid * 1024 + lane * 16) = kv[2 * s_]; *(LAS u32x4*)(lds + DL_V + s_ * 8192 + wid * 1024 + lane * 16) = kv[2 * s_ + 1]; }
        { for (int j = tid; j < 384; j += 512) { const int rel = 255 - j; tab[j] = (rel >= 0 && rel <= 128) ? rbl[t5_bucket(rel * dil) * 16 + h] : NEG; } }
        __syncthreads();
        if (i + 1 < NIT) { int h2_, g2_, d2, c2, q2; dil_params((i + 1) % 24, j, h2_, g2_, d2, c2, q2); DIL_PREFETCH(h2_, q2, d2, c2); DIL_PREFETCH_Q2(h2_, q2, d2, c2); }
        f32x16 o0 = {}, o1 = {}, o2 = {};
        float cshift = 0.f;
#pragma unroll 1
        for (int attempt = 0; attempt < 2; ++attempt) {
            if (attempt == 1) { float mx = NEG; o0 = f32x16{}; o1 = f32x16{}; o2 = f32x16{};
#pragma unroll
                for (int jj = 0; jj < 3; ++jj) { const int slot = (wid >> 1) + jj;
                    if (4 * qt - 2 + slot >= 0) { const int relbase = 32 * (wid & 1) + r32 + 128 - 64 * jj - 4 * hi; const LAS float* tj = tab + (255 - relbase);
                        f32x16 p0, p1;
#pragma unroll
                        for (int r = 0; r < 16; ++r) { const int cr = (r & 3) + 8 * (r >> 2); p0[r] = tj[cr]; p1[r] = tj[cr + 32]; }
                        const LAS unsigned char* Ks = lds + DL_K + slot * 8192;
                        { bf16x8 (&qr)[4] = qn; ATT_QK(Ks); }
#pragma unroll
                        for (int r = 0; r < 16; ++r) mx = fmaxf(mx, fmaxf(p0[r], p1[r])); } }
                cshift = swapmax(mx); }
#pragma unroll
            for (int jj = 0; jj < 3; ++jj) { const int slot = (wid >> 1) + jj;
                if (4 * qt - 2 + slot >= 0) { const int relbase = 32 * (wid & 1) + r32 + 128 - 64 * jj - 4 * hi; const LAS float* tj = tab + (255 - relbase);
                    f32x16 p0, p1;
                    if (attempt == 0) {
#pragma unroll
                        for (int r = 0; r < 16; ++r) { const int cr = (r & 3) + 8 * (r >> 2); p0[r] = tj[cr]; p1[r] = tj[cr + 32]; } }
                    else {
#pragma unroll
                        for (int r = 0; r < 16; ++r) { const int cr = (r & 3) + 8 * (r >> 2); p0[r] = tj[cr] - cshift; p1[r] = tj[cr + 32] - cshift; } }
                    const LAS unsigned char* Ks = lds + DL_K + slot * 8192;
                    { bf16x8 (&qr)[4] = qn; ATT_QK(Ks); }
                    const LAS unsigned char* vp = vp0 + slot * 8192;
                    ATT_FAST_PV(vp); } }
            if (attempt == 0) { const float l0 = o2[0]; if (!__any(!(l0 > 7.9e-31f && l0 < 1.3e36f))) break; }
        }
        const float m = cshift;
        const float lt = o2[0], inv = 1.f / lt;
        bf16* Op = gp == 0 ? O0 : (gp == 1 ? O1 : O2);
        const int mytok = (256 * qt + 32 * wid + r32) * dil + cls;
        bf16* orow = Op + ((size_t)b * SEQ + mytok) * DM + h * 64 + 4 * hi;
        ATT_STORE_O(orow, inv);
        if (hi == 0) { f32x2 v; v.x = m; v.y = lt; *(f32x2*)(ml + (size_t)gp * NTOK * NH * 2 + (((size_t)b * SEQ + mytok) * NH + h) * 2) = v; }
        __syncthreads();
    }
#undef DIL_PREFETCH
#undef DIL_PREFETCH_Q
}
}

#define XB_TMO      128
#define XB_XCNT(j)  (256  + 64 * (j))
#define XB_XSUB(j)  (1280 + 64 * (j))
#define XB_XGEN(j)  (2304 + 64 * (j))
#define XB_TOP      3328
#define XB_TOPGEN   3392
#define XCD_BAR_WORDS 3456
#define XB_SPIN_CAP (1u << 18)
__device__ __forceinline__ unsigned xb_ld(unsigned* p)              { return __hip_atomic_load(p, __ATOMIC_RELAXED, __HIP_MEMORY_SCOPE_AGENT); }
__device__ __forceinline__ unsigned xb_add(unsigned* p, unsigned v) { return __hip_atomic_fetch_add(p, v, __ATOMIC_RELAXED, __HIP_MEMORY_SCOPE_AGENT); }
__device__ __forceinline__ unsigned xb_xcc_id() { return (unsigned)__builtin_amdgcn_s_getreg((3 << 11) | 20) & 0xFu; }
#define XB_SPIN(cond, bar) do { unsigned _sp = 0; while (cond) { __builtin_amdgcn_s_sleep(1); \
    if ((++_sp & 255u) == 0u) { if (xb_ld(&(bar)[XB_TMO])) break; if (_sp > XB_SPIN_CAP) { atomicAdd(&(bar)[XB_TMO], 1u); break; } } } } while (0)
struct XcdBarrier { unsigned* bar; unsigned x; volatile LAS unsigned* st; };
__device__ __forceinline__ XcdBarrier xcd_barrier_post(unsigned* bar, volatile LAS unsigned* st) {
    XcdBarrier b; b.bar = bar; b.x = xb_xcc_id(); b.st = st;
    if (threadIdx.x == 0) (void)xb_add(&bar[XB_XCNT(b.x)], 1u);
    return b;
}
__device__ __forceinline__ void xcd_barrier_complete(unsigned* bar, unsigned x, unsigned& nloc, unsigned& nx) {
    const unsigned G = gridDim.x * gridDim.y * gridDim.z;
    unsigned sum, cnt, mine, sp = 0u;
    for (;;) {
        sum = 0u; cnt = 0u; mine = 0u;
#pragma unroll
        for (unsigned j = 0; j < 16; ++j) { const unsigned c = xb_ld(&bar[XB_XCNT(j)]); sum += c; cnt += (c > 0u) ? 1u : 0u; mine = (j == x) ? c : mine; }
        if (sum == G) break;
        __builtin_amdgcn_s_sleep(1);
        if ((++sp & 255u) == 0u) { if (xb_ld(&bar[XB_TMO])) break; if (sp > XB_SPIN_CAP) { atomicAdd(&bar[XB_TMO], 1u); break; } }
    }
    nloc = mine > 0u ? mine : 1u; nx = cnt > 0u ? cnt : 1u;
}
__device__ __forceinline__ void xcd_barrier(const XcdBarrier& b) {
    asm volatile("s_waitcnt vmcnt(0)" ::: "memory");
    __syncthreads();
    if (threadIdx.x == 0) {
        unsigned* bar = b.bar;
        __builtin_amdgcn_s_waitcnt(0);
        unsigned nloc = b.st[0], nx = b.st[1];
        if (nloc == 0u) { xcd_barrier_complete(bar, b.x, nloc, nx); b.st[0] = nloc; b.st[1] = nx; }
        const unsigned old = xb_add(&bar[XB_XSUB(b.x)], 1u);
        const unsigned gen = old / nloc;
        if (old + 1u == (gen + 1u) * nloc) {
            __builtin_amdgcn_fence(__ATOMIC_RELEASE, "agent");
            asm volatile("s_waitcnt vmcnt(0)" ::: "memory");
            const unsigned og = xb_add(&bar[XB_TOP], 1u);
            const unsigned tg = og / nx;
            if (og + 1u == (tg + 1u) * nx) xb_add(&bar[XB_TOPGEN], 1u);
            else XB_SPIN(xb_ld(&bar[XB_TOPGEN]) == tg, bar);
            __builtin_amdgcn_fence(__ATOMIC_ACQUIRE, "agent");
            xb_add(&bar[XB_XGEN(b.x)], 1u);
            asm volatile("s_waitcnt vmcnt(0)" ::: "memory");
        } else {
            XB_SPIN(xb_ld(&bar[XB_XGEN(b.x)]) == gen, bar);
            __builtin_amdgcn_fence(__ATOMIC_ACQUIRE, "agent");
            asm volatile("s_waitcnt vmcnt(0)" ::: "memory");
        }
    }
    __syncthreads();
}

struct Args { const float* in[18]; float* out; unsigned char* ws; int ph_lo, ph_hi; };
struct Frame {
    LAS unsigned char* lds; int tid, lane, wave, vcu, G;
    const float *x, *c, *mod_w, *mod_b, *norm_g, *w_in0, *fox_bias, *w_out0, *w_in1, *w_out1, *relb, *ffn_g, *ffn_u, *ffn_d, *router_w, *ex_g, *ex_u, *ex_d;
    float* out; unsigned char* ws;
};

template <int MODE> __device__ __forceinline__ int dest_row(int n) {
    if (MODE == 0) return n;
    if (MODE == 1) return ((n >> 7) << 8) + (n & 127);
    return n < 1536 ? n : (n >= 1544 ? n - 8 : -1);
}
template <int MODE, bool FP8 = false>
__device__ __forceinline__ void transpose_item(const float* __restrict__ W, int K, int N, bf16* __restrict__ WT, int row_off, LAS float* scr, int item, int lane) {
    const int nblk = (N + 31) / 32, kb = item / nblk, nb = item % nblk, k0 = 64 * kb, n0 = 32 * nb;
    const int nc = n0 + (lane & 31); const bool okc = nc < N;
#pragma unroll 8
    for (int i = 0; i < 32; ++i) { const int kk = 2 * i + (lane >> 5); scr[kk * 33 + (lane & 31)] = okc ? W[(size_t)(k0 + kk) * N + nc] : 0.f; }
    LDS_WAIT(); asm volatile("" ::: "memory");
    const int c = lane & 7;
#pragma unroll
    for (int j = 0; j < 4; ++j) { const int n = (lane >> 3) + 8 * j; const int dr = dest_row<MODE>(n0 + n); const LAS float* s = scr + (8 * c) * 33 + n;
        if constexpr (FP8) { u32x2 o; o.x = pk4_fp8(s[0 * 33] * FP8_SW, s[1 * 33] * FP8_SW, s[2 * 33] * FP8_SW, s[3 * 33] * FP8_SW); o.y = pk4_fp8(s[4 * 33] * FP8_SW, s[5 * 33] * FP8_SW, s[6 * 33] * FP8_SW, s[7 * 33] * FP8_SW);
            if (n0 + n < N && dr >= 0) *(u32x2*)((unsigned char*)WT + (size_t)(row_off + dr) * K + k0 + 8 * c) = o; }
        else { u32x4 o; o.x = pk2(s[0 * 33], s[1 * 33]); o.y = pk2(s[2 * 33], s[3 * 33]); o.z = pk2(s[4 * 33], s[5 * 33]); o.w = pk2(s[6 * 33], s[7 * 33]);
        if (n0 + n < N && dr >= 0) *(u32x4*)(WT + (size_t)(row_off + dr) * K + k0 + 8 * c) = o; } }
    LDS_WAIT(); asm volatile("" ::: "memory");
}

__device__ __forceinline__ void weight_copies(Frame& F) {
    LAS float* scr = (LAS float*)(F.lds + F.wave * 16384);
    const int gw = F.vcu * NWAVES + F.wave, NGW = F.G * NWAVES;
    bf16* wo = (bf16*)(F.ws + WS_WOTHER);
    constexpr int I_IN0 = 16 * 97, I_OUT = 16 * 32, I_IN1 = 16 * 96, I_FG = 16 * 88, I_FD = 44 * 32;
    constexpr int NITEMS = I_IN0 + I_OUT + I_IN1 + I_OUT + 2 * I_FG + I_FD;
    for (int it = gw; it < NITEMS; it += NGW) {
        int r = it;
        if (r < I_IN0) { transpose_item<2>(F.w_in0, DM, DIN0, wo + WO_IN0 / 2, 0, scr, r, F.lane); continue; } r -= I_IN0;
        if (r < I_OUT) { transpose_item<0>(F.w_out0, DM, DM, wo + WO_OUT0 / 2, 0, scr, r, F.lane); continue; } r -= I_OUT;
        if (r < I_IN1) { transpose_item<0>(F.w_in1, DM, 3 * DM, wo + WO_IN1 / 2, 0, scr, r, F.lane); continue; } r -= I_IN1;
        if (r < I_OUT) { transpose_item<0>(F.w_out1, DM, DM, wo + WO_OUT1 / 2, 0, scr, r, F.lane); continue; } r -= I_OUT;
        if (r < I_FG) { transpose_item<1, true>(F.ffn_g, DM, DFF, wo + WO_FGU / 2, 0, scr, r, F.lane); continue; } r -= I_FG;
        if (r < I_FG) { transpose_item<1, true>(F.ffn_u, DM, DFF, wo + WO_FGU / 2, 128, scr, r, F.lane); continue; } r -= I_FG;
        transpose_item<0, true>(F.ffn_d, DFF, DM, wo + WO_FDN / 2, 0, scr, r, F.lane);
    }
    __syncthreads();
}

__device__ __forceinline__ void phase_prologue(Frame& F) {
    if (F.vcu < 192) {
        LAS float* sc = (LAS float*)F.lds;
        LAS float* red = (LAS float*)(F.lds + 32768);
        for (int i = F.tid; i < NB * DM; i += 512) { const float v = F.c[i]; sc[i] = v / (1.f + expf(-v)); }
        __syncthreads();
        const int l = F.vcu / 96, e0 = (F.vcu % 96) * 64, col = F.lane, kq = F.wave;
        float acc[8];
#pragma unroll
        for (int b = 0; b < 8; ++b) acc[b] = 0.f;
        const float* wp = F.mod_w + ((size_t)l * DM + kq * 128) * 6144 + e0 + col;
#pragma unroll 32
        for (int k = 0; k < 128; ++k) { const float w = wp[(size_t)k * 6144];
#pragma unroll
            for (int b = 0; b < 8; ++b) acc[b] += sc[b * DM + kq * 128 + k] * w; }
#pragma unroll
        for (int b = 0; b < 8; ++b) red[(kq * 8 + b) * 64 + col] = acc[b];
        __syncthreads();
        { const int b = F.tid >> 6; float s = 0.f;
#pragma unroll
          for (int q = 0; q < 8; ++q) s += red[(q * 8 + b) * 64 + col];
          ((float*)(F.ws + WS_MODS))[((size_t)l * NB + b) * 6144 + e0 + col] = s + F.mod_b[l * 6144 + e0 + col]; }
        __syncthreads();
    }
}

__device__ __forceinline__ void expert_weight_copies(Frame& F) {
    LAS float* scr = (LAS float*)(F.lds + F.wave * 16384);
    const int gw = F.vcu * NWAVES + F.wave, NGW = F.G * NWAVES;
    constexpr int I_GU = 16 * 112, I_DN = 56 * 32, PER_E = 2 * I_GU + I_DN;
    for (int it = gw; it < NEXP * PER_E; it += NGW) {
        const int e = it / PER_E; int r = it % PER_E;
        bf16* we = (bf16*)(F.ws + WS_WEXP + (size_t)e * WEXP_STRIDE);
        if (r < I_GU) { transpose_item<1, true>(F.ex_g + (size_t)e * DM * DFE, DM, DFE, we, 0, scr, r, F.lane); continue; } r -= I_GU;
        if (r < I_GU) { transpose_item<1, true>(F.ex_u + (size_t)e * DM * DFE, DM, DFE, we, 128, scr, r, F.lane); continue; } r -= I_GU;
        transpose_item<0, true>(F.ex_d + (size_t)e * DFE * DM, DFE, DM, (bf16*)((unsigned char*)we + WEXP_DN_OFF), 0, scr, r, F.lane);
    }
}

template <bool RES, int EXTRA, bool U8 = false>
__device__ __forceinline__ void thin_phase(Frame& F, const float* hin, const bf16* y, const float* gy, const float* gatev  ,
                                           const float* gu, const float* shv, const float* scv, bf16* uout) {
    const int gw = F.vcu * NWAVES + F.wave;
    const int row0 = gw * 16, b = row0 >> 12;
    LAS float* w8 = (LAS float*)F.lds;
    LAS int* lcnt = (LAS int*)(F.lds + 32768);
    if (EXTRA == 1) { for (int i = F.tid; i < 8 * DM; i += 512) { const int k = i >> 3, j = i & 7; w8[j * DM + k] = F.w_in0[(size_t)k * DIN0 + 1536 + j]; } }
    if (EXTRA == 2) { for (int i = F.tid; i < 8 * DM; i += 512) { const int k = i >> 3, j = i & 7; w8[j * DM + k] = F.router_w[(size_t)k * NEXP + j]; }
        if (F.tid < 16) lcnt[F.tid] = 0; }
    if (EXTRA != 0) __syncthreads();
    f32x4 Gv[4], Av[4], Bv[4];
#pragma unroll
    for (int j = 0; j < 4; ++j) { const int c = 256 * j + 4 * F.lane;
        const f32x4 g = *(const f32x4*)(gu + c), s1 = *(const f32x4*)(scv + (size_t)b * 6144 + c); Av[j] = g * (s1 + 1.f); Bv[j] = *(const f32x4*)(shv + (size_t)b * 6144 + c);
        if (RES) Gv[j] = *(const f32x4*)(gatev + (size_t)b * 6144 + c) * *(const f32x4*)(gy + c); }
    for (int i = 0; i < 16; ++i) {
        const int row = row0 + i;
        f32x4 hv[4];
#pragma unroll
        for (int j = 0; j < 4; ++j) hv[j] = *(const f32x4*)(hin + (size_t)row * DM + 256 * j + 4 * F.lane);
        if (RES) {
            f32x4 yv[4]; float ss = 0.f;
#pragma unroll
            for (int j = 0; j < 4; ++j) { const u32x2 w = *(const u32x2*)(y + (size_t)row * DM + 256 * j + 4 * F.lane); yv[j] = (f32x4){bflo(w.x), bfhi(w.x), bflo(w.y), bfhi(w.y)};
#ifdef DBG_SANITIZE
                for (int e_ = 0; e_ < 4; ++e_) if (!(fabsf(yv[j][e_]) < 1e30f)) yv[j][e_] = 0.f;
#endif
                ss += (yv[j].x * yv[j].x + yv[j].y * yv[j].y) + (yv[j].z * yv[j].z + yv[j].w * yv[j].w); }
            const float rstd = 1.f / sqrtf(wave_sum(ss) * (1.f / DM) + NORM_EPS);
#pragma unroll
            for (int j = 0; j < 4; ++j) { hv[j] = hv[j] + Gv[j] * (yv[j] * rstd); *(f32x4*)(F.out + (size_t)row * DM + 256 * j + 4 * F.lane) = hv[j]; }
        }
        float s2 = 0.f;
#pragma unroll
        for (int j = 0; j < 4; ++j) s2 += (hv[j].x * hv[j].x + hv[j].y * hv[j].y) + (hv[j].z * hv[j].z + hv[j].w * hv[j].w);
        const float rs = 1.f / sqrtf(wave_sum(s2) * (1.f / DM) + NORM_EPS);
        f32x4 uv[4];
#pragma unroll
        for (int j = 0; j < 4; ++j) { uv[j] = hv[j] * rs * Av[j] + Bv[j];
            if constexpr (U8) { *(unsigned*)((unsigned char*)uout + (size_t)row * DM + 256 * j + 4 * F.lane) = pk4_fp8(clamp448(uv[j].x * FP8_SU), clamp448(uv[j].y * FP8_SU), clamp448(uv[j].z * FP8_SU), clamp448(uv[j].w * FP8_SU)); }
            else { u32x2 w; w.x = pk2(uv[j].x, uv[j].y); w.y = pk2(uv[j].z, uv[j].w); *(u32x2*)(uout + (size_t)row * DM + 256 * j + 4 * F.lane) = w; } }
        if (EXTRA != 0) {
            float d[8];
#pragma unroll
            for (int q = 0; q < 8; ++q) { float s = 0.f;
#pragma unroll
                for (int j = 0; j < 4; ++j) { const f32x4 w = *(const LAS f32x4*)(w8 + q * DM + 256 * j + 4 * F.lane); s += (uv[j].x * w.x + uv[j].y * w.y) + (uv[j].z * w.z + uv[j].w * w.w); }
                d[q] = wave_sum(s); }
            if (EXTRA == 1) {
                float z = d[0];
#pragma unroll
                for (int q = 1; q < 8; ++q) z = (F.lane == q) ? d[q] : z;
                if (F.lane < 8) { z += F.fox_bias[F.lane]; const float ls = fminf(z, 0.f) - log1pf(expf(-fabsf(z)));
                    ((float*)(F.ws + WS_LOGF))[((size_t)b * 8 + F.lane) * SEQ + (row & (SEQ - 1))] = ls; }
            } else {
                int i1 = 0; float v1 = d[0];
#pragma unroll
                for (int q = 1; q < 8; ++q) if (d[q] > v1) { v1 = d[q]; i1 = q; }
                int i2 = -1; float v2 = -INFINITY;
#pragma unroll
                for (int q = 0; q < 8; ++q) if (q != i1 && d[q] > v2) { v2 = d[q]; i2 = q; }
                if (i2 < 0) { i2 = (i1 + 1) & 7; v2 = v1; }
                const float p1 = 1.f / (1.f + expf(v2 - v1)), p2 = 1.f - p1;
                if (F.lane == 0) {
                    const int rl = row - F.vcu * 128;
                    const int k1 = __hip_atomic_fetch_add(&lcnt[i1], 1, __ATOMIC_RELAXED, __HIP_MEMORY_SCOPE_WORKGROUP);
                    const int k2 = __hip_atomic_fetch_add(&lcnt[i2], 1, __ATOMIC_RELAXED, __HIP_MEMORY_SCOPE_WORKGROUP);
                    lcnt[16 + rl * 2] = i1; lcnt[16 + rl * 2 + 1] = i2; lcnt[16 + 256 + rl * 2] = k1; lcnt[16 + 256 + rl * 2 + 1] = k2;
                    f32x2 pv; pv.x = p1; pv.y = p2; *(f32x2*)((float*)(F.ws + WS_TOKP) + (size_t)row * 2) = pv;
                }
            }
        }
    }
    if (EXTRA == 2) {
        __syncthreads();
        if (F.tid < 8) lcnt[8 + F.tid] = (int)__hip_atomic_fetch_add((unsigned*)(F.ws + WS_CTL) + CW_GCNT + 64 * F.tid, (unsigned)lcnt[F.tid], __ATOMIC_RELAXED, __HIP_MEMORY_SCOPE_AGENT);
        __syncthreads();
        if (F.tid < 256) { const int rl = F.tid >> 1, k = F.tid & 1, e = lcnt[16 + F.tid], rk = lcnt[16 + 256 + F.tid]; const size_t row = (size_t)F.vcu * 128 + rl;
            ((int*)(F.ws + WS_TOKE))[row * 2 + k] = e; ((int*)(F.ws + WS_TOKR))[row * 2 + k] = lcnt[8 + e] + rk; }
        __syncthreads();
    }
}

__device__ __forceinline__ void phase_cum_kmean(Frame& F) {
    if (F.vcu < 64) {
        const float* lf = (const float*)(F.ws + WS_LOGF) + (size_t)F.vcu * SEQ; float* cu = (float*)(F.ws + WS_CUM) + (size_t)F.vcu * SEQ;
        LAS float* wt = (LAS float*)F.lds;
        f32x4 a = *(const f32x4*)(lf + F.tid * 8), c = *(const f32x4*)(lf + F.tid * 8 + 4);
        float v[8] = {a.x, a.y, a.z, a.w, c.x, c.y, c.z, c.w};
#pragma unroll
        for (int i = 1; i < 8; ++i) v[i] += v[i - 1];
        float run = v[7];
#pragma unroll
        for (int o = 1; o < 64; o <<= 1) { const float t = __shfl_up(run, o); if (F.lane >= o) run += t; }
        if (F.lane == 63) wt[F.wave] = run;
        __syncthreads();
        float off = run - v[7];
        for (int w = 0; w < F.wave; ++w) off += wt[w];
        f32x4 o0 = {v[0] + off, v[1] + off, v[2] + off, v[3] + off}, o1 = {v[4] + off, v[5] + off, v[6] + off, v[7] + off};
        *(f32x4*)(cu + F.tid * 8) = o0; *(f32x4*)(cu + F.tid * 8 + 4) = o1;
        __syncthreads();
    }
    const int gw = F.vcu * NWAVES + F.wave, NGW = F.G * NWAVES;
    const bf16* qkv = (const bf16*)(F.ws + WS_RB);
    for (int it = gw; it < NB * 8 * 16; it += NGW) {
        const int blk = it & 15, hh = (it >> 4) & 7, b = it >> 7;
        const bf16* kp = qkv + ((size_t)(32 + hh) * NTOK + (size_t)b * SEQ + blk * 256) * 64 + (F.lane & 7) * 8;
        float s[8] = {0.f, 0.f, 0.f, 0.f, 0.f, 0.f, 0.f, 0.f};
#pragma unroll 8
        for (int i = 0; i < 32; ++i) { const u32x4 w = *(const u32x4*)(kp + (size_t)((F.lane >> 3) + 8 * i) * 64);
            s[0] += bflo(w.x); s[1] += bfhi(w.x); s[2] += bflo(w.y); s[3] += bfhi(w.y); s[4] += bflo(w.z); s[5] += bfhi(w.z); s[6] += bflo(w.w); s[7] += bfhi(w.w); }
#pragma unroll
        for (int q = 0; q < 8; ++q) { s[q] += __shfl_xor(s[q], 8); s[q] += __shfl_xor(s[q], 16); s[q] += __shfl_xor(s[q], 32); }
        if (F.lane < 8) { float* o = (float*)(F.ws + WS_KMEAN) + (size_t)it * 64 + F.lane * 8;
            f32x4 o0 = {s[0], s[1], s[2], s[3]}, o1 = {s[4], s[5], s[6], s[7]}; *(f32x4*)o = o0 * (1.f / 256.f); *(f32x4*)(o + 4) = o1 * (1.f / 256.f); }
    }
    for (int it = gw; it < NB * 8 * 16; it += NGW) {
        const int blk = it & 15, hx = (it >> 4) & 7, b = it >> 7; const int qs = hx;
        const bf16* qp = qkv + ((size_t)qs * NTOK + (size_t)b * SEQ + blk * 256) * 64 + (F.lane & 7) * 8;
        float mq = 0.f, mk = 0.f;
        for (int i0 = 0; i0 < 32; i0 += 8) {
            u32x4 wq[8], wk[8];
#pragma unroll
            for (int i = 0; i < 8; ++i) { wq[i] = *(const u32x4*)(qp + (size_t)((F.lane >> 3) + 8 * (i0 + i)) * 64); wk[i] = *(const u32x4*)(qp + (size_t)8 * NTOK * 64 + (size_t)((F.lane >> 3) + 8 * (i0 + i)) * 64); }
#pragma unroll
            for (int i = 0; i < 8; ++i) { float sq = 0.f, sk = 0.f;
#pragma unroll
                for (int e = 0; e < 4; ++e) { sq += bflo(wq[i][e]) * bflo(wq[i][e]) + bfhi(wq[i][e]) * bfhi(wq[i][e]); sk += bflo(wk[i][e]) * bflo(wk[i][e]) + bfhi(wk[i][e]) * bfhi(wk[i][e]); }
                sq += __shfl_xor(sq, 1); sq += __shfl_xor(sq, 2); sq += __shfl_xor(sq, 4); sk += __shfl_xor(sk, 1); sk += __shfl_xor(sk, 2); sk += __shfl_xor(sk, 4);
                mq = fmaxf(mq, sq); mk = fmaxf(mk, sk); } }
#pragma unroll
        for (int o = 8; o < 64; o <<= 1) { mq = fmaxf(mq, __shfl_xor(mq, o)); mk = fmaxf(mk, __shfl_xor(mk, o)); }
        if (F.lane == 0) { unsigned* w = (unsigned*)(F.ws + WS_CTL) + CW_QKN + 2 * (b * 16 + hx);
            __hip_atomic_fetch_max(w, __builtin_bit_cast(unsigned, sqrtf(mq)), __ATOMIC_RELAXED, __HIP_MEMORY_SCOPE_AGENT);
            __hip_atomic_fetch_max(w + 1, __builtin_bit_cast(unsigned, sqrtf(mk)), __ATOMIC_RELAXED, __HIP_MEMORY_SCOPE_AGENT); }
    }
}

__device__ __forceinline__ void phase_merge(Frame& F) {
    const int gw = F.vcu * NWAVES + F.wave;
    bf16* p0 = (bf16*)(F.ws + WS_RA); const bf16* p1 = (const bf16*)(F.ws + WS_RC); const bf16* p2 = (const bf16*)(F.ws + WS_RD);
    const float* ml = (const float*)(F.ws + WS_ML);
    for (int i = 0; i < 16; ++i) { const size_t row = (size_t)gw * 16 + i;
#pragma unroll
        for (int j = 0; j < 4; ++j) { const int head = 4 * j + (F.lane >> 4); const size_t mi = (row * NH + head) * 2;
            const f32x2 a = *(const f32x2*)(ml + mi), b = *(const f32x2*)(ml + (size_t)NTOK * NH * 2 + mi), c = *(const f32x2*)(ml + (size_t)2 * NTOK * NH * 2 + mi);
            const float M = fmaxf(a.x, fmaxf(b.x, c.x));
            float wa = a.y * __builtin_amdgcn_exp2f(a.x - M), wb = b.y * __builtin_amdgcn_exp2f(b.x - M), wc = c.y * __builtin_amdgcn_exp2f(c.x - M);
            const float inv = 1.f / (wa + wb + wc); wa *= inv; wb *= inv; wc *= inv;
            const size_t off = row * DM + 256 * j + 4 * F.lane;
            const u32x2 xa = *(const u32x2*)(p0 + off), xb = *(const u32x2*)(p1 + off), xc = *(const u32x2*)(p2 + off);
            u32x2 w; w.x = pk2(wa * bflo(xa.x) + wb * bflo(xb.x) + wc * bflo(xc.x), wa * bfhi(xa.x) + wb * bfhi(xb.x) + wc * bfhi(xc.x));
            w.y = pk2(wa * bflo(xa.y) + wb * bflo(xb.y) + wc * bflo(xc.y), wa * bfhi(xa.y) + wb * bfhi(xb.y) + wc * bfhi(xc.y));
            *(u32x2*)(p0 + off) = w; }
    }
}

__device__ __forceinline__ void phase_gather(Frame& F) {
    LAS int* so = (LAS int*)F.lds;
    if (F.tid == 0) { int acc = 0; for (int e = 0; e < 8; ++e) { so[e] = acc; const int c = (int)__hip_atomic_load((unsigned*)(F.ws + WS_CTL) + CW_GCNT + 64 * e, __ATOMIC_RELAXED, __HIP_MEMORY_SCOPE_AGENT); acc += (c + 255) & ~255; } so[8] = acc; }
    __syncthreads();
    if (F.vcu == 0) { int* te = (int*)(F.ws + WS_TILEE); const int nt = so[8] >> 8;
        for (int t = F.tid; t < MAXTILES; t += 512) { int e = 0; for (int q = 1; q < 8; ++q) if (t * 256 >= so[q]) e = q; te[t] = e; }
        if (F.tid == 0) te[MAXTILES] = nt < MAXTILES ? nt : MAXTILES; }
    const int gw = F.vcu * NWAVES + F.wave;
    const bf16* u = (const bf16*)(F.ws + WS_RA); unsigned char* us = F.ws + WS_USORT;
    const int* te = (const int*)(F.ws + WS_TOKE); const int* tr = (const int*)(F.ws + WS_TOKR); int* ts = (int*)(F.ws + WS_TOKS);
    int d_l = 0;
    if (F.lane < 32) { const int e = te[gw * 32 + F.lane] & 7; d_l = so[e] + tr[gw * 32 + F.lane]; d_l = d_l < 0 ? 0 : (d_l >= MAXTILES * 256 ? MAXTILES * 256 - 1 : d_l); ts[gw * 32 + F.lane] = d_l; }
#pragma unroll 1
    for (int i0 = 0; i0 < 16; i0 += 4) {
        u32x4 a[4], b[4];
#pragma unroll
        for (int r = 0; r < 4; ++r) { const size_t row = (size_t)gw * 16 + i0 + r; a[r] = *(const u32x4*)(u + row * DM + F.lane * 8); b[r] = *(const u32x4*)(u + row * DM + 512 + F.lane * 8); }
#pragma unroll
        for (int r = 0; r < 4; ++r) { u32x2 fa, fb;
            fa.x = pk4_fp8(bflo(a[r].x) * FP8_SU, bfhi(a[r].x) * FP8_SU, bflo(a[r].y) * FP8_SU, bfhi(a[r].y) * FP8_SU); fa.y = pk4_fp8(bflo(a[r].z) * FP8_SU, bfhi(a[r].z) * FP8_SU, bflo(a[r].w) * FP8_SU, bfhi(a[r].w) * FP8_SU);
            fb.x = pk4_fp8(bflo(b[r].x) * FP8_SU, bfhi(b[r].x) * FP8_SU, bflo(b[r].y) * FP8_SU, bfhi(b[r].y) * FP8_SU); fb.y = pk4_fp8(bflo(b[r].z) * FP8_SU, bfhi(b[r].z) * FP8_SU, bflo(b[r].w) * FP8_SU, bfhi(b[r].w) * FP8_SU);
#pragma unroll
            for (int k = 0; k < 2; ++k) { const int dst = __builtin_amdgcn_readlane(d_l, 2 * (i0 + r) + k);
                *(u32x2*)(us + (size_t)dst * DM + F.lane * 8) = fa; *(u32x2*)(us + (size_t)dst * DM + 512 + F.lane * 8) = fb; } }
    }
}

__device__ __forceinline__ void phase_final(Frame& F, const float* __restrict__ gy, const float* __restrict__ gatev) {
    const int gw = F.vcu * NWAVES + F.wave; const int row0 = gw * 16, b = row0 >> 12;
    const bf16* ys = (const bf16*)(F.ws + WS_YSLOT); const int* ts = (const int*)(F.ws + WS_TOKS); const float* tp = (const float*)(F.ws + WS_TOKP);
    f32x4 Gv[4];
#pragma unroll
    for (int j = 0; j < 4; ++j) { const int c = 256 * j + 4 * F.lane; Gv[j] = *(const f32x4*)(gatev + (size_t)b * 6144 + c) * *(const f32x4*)(gy + c); }
    for (int i = 0; i < 16; ++i) { const size_t row = (size_t)row0 + i;
        int s1 = ts[row * 2], s2 = ts[row * 2 + 1]; const float p1 = tp[row * 2], p2 = tp[row * 2 + 1];
        s1 = s1 < 0 ? 0 : (s1 >= MAXTILES * 256 ? MAXTILES * 256 - 1 : s1); s2 = s2 < 0 ? 0 : (s2 >= MAXTILES * 256 ? MAXTILES * 256 - 1 : s2);
        f32x4 yv[4]; float ss = 0.f;
#pragma unroll
        for (int j = 0; j < 4; ++j) { const u32x2 wa = *(const u32x2*)(ys + (size_t)s1 * DM + 256 * j + 4 * F.lane), wb = *(const u32x2*)(ys + (size_t)s2 * DM + 256 * j + 4 * F.lane);
            yv[j] = (f32x4){p1 * bflo(wa.x) + p2 * bflo(wb.x), p1 * bfhi(wa.x) + p2 * bfhi(wb.x), p1 * bflo(wa.y) + p2 * bflo(wb.y), p1 * bfhi(wa.y) + p2 * bfhi(wb.y)};
            ss += (yv[j].x * yv[j].x + yv[j].y * yv[j].y) + (yv[j].z * yv[j].z + yv[j].w * yv[j].w); }
        const float rstd = 1.f / sqrtf(wave_sum(ss) * (1.f / DM) + NORM_EPS);
#pragma unroll
        for (int j = 0; j < 4; ++j) { float* op = F.out + row * DM + 256 * j + 4 * F.lane; const f32x4 hv = *(const f32x4*)op; *(f32x4*)op = hv + Gv[j] * (yv[j] * rstd); }
    }
}

constexpr int NPHASES = 21;
__global__ void __launch_bounds__(NWAVES * 64, 2) trunk_fwd(Args args) {
    extern __shared__ __attribute__((aligned(16))) unsigned char lds_raw[];
    Frame F;
    F.lds = (LAS unsigned char*)lds_raw;
    volatile LAS unsigned* MISC = (volatile LAS unsigned*)(F.lds + MISC_OFF);
    F.tid = threadIdx.x; F.lane = F.tid & 63; F.wave = __builtin_amdgcn_readfirstlane(F.tid >> 6);
    F.G = gridDim.x; { const int bx = blockIdx.x; F.vcu = (F.G % 8 == 0) ? (bx % 8) * (F.G / 8) + bx / 8 : bx; }
    F.x = args.in[0]; F.c = args.in[1]; F.mod_w = args.in[2]; F.mod_b = args.in[3]; F.norm_g = args.in[4]; F.w_in0 = args.in[5]; F.fox_bias = args.in[6]; F.w_out0 = args.in[7];
    F.w_in1 = args.in[8]; F.w_out1 = args.in[9]; F.relb = args.in[10]; F.ffn_g = args.in[11]; F.ffn_u = args.in[12]; F.ffn_d = args.in[13]; F.router_w = args.in[14];
    F.ex_g = args.in[15]; F.ex_u = args.in[16]; F.ex_d = args.in[17]; F.out = args.out; F.ws = args.ws;
    for (int u = F.tid; u < (LDS_BYTES - RING_BYTES) / 4; u += NWAVES * 64) ((LAS unsigned*)(F.lds + RING_BYTES))[u] = 0u;
    __syncthreads();
    const int lo = args.ph_lo, hi = args.ph_hi;
    XcdBarrier bar; bar.bar = (unsigned*)(F.ws + WS_CTL) + CW_BAR; bar.x = 0; bar.st = nullptr;
    if (hi - lo > 1) bar = xcd_barrier_post((unsigned*)(F.ws + WS_CTL) + CW_BAR, MISC + 8);
#define IN(k) (lo <= (k) && (k) < hi)
#define SEAM(k) do { if (IN(k) && IN((k) + 1)) xcd_barrier(bar); } while (0)
    const float* mods = (const float*)(F.ws + WS_MODS);
    const float* mods0 = mods, * mods1 = mods + (size_t)NB * 6144;
    const float* ng0 = F.norm_g, * ng1 = F.norm_g + 4 * DM;
    bf16* RA = (bf16*)(F.ws + WS_RA); bf16* RB = (bf16*)(F.ws + WS_RB); bf16* RC = (bf16*)(F.ws + WS_RC); bf16* RD = (bf16*)(F.ws + WS_RD);
    const bf16* wo = (const bf16*)(F.ws + WS_WOTHER);

    if (IN(0)) { phase_prologue(F); } SEAM(0);
    if (IN(1)) { thin_phase<false, 1>(F, F.x, nullptr, nullptr, nullptr, ng0, mods0 + 0, mods0 + 1024, RA); __syncthreads(); weight_copies(F); } SEAM(1);
    if (IN(2)) { pg8::Gemm g{RA, wo + WO_IN0 / 2, NTOK, 3072, DM}; pg8::StaticOrder S; S.init(NTOK, 3072, F.G, (int)blockIdx.x); pg8::EpiHeadMajor E{RB, NTOK, 0xFFull | (0xFFull << 24), att::C2};
        pg8::gemm_phase<pg8::EpiHeadMajor, pg8::StaticOrder>(F.lds, g, S, E); } SEAM(2);
    if (IN(3)) { phase_cum_kmean(F); } SEAM(3);
    if (IN(4)) {
        const int b = F.vcu >> 5, j = F.vcu & 31, a = j & 15;
        const float* cum = (const float*)(F.ws + WS_CUM); const float* km = (const float*)(F.ws + WS_KMEAN); const unsigned* qkn = (const unsigned*)(F.ws + WS_CTL) + CW_QKN;
        for (int r = 0; r < (MK_DUP == 41 ? 8 : 4); ++r) { const int r4 = r & 3; const int a8 = (a + 8) & 15; const int qt = (r4 == 0) ? a : (r4 == 1) ? 15 - a : (r4 == 2) ? a8 : 15 - a8;
            att::attn_unit_v2<1>(F.lds, RB, b, 8 + 2 * r4 + (j >> 4), qt, nullptr, km, F.relb, RA, qkn); }
        { const int hf = j >> 2, qq = j & 3;
          for (int i = 0; i < (MK_DUP == 40 ? 8 : 4); ++i) { const int i4 = i & 3; const int qt = (i4 == 0) ? 15 - qq : (i4 == 1) ? 8 + qq : (i4 == 2) ? 7 - qq : qq;
            att::attn_unit_v2<0>(F.lds, RB, b, hf, qt, cum, nullptr, nullptr, RA, qkn); } }
    } SEAM(4);
    if (IN(5)) { pg8::Gemm g{RA, wo + WO_OUT0 / 2, NTOK, DM, DM}; pg8::StaticOrder S; S.init(NTOK, DM, F.G, (int)blockIdx.x); pg8::EpiBf16 E{RC, DM};
        pg8::gemm_phase<pg8::EpiBf16, pg8::StaticOrder>(F.lds, g, S, E); } SEAM(5);
    if (IN(6)) { thin_phase<true, 0, true>(F, F.x, RC, ng0 + 1 * DM, mods0 + 2048, ng0 + 2 * DM, mods0 + 3072, mods0 + 4096, RA);
#if MK_DUP == 6
        xcd_barrier(bar); thin_phase<true, 0, true>(F, F.x, RC, ng0 + 1 * DM, mods0 + 2048, ng0 + 2 * DM, mods0 + 3072, mods0 + 4096, RA);
#endif
    } SEAM(6);
    if (IN(7)) { { pg8::Gemm g{RA, wo + WO_FGU / 2, NTOK, 2 * DFF, DM / 2}; pg8::StaticOrder S; S.init(NTOK, 2 * DFF, F.G, (int)blockIdx.x); pg8::EpiSwigluFp8 E{(unsigned char*)RB, DFF, 1.f / (FP8_SU * FP8_SW), FP8_SH};
        pg8::gemm_phase<pg8::EpiSwigluFp8, pg8::StaticOrder, true, true, DM / 2>(F.lds, g, S, E); }
#if MK_DUP == 7
        xcd_barrier(bar); { pg8::Gemm g{RA, wo + WO_FGU / 2, NTOK, 2 * DFF, DM / 2}; pg8::StaticOrder S; S.init(NTOK, 2 * DFF, F.G, (int)blockIdx.x); pg8::EpiSwigluFp8 E{(unsigned char*)RB, DFF, 1.f / (FP8_SU * FP8_SW), FP8_SH};
        pg8::gemm_phase<pg8::EpiSwigluFp8, pg8::StaticOrder, true, true, DM / 2>(F.lds, g, S, E); }
#endif
    } SEAM(7);
    if (IN(8)) { pg8::Gemm g{RB, wo + WO_FDN / 2, NTOK, DM, DFF / 2}; pg8::StaticOrder S; S.init(NTOK, DM, F.G, (int)blockIdx.x); pg8::EpiBf16Scaled E{RC, DM, 1.f / (FP8_SH * FP8_SW)};
        pg8::gemm_phase<pg8::EpiBf16Scaled, pg8::StaticOrder, true, true, DFF / 2>(F.lds, g, S, E); } SEAM(8);
    if (IN(9)) { thin_phase<true, 0>(F, F.out, RC, ng0 + 3 * DM, mods0 + 5120, ng1 + 0, mods1 + 0, mods1 + 1024, RA); } SEAM(9);
    if (IN(10)) { pg8::Gemm g{RA, wo + WO_IN1 / 2, NTOK, 3072, DM}; pg8::StaticOrder S; S.init(NTOK, 3072, F.G, (int)blockIdx.x); pg8::EpiHeadMajor E{RB, NTOK, 0xFFFFull, att::C2};
        pg8::gemm_phase<pg8::EpiHeadMajor, pg8::StaticOrder>(F.lds, g, S, E); } SEAM(10);
    if (IN(11)) {
        float* ml = (float*)(F.ws + WS_ML);
        att::dilated_phase(F.lds, RB, F.vcu >> 5, F.vcu & 31, F.relb, RA, RC, RD, ml, (const unsigned*)(F.ws + WS_CTL) + CW_KN1);
    } SEAM(11);
    if (IN(12)) { phase_merge(F); } SEAM(12);
    if (IN(13)) { pg8::Gemm g{RA, wo + WO_OUT1 / 2, NTOK, DM, DM}; pg8::StaticOrder S; S.init(NTOK, DM, F.G, (int)blockIdx.x); pg8::EpiBf16 E{RC, DM};
        pg8::gemm_phase<pg8::EpiBf16, pg8::StaticOrder>(F.lds, g, S, E); } SEAM(13);
    if (IN(14)) { thin_phase<true, 2>(F, F.out, RC, ng1 + 1 * DM, mods1 + 2048, ng1 + 2 * DM, mods1 + 3072, mods1 + 4096, RA); expert_weight_copies(F); } SEAM(14);
    if (IN(15)) { phase_gather(F); } SEAM(15);
    { int t_ = F.tid; asm volatile("" : "+v"(t_)); F.tid = t_; F.lane = t_ & 63; }
    {
        const int* te = (const int*)(F.ws + WS_TILEE);
        const unsigned char* us = F.ws + WS_USORT; unsigned char* hid = F.ws + WS_HID; bf16* ysl = (bf16*)(F.ws + WS_YSLOT);
        const unsigned char* wexp = F.ws + WS_WEXP;
        if (IN(16) || IN(17)) {
            int n = __builtin_amdgcn_readfirstlane(te[MAXTILES]); if (n > MAXTILES) n = MAXTILES;
            if (IN(16) && n > 0) { pg8::Gemm g{(const bf16*)us, (const bf16*)wexp, n * 256, 2 * DFE, DM / 2}; pg8::MoeOrder S; S.so.init(n * 256, 2 * DFE, F.G, (int)blockIdx.x); S.tile_e = te; S.estride = WEXP_STRIDE;
                pg8::EpiSwigluFp8 E{hid, DFE, 1.f / (FP8_SU * FP8_SW), FP8_SH}; pg8::gemm_phase<pg8::EpiSwigluFp8, pg8::MoeOrder, true, true, DM / 2>(F.lds, g, S, E); }
            SEAM(16);
            if (IN(17) && n > 0) { pg8::Gemm g{(const bf16*)hid, (const bf16*)(wexp + WEXP_DN_OFF), n * 256, DM, DFE / 2}; pg8::MoeOrder S; S.so.init(n * 256, DM, F.G, (int)blockIdx.x); S.tile_e = te; S.estride = WEXP_STRIDE;
                pg8::EpiBf16Scaled E{ysl, DM, 1.f / (FP8_SH * FP8_SW)}; pg8::gemm_phase<pg8::EpiBf16Scaled, pg8::MoeOrder, true, true, DFE / 2>(F.lds, g, S, E); }
            SEAM(17);
        }
    }
    { int t_ = F.tid; asm volatile("" : "+v"(t_)); F.tid = t_; F.lane = t_ & 63; }
    if (IN(20)) { phase_final(F, ng1 + 3 * DM, mods1 + 5120); }
#undef IN
#undef SEAM
}

extern "C" void kernel_launch(void* const* d_in, const int* in_sizes, int n_in, void* d_out, int out_size, void* d_ws, size_t ws_size, hipStream_t stream) {
    static int grid = 0;
    if (grid == 0) {
        if (n_in != 18 || in_sizes[0] != NTOK * DM || out_size != NTOK * DM || ws_size < WS_END) { fprintf(stderr, "kernel_launch: unexpected shapes / workspace (%d inputs, ws %zu, need %zu); nothing launched\n", n_in, ws_size, (size_t)WS_END); grid = -1; return; }
        int dev = 0, cus = 0, per_cu = 0;
        if (hipGetDevice(&dev) != hipSuccess || hipDeviceGetAttribute(&cus, hipDeviceAttributeMultiprocessorCount, dev) != hipSuccess) { grid = -1; return; }
        if (hipFuncSetAttribute((const void*)trunk_fwd, hipFuncAttributeMaxDynamicSharedMemorySize, LDS_BYTES) != hipSuccess) { fprintf(stderr, "kernel_launch: hipFuncSetAttribute failed\n"); grid = -1; return; }
        if (hipOccupancyMaxActiveBlocksPerMultiprocessor(&per_cu, (const void*)trunk_fwd, NWAVES * 64, LDS_BYTES) != hipSuccess || per_cu < 1) { fprintf(stderr, "kernel_launch: occupancy query reports %d\n", per_cu); }
        (void)hipGetLastError();
        grid = cus;
        if (grid != 256) { fprintf(stderr, "kernel_launch: built for 256 CUs, found %d; nothing launched\n", grid); grid = -1; return; }
    }
    if (grid < 0) return;
    if (hipMemsetAsync((char*)d_ws + WS_CTL, 0, CTL_ZERO_BYTES, stream) != hipSuccess) return;
    Args a{};
    for (int i = 0; i < 18; ++i) a.in[i] = (const float*)d_in[i];
    a.out = (float*)d_out; a.ws = (unsigned char*)d_ws;
#if MK_ONE_LAUNCH
    a.ph_lo = 0; a.ph_hi = MK_LAST_PHASE;
    hipLaunchKernelGGL(trunk_fwd, dim3(grid), dim3(NWAVES * 64), LDS_BYTES, stream, a);
#else
    for (int p = 0; p < MK_LAST_PHASE; ++p) { a.ph_lo = p; a.ph_hi = p + 1; hipLaunchKernelGGL(trunk_fwd, dim3(grid), dim3(NWAVES * 64), LDS_BYTES, stream, a); }
#endif
}
```

```cpp
#include <hip/hip_runtime.h>
#include <cstdio>
#include <cstdint>

#ifndef MK_ONE_LAUNCH
#define MK_ONE_LAUNCH 1
#endif
#ifndef MK_DUP
#define MK_DUP 0
#endif
#ifndef MK_LAST_PHASE
#define MK_LAST_PHASE 21
#endif

#define GAS __attribute__((address_space(1)))
#define LAS __attribute__((address_space(3)))
typedef unsigned short bf16;
typedef unsigned u32x4 __attribute__((ext_vector_type(4)));
typedef unsigned u32x2 __attribute__((ext_vector_type(2)));
typedef float f32x4 __attribute__((ext_vector_type(4)));
typedef float f32x2 __attribute__((ext_vector_type(2)));
typedef float f32x16 __attribute__((ext_vector_type(16)));
typedef short bf16x8 __attribute__((ext_vector_type(8)));
typedef short s16x4 __attribute__((ext_vector_type(4)));
typedef GAS unsigned gu32;

constexpr int NB = 8, SEQ = 4096, DM = 1024, NTOK = NB * SEQ, NH = 16, HD = 64;
constexpr int DFF = 2816, NEXP = 8, DFE = 3584;
constexpr int QKVP = 3072;
constexpr int DIN0 = 3080;
constexpr float NORM_EPS = 1e-6f;
constexpr float LOG2E = 1.4426950408889634f;
constexpr int NWAVES = 8;
constexpr int MAXTILES = 264;
constexpr int PASS0_TILES = 128, PASS1_MAXTILES = MAXTILES - PASS0_TILES;

constexpr size_t MiB = 1u << 20;
constexpr size_t WS_CTL = 0, CTL_ZERO_BYTES = 1 * MiB;
constexpr size_t WS_MODS = 1 * MiB;
constexpr size_t WS_LOGF = 2 * MiB;
constexpr size_t WS_CUM = 3 * MiB;
constexpr size_t WS_KMEAN = 4 * MiB;
constexpr size_t WS_TOKE = 5 * MiB;
constexpr size_t WS_TOKP = WS_TOKE + 256 * 1024;
constexpr size_t WS_TOKR = WS_TOKP + 256 * 1024;
constexpr size_t WS_TOKS = WS_TOKR + 256 * 1024;
constexpr size_t WS_TILEE = 6 * MiB;
constexpr size_t WS_ML = 8 * MiB;
constexpr size_t WS_RA = 24 * MiB;
constexpr size_t WS_RC = 88 * MiB;
constexpr size_t WS_WOTHER = 152 * MiB;
constexpr size_t WS_RB = 185 * MiB;
constexpr size_t WS_RD = 377 * MiB;
constexpr size_t WS_HID = 24 * MiB;
constexpr size_t WS_USORT = 262 * MiB;
constexpr size_t WS_YSLOT = 328 * MiB;
constexpr size_t WS_WEXP = 460 * MiB;
constexpr size_t WS_END = 544 * MiB;
constexpr size_t WEXP_STRIDE = 10 * MiB + 512 * 1024, WEXP_DN_OFF = 7 * MiB;
constexpr float FP8_SW = 64.f, FP8_SU = 4.f, FP8_SH = 8.f;
constexpr size_t WO_IN0 = 0, WO_OUT0 = 6 * MiB, WO_IN1 = 8 * MiB, WO_OUT1 = 14 * MiB, WO_FGU = 16 * MiB, WO_FDN = 27 * MiB;
static_assert(WS_RB + (size_t)NTOK * QKVP * 2 <= WS_RD && WS_HID + (size_t)MAXTILES * 256 * DFE <= WS_USORT && WS_USORT + (size_t)MAXTILES * 256 * DM <= WS_YSLOT && WS_YSLOT + (size_t)MAXTILES * 256 * DM * 2 <= WS_WEXP && WS_WEXP + 8 * WEXP_STRIDE <= WS_END, "d_ws map");
constexpr int CW_GCNT = 1024;
constexpr int CW_QKN = 2048;
constexpr int CW_KN1 = 3072;
constexpr int CW_BAR = 4096;

constexpr int RING_BYTES = 131072;
constexpr int MISC_OFF = RING_BYTES + 320;
constexpr int LDS_BYTES = 147456;

__device__ __forceinline__ unsigned f2bf(float f) { unsigned u = __builtin_bit_cast(unsigned, f); return (u + 0x7fffu + ((u >> 16) & 1u)) >> 16; }
__device__ __forceinline__ unsigned pk2(float lo, float hi) { return f2bf(lo) | (f2bf(hi) << 16); }
__device__ __forceinline__ float bf2f(unsigned short b) { return __builtin_bit_cast(float, (unsigned)b << 16); }
__device__ __forceinline__ float bflo(unsigned w) { return __builtin_bit_cast(float, w << 16); }
__device__ __forceinline__ float bfhi(unsigned w) { return __builtin_bit_cast(float, w & 0xffff0000u); }
__device__ __forceinline__ float wave_sum(float v) {
#pragma unroll
    for (int o = 1; o < 64; o <<= 1) v += __shfl_xor(v, o);
    return v;
}
__device__ __forceinline__ unsigned pk4_fp8(float a, float b, float c, float d) { unsigned w = __builtin_amdgcn_cvt_pk_fp8_f32(a, b, 0u, false); return __builtin_amdgcn_cvt_pk_fp8_f32(c, d, w, true); }
__device__ __forceinline__ float clamp448(float v) { return __builtin_amdgcn_fmed3f(v, -448.f, 448.f); }
#define LDS_WAIT() asm volatile("s_waitcnt lgkmcnt(0)" ::: "memory")
#define VM_WAIT() asm volatile("s_waitcnt vmcnt(0)" ::: "memory")

namespace pg8 {
typedef unsigned short bf16_t;
typedef int v8i_t __attribute__((ext_vector_type(8)));
constexpr int BM = 256, BK = 64, HALF = 128, HTB = HALF * BK * 2, STAGE_BYTES = 8 * HTB, NXCD = 8, WGM = 8;
__host__ __device__ __forceinline__ int lds_byte(int r, int c) { const int st = (r >> 4) * 2 + (c >> 5), rr = r & 15, cc = c & 31, ob = rr * 64 + cc * 2; return st * 1024 + (ob ^ (((ob >> 9) & 1) << 5)); }
__host__ __device__ __forceinline__ void stage_rc(int b, int& R, int& C) { const int st = b / 1024, sb = b % 1024, swz = sb ^ (((sb >> 9) & 1) << 5); R = (st >> 1) * 16 + swz / 64; C = (st & 1) * 32 + (swz % 64) / 2; }
__host__ __device__ __forceinline__ int perm32(int rho) { const int n = rho >> 4, i = rho & 15; return 8 * (i >> 2) + 4 * n + (i & 3); }

struct Unit { int pm, pn; };
struct Gemm { const bf16_t* A; const bf16_t* Bt; int M, N, K; };

struct StaticOrder {
    int nM, nN, nwg, G, c, wgm = WGM;
    __device__ void init(int M, int N, int G_, int c_) { nM = M / BM; nN = N / BM; nwg = nM * nN; G = G_; c = c_; }
    __device__ bool next(int i, Unit& u) const {
        const long L = (long)i * G + c; if (L >= nwg) return false;
        int wgid = (int)L; { const int q = nwg / NXCD, r = nwg % NXCD, xcd = wgid % NXCD, off = wgid / NXCD; wgid = (xcd < r ? xcd * (q + 1) : r * (q + 1) + (xcd - r) * q) + off; }
        const int nig = wgm * nN, gid = wgid / nig, fm = gid * wgm, gsz = (nM - fm) < wgm ? (nM - fm) : wgm;
        u.pm = fm + ((wgid % nig) % gsz); u.pn = (wgid % nig) / gsz; return true;
    }
    __device__ __forceinline__ const char* abase(const Gemm& g, const Unit& u) const { return (const char*)g.A + (size_t)u.pm * ((size_t)BM * g.K * 2); }
    __device__ __forceinline__ const char* bbase(const Gemm& g, const Unit& u) const { return (const char*)g.Bt + (size_t)u.pn * ((size_t)BM * g.K * 2); }
};
struct MoeOrder {
    StaticOrder so; const int* tile_e; size_t estride;
    __device__ bool next(int i, Unit& u) const { return so.next(i, u); }
    __device__ __forceinline__ const char* abase(const Gemm& g, const Unit& u) const { return (const char*)g.A + (size_t)u.pm * ((size_t)BM * g.K * 2); }
    __device__ __forceinline__ const char* bbase(const Gemm& g, const Unit& u) const { const int e = __builtin_amdgcn_readfirstlane(tile_e[u.pm]); return (const char*)g.Bt + (size_t)e * estride + (size_t)u.pn * ((size_t)BM * g.K * 2); }
};

typedef float f32x2_t __attribute__((ext_vector_type(2))); typedef __bf16 bf16x2_t __attribute__((ext_vector_type(2)));
__device__ __forceinline__ unsigned cvt_pk_bf16(float lo, float hi) { f32x2_t v = {lo, hi}; bf16x2_t b = __builtin_convertvector(v, bf16x2_t); return __builtin_bit_cast(unsigned, b); }

struct EpiBf16 {
    static constexpr bool PERM = true;
    bf16_t* O; int ldc;
    __device__ __forceinline__ void operator()(const f32x4 (&acc)[2][2][4][2], const Unit& u, int wr, int wc, int fr, int fq) const {
        const int row0 = u.pm * BM + wr * 64 + fr; const int col0 = u.pn * BM + wc * 32 + 8 * fq;
#pragma unroll
        for (int ai = 0; ai < 2; ++ai)
#pragma unroll
            for (int m = 0; m < 4; ++m) { bf16_t* rowp = O + (size_t)(row0 + ai * HALF + m * 16) * ldc + col0;
#pragma unroll
                for (int bj = 0; bj < 2; ++bj) { const f32x4 v0 = acc[ai][bj][m][0], v1 = acc[ai][bj][m][1];
                    u32x4 w; w.x = cvt_pk_bf16(v0[0], v0[1]); w.y = cvt_pk_bf16(v0[2], v0[3]); w.z = cvt_pk_bf16(v1[0], v1[1]); w.w = cvt_pk_bf16(v1[2], v1[3]);
                    *(u32x4*)(rowp + bj * HALF) = w; } }
    }
};
struct EpiHeadMajor {
    static constexpr bool PERM = true;
    bf16_t* O; int M; unsigned long long qmask; float qscale;
    __device__ __forceinline__ void operator()(const f32x4 (&acc)[2][2][4][2], const Unit& u, int wr, int wc, int fr, int fq) const {
        const int row0 = u.pm * BM + wr * 64 + fr; const int col0 = u.pn * BM + wc * 32 + 8 * fq;
#pragma unroll
        for (int ai = 0; ai < 2; ++ai)
#pragma unroll
            for (int m = 0; m < 4; ++m) { const int row = row0 + ai * HALF + m * 16;
#pragma unroll
                for (int bj = 0; bj < 2; ++bj) { const int col = col0 + bj * HALF; const float sc = ((qmask >> (col >> 6)) & 1ull) ? qscale : 1.f; const f32x4 v0 = acc[ai][bj][m][0] * sc, v1 = acc[ai][bj][m][1] * sc;
                    u32x4 w; w.x = cvt_pk_bf16(v0[0], v0[1]); w.y = cvt_pk_bf16(v0[2], v0[3]); w.z = cvt_pk_bf16(v1[0], v1[1]); w.w = cvt_pk_bf16(v1[2], v1[3]);
                    *(u32x4*)(O + ((size_t)(col >> 6) * M + row) * 64 + (col & 63)) = w; } }
    }
};
__device__ __forceinline__ float silu_mul(float g, float u) { return g * u * __builtin_amdgcn_rcpf(1.f + __builtin_amdgcn_exp2f(-g * LOG2E)); }
struct EpiBf16Scaled {
    static constexpr bool PERM = true;
    bf16_t* O; int ldc; float scale;
    __device__ __forceinline__ void operator()(const f32x4 (&acc)[2][2][4][2], const Unit& u, int wr, int wc, int fr, int fq) const {
        const int row0 = u.pm * BM + wr * 64 + fr; const int col0 = u.pn * BM + wc * 32 + 8 * fq;
#pragma unroll
        for (int ai = 0; ai < 2; ++ai)
#pragma unroll
            for (int m = 0; m < 4; ++m) { bf16_t* rowp = O + (size_t)(row0 + ai * HALF + m * 16) * ldc + col0;
#pragma unroll
                for (int bj = 0; bj < 2; ++bj) { const f32x4 v0 = acc[ai][bj][m][0] * scale, v1 = acc[ai][bj][m][1] * scale;
                    u32x4 w; w.x = cvt_pk_bf16(v0[0], v0[1]); w.y = cvt_pk_bf16(v0[2], v0[3]); w.z = cvt_pk_bf16(v1[0], v1[1]); w.w = cvt_pk_bf16(v1[2], v1[3]);
                    *(u32x4*)(rowp + bj * HALF) = w; } }
    }
};
struct EpiSwigluFp8 {
    static constexpr bool PERM = true;
    unsigned char* O; int ldc; float sin, sout;
    __device__ __forceinline__ void operator()(const f32x4 (&acc)[2][2][4][2], const Unit& u, int wr, int wc, int fr, int fq) const {
        const int row0 = u.pm * BM + wr * 64 + fr; const int col0 = u.pn * HALF + wc * 32 + 8 * fq;
#pragma unroll
        for (int ai = 0; ai < 2; ++ai)
#pragma unroll
            for (int m = 0; m < 4; ++m) { unsigned char* rowp = O + (size_t)(row0 + ai * HALF + m * 16) * ldc + col0;
                const f32x4 ag0 = acc[ai][0][m][0], ag1 = acc[ai][0][m][1];
                const f32x4 t0 = ag0 * (-sin * LOG2E), t1 = ag1 * (-sin * LOG2E);
                f32x4 d0, d1;
#pragma unroll
                for (int e = 0; e < 4; ++e) { d0[e] = __builtin_amdgcn_exp2f(t0[e]); d1[e] = __builtin_amdgcn_exp2f(t1[e]); }
                d0 = d0 + 1.f; d1 = d1 + 1.f;
                f32x4 r0, r1;
#pragma unroll
                for (int e = 0; e < 4; ++e) { r0[e] = __builtin_amdgcn_rcpf(d0[e]); r1[e] = __builtin_amdgcn_rcpf(d1[e]); }
                const f32x4 v0 = (ag0 * acc[ai][1][m][0]) * (sin * sin * sout) * r0, v1 = (ag1 * acc[ai][1][m][1]) * (sin * sin * sout) * r1;
                u32x2 w; w.x = pk4_fp8(clamp448(v0[0]), clamp448(v0[1]), clamp448(v0[2]), clamp448(v0[3]));
                w.y = pk4_fp8(clamp448(v1[0]), clamp448(v1[1]), clamp448(v1[2]), clamp448(v1[3]));
                *(u32x2*)rowp = w; __builtin_amdgcn_sched_barrier(0); }
    }
};
struct EpiSwiglu {
    static constexpr bool PERM = true;
    bf16_t* O; int ldc;
    __device__ __forceinline__ void operator()(const f32x4 (&acc)[2][2][4][2], const Unit& u, int wr, int wc, int fr, int fq) const {
        const int row0 = u.pm * BM + wr * 64 + fr; const int col0 = u.pn * HALF + wc * 32 + 8 * fq;
#pragma unroll
        for (int ai = 0; ai < 2; ++ai)
#pragma unroll
            for (int m = 0; m < 4; ++m) { bf16_t* rowp = O + (size_t)(row0 + ai * HALF + m * 16) * ldc + col0;
                const f32x4 g0 = acc[ai][0][m][0], g1 = acc[ai][0][m][1], u0 = acc[ai][1][m][0], u1 = acc[ai][1][m][1];
                u32x4 w; w.x = cvt_pk_bf16(silu_mul(g0[0], u0[0]), silu_mul(g0[1], u0[1])); w.y = cvt_pk_bf16(silu_mul(g0[2], u0[2]), silu_mul(g0[3], u0[3]));
                w.z = cvt_pk_bf16(silu_mul(g1[0], u1[0]), silu_mul(g1[1], u1[1])); w.w = cvt_pk_bf16(silu_mul(g1[2], u1[2]), silu_mul(g1[3], u1[3]));
                *(u32x4*)rowp = w; }
    }
};

__device__ __forceinline__ void glds16s(const void* sbase, unsigned voff, unsigned lds_dst) { unsigned keep;
    asm volatile("s_mov_b32 %0, m0\n\ts_mov_b32 m0, %3\n\ts_nop 0\n\tglobal_load_lds_dwordx4 %2, %1\n\ts_mov_b32 m0, %0" : "=&s"(keep) : "s"(sbase), "v"(voff), "s"(lds_dst) : "memory"); }
template <class Epi, class Sched, bool ALIGN_EPI = true, bool FP8 = false, int KC = 0>
__device__ __forceinline__ void gemm_phase(LAS unsigned char* lds, const Gemm g, const Sched& S, const Epi& E) {
    const int tid = threadIdx.x, wid = __builtin_amdgcn_readfirstlane(tid >> 6), lane = tid & 63, wr = wid >> 2, wc = wid & 3, fr = lane & 15, fq = lane >> 4;
    const int K = KC > 0 ? KC : g.K, nt = K / BK;
    unsigned voffA[2], voffB[2];
#pragma unroll
    for (int i = 0; i < 2; ++i) { int R, C; stage_rc(tid * 16 + i * 8192, R, C); const int Rb = Epi::PERM ? ((R & ~31) + perm32(R & 31)) : R;
        voffA[i] = (unsigned)(R * K + C) * 2u; voffB[i] = (unsigned)(Rb * K + C) * 2u; }
    const size_t kstep = (size_t)(BK * 2);
    const size_t hstep = (size_t)HALF * K * 2;
    const unsigned ldsw = (unsigned)wid * 1024u;
    const unsigned lds_u32 = (unsigned)(unsigned long long)lds;
    const int aoff = lds_byte(wr * 64 + fr, fq * 8), boff = lds_byte(wc * 32 + fr, fq * 8);
    const int aoff8 = lds_byte(wr * 64 + fr, (fq & 1) * 16) + (fq >> 1) * 1024, boff8 = lds_byte(wc * 32 + fr, (fq & 1) * 16) + (fq >> 1) * 1024;
#define PG8_SA(b, h) (((b) * 2 + (h)) * HTB)
#define PG8_SB(b, h) ((4 + (b) * 2 + (h)) * HTB)
#define PG8_STAGE(bufoff, gbase, voff) do { _Pragma("unroll") for (int _i = 0; _i < 2; ++_i) \
        glds16s((const void*)(gbase), (voff)[_i], lds_u32 + (unsigned)(bufoff) + ldsw + (unsigned)(_i * 8192)); } while (0)
#define PG8_LD8(p_) (*(const LAS v8i_t*)(p_))
#define PG8_LDA(dst, b, h) do { if constexpr (FP8) { _Pragma("unroll") for (int m = 0; m < 4; ++m) dst##8[m] = PG8_LD8(lds + PG8_SA(b, h) + aoff8 + m * 2048); } \
        else { _Pragma("unroll") for (int m = 0; m < 4; ++m) _Pragma("unroll") for (int k = 0; k < 2; ++k) dst[m][k] = *(const LAS bf16x8*)(lds + PG8_SA(b, h) + aoff + m * 2048 + k * 1024); } } while (0)
#define PG8_LDB(dst, b, h) do { if constexpr (FP8) { _Pragma("unroll") for (int n = 0; n < 2; ++n) dst##8[n] = PG8_LD8(lds + PG8_SB(b, h) + boff8 + n * 2048); } \
        else { _Pragma("unroll") for (int n = 0; n < 2; ++n) _Pragma("unroll") for (int k = 0; k < 2; ++k) dst[n][k] = *(const LAS bf16x8*)(lds + PG8_SB(b, h) + boff + n * 2048 + k * 1024); } } while (0)
#define PG8_MMA(ai, bj, At, Bt) do { __builtin_amdgcn_s_setprio(1); if constexpr (FP8) { _Pragma("unroll") for (int m = 0; m < 4; ++m) _Pragma("unroll") for (int n = 0; n < 2; ++n) \
            asm volatile("v_mfma_f32_16x16x128_f8f6f4 %0, %1, %2, %0" : "+v"(acc[ai][bj][m][n]) : "v"(Bt##8[n]), "v"(At##8[m])); } \
        else { _Pragma("unroll") for (int m = 0; m < 4; ++m) _Pragma("unroll") for (int n = 0; n < 2; ++n) _Pragma("unroll") for (int k = 0; k < 2; ++k) \
        acc[ai][bj][m][n] = __builtin_amdgcn_mfma_f32_16x16x32_bf16(Bt[n][k], At[m][k], acc[ai][bj][m][n], 0, 0, 0); } __builtin_amdgcn_s_setprio(0); } while (0)
#define PG8_WAIT_V(n) asm volatile("s_waitcnt vmcnt(" #n ")" ::: "memory")
#define PG8_WAIT_L(n) asm volatile("s_waitcnt lgkmcnt(" #n ")" ::: "memory")
#define PG8_BAR __builtin_amdgcn_s_barrier()
#define PG8_SCHED __builtin_amdgcn_sched_barrier(0)
    Unit cur, nxt; int ui = 0;
    if (!S.next(0, cur)) return;
    f32x4 acc[2][2][4][2];
#pragma unroll
    for (int a = 0; a < 2; ++a)
#pragma unroll
        for (int b = 0; b < 2; ++b)
#pragma unroll
            for (int m = 0; m < 4; ++m)
#pragma unroll
                for (int n = 0; n < 2; ++n) acc[a][b][m][n] = (f32x4){0.f, 0.f, 0.f, 0.f};
    bf16x8 At[4][2], B0[2][2], B1[2][2]; v8i_t At8[4], B08[2], B18[2];
    const char* cA = S.abase(g, cur); const char* cB = S.bbase(g, cur);
    PG8_STAGE(PG8_SB(0, 0), cB, voffB); PG8_STAGE(PG8_SB(0, 1), cB + hstep, voffB); PG8_STAGE(PG8_SA(0, 0), cA, voffA); PG8_STAGE(PG8_SA(0, 1), cA + hstep, voffA);
    if (wr == 1) PG8_BAR;
    PG8_WAIT_V(2); PG8_BAR;
    PG8_STAGE(PG8_SB(1, 0), cB + kstep, voffB); PG8_STAGE(PG8_SA(1, 0), cA + kstep, voffA); PG8_STAGE(PG8_SB(1, 1), cB + hstep + kstep, voffB);
    PG8_WAIT_V(6); PG8_BAR;
    for (;;) {
        const bool has_next = S.next(ui + 1, nxt);
        const char* nA = cA; const char* nB = cB;
        if (has_next) { nA = S.abase(g, nxt); nB = S.bbase(g, nxt); }
        for (int t = 0; t < nt; t += 2) {
            const bool last = (t == nt - 2);
            const char* a1 = cA + (size_t)(t + 1) * kstep;
            const char* a2 = last ? nA : cA + (size_t)(t + 2) * kstep; const char* b2 = last ? nB : cB + (size_t)(t + 2) * kstep;
            const char* a3 = a2 + kstep; const char* b3 = b2 + kstep;
            PG8_LDB(B0, 0, 0); PG8_LDB(B1, 0, 1); PG8_SCHED; PG8_LDA(At, 0, 0); PG8_STAGE(PG8_SA(1, 1), a1 + hstep, voffA);
            PG8_WAIT_V(8); PG8_WAIT_L(0); PG8_BAR; PG8_MMA(0, 0, At, B0); PG8_MMA(0, 1, At, B1); PG8_BAR; PG8_SCHED;
            PG8_LDA(At, 0, 1); PG8_STAGE(PG8_SB(0, 0), b2, voffB); PG8_STAGE(PG8_SB(0, 1), b2 + hstep, voffB); PG8_STAGE(PG8_SA(0, 0), a2, voffA);
            PG8_WAIT_V(8); PG8_WAIT_L(0); PG8_BAR; PG8_MMA(1, 0, At, B0); PG8_MMA(1, 1, At, B1); PG8_BAR; PG8_SCHED;
            PG8_LDB(B0, 1, 0); PG8_LDB(B1, 1, 1); PG8_SCHED; PG8_LDA(At, 1, 0); PG8_STAGE(PG8_SA(0, 1), a2 + hstep, voffA);
            PG8_WAIT_V(8); PG8_WAIT_L(0); PG8_BAR; PG8_MMA(0, 0, At, B0); PG8_MMA(0, 1, At, B1); PG8_BAR; PG8_SCHED;
            PG8_LDA(At, 1, 1); PG8_STAGE(PG8_SB(1, 0), b3, voffB); PG8_STAGE(PG8_SB(1, 1), b3 + hstep, voffB); PG8_STAGE(PG8_SA(1, 0), a3, voffA);
            PG8_WAIT_V(8); PG8_WAIT_L(0); PG8_BAR; PG8_MMA(1, 0, At, B0); PG8_MMA(1, 1, At, B1); PG8_BAR; PG8_SCHED;
        }
        if constexpr (ALIGN_EPI) { if (wr == 0) PG8_BAR; }
        if constexpr (FP8) asm volatile("s_nop 15\n\ts_nop 15" ::: "memory");
        E(acc, cur, wr, wc, fr, fq);
#if MK_DUP == 116
        if constexpr (FP8) { asm volatile("" ::: "memory"); E(acc, cur, wr, wc, fr, fq); }
#endif
        if (!has_next) break;
#pragma unroll
        for (int a = 0; a < 2; ++a)
#pragma unroll
            for (int b = 0; b < 2; ++b)
#pragma unroll
                for (int m = 0; m < 4; ++m)
#pragma unroll
                    for (int n = 0; n < 2; ++n) acc[a][b][m][n] = (f32x4){0.f, 0.f, 0.f, 0.f};
        cur = nxt; cA = nA; cB = nB; ++ui;
        if constexpr (ALIGN_EPI) { if (wr == 1) PG8_BAR; }
    }
    PG8_WAIT_V(0);
    if constexpr (!ALIGN_EPI) { if (wr == 0) PG8_BAR; }
    PG8_BAR;
#undef PG8_SA
#undef PG8_SB
#undef PG8_STAGE
#undef PG8_LDA
#undef PG8_LDB
#undef PG8_MMA
#undef PG8_WAIT_V
#undef PG8_WAIT_L
#undef PG8_BAR
#undef PG8_SCHED
}
}

namespace att {
constexpr int KS = 0, VS = 16384, TAB = 32768, KM = TAB + 4224 * 4, LDS_END = KM + 4096;
constexpr float C2 = 0.125f * LOG2E;
constexpr float NEG = -1e30f;
__device__ __forceinline__ int crow(int r, int hi) { return (r & 3) + 8 * (r >> 2) + 4 * hi; }
__device__ __forceinline__ int t5_bucket(int d) {
    if (d < 16) return d < 0 ? 0 : d;
    int b = 16;
    b += (d >= 22); b += (d >= 30); b += (d >= 40); b += (d >= 54); b += (d >= 73); b += (d >= 99); b += (d >= 134); b += (d >= 182);
    b += (d >= 246); b += (d >= 332); b += (d >= 450); b += (d >= 609); b += (d >= 825); b += (d >= 1117); b += (d >= 1513);
    return b;
}
__device__ __forceinline__ float swapmax(float m) { return fmaxf(m, __shfl_xor(m, 32)); }
__device__ __forceinline__ float swapsum(float m) { return m + __shfl_xor(m, 32); }
typedef short v4i16_t __attribute__((ext_vector_type(4)));
__device__ __forceinline__ s16x4 vtr(const LAS unsigned char* p) { return __builtin_bit_cast(s16x4, __builtin_amdgcn_ds_read_tr16_b64_v4i16((LAS v4i16_t*)p)); }

constexpr int R_K = 0, R_V = 32768, R_TAB = 65536, R_KM = R_TAB + 4288 * 4, R_TS = R_KM + 4096, R_END = R_TS + 64;
#define ATT_WAITBAR(N) asm volatile("s_waitcnt vmcnt(" #N ") lgkmcnt(0)\n\ts_barrier" ::: "memory")
__device__ __forceinline__ bf16x8 scale_q(bf16x8 q) { bf16x8 r;
#pragma unroll
    for (int e = 0; e < 8; ++e) r[e] = (short)f2bf(bf2f((unsigned short)q[e]) * C2);
    return r; }

#define ATT_QK(Ks) do { _Pragma("unroll") for (int d0 = 0; d0 < 4; ++d0) { const bf16x8 k0_ = *(const LAS bf16x8*)((Ks) + koff[d0]), k1_ = *(const LAS bf16x8*)((Ks) + koff[d0] + 4096); \
        p0 = __builtin_amdgcn_mfma_f32_32x32x16_bf16(k0_, qr[d0], p0, 0, 0, 0); p1 = __builtin_amdgcn_mfma_f32_32x32x16_bf16(k1_, qr[d0], p1, 0, 0, 0); } } while (0)
#define ATT_SOFTMAX_PV(vp) do { \
        float mx_ = fmaxf(p0[0], p1[0]); \
        _Pragma("unroll") for (int r = 1; r < 16; ++r) mx_ = fmaxf(mx_, fmaxf(p0[r], p1[r])); \
        mx_ = swapmax(mx_); \
        const float mn_ = fmaxf(m, mx_); \
        if (__any(mn_ > m)) { const float alpha_ = __builtin_amdgcn_exp2f(m - mn_); l *= alpha_; \
            _Pragma("unroll") for (int r = 0; r < 16; ++r) { o0[r] *= alpha_; o1[r] *= alpha_; } } \
        m = mn_; float rs_ = 0.f; \
        _Pragma("unroll") for (int r = 0; r < 16; ++r) { p0[r] = __builtin_amdgcn_exp2f(p0[r] - mn_); p1[r] = __builtin_amdgcn_exp2f(p1[r] - mn_); rs_ += p0[r] + p1[r]; } \
        l += rs_; \
        bf16x8 pa_[4]; \
        _Pragma("unroll") for (int ks = 0; ks < 4; ++ks) { u32x4 w_; \
            _Pragma("unroll") for (int e = 0; e < 4; ++e) { const int r = 8 * (ks & 1) + 2 * e; w_[e] = (ks < 2) ? pg8::cvt_pk_bf16(p0[r], p0[r + 1]) : pg8::cvt_pk_bf16(p1[r], p1[r + 1]); } \
            pa_[ks] = __builtin_bit_cast(bf16x8, w_); } \
        _Pragma("unroll") for (int ks = 0; ks < 4; ++ks) { \
            const s16x4 a0_ = vtr((vp) + ks * 1024), a1_ = vtr((vp) + ks * 1024 + 512), b0_ = vtr((vp) + 4096 + ks * 1024), b1_ = vtr((vp) + 4096 + ks * 1024 + 512); \
            const bf16x8 va_ = (bf16x8){a0_[0], a0_[1], a0_[2], a0_[3], a1_[0], a1_[1], a1_[2], a1_[3]}, vb_ = (bf16x8){b0_[0], b0_[1], b0_[2], b0_[3], b1_[0], b1_[1], b1_[2], b1_[3]}; \
            o0 = __builtin_amdgcn_mfma_f32_32x32x16_bf16(va_, pa_[ks], o0, 0, 0, 0); o1 = __builtin_amdgcn_mfma_f32_32x32x16_bf16(vb_, pa_[ks], o1, 0, 0, 0); } \
    } while (0)
#define ATT_FAST_PV(vp) do { \
        _Pragma("unroll") for (int r = 0; r < 16; ++r) { p0[r] = __builtin_amdgcn_exp2f(p0[r]); p1[r] = __builtin_amdgcn_exp2f(p1[r]); } \
        bf16x8 pa_[4]; \
        _Pragma("unroll") for (int ks = 0; ks < 4; ++ks) { u32x4 w_; \
            _Pragma("unroll") for (int e = 0; e < 4; ++e) { const int r = 8 * (ks & 1) + 2 * e; w_[e] = (ks < 2) ? pg8::cvt_pk_bf16(p0[r], p0[r + 1]) : pg8::cvt_pk_bf16(p1[r], p1[r + 1]); } \
            pa_[ks] = __builtin_bit_cast(bf16x8, w_); } \
        _Pragma("unroll") for (int ks = 0; ks < 4; ++ks) { \
            const s16x4 a0_ = vtr((vp) + ks * 1024), a1_ = vtr((vp) + ks * 1024 + 512), b0_ = vtr((vp) + 4096 + ks * 1024), b1_ = vtr((vp) + 4096 + ks * 1024 + 512); \
            const bf16x8 va_ = (bf16x8){a0_[0], a0_[1], a0_[2], a0_[3], a1_[0], a1_[1], a1_[2], a1_[3]}, vb_ = (bf16x8){b0_[0], b0_[1], b0_[2], b0_[3], b1_[0], b1_[1], b1_[2], b1_[3]}; \
            o0 = __builtin_amdgcn_mfma_f32_32x32x16_bf16(va_, pa_[ks], o0, 0, 0, 0); o1 = __builtin_amdgcn_mfma_f32_32x32x16_bf16(vb_, pa_[ks], o1, 0, 0, 0); \
            o2 = __builtin_amdgcn_mfma_f32_32x32x16_bf16(ones8, pa_[ks], o2, 0, 0, 0); } \
    } while (0)
#define ATT_STORE_O(orow, inv) do { _Pragma("unroll") for (int a = 0; a < 4; ++a) { \
        u32x2 w0_, w1_; w0_.x = pg8::cvt_pk_bf16(o0[4 * a] * (inv), o0[4 * a + 1] * (inv)); w0_.y = pg8::cvt_pk_bf16(o0[4 * a + 2] * (inv), o0[4 * a + 3] * (inv)); \
        w1_.x = pg8::cvt_pk_bf16(o1[4 * a] * (inv), o1[4 * a + 1] * (inv)); w1_.y = pg8::cvt_pk_bf16(o1[4 * a + 2] * (inv), o1[4 * a + 3] * (inv)); \
        *(u32x2*)((orow) + 8 * a) = w0_; *(u32x2*)((orow) + 32 + 8 * a) = w1_; } } while (0)

template <int MODE>
__device__ __forceinline__ void attn_unit_v2(LAS unsigned char* lds, const bf16* __restrict__ qkv, int b, int h, int qt,
                                             const float* __restrict__ cum, const float* __restrict__ kmean, const float* __restrict__ relb,
                                             bf16* __restrict__ O, const unsigned* __restrict__ qkn) {
    const int tid = threadIdx.x, lane = tid & 63, r32 = lane & 31, hi = lane >> 5; const int wid = __builtin_amdgcn_readfirstlane(tid >> 6);
    const int qs = (MODE == 0) ? h : 24 + (h - 8), ks = qs + 8, vs = qs + 16;
    const bf16* qb = qkv + ((size_t)qs * NTOK + (size_t)b * SEQ) * 64; const bf16* kb = qkv + ((size_t)ks * NTOK + (size_t)b * SEQ) * 64; const bf16* vb = qkv + ((size_t)vs * NTOK + (size_t)b * SEQ) * 64;
    const int pw = 256 * qt + 32 * wid, myq = pw + r32;
    bf16x8 qr[4];
    { const bf16* qrow = qb + (size_t)myq * 64 + hi * 8;
#pragma unroll
      for (int d0 = 0; d0 < 4; ++d0) qr[d0] = *(const bf16x8*)(qrow + d0 * 16); }
    LAS float* tab = (LAS float*)(lds + R_TAB); LAS float* kml = (LAS float*)(lds + R_KM); LAS int* tsl = (LAS int*)(lds + R_TS);
    const int thi = 4 * qt + 3; int tlo = 0; float fox_b2 = 0.f;
    if (MODE == 0) {
        fox_b2 = 2.f * __builtin_bit_cast(float, qkn[2 * (b * 16 + h)]) * __builtin_bit_cast(float, qkn[2 * (b * 16 + h) + 1]);
        const float* cp = cum + (size_t)(b * 8 + h) * SEQ; const int nk = 256 * (qt + 1);
        for (int s = tid; s < nk; s += 512) tab[s] = -cp[s] * LOG2E;
        if (tid == 0) tsl[0] = 4 * qt;
        __syncthreads();
        if (tid < 4 * qt) { const float qn = __builtin_bit_cast(float, qkn[2 * (b * 16 + h)]), kn = __builtin_bit_cast(float, qkn[2 * (b * 16 + h) + 1]);
            const float bound = 2.f * qn * kn + (cp[256 * qt] - cp[64 * tid + 63]) * LOG2E;
            if (bound >= -64.f) __hip_atomic_fetch_min(&tsl[0], tid, __ATOMIC_RELAXED, __HIP_MEMORY_SCOPE_WORKGROUP); }
        __syncthreads();
        tlo = __builtin_amdgcn_readfirstlane(tsl[0]);
    } else {
        for (int j = tid; j < 4288; j += 512) { const int rel = 4095 - j; tab[j] = rel >= 0 ? relb[t5_bucket(rel) * 16 + h] * LOG2E : NEG; }
        const float* kp = kmean + (size_t)(b * 8 + (h - 8)) * 16 * 64;
        for (int j = tid; j < qt * 64; j += 512) kml[j] = kp[j];
        __syncthreads();
    }
    unsigned sel = 0u;
    if (MODE == 1) {
        float v1 = -INFINITY, v2 = -INFINITY, v3 = -INFINITY; int i1 = -1, i2 = -1, i3 = -1;
        for (int n = 0; n < qt; ++n) {
            float part = 0.f;
#pragma unroll
            for (int d0 = 0; d0 < 4; ++d0) { const f32x4 ka = *(const LAS f32x4*)(kml + n * 64 + d0 * 16 + hi * 8), kb = *(const LAS f32x4*)(kml + n * 64 + d0 * 16 + hi * 8 + 4);
                part += bf2f((unsigned short)qr[d0][0]) * ka[0] + bf2f((unsigned short)qr[d0][1]) * ka[1] + bf2f((unsigned short)qr[d0][2]) * ka[2] + bf2f((unsigned short)qr[d0][3]) * ka[3];
                part += bf2f((unsigned short)qr[d0][4]) * kb[0] + bf2f((unsigned short)qr[d0][5]) * kb[1] + bf2f((unsigned short)qr[d0][6]) * kb[2] + bf2f((unsigned short)qr[d0][7]) * kb[3]; }
            const float gt = swapsum(part);
            if (gt > v1) { v3 = v2; i3 = i2; v2 = v1; i2 = i1; v1 = gt; i1 = n; }
            else if (gt > v2) { v3 = v2; i3 = i2; v2 = gt; i2 = n; }
            else if (gt > v3) { v3 = gt; i3 = n; }
        }
        if (i1 >= 0) sel |= 1u << i1; if (i2 >= 0) sel |= 1u << i2; if (i3 >= 0) sel |= 1u << i3;
    }
    bool fast = false; f32x16 o2 = {}; bf16x8 ones8;
#pragma unroll
    for (int e = 0; e < 8; ++e) ones8[e] = (short)0x3F80;
    if (MODE == 1) fast = true;
    const int vrow = 16 * (wid & 3) + (lane >> 2);
    const int krow = 8 * wid + (lane >> 3);
    const bf16* ksrc0 = kb + (size_t)krow * 64 + (((lane & 7) ^ ((krow >> 1) & 7)) * 8);
    const bf16* vsrc0 = vb + (size_t)vrow * 64 + (wid >> 2) * 32 + (lane & 3) * 8;
    int koff[4];
#pragma unroll
    for (int d0 = 0; d0 < 4; ++d0) koff[d0] = r32 * 128 + (((2 * d0 + hi) ^ ((r32 >> 1) & 7)) << 4);
#define ATT_DMA(t) do { const unsigned so_ = (unsigned)((((t) & 3) * 8192) + wid * 1024); \
        __builtin_amdgcn_global_load_lds((const unsigned*)(ksrc0 + (size_t)(t) * 4096), (LAS unsigned*)(lds + R_K + so_), 16, 0, 0); \
        __builtin_amdgcn_global_load_lds((const unsigned*)(vsrc0 + (size_t)(t) * 4096), (LAS unsigned*)(lds + R_V + so_), 16, 0, 0); } while (0)
    const LAS unsigned char* vp0 = lds + R_V + ((lane >> 4) & 1) * 32 + (lane & 3) * 8 + (4 * hi + ((lane & 15) >> 2)) * 64;
    float m = NEG, l = 0.f; f32x16 o0 = {}, o1 = {};
#pragma unroll 1
  for (int attempt = 0; attempt < (MODE == 1 ? 2 : 1); ++attempt) {
    if (attempt == 1) { fast = false; m = NEG; l = 0.f; o0 = f32x16{}; o1 = f32x16{}; }
    asm volatile("s_waitcnt vmcnt(0)" ::: "memory");
    ATT_DMA(tlo); ATT_DMA(tlo + 1); ATT_DMA(tlo + 2);
    ATT_WAITBAR(4);
    for (int t = tlo; t <= thi; ++t) {
        if (t + 3 <= thi) ATT_DMA(t + 3);
        bool active = (64 * t <= pw + 31);
        if (MODE == 1) { if (t < 4 * qt) active = (__ballot((sel >> (t >> 2)) & 1u) != 0ull); }
        if (MODE == 0) { if (64 * t + 63 < pw) active = active && !((fox_b2 + tab[64 * t + 63] - tab[pw]) < -64.f); }
        if (active) {
            const LAS unsigned char* Ks = lds + R_K + (t & 3) * 8192;
            f32x16 p0, p1;
            if (MODE == 0) {
                const LAS float* cn = tab + 64 * t + 4 * hi;
#pragma unroll
                for (int a = 0; a < 4; ++a) { const f32x4 c0 = *(const LAS f32x4*)(cn + 8 * a), c1 = *(const LAS f32x4*)(cn + 32 + 8 * a);
#pragma unroll
                    for (int e = 0; e < 4; ++e) { p0[4 * a + e] = c0[e]; p1[4 * a + e] = c1[e]; } }
            } else {
                const int relbase = myq - 64 * t - 4 * hi;
                const LAS float* tj = tab + (4095 - relbase);
                if (t < 4 * qt) { if (!((sel >> (t >> 2)) & 1u)) tj = tab + 4224; }
#pragma unroll
                for (int r = 0; r < 16; ++r) { const int cr = (r & 3) + 8 * (r >> 2); p0[r] = tj[cr]; p1[r] = tj[cr + 32]; }
            }
            ATT_QK(Ks);
            if (MODE == 0) { if (t >= 4 * qt) {
#pragma unroll
                    for (int r = 0; r < 16; ++r) { const int kp = 64 * t + crow(r, hi); if (kp > myq) p0[r] = NEG; if (kp + 32 > myq) p1[r] = NEG; } } }
            const LAS unsigned char* vp = vp0 + (t & 3) * 8192;
            if (MODE == 1 && fast) { ATT_FAST_PV(vp); } else { ATT_SOFTMAX_PV(vp); }
        }
        if (t + 3 <= thi) ATT_WAITBAR(4); else if (t + 2 <= thi) ATT_WAITBAR(2); else ATT_WAITBAR(0);
    }
    if (MODE == 1 && attempt == 0) {
        const float l0 = o2[0]; const bool bad = __any(!(l0 > 7.9e-31f && l0 < 1.3e36f));
        if (tid == 0) tsl[1] = 0;
        __syncthreads();
        if (bad && lane == 0) tsl[1] = 1;
        __syncthreads();
        const int redo = __builtin_amdgcn_readfirstlane(tsl[1]);
        __syncthreads();
        if (!redo) break;
    }
  }
#undef ATT_DMA
    const float lt = (MODE == 1 && fast) ? o2[0] : swapsum(l), inv = 1.f / lt;
    bf16* orow = O + ((size_t)b * SEQ + myq) * DM + h * 64 + 4 * hi;
    ATT_STORE_O(orow, inv);
}

constexpr int DL_K = 0, DL_V = 49152, DL_TAB = 98304, DL_END = DL_TAB + 1536 + 128 + 2048;
__device__ __forceinline__ void dil_params(int i, int j, int& h, int& gp, int& dil, int& cls, int& qt) { const int hp = i / 3, idx = j + 32 * (i % 3), h2 = idx / 48, rem = idx % 48, x = rem & 15;
    h = 2 * hp + h2; gp = rem >> 4; dil = gp == 0 ? 1 : (gp == 1 ? 4 : 16); qt = gp == 0 ? x : (gp == 1 ? (x >> 2) : 0); cls = gp == 0 ? 0 : (gp == 1 ? (x & 3) : x); }
__device__ __forceinline__ void dilated_phase(LAS unsigned char* lds, const bf16* __restrict__ qkv, int b, int j, const float* __restrict__ relb,
                                              bf16* O0, bf16* O1, bf16* O2, float* __restrict__ ml, const unsigned* __restrict__ knw  ) {
    const int tid = threadIdx.x, lane = tid & 63, r32 = lane & 31, hi = lane >> 5; const int wid = __builtin_amdgcn_readfirstlane(tid >> 6);
    const int vrow = 16 * (wid & 3) + (lane >> 2), krow = 8 * wid + (lane >> 3);
    int koff[4];
#pragma unroll
    for (int d0 = 0; d0 < 4; ++d0) koff[d0] = r32 * 128 + (((2 * d0 + hi) ^ ((r32 >> 1) & 7)) << 4);
    LAS float* tab = (LAS float*)(lds + DL_TAB);
    LAS float* rbl = (LAS float*)(lds + DL_TAB + 1536 + 128);
    if (tid < 512) rbl[tid] = relb[tid] * LOG2E;
    __syncthreads();
    u32x4 kv[12]; bf16x8 qn[4], qn2[4];
#define DIL_PREFETCH(h_, qt_, dil_, cls_) do { const int T0_ = 4 * (qt_) - 2; \
        const bf16* ksrc0 = qkv + ((size_t)(16 + (h_)) * NTOK + (size_t)b * SEQ) * 64 + (((lane & 7) ^ ((krow >> 1) & 7)) * 8); \
        const bf16* vsrc0 = qkv + ((size_t)(32 + (h_)) * NTOK + (size_t)b * SEQ) * 64 + (wid >> 2) * 32 + (lane & 3) * 8; \
        _Pragma("unroll") for (int s_ = 0; s_ < 6; ++s_) { int kp_ = 64 * (T0_ + s_) + krow, vq_ = 64 * (T0_ + s_) + vrow; kp_ = kp_ < 0 ? 0 : kp_; vq_ = vq_ < 0 ? 0 : vq_; \
            kv[2 * s_] = *(const u32x4*)(ksrc0 + (size_t)(kp_ * (dil_) + (cls_)) * 64); kv[2 * s_ + 1] = *(const u32x4*)(vsrc0 + (size_t)(vq_ * (dil_) + (cls_)) * 64); } \
        } while (0)
#define DIL_PREFETCH_Q2(h_, qt_, dil_, cls_) do { const bf16* qrow_ = qkv + ((size_t)(h_) * NTOK + (size_t)b * SEQ) * 64 + (size_t)((256 * (qt_) + 32 * wid + r32) * (dil_) + (cls_)) * 64 + hi * 8; \
          _Pragma("unroll") for (int d0 = 0; d0 < 4; ++d0) qn2[d0] = *(const bf16x8*)(qrow_ + d0 * 16); } while (0)
#define DIL_PREFETCH_Q(h_, qt_, dil_, cls_) do { const bf16* qrow_ = qkv + ((size_t)(h_) * NTOK + (size_t)b * SEQ) * 64 + (size_t)((256 * (qt_) + 32 * wid + r32) * (dil_) + (cls_)) * 64 + hi * 8; \
          _Pragma("unroll") for (int d0 = 0; d0 < 4; ++d0) qn[d0] = *(const bf16x8*)(qrow_ + d0 * 16); } while (0)
    bf16x8 ones8;
#pragma unroll
    for (int e = 0; e < 8; ++e) ones8[e] = (short)0x3F80;
    int h, gp, dil, cls, qt;
    const LAS unsigned char* vp0 = lds + DL_V + ((lane >> 4) & 1) * 32 + (lane & 3) * 8 + (4 * hi + ((lane & 15) >> 2)) * 64;
    dil_params(0, j, h, gp, dil, cls, qt);
    DIL_PREFETCH(h, qt, dil, cls); DIL_PREFETCH_Q(h, qt, dil, cls);
    constexpr int NIT = (MK_DUP == 113) ? 48 : 24;
#pragma unroll 1
    for (int i = 0; i < NIT; ++i) {
        dil_params(i % 24, j, h, gp, dil, cls, qt);
        if (i > 0) {
#pragma unroll
            for (int d0 = 0; d0 < 4; ++d0) qn[d0] = qn2[d0]; }
#pragma unroll
        for (int s_ = 0; s_ < 6; ++s_) { *(LAS u32x4*)(lds + DL_K + s_ * 8192 + wid * 1024 + lane * 16) = kv[2 * s_]; *(LAS u32x4*)(lds + DL_V + s_ * 8192 + wid * 1024 + lane * 16) = kv[2 * s_ + 1]; }
        { for (int j = tid; j < 384; j += 512) { const int rel = 255 - j; tab[j] = (rel >= 0 && rel <= 128) ? rbl[t5_bucket(rel * dil) * 16 + h] : NEG; } }
        __syncthreads();
        if (i + 1 < NIT) { int h2_, g2_, d2, c2, q2; dil_params((i + 1) % 24, j, h2_, g2_, d2, c2, q2); DIL_PREFETCH(h2_, q2, d2, c2); DIL_PREFETCH_Q2(h2_, q2, d2, c2); }
        f32x16 o0 = {}, o1 = {}, o2 = {};
        float cshift = 0.f;
#pragma unroll 1
        for (int attempt = 0; attempt < 2; ++attempt) {
            if (attempt == 1) { float mx = NEG; o0 = f32x16{}; o1 = f32x16{}; o2 = f32x16{};
#pragma unroll
                for (int jj = 0; jj < 3; ++jj) { const int slot = (wid >> 1) + jj;
                    if (4 * qt - 2 + slot >= 0) { const int relbase = 32 * (wid & 1) + r32 + 128 - 64 * jj - 4 * hi; const LAS float* tj = tab + (255 - relbase);
                        f32x16 p0, p1;
#pragma unroll
                        for (int r = 0; r < 16; ++r) { const int cr = (r & 3) + 8 * (r >> 2); p0[r] = tj[cr]; p1[r] = tj[cr + 32]; }
                        const LAS unsigned char* Ks = lds + DL_K + slot * 8192;
                        { bf16x8 (&qr)[4] = qn; ATT_QK(Ks); }
#pragma unroll
                        for (int r = 0; r < 16; ++r) mx = fmaxf(mx, fmaxf(p0[r], p1[r])); } }
                cshift = swapmax(mx); }
#pragma unroll
            for (int jj = 0; jj < 3; ++jj) { const int slot = (wid >> 1) + jj;
                if (4 * qt - 2 + slot >= 0) { const int relbase = 32 * (wid & 1) + r32 + 128 - 64 * jj - 4 * hi; const LAS float* tj = tab + (255 - relbase);
                    f32x16 p0, p1;
                    if (attempt == 0) {
#pragma unroll
                        for (int r = 0; r < 16; ++r) { const int cr = (r & 3) + 8 * (r >> 2); p0[r] = tj[cr]; p1[r] = tj[cr + 32]; } }
                    else {
#pragma unroll
                        for (int r = 0; r < 16; ++r) { const int cr = (r & 3) + 8 * (r >> 2); p0[r] = tj[cr] - cshift; p1[r] = tj[cr + 32] - cshift; } }
                    const LAS unsigned char* Ks = lds + DL_K + slot * 8192;
                    { bf16x8 (&qr)[4] = qn; ATT_QK(Ks); }
                    const LAS unsigned char* vp = vp0 + slot * 8192;
                    ATT_FAST_PV(vp); } }
            if (attempt == 0) { const float l0 = o2[0]; if (!__any(!(l0 > 7.9e-31f && l0 < 1.3e36f))) break; }
        }
        const float m = cshift;
        const float lt = o2[0], inv = 1.f / lt;
        bf16* Op = gp == 0 ? O0 : (gp == 1 ? O1 : O2);
        const int mytok = (256 * qt + 32 * wid + r32) * dil + cls;
        bf16* orow = Op + ((size_t)b * SEQ + mytok) * DM + h * 64 + 4 * hi;
        ATT_STORE_O(orow, inv);
        if (hi == 0) { f32x2 v; v.x = m; v.y = lt; *(f32x2*)(ml + (size_t)gp * NTOK * NH * 2 + (((size_t)b * SEQ + mytok) * NH + h) * 2) = v; }
        __syncthreads();
    }
#undef DIL_PREFETCH
#undef DIL_PREFETCH_Q
}
}

#define XB_TMO      128
#define XB_XCNT(j)  (256  + 64 * (j))
#define XB_XSUB(j)  (1280 + 64 * (j))
#define XB_XGEN(j)  (2304 + 64 * (j))
#define XB_TOP      3328
#define XB_TOPGEN   3392
#define XCD_BAR_WORDS 3456
#define XB_SPIN_CAP (1u << 18)
__device__ __forceinline__ unsigned xb_ld(unsigned* p)              { return __hip_atomic_load(p, __ATOMIC_RELAXED, __HIP_MEMORY_SCOPE_AGENT); }
__device__ __forceinline__ unsigned xb_add(unsigned* p, unsigned v) { return __hip_atomic_fetch_add(p, v, __ATOMIC_RELAXED, __HIP_MEMORY_SCOPE_AGENT); }
__device__ __forceinline__ unsigned xb_xcc_id() { return (unsigned)__builtin_amdgcn_s_getreg((3 << 11) | 20) & 0xFu; }
#define XB_SPIN(cond, bar) do { unsigned _sp = 0; while (cond) { __builtin_amdgcn_s_sleep(1); \
    if ((++_sp & 255u) == 0u) { if (xb_ld(&(bar)[XB_TMO])) break; if (_sp > XB_SPIN_CAP) { atomicAdd(&(bar)[XB_TMO], 1u); break; } } } } while (0)
struct XcdBarrier { unsigned* bar; unsigned x; volatile LAS unsigned* st; };
__device__ __forceinline__ XcdBarrier xcd_barrier_post(unsigned* bar, volatile LAS unsigned* st) {
    XcdBarrier b; b.bar = bar; b.x = xb_xcc_id(); b.st = st;
    if (threadIdx.x == 0) (void)xb_add(&bar[XB_XCNT(b.x)], 1u);
    return b;
}
__device__ __forceinline__ void xcd_barrier_complete(unsigned* bar, unsigned x, unsigned& nloc, unsigned& nx) {
    const unsigned G = gridDim.x * gridDim.y * gridDim.z;
    unsigned sum, cnt, mine, sp = 0u;
    for (;;) {
        sum = 0u; cnt = 0u; mine = 0u;
#pragma unroll
        for (unsigned j = 0; j < 16; ++j) { const unsigned c = xb_ld(&bar[XB_XCNT(j)]); sum += c; cnt += (c > 0u) ? 1u : 0u; mine = (j == x) ? c : mine; }
        if (sum == G) break;
        __builtin_amdgcn_s_sleep(1);
        if ((++sp & 255u) == 0u) { if (xb_ld(&bar[XB_TMO])) break; if (sp > XB_SPIN_CAP) { atomicAdd(&bar[XB_TMO], 1u); break; } }
    }
    nloc = mine > 0u ? mine : 1u; nx = cnt > 0u ? cnt : 1u;
}
__device__ __forceinline__ void xcd_barrier(const XcdBarrier& b) {
    asm volatile("s_waitcnt vmcnt(0)" ::: "memory");
    __syncthreads();
    if (threadIdx.x == 0) {
        unsigned* bar = b.bar;
        __builtin_amdgcn_s_waitcnt(0);
        unsigned nloc = b.st[0], nx = b.st[1];
        if (nloc == 0u) { xcd_barrier_complete(bar, b.x, nloc, nx); b.st[0] = nloc; b.st[1] = nx; }
        const unsigned old = xb_add(&bar[XB_XSUB(b.x)], 1u);
        const unsigned gen = old / nloc;
        if (old + 1u == (gen + 1u) * nloc) {
            __builtin_amdgcn_fence(__ATOMIC_RELEASE, "agent");
            asm volatile("s_waitcnt vmcnt(0)" ::: "memory");
            const unsigned og = xb_add(&bar[XB_TOP], 1u);
            const unsigned tg = og / nx;
            if (og + 1u == (tg + 1u) * nx) xb_add(&bar[XB_TOPGEN], 1u);
            else XB_SPIN(xb_ld(&bar[XB_TOPGEN]) == tg, bar);
            __builtin_amdgcn_fence(__ATOMIC_ACQUIRE, "agent");
            xb_add(&bar[XB_XGEN(b.x)], 1u);
            asm volatile("s_waitcnt vmcnt(0)" ::: "memory");
        } else {
            XB_SPIN(xb_ld(&bar[XB_XGEN(b.x)]) == gen, bar);
            __builtin_amdgcn_fence(__ATOMIC_ACQUIRE, "agent");
            asm volatile("s_waitcnt vmcnt(0)" ::: "memory");
        }
    }
    __syncthreads();
}

struct Args { const float* in[18]; float* out; unsigned char* ws; int ph_lo, ph_hi; };
struct Frame {
    LAS unsigned char* lds; int tid, lane, wave, vcu, G;
    const float *x, *c, *mod_w, *mod_b, *norm_g, *w_in0, *fox_bias, *w_out0, *w_in1, *w_out1, *relb, *ffn_g, *ffn_u, *ffn_d, *router_w, *ex_g, *ex_u, *ex_d;
    float* out; unsigned char* ws;
};

template <int MODE> __device__ __forceinline__ int dest_row(int n) {
    if (MODE == 0) return n;
    if (MODE == 1) return ((n >> 7) << 8) + (n & 127);
    return n < 1536 ? n : (n >= 1544 ? n - 8 : -1);
}
template <int MODE, bool FP8 = false>
__device__ __forceinline__ void transpose_item(const float* __restrict__ W, int K, int N, bf16* __restrict__ WT, int row_off, LAS float* scr, int item, int lane) {
    const int nblk = (N + 31) / 32, kb = item / nblk, nb = item % nblk, k0 = 64 * kb, n0 = 32 * nb;
    const int nc = n0 + (lane & 31); const bool okc = nc < N;
#pragma unroll 8
    for (int i = 0; i < 32; ++i) { const int kk = 2 * i + (lane >> 5); scr[kk * 33 + (lane & 31)] = okc ? W[(size_t)(k0 + kk) * N + nc] : 0.f; }
    LDS_WAIT(); asm volatile("" ::: "memory");
    const int c = lane & 7;
#pragma unroll
    for (int j = 0; j < 4; ++j) { const int n = (lane >> 3) + 8 * j; const int dr = dest_row<MODE>(n0 + n); const LAS float* s = scr + (8 * c) * 33 + n;
        if constexpr (FP8) { u32x2 o; o.x = pk4_fp8(s[0 * 33] * FP8_SW, s[1 * 33] * FP8_SW, s[2 * 33] * FP8_SW, s[3 * 33] * FP8_SW); o.y = pk4_fp8(s[4 * 33] * FP8_SW, s[5 * 33] * FP8_SW, s[6 * 33] * FP8_SW, s[7 * 33] * FP8_SW);
            if (n0 + n < N && dr >= 0) *(u32x2*)((unsigned char*)WT + (size_t)(row_off + dr) * K + k0 + 8 * c) = o; }
        else { u32x4 o; o.x = pk2(s[0 * 33], s[1 * 33]); o.y = pk2(s[2 * 33], s[3 * 33]); o.z = pk2(s[4 * 33], s[5 * 33]); o.w = pk2(s[6 * 33], s[7 * 33]);
        if (n0 + n < N && dr >= 0) *(u32x4*)(WT + (size_t)(row_off + dr) * K + k0 + 8 * c) = o; } }
    LDS_WAIT(); asm volatile("" ::: "memory");
}

__device__ __forceinline__ void weight_copies(Frame& F) {
    LAS float* scr = (LAS float*)(F.lds + F.wave * 16384);
    const int gw = F.vcu * NWAVES + F.wave, NGW = F.G * NWAVES;
    bf16* wo = (bf16*)(F.ws + WS_WOTHER);
    constexpr int I_IN0 = 16 * 97, I_OUT = 16 * 32, I_IN1 = 16 * 96, I_FG = 16 * 88, I_FD = 44 * 32;
    constexpr int NITEMS = I_IN0 + I_OUT + I_IN1 + I_OUT + 2 * I_FG + I_FD;
    for (int it = gw; it < NITEMS; it += NGW) {
        int r = it;
        if (r < I_IN0) { transpose_item<2>(F.w_in0, DM, DIN0, wo + WO_IN0 / 2, 0, scr, r, F.lane); continue; } r -= I_IN0;
        if (r < I_OUT) { transpose_item<0>(F.w_out0, DM, DM, wo + WO_OUT0 / 2, 0, scr, r, F.lane); continue; } r -= I_OUT;
        if (r < I_IN1) { transpose_item<0>(F.w_in1, DM, 3 * DM, wo + WO_IN1 / 2, 0, scr, r, F.lane); continue; } r -= I_IN1;
        if (r < I_OUT) { transpose_item<0>(F.w_out1, DM, DM, wo + WO_OUT1 / 2, 0, scr, r, F.lane); continue; } r -= I_OUT;
        if (r < I_FG) { transpose_item<1, true>(F.ffn_g, DM, DFF, wo + WO_FGU / 2, 0, scr, r, F.lane); continue; } r -= I_FG;
        if (r < I_FG) { transpose_item<1, true>(F.ffn_u, DM, DFF, wo + WO_FGU / 2, 128, scr, r, F.lane); continue; } r -= I_FG;
        transpose_item<0, true>(F.ffn_d, DFF, DM, wo + WO_FDN / 2, 0, scr, r, F.lane);
    }
    __syncthreads();
}

__device__ __forceinline__ void phase_prologue(Frame& F) {
    if (F.vcu < 192) {
        LAS float* sc = (LAS float*)F.lds;
        LAS float* red = (LAS float*)(F.lds + 32768);
        for (int i = F.tid; i < NB * DM; i += 512) { const float v = F.c[i]; sc[i] = v / (1.f + expf(-v)); }
        __syncthreads();
        const int l = F.vcu / 96, e0 = (F.vcu % 96) * 64, col = F.lane, kq = F.wave;
        float acc[8];
#pragma unroll
        for (int b = 0; b < 8; ++b) acc[b] = 0.f;
        const float* wp = F.mod_w + ((size_t)l * DM + kq * 128) * 6144 + e0 + col;
#pragma unroll 32
        for (int k = 0; k < 128; ++k) { const float w = wp[(size_t)k * 6144];
#pragma unroll
            for (int b = 0; b < 8; ++b) acc[b] += sc[b * DM + kq * 128 + k] * w; }
#pragma unroll
        for (int b = 0; b < 8; ++b) red[(kq * 8 + b) * 64 + col] = acc[b];
        __syncthreads();
        { const int b = F.tid >> 6; float s = 0.f;
#pragma unroll
          for (int q = 0; q < 8; ++q) s += red[(q * 8 + b) * 64 + col];
          ((float*)(F.ws + WS_MODS))[((size_t)l * NB + b) * 6144 + e0 + col] = s + F.mod_b[l * 6144 + e0 + col]; }
        __syncthreads();
    }
}

__device__ __forceinline__ void expert_weight_copies(Frame& F) {
    LAS float* scr = (LAS float*)(F.lds + F.wave * 16384);
    const int gw = F.vcu * NWAVES + F.wave, NGW = F.G * NWAVES;
    constexpr int I_GU = 16 * 112, I_DN = 56 * 32, PER_E = 2 * I_GU + I_DN;
    for (int it = gw; it < NEXP * PER_E; it += NGW) {
        const int e = it / PER_E; int r = it % PER_E;
        bf16* we = (bf16*)(F.ws + WS_WEXP + (size_t)e * WEXP_STRIDE);
        if (r < I_GU) { transpose_item<1, true>(F.ex_g + (size_t)e * DM * DFE, DM, DFE, we, 0, scr, r, F.lane); continue; } r -= I_GU;
        if (r < I_GU) { transpose_item<1, true>(F.ex_u + (size_t)e * DM * DFE, DM, DFE, we, 128, scr, r, F.lane); continue; } r -= I_GU;
        transpose_item<0, true>(F.ex_d + (size_t)e * DFE * DM, DFE, DM, (bf16*)((unsigned char*)we + WEXP_DN_OFF), 0, scr, r, F.lane);
    }
}

template <bool RES, int EXTRA, bool U8 = false>
__device__ __forceinline__ void thin_phase(Frame& F, const float* hin, const bf16* y, const float* gy, const float* gatev  ,
                                           const float* gu, const float* shv, const float* scv, bf16* uout) {
    const int gw = F.vcu * NWAVES + F.wave;
    const int row0 = gw * 16, b = row0 >> 12;
    LAS float* w8 = (LAS float*)F.lds;
    LAS int* lcnt = (LAS int*)(F.lds + 32768);
    if (EXTRA == 1) { for (int i = F.tid; i < 8 * DM; i += 512) { const int k = i >> 3, j = i & 7; w8[j * DM + k] = F.w_in0[(size_t)k * DIN0 + 1536 + j]; } }
    if (EXTRA == 2) { for (int i = F.tid; i < 8 * DM; i += 512) { const int k = i >> 3, j = i & 7; w8[j * DM + k] = F.router_w[(size_t)k * NEXP + j]; }
        if (F.tid < 16) lcnt[F.tid] = 0; }
    if (EXTRA != 0) __syncthreads();
    f32x4 Gv[4], Av[4], Bv[4];
#pragma unroll
    for (int j = 0; j < 4; ++j) { const int c = 256 * j + 4 * F.lane;
        const f32x4 g = *(const f32x4*)(gu + c), s1 = *(const f32x4*)(scv + (size_t)b * 6144 + c); Av[j] = g * (s1 + 1.f); Bv[j] = *(const f32x4*)(shv + (size_t)b * 6144 + c);
        if (RES) Gv[j] = *(const f32x4*)(gatev + (size_t)b * 6144 + c) * *(const f32x4*)(gy + c); }
    for (int i = 0; i < 16; ++i) {
        const int row = row0 + i;
        f32x4 hv[4];
#pragma unroll
        for (int j = 0; j < 4; ++j) hv[j] = *(const f32x4*)(hin + (size_t)row * DM + 256 * j + 4 * F.lane);
        if (RES) {
            f32x4 yv[4]; float ss = 0.f;
#pragma unroll
            for (int j = 0; j < 4; ++j) { const u32x2 w = *(const u32x2*)(y + (size_t)row * DM + 256 * j + 4 * F.lane); yv[j] = (f32x4){bflo(w.x), bfhi(w.x), bflo(w.y), bfhi(w.y)};
#ifdef DBG_SANITIZE
                for (int e_ = 0; e_ < 4; ++e_) if (!(fabsf(yv[j][e_]) < 1e30f)) yv[j][e_] = 0.f;
#endif
                ss += (yv[j].x * yv[j].x + yv[j].y * yv[j].y) + (yv[j].z * yv[j].z + yv[j].w * yv[j].w); }
            const float rstd = 1.f / sqrtf(wave_sum(ss) * (1.f / DM) + NORM_EPS);
#pragma unroll
            for (int j = 0; j < 4; ++j) { hv[j] = hv[j] + Gv[j] * (yv[j] * rstd); *(f32x4*)(F.out + (size_t)row * DM + 256 * j + 4 * F.lane) = hv[j]; }
        }
        float s2 = 0.f;
#pragma unroll
        for (int j = 0; j < 4; ++j) s2 += (hv[j].x * hv[j].x + hv[j].y * hv[j].y) + (hv[j].z * hv[j].z + hv[j].w * hv[j].w);
        const float rs = 1.f / sqrtf(wave_sum(s2) * (1.f / DM) + NORM_EPS);
        f32x4 uv[4];
#pragma unroll
        for (int j = 0; j < 4; ++j) { uv[j] = hv[j] * rs * Av[j] + Bv[j];
            if constexpr (U8) { *(unsigned*)((unsigned char*)uout + (size_t)row * DM + 256 * j + 4 * F.lane) = pk4_fp8(clamp448(uv[j].x * FP8_SU), clamp448(uv[j].y * FP8_SU), clamp448(uv[j].z * FP8_SU), clamp448(uv[j].w * FP8_SU)); }
            else { u32x2 w; w.x = pk2(uv[j].x, uv[j].y); w.y = pk2(uv[j].z, uv[j].w); *(u32x2*)(uout + (size_t)row * DM + 256 * j + 4 * F.lane) = w; } }
        if (EXTRA != 0) {
            float d[8];
#pragma unroll
            for (int q = 0; q < 8; ++q) { float s = 0.f;
#pragma unroll
                for (int j = 0; j < 4; ++j) { const f32x4 w = *(const LAS f32x4*)(w8 + q * DM + 256 * j + 4 * F.lane); s += (uv[j].x * w.x + uv[j].y * w.y) + (uv[j].z * w.z + uv[j].w * w.w); }
                d[q] = wave_sum(s); }
            if (EXTRA == 1) {
                float z = d[0];
#pragma unroll
                for (int q = 1; q < 8; ++q) z = (F.lane == q) ? d[q] : z;
                if (F.lane < 8) { z += F.fox_bias[F.lane]; const float ls = fminf(z, 0.f) - log1pf(expf(-fabsf(z)));
                    ((float*)(F.ws + WS_LOGF))[((size_t)b * 8 + F.lane) * SEQ + (row & (SEQ - 1))] = ls; }
            } else {
                int i1 = 0; float v1 = d[0];
#pragma unroll
                for (int q = 1; q < 8; ++q) if (d[q] > v1) { v1 = d[q]; i1 = q; }
                int i2 = -1; float v2 = -INFINITY;
#pragma unroll
                for (int q = 0; q < 8; ++q) if (q != i1 && d[q] > v2) { v2 = d[q]; i2 = q; }
                if (i2 < 0) { i2 = (i1 + 1) & 7; v2 = v1; }
                const float p1 = 1.f / (1.f + expf(v2 - v1)), p2 = 1.f - p1;
                if (F.lane == 0) {
                    const int rl = row - F.vcu * 128;
                    const int k1 = __hip_atomic_fetch_add(&lcnt[i1], 1, __ATOMIC_RELAXED, __HIP_MEMORY_SCOPE_WORKGROUP);
                    const int k2 = __hip_atomic_fetch_add(&lcnt[i2], 1, __ATOMIC_RELAXED, __HIP_MEMORY_SCOPE_WORKGROUP);
                    lcnt[16 + rl * 2] = i1; lcnt[16 + rl * 2 + 1] = i2; lcnt[16 + 256 + rl * 2] = k1; lcnt[16 + 256 + rl * 2 + 1] = k2;
                    f32x2 pv; pv.x = p1; pv.y = p2; *(f32x2*)((float*)(F.ws + WS_TOKP) + (size_t)row * 2) = pv;
                }
            }
        }
    }
    if (EXTRA == 2) {
        __syncthreads();
        if (F.tid < 8) lcnt[8 + F.tid] = (int)__hip_atomic_fetch_add((unsigned*)(F.ws + WS_CTL) + CW_GCNT + 64 * F.tid, (unsigned)lcnt[F.tid], __ATOMIC_RELAXED, __HIP_MEMORY_SCOPE_AGENT);
        __syncthreads();
        if (F.tid < 256) { const int rl = F.tid >> 1, k = F.tid & 1, e = lcnt[16 + F.tid], rk = lcnt[16 + 256 + F.tid]; const size_t row = (size_t)F.vcu * 128 + rl;
            ((int*)(F.ws + WS_TOKE))[row * 2 + k] = e; ((int*)(F.ws + WS_TOKR))[row * 2 + k] = lcnt[8 + e] + rk; }
        __syncthreads();
    }
}

__device__ __forceinline__ void phase_cum_kmean(Frame& F) {
    if (F.vcu < 64) {
        const float* lf = (const float*)(F.ws + WS_LOGF) + (size_t)F.vcu * SEQ; float* cu = (float*)(F.ws + WS_CUM) + (size_t)F.vcu * SEQ;
        LAS float* wt = (LAS float*)F.lds;
        f32x4 a = *(const f32x4*)(lf + F.tid * 8), c = *(const f32x4*)(lf + F.tid * 8 + 4);
        float v[8] = {a.x, a.y, a.z, a.w, c.x, c.y, c.z, c.w};
#pragma unroll
        for (int i = 1; i < 8; ++i) v[i] += v[i - 1];
        float run = v[7];
#pragma unroll
        for (int o = 1; o < 64; o <<= 1) { const float t = __shfl_up(run, o); if (F.lane >= o) run += t; }
        if (F.lane == 63) wt[F.wave] = run;
        __syncthreads();
        float off = run - v[7];
        for (int w = 0; w < F.wave; ++w) off += wt[w];
        f32x4 o0 = {v[0] + off, v[1] + off, v[2] + off, v[3] + off}, o1 = {v[4] + off, v[5] + off, v[6] + off, v[7] + off};
        *(f32x4*)(cu + F.tid * 8) = o0; *(f32x4*)(cu + F.tid * 8 + 4) = o1;
        __syncthreads();
    }
    const int gw = F.vcu * NWAVES + F.wave, NGW = F.G * NWAVES;
    const bf16* qkv = (const bf16*)(F.ws + WS_RB);
    for (int it = gw; it < NB * 8 * 16; it += NGW) {
        const int blk = it & 15, hh = (it >> 4) & 7, b = it >> 7;
        const bf16* kp = qkv + ((size_t)(32 + hh) * NTOK + (size_t)b * SEQ + blk * 256) * 64 + (F.lane & 7) * 8;
        float s[8] = {0.f, 0.f, 0.f, 0.f, 0.f, 0.f, 0.f, 0.f};
#pragma unroll 8
        for (int i = 0; i < 32; ++i) { const u32x4 w = *(const u32x4*)(kp + (size_t)((F.lane >> 3) + 8 * i) * 64);
            s[0] += bflo(w.x); s[1] += bfhi(w.x); s[2] += bflo(w.y); s[3] += bfhi(w.y); s[4] += bflo(w.z); s[5] += bfhi(w.z); s[6] += bflo(w.w); s[7] += bfhi(w.w); }
#pragma unroll
        for (int q = 0; q < 8; ++q) { s[q] += __shfl_xor(s[q], 8); s[q] += __shfl_xor(s[q], 16); s[q] += __shfl_xor(s[q], 32); }
        if (F.lane < 8) { float* o = (float*)(F.ws + WS_KMEAN) + (size_t)it * 64 + F.lane * 8;
            f32x4 o0 = {s[0], s[1], s[2], s[3]}, o1 = {s[4], s[5], s[6], s[7]}; *(f32x4*)o = o0 * (1.f / 256.f); *(f32x4*)(o + 4) = o1 * (1.f / 256.f); }
    }
    for (int it = gw; it < NB * 8 * 16; it += NGW) {
        const int blk = it & 15, hx = (it >> 4) & 7, b = it >> 7; const int qs = hx;
        const bf16* qp = qkv + ((size_t)qs * NTOK + (size_t)b * SEQ + blk * 256) * 64 + (F.lane & 7) * 8;
        float mq = 0.f, mk = 0.f;
        for (int i0 = 0; i0 < 32; i0 += 8) {
            u32x4 wq[8], wk[8];
#pragma unroll
            for (int i = 0; i < 8; ++i) { wq[i] = *(const u32x4*)(qp + (size_t)((F.lane >> 3) + 8 * (i0 + i)) * 64); wk[i] = *(const u32x4*)(qp + (size_t)8 * NTOK * 64 + (size_t)((F.lane >> 3) + 8 * (i0 + i)) * 64); }
#pragma unroll
            for (int i = 0; i < 8; ++i) { float sq = 0.f, sk = 0.f;
#pragma unroll
                for (int e = 0; e < 4; ++e) { sq += bflo(wq[i][e]) * bflo(wq[i][e]) + bfhi(wq[i][e]) * bfhi(wq[i][e]); sk += bflo(wk[i][e]) * bflo(wk[i][e]) + bfhi(wk[i][e]) * bfhi(wk[i][e]); }
                sq += __shfl_xor(sq, 1); sq += __shfl_xor(sq, 2); sq += __shfl_xor(sq, 4); sk += __shfl_xor(sk, 1); sk += __shfl_xor(sk, 2); sk += __shfl_xor(sk, 4);
                mq = fmaxf(mq, sq); mk = fmaxf(mk, sk); } }
#pragma unroll
        for (int o = 8; o < 64; o <<= 1) { mq = fmaxf(mq, __shfl_xor(mq, o)); mk = fmaxf(mk, __shfl_xor(mk, o)); }
        if (F.lane == 0) { unsigned* w = (unsigned*)(F.ws + WS_CTL) + CW_QKN + 2 * (b * 16 + hx);
            __hip_atomic_fetch_max(w, __builtin_bit_cast(unsigned, sqrtf(mq)), __ATOMIC_RELAXED, __HIP_MEMORY_SCOPE_AGENT);
            __hip_atomic_fetch_max(w + 1, __builtin_bit_cast(unsigned, sqrtf(mk)), __ATOMIC_RELAXED, __HIP_MEMORY_SCOPE_AGENT); }
    }
}

__device__ __forceinline__ void phase_merge(Frame& F) {
    const int gw = F.vcu * NWAVES + F.wave;
    bf16* p0 = (bf16*)(F.ws + WS_RA); const bf16* p1 = (const bf16*)(F.ws + WS_RC); const bf16* p2 = (const bf16*)(F.ws + WS_RD);
    const float* ml = (const float*)(F.ws + WS_ML);
    for (int i = 0; i < 16; ++i) { const size_t row = (size_t)gw * 16 + i;
#pragma unroll
        for (int j = 0; j < 4; ++j) { const int head = 4 * j + (F.lane >> 4); const size_t mi = (row * NH + head) * 2;
            const f32x2 a = *(const f32x2*)(ml + mi), b = *(const f32x2*)(ml + (size_t)NTOK * NH * 2 + mi), c = *(const f32x2*)(ml + (size_t)2 * NTOK * NH * 2 + mi);
            const float M = fmaxf(a.x, fmaxf(b.x, c.x));
            float wa = a.y * __builtin_amdgcn_exp2f(a.x - M), wb = b.y * __builtin_amdgcn_exp2f(b.x - M), wc = c.y * __builtin_amdgcn_exp2f(c.x - M);
            const float inv = 1.f / (wa + wb + wc); wa *= inv; wb *= inv; wc *= inv;
            const size_t off = row * DM + 256 * j + 4 * F.lane;
            const u32x2 xa = *(const u32x2*)(p0 + off), xb = *(const u32x2*)(p1 + off), xc = *(const u32x2*)(p2 + off);
            u32x2 w; w.x = pk2(wa * bflo(xa.x) + wb * bflo(xb.x) + wc * bflo(xc.x), wa * bfhi(xa.x) + wb * bfhi(xb.x) + wc * bfhi(xc.x));
            w.y = pk2(wa * bflo(xa.y) + wb * bflo(xb.y) + wc * bflo(xc.y), wa * bfhi(xa.y) + wb * bfhi(xb.y) + wc * bfhi(xc.y));
            *(u32x2*)(p0 + off) = w; }
    }
}

__device__ __forceinline__ void phase_gather(Frame& F) {
    LAS int* so = (LAS int*)F.lds;
    if (F.tid == 0) { int acc = 0; for (int e = 0; e < 8; ++e) { so[e] = acc; const int c = (int)__hip_atomic_load((unsigned*)(F.ws + WS_CTL) + CW_GCNT + 64 * e, __ATOMIC_RELAXED, __HIP_MEMORY_SCOPE_AGENT); acc += (c + 255) & ~255; } so[8] = acc; }
    __syncthreads();
    if (F.vcu == 0) { int* te = (int*)(F.ws + WS_TILEE); const int nt = so[8] >> 8;
        for (int t = F.tid; t < MAXTILES; t += 512) { int e = 0; for (int q = 1; q < 8; ++q) if (t * 256 >= so[q]) e = q; te[t] = e; }
        if (F.tid == 0) te[MAXTILES] = nt < MAXTILES ? nt : MAXTILES; }
    const int gw = F.vcu * NWAVES + F.wave;
    const bf16* u = (const bf16*)(F.ws + WS_RA); unsigned char* us = F.ws + WS_USORT;
    const int* te = (const int*)(F.ws + WS_TOKE); const int* tr = (const int*)(F.ws + WS_TOKR); int* ts = (int*)(F.ws + WS_TOKS);
    int d_l = 0;
    if (F.lane < 32) { const int e = te[gw * 32 + F.lane] & 7; d_l = so[e] + tr[gw * 32 + F.lane]; d_l = d_l < 0 ? 0 : (d_l >= MAXTILES * 256 ? MAXTILES * 256 - 1 : d_l); ts[gw * 32 + F.lane] = d_l; }
#pragma unroll 1
    for (int i0 = 0; i0 < 16; i0 += 4) {
        u32x4 a[4], b[4];
#pragma unroll
        for (int r = 0; r < 4; ++r) { const size_t row = (size_t)gw * 16 + i0 + r; a[r] = *(const u32x4*)(u + row * DM + F.lane * 8); b[r] = *(const u32x4*)(u + row * DM + 512 + F.lane * 8); }
#pragma unroll
        for (int r = 0; r < 4; ++r) { u32x2 fa, fb;
            fa.x = pk4_fp8(bflo(a[r].x) * FP8_SU, bfhi(a[r].x) * FP8_SU, bflo(a[r].y) * FP8_SU, bfhi(a[r].y) * FP8_SU); fa.y = pk4_fp8(bflo(a[r].z) * FP8_SU, bfhi(a[r].z) * FP8_SU, bflo(a[r].w) * FP8_SU, bfhi(a[r].w) * FP8_SU);
            fb.x = pk4_fp8(bflo(b[r].x) * FP8_SU, bfhi(b[r].x) * FP8_SU, bflo(b[r].y) * FP8_SU, bfhi(b[r].y) * FP8_SU); fb.y = pk4_fp8(bflo(b[r].z) * FP8_SU, bfhi(b[r].z) * FP8_SU, bflo(b[r].w) * FP8_SU, bfhi(b[r].w) * FP8_SU);
#pragma unroll
            for (int k = 0; k < 2; ++k) { const int dst = __builtin_amdgcn_readlane(d_l, 2 * (i0 + r) + k);
                *(u32x2*)(us + (size_t)dst * DM + F.lane * 8) = fa; *(u32x2*)(us + (size_t)dst * DM + 512 + F.lane * 8) = fb; } }
    }
}

__device__ __forceinline__ void phase_final(Frame& F, const float* __restrict__ gy, const float* __restrict__ gatev) {
    const int gw = F.vcu * NWAVES + F.wave; const int row0 = gw * 16, b = row0 >> 12;
    const bf16* ys = (const bf16*)(F.ws + WS_YSLOT); const int* ts = (const int*)(F.ws + WS_TOKS); const float* tp = (const float*)(F.ws + WS_TOKP);
    f32x4 Gv[4];
#pragma unroll
    for (int j = 0; j < 4; ++j) { const int c = 256 * j + 4 * F.lane; Gv[j] = *(const f32x4*)(gatev + (size_t)b * 6144 + c) * *(const f32x4*)(gy + c); }
    for (int i = 0; i < 16; ++i) { const size_t row = (size_t)row0 + i;
        int s1 = ts[row * 2], s2 = ts[row * 2 + 1]; const float p1 = tp[row * 2], p2 = tp[row * 2 + 1];
        s1 = s1 < 0 ? 0 : (s1 >= MAXTILES * 256 ? MAXTILES * 256 - 1 : s1); s2 = s2 < 0 ? 0 : (s2 >= MAXTILES * 256 ? MAXTILES * 256 - 1 : s2);
        f32x4 yv[4]; float ss = 0.f;
#pragma unroll
        for (int j = 0; j < 4; ++j) { const u32x2 wa = *(const u32x2*)(ys + (size_t)s1 * DM + 256 * j + 4 * F.lane), wb = *(const u32x2*)(ys + (size_t)s2 * DM + 256 * j + 4 * F.lane);
            yv[j] = (f32x4){p1 * bflo(wa.x) + p2 * bflo(wb.x), p1 * bfhi(wa.x) + p2 * bfhi(wb.x), p1 * bflo(wa.y) + p2 * bflo(wb.y), p1 * bfhi(wa.y) + p2 * bfhi(wb.y)};
            ss += (yv[j].x * yv[j].x + yv[j].y * yv[j].y) + (yv[j].z * yv[j].z + yv[j].w * yv[j].w); }
        const float rstd = 1.f / sqrtf(wave_sum(ss) * (1.f / DM) + NORM_EPS);
#pragma unroll
        for (int j = 0; j < 4; ++j) { float* op = F.out + row * DM + 256 * j + 4 * F.lane; const f32x4 hv = *(const f32x4*)op; *(f32x4*)op = hv + Gv[j] * (yv[j] * rstd); }
    }
}

constexpr int NPHASES = 21;
__global__ void __launch_bounds__(NWAVES * 64, 2) trunk_fwd(Args args) {
    extern __shared__ __attribute__((aligned(16))) unsigned char lds_raw[];
    Frame F;
    F.lds = (LAS unsigned char*)lds_raw;
    volatile LAS unsigned* MISC = (volatile LAS unsigned*)(F.lds + MISC_OFF);
    F.tid = threadIdx.x; F.lane = F.tid & 63; F.wave = __builtin_amdgcn_readfirstlane(F.tid >> 6);
    F.G = gridDim.x; { const int bx = blockIdx.x; F.vcu = (F.G % 8 == 0) ? (bx % 8) * (F.G / 8) + bx / 8 : bx; }
    F.x = args.in[0]; F.c = args.in[1]; F.mod_w = args.in[2]; F.mod_b = args.in[3]; F.norm_g = args.in[4]; F.w_in0 = args.in[5]; F.fox_bias = args.in[6]; F.w_out0 = args.in[7];
    F.w_in1 = args.in[8]; F.w_out1 = args.in[9]; F.relb = args.in[10]; F.ffn_g = args.in[11]; F.ffn_u = args.in[12]; F.ffn_d = args.in[13]; F.router_w = args.in[14];
    F.ex_g = args.in[15]; F.ex_u = args.in[16]; F.ex_d = args.in[17]; F.out = args.out; F.ws = args.ws;
    for (int u = F.tid; u < (LDS_BYTES - RING_BYTES) / 4; u += NWAVES * 64) ((LAS unsigned*)(F.lds + RING_BYTES))[u] = 0u;
    __syncthreads();
    const int lo = args.ph_lo, hi = args.ph_hi;
    XcdBarrier bar; bar.bar = (unsigned*)(F.ws + WS_CTL) + CW_BAR; bar.x = 0; bar.st = nullptr;
    if (hi - lo > 1) bar = xcd_barrier_post((unsigned*)(F.ws + WS_CTL) + CW_BAR, MISC + 8);
#define IN(k) (lo <= (k) && (k) < hi)
#define SEAM(k) do { if (IN(k) && IN((k) + 1)) xcd_barrier(bar); } while (0)
    const float* mods = (const float*)(F.ws + WS_MODS);
    const float* mods0 = mods, * mods1 = mods + (size_t)NB * 6144;
    const float* ng0 = F.norm_g, * ng1 = F.norm_g + 4 * DM;
    bf16* RA = (bf16*)(F.ws + WS_RA); bf16* RB = (bf16*)(F.ws + WS_RB); bf16* RC = (bf16*)(F.ws + WS_RC); bf16* RD = (bf16*)(F.ws + WS_RD);
    const bf16* wo = (const bf16*)(F.ws + WS_WOTHER);

    if (IN(0)) { phase_prologue(F); } SEAM(0);
    if (IN(1)) { thin_phase<false, 1>(F, F.x, nullptr, nullptr, nullptr, ng0, mods0 + 0, mods0 + 1024, RA); __syncthreads(); weight_copies(F); } SEAM(1);
    if (IN(2)) { pg8::Gemm g{RA, wo + WO_IN0 / 2, NTOK, 3072, DM}; pg8::StaticOrder S; S.init(NTOK, 3072, F.G, (int)blockIdx.x); pg8::EpiHeadMajor E{RB, NTOK, 0xFFull | (0xFFull << 24), att::C2};
        pg8::gemm_phase<pg8::EpiHeadMajor, pg8::StaticOrder>(F.lds, g, S, E); } SEAM(2);
    if (IN(3)) { phase_cum_kmean(F); } SEAM(3);
    if (IN(4)) {
        const int b = F.vcu >> 5, j = F.vcu & 31, a = j & 15;
        const float* cum = (const float*)(F.ws + WS_CUM); const float* km = (const float*)(F.ws + WS_KMEAN); const unsigned* qkn = (const unsigned*)(F.ws + WS_CTL) + CW_QKN;
        for (int r = 0; r < (MK_DUP == 41 ? 8 : 4); ++r) { const int r4 = r & 3; const int a8 = (a + 8) & 15; const int qt = (r4 == 0) ? a : (r4 == 1) ? 15 - a : (r4 == 2) ? a8 : 15 - a8;
            att::attn_unit_v2<1>(F.lds, RB, b, 8 + 2 * r4 + (j >> 4), qt, nullptr, km, F.relb, RA, qkn); }
        { const int hf = j >> 2, qq = j & 3;
          for (int i = 0; i < (MK_DUP == 40 ? 8 : 4); ++i) { const int i4 = i & 3; const int qt = (i4 == 0) ? 15 - qq : (i4 == 1) ? 8 + qq : (i4 == 2) ? 7 - qq : qq;
            att::attn_unit_v2<0>(F.lds, RB, b, hf, qt, cum, nullptr, nullptr, RA, qkn); } }
    } SEAM(4);
    if (IN(5)) { pg8::Gemm g{RA, wo + WO_OUT0 / 2, NTOK, DM, DM}; pg8::StaticOrder S; S.init(NTOK, DM, F.G, (int)blockIdx.x); pg8::EpiBf16 E{RC, DM};
        pg8::gemm_phase<pg8::EpiBf16, pg8::StaticOrder>(F.lds, g, S, E); } SEAM(5);
    if (IN(6)) { thin_phase<true, 0, true>(F, F.x, RC, ng0 + 1 * DM, mods0 + 2048, ng0 + 2 * DM, mods0 + 3072, mods0 + 4096, RA);
#if MK_DUP == 6
        xcd_barrier(bar); thin_phase<true, 0, true>(F, F.x, RC, ng0 + 1 * DM, mods0 + 2048, ng0 + 2 * DM, mods0 + 3072, mods0 + 4096, RA);
#endif
    } SEAM(6);
    if (IN(7)) { { pg8::Gemm g{RA, wo + WO_FGU / 2, NTOK, 2 * DFF, DM / 2}; pg8::StaticOrder S; S.init(NTOK, 2 * DFF, F.G, (int)blockIdx.x); pg8::EpiSwigluFp8 E{(unsigned char*)RB, DFF, 1.f / (FP8_SU * FP8_SW), FP8_SH};
        pg8::gemm_phase<pg8::EpiSwigluFp8, pg8::StaticOrder, true, true, DM / 2>(F.lds, g, S, E); }
#if MK_DUP == 7
        xcd_barrier(bar); { pg8::Gemm g{RA, wo + WO_FGU / 2, NTOK, 2 * DFF, DM / 2}; pg8::StaticOrder S; S.init(NTOK, 2 * DFF, F.G, (int)blockIdx.x); pg8::EpiSwigluFp8 E{(unsigned char*)RB, DFF, 1.f / (FP8_SU * FP8_SW), FP8_SH};
        pg8::gemm_phase<pg8::EpiSwigluFp8, pg8::StaticOrder, true, true, DM / 2>(F.lds, g, S, E); }
#endif
    } SEAM(7);
    if (IN(8)) { pg8::Gemm g{RB, wo + WO_FDN / 2, NTOK, DM, DFF / 2}; pg8::StaticOrder S; S.init(NTOK, DM, F.G, (int)blockIdx.x); pg8::EpiBf16Scaled E{RC, DM, 1.f / (FP8_SH * FP8_SW)};
        pg8::gemm_phase<pg8::EpiBf16Scaled, pg8::StaticOrder, true, true, DFF / 2>(F.lds, g, S, E); } SEAM(8);
    if (IN(9)) { thin_phase<true, 0>(F, F.out, RC, ng0 + 3 * DM, mods0 + 5120, ng1 + 0, mods1 + 0, mods1 + 1024, RA); } SEAM(9);
    if (IN(10)) { pg8::Gemm g{RA, wo + WO_IN1 / 2, NTOK, 3072, DM}; pg8::StaticOrder S; S.init(NTOK, 3072, F.G, (int)blockIdx.x); pg8::EpiHeadMajor E{RB, NTOK, 0xFFFFull, att::C2};
        pg8::gemm_phase<pg8::EpiHeadMajor, pg8::StaticOrder>(F.lds, g, S, E); } SEAM(10);
    if (IN(11)) {
        float* ml = (float*)(F.ws + WS_ML);
        att::dilated_phase(F.lds, RB, F.vcu >> 5, F.vcu & 31, F.relb, RA, RC, RD, ml, (const unsigned*)(F.ws + WS_CTL) + CW_KN1);
    } SEAM(11);
    if (IN(12)) { phase_merge(F); } SEAM(12);
    if (IN(13)) { pg8::Gemm g{RA, wo + WO_OUT1 / 2, NTOK, DM, DM}; pg8::StaticOrder S; S.init(NTOK, DM, F.G, (int)blockIdx.x); pg8::EpiBf16 E{RC, DM};
        pg8::gemm_phase<pg8::EpiBf16, pg8::StaticOrder>(F.lds, g, S, E); } SEAM(13);
    if (IN(14)) { thin_phase<true, 2>(F, F.out, RC, ng1 + 1 * DM, mods1 + 2048, ng1 + 2 * DM, mods1 + 3072, mods1 + 4096, RA); expert_weight_copies(F); } SEAM(14);
    if (IN(15)) { phase_gather(F); } SEAM(15);
    { int t_ = F.tid; asm volatile("" : "+v"(t_)); F.tid = t_; F.lane = t_ & 63; }
    {
        const int* te = (const int*)(F.ws + WS_TILEE);
        const unsigned char* us = F.ws + WS_USORT; unsigned char* hid = F.ws + WS_HID; bf16* ysl = (bf16*)(F.ws + WS_YSLOT);
        const unsigned char* wexp = F.ws + WS_WEXP;
        if (IN(16) || IN(17)) {
            int n = __builtin_amdgcn_readfirstlane(te[MAXTILES]); if (n > MAXTILES) n = MAXTILES;
            if (IN(16) && n > 0) { pg8::Gemm g{(const bf16*)us, (const bf16*)wexp, n * 256, 2 * DFE, DM / 2}; pg8::MoeOrder S; S.so.init(n * 256, 2 * DFE, F.G, (int)blockIdx.x); S.so.wgm = 16; S.tile_e = te; S.estride = WEXP_STRIDE;
                pg8::EpiSwigluFp8 E{hid, DFE, 1.f / (FP8_SU * FP8_SW), FP8_SH}; pg8::gemm_phase<pg8::EpiSwigluFp8, pg8::MoeOrder, true, true, DM / 2>(F.lds, g, S, E); }
            SEAM(16);
            if (IN(17) && n > 0) { pg8::Gemm g{(const bf16*)hid, (const bf16*)(wexp + WEXP_DN_OFF), n * 256, DM, DFE / 2}; pg8::MoeOrder S; S.so.init(n * 256, DM, F.G, (int)blockIdx.x); S.tile_e = te; S.estride = WEXP_STRIDE;
                pg8::EpiBf16Scaled E{ysl, DM, 1.f / (FP8_SH * FP8_SW)}; pg8::gemm_phase<pg8::EpiBf16Scaled, pg8::MoeOrder, true, true, DFE / 2>(F.lds, g, S, E); }
            SEAM(17);
        }
    }
    { int t_ = F.tid; asm volatile("" : "+v"(t_)); F.tid = t_; F.lane = t_ & 63; }
    if (IN(20)) { phase_final(F, ng1 + 3 * DM, mods1 + 5120); }
#undef IN
#undef SEAM
}

extern "C" void kernel_launch(void* const* d_in, const int* in_sizes, int n_in, void* d_out, int out_size, void* d_ws, size_t ws_size, hipStream_t stream) {
    static int grid = 0;
    if (grid == 0) {
        if (n_in != 18 || in_sizes[0] != NTOK * DM || out_size != NTOK * DM || ws_size < WS_END) { fprintf(stderr, "kernel_launch: unexpected shapes / workspace (%d inputs, ws %zu, need %zu); nothing launched\n", n_in, ws_size, (size_t)WS_END); grid = -1; return; }
        int dev = 0, cus = 0, per_cu = 0;
        if (hipGetDevice(&dev) != hipSuccess || hipDeviceGetAttribute(&cus, hipDeviceAttributeMultiprocessorCount, dev) != hipSuccess) { grid = -1; return; }
        if (hipFuncSetAttribute((const void*)trunk_fwd, hipFuncAttributeMaxDynamicSharedMemorySize, LDS_BYTES) != hipSuccess) { fprintf(stderr, "kernel_launch: hipFuncSetAttribute failed\n"); grid = -1; return; }
        if (hipOccupancyMaxActiveBlocksPerMultiprocessor(&per_cu, (const void*)trunk_fwd, NWAVES * 64, LDS_BYTES) != hipSuccess || per_cu < 1) { fprintf(stderr, "kernel_launch: occupancy query reports %d\n", per_cu); }
        (void)hipGetLastError();
        grid = cus;
        if (grid != 256) { fprintf(stderr, "kernel_launch: built for 256 CUs, found %d; nothing launched\n", grid); grid = -1; return; }
    }
    if (grid < 0) return;
    if (hipMemsetAsync((char*)d_ws + WS_CTL, 0, CTL_ZERO_BYTES, stream) != hipSuccess) return;
    Args a{};
    for (int i = 0; i < 18; ++i) a.in[i] = (const float*)d_in[i];
    a.out = (float*)d_out; a.ws = (unsigned char*)d_ws;
#if MK_ONE_LAUNCH
    a.ph_lo = 0; a.ph_hi = MK_LAST_PHASE;
    hipLaunchKernelGGL(trunk_fwd, dim3(grid), dim3(NWAVES * 64), LDS_BYTES, stream, a);
#else
    for (int p = 0; p < MK_LAST_PHASE; ++p) { a.ph_lo = p; a.ph_hi = p + 1; hipLaunchKernelGGL(trunk_fwd, dim3(grid), dim3(NWAVES * 64), LDS_BYTES, stream, a); }
#endif
}
```

```cpp
#include <hip/hip_runtime.h>
#include <cstdio>
#include <cstdint>

#ifndef MK_ONE_LAUNCH
#define MK_ONE_LAUNCH 1
#endif
#ifndef MK_DUP
#define MK_DUP 0
#endif
#ifndef MK_LAST_PHASE
#define MK_LAST_PHASE 21
#endif

#define GAS __attribute__((address_space(1)))
#define LAS __attribute__((address_space(3)))
typedef unsigned short bf16;
typedef unsigned u32x4 __attribute__((ext_vector_type(4)));
typedef unsigned u32x2 __attribute__((ext_vector_type(2)));
typedef float f32x4 __attribute__((ext_vector_type(4)));
typedef float f32x2 __attribute__((ext_vector_type(2)));
typedef float f32x16 __attribute__((ext_vector_type(16)));
typedef short bf16x8 __attribute__((ext_vector_type(8)));
typedef short s16x4 __attribute__((ext_vector_type(4)));
typedef GAS unsigned gu32;

constexpr int NB = 8, SEQ = 4096, DM = 1024, NTOK = NB * SEQ, NH = 16, HD = 64;
constexpr int DFF = 2816, NEXP = 8, DFE = 3584;
constexpr int QKVP = 3072;
constexpr int DIN0 = 3080;
constexpr float NORM_EPS = 1e-6f;
constexpr float LOG2E = 1.4426950408889634f;
constexpr int NWAVES = 8;
constexpr int MAXTILES = 264;
constexpr int PASS0_TILES = 128, PASS1_MAXTILES = MAXTILES - PASS0_TILES;

constexpr size_t MiB = 1u << 20;
constexpr size_t WS_CTL = 0, CTL_ZERO_BYTES = 1 * MiB;
constexpr size_t WS_MODS = 1 * MiB;
constexpr size_t WS_LOGF = 2 * MiB;
constexpr size_t WS_CUM = 3 * MiB;
constexpr size_t WS_KMEAN = 4 * MiB;
constexpr size_t WS_TOKE = 5 * MiB;
constexpr size_t WS_TOKP = WS_TOKE + 256 * 1024;
constexpr size_t WS_TOKR = WS_TOKP + 256 * 1024;
constexpr size_t WS_TOKS = WS_TOKR + 256 * 1024;
constexpr size_t WS_TILEE = 6 * MiB;
constexpr size_t WS_ML = 8 * MiB;
constexpr size_t WS_RA = 24 * MiB;
constexpr size_t WS_RC = 88 * MiB;
constexpr size_t WS_WOTHER = 152 * MiB;
constexpr size_t WS_RB = 185 * MiB;
constexpr size_t WS_RD = 377 * MiB;
constexpr size_t WS_HID = 24 * MiB;
constexpr size_t WS_USORT = 262 * MiB;
constexpr size_t WS_YSLOT = 328 * MiB;
constexpr size_t WS_WEXP = 460 * MiB;
constexpr size_t WS_END = 544 * MiB;
constexpr size_t WEXP_STRIDE = 10 * MiB + 512 * 1024, WEXP_DN_OFF = 7 * MiB;
constexpr float FP8_SW = 64.f, FP8_SU = 4.f, FP8_SH = 8.f;
constexpr size_t WO_IN0 = 0, WO_OUT0 = 6 * MiB, WO_IN1 = 8 * MiB, WO_OUT1 = 14 * MiB, WO_FGU = 16 * MiB, WO_FDN = 27 * MiB;
static_assert(WS_RB + (size_t)NTOK * QKVP * 2 <= WS_RD && WS_HID + (size_t)MAXTILES * 256 * DFE <= WS_USORT && WS_USORT + (size_t)MAXTILES * 256 * DM <= WS_YSLOT && WS_YSLOT + (size_t)MAXTILES * 256 * DM * 2 <= WS_WEXP && WS_WEXP + 8 * WEXP_STRIDE <= WS_END, "d_ws map");
constexpr int CW_GCNT = 1024;
constexpr int CW_QKN = 2048;
constexpr int CW_KN1 = 3072;
constexpr int CW_BAR = 4096;

constexpr int RING_BYTES = 131072;
constexpr int MISC_OFF = RING_BYTES + 320;
constexpr int LDS_BYTES = 147456;

__device__ __forceinline__ unsigned f2bf(float f) { unsigned u = __builtin_bit_cast(unsigned, f); return (u + 0x7fffu + ((u >> 16) & 1u)) >> 16; }
__device__ __forceinline__ unsigned pk2(float lo, float hi) { return f2bf(lo) | (f2bf(hi) << 16); }
__device__ __forceinline__ float bf2f(unsigned short b) { return __builtin_bit_cast(float, (unsigned)b << 16); }
__device__ __forceinline__ float bflo(unsigned w) { return __builtin_bit_cast(float, w << 16); }
__device__ __forceinline__ float bfhi(unsigned w) { return __builtin_bit_cast(float, w & 0xffff0000u); }
__device__ __forceinline__ float wave_sum(float v) {
#pragma unroll
    for (int o = 1; o < 64; o <<= 1) v += __shfl_xor(v, o);
    return v;
}
__device__ __forceinline__ unsigned pk4_fp8(float a, float b, float c, float d) { unsigned w = __builtin_amdgcn_cvt_pk_fp8_f32(a, b, 0u, false); return __builtin_amdgcn_cvt_pk_fp8_f32(c, d, w, true); }
__device__ __forceinline__ float clamp448(float v) { return __builtin_amdgcn_fmed3f(v, -448.f, 448.f); }
#define LDS_WAIT() asm volatile("s_waitcnt lgkmcnt(0)" ::: "memory")
#define VM_WAIT() asm volatile("s_waitcnt vmcnt(0)" ::: "memory")

namespace pg8 {
typedef unsigned short bf16_t;
typedef int v8i_t __attribute__((ext_vector_type(8)));
constexpr int BM = 256, BK = 64, HALF = 128, HTB = HALF * BK * 2, STAGE_BYTES = 8 * HTB, NXCD = 8, WGM = 8;
__host__ __device__ __forceinline__ int lds_byte(int r, int c) { const int st = (r >> 4) * 2 + (c >> 5), rr = r & 15, cc = c & 31, ob = rr * 64 + cc * 2; return st * 1024 + (ob ^ (((ob >> 9) & 1) << 5)); }
__host__ __device__ __forceinline__ void stage_rc(int b, int& R, int& C) { const int st = b / 1024, sb = b % 1024, swz = sb ^ (((sb >> 9) & 1) << 5); R = (st >> 1) * 16 + swz / 64; C = (st & 1) * 32 + (swz % 64) / 2; }
__host__ __device__ __forceinline__ int perm32(int rho) { const int n = rho >> 4, i = rho & 15; return 8 * (i >> 2) + 4 * n + (i & 3); }

struct Unit { int pm, pn; };
struct Gemm { const bf16_t* A; const bf16_t* Bt; int M, N, K; };

struct StaticOrder {
    int nM, nN, nwg, G, c, wgm = WGM;
    __device__ void init(int M, int N, int G_, int c_) { nM = M / BM; nN = N / BM; nwg = nM * nN; G = G_; c = c_; }
    __device__ bool next(int i, Unit& u) const {
        const long L = (long)i * G + c; if (L >= nwg) return false;
        int wgid = (int)L; { const int q = nwg / NXCD, r = nwg % NXCD, xcd = wgid % NXCD, off = wgid / NXCD; wgid = (xcd < r ? xcd * (q + 1) : r * (q + 1) + (xcd - r) * q) + off; }
        const int nig = wgm * nN, gid = wgid / nig, fm = gid * wgm, gsz = (nM - fm) < wgm ? (nM - fm) : wgm;
        u.pm = fm + ((wgid % nig) % gsz); u.pn = (wgid % nig) / gsz; return true;
    }
    __device__ __forceinline__ const char* abase(const Gemm& g, const Unit& u) const { return (const char*)g.A + (size_t)u.pm * ((size_t)BM * g.K * 2); }
    __device__ __forceinline__ const char* bbase(const Gemm& g, const Unit& u) const { return (const char*)g.Bt + (size_t)u.pn * ((size_t)BM * g.K * 2); }
};
struct MoeOrder {
    StaticOrder so; const int* tile_e; size_t estride;
    __device__ bool next(int i, Unit& u) const { return so.next(i, u); }
    __device__ __forceinline__ const char* abase(const Gemm& g, const Unit& u) const { return (const char*)g.A + (size_t)u.pm * ((size_t)BM * g.K * 2); }
    __device__ __forceinline__ const char* bbase(const Gemm& g, const Unit& u) const { const int e = __builtin_amdgcn_readfirstlane(tile_e[u.pm]); return (const char*)g.Bt + (size_t)e * estride + (size_t)u.pn * ((size_t)BM * g.K * 2); }
};

typedef float f32x2_t __attribute__((ext_vector_type(2))); typedef __bf16 bf16x2_t __attribute__((ext_vector_type(2)));
__device__ __forceinline__ unsigned cvt_pk_bf16(float lo, float hi) { f32x2_t v = {lo, hi}; bf16x2_t b = __builtin_convertvector(v, bf16x2_t); return __builtin_bit_cast(unsigned, b); }

struct EpiBf16 {
    static constexpr bool PERM = true;
    bf16_t* O; int ldc;
    __device__ __forceinline__ void operator()(const f32x4 (&acc)[2][2][4][2], const Unit& u, int wr, int wc, int fr, int fq) const {
        const int row0 = u.pm * BM + wr * 64 + fr; const int col0 = u.pn * BM + wc * 32 + 8 * fq;
#pragma unroll
        for (int ai = 0; ai < 2; ++ai)
#pragma unroll
            for (int m = 0; m < 4; ++m) { bf16_t* rowp = O + (size_t)(row0 + ai * HALF + m * 16) * ldc + col0;
#pragma unroll
                for (int bj = 0; bj < 2; ++bj) { const f32x4 v0 = acc[ai][bj][m][0], v1 = acc[ai][bj][m][1];
                    u32x4 w; w.x = cvt_pk_bf16(v0[0], v0[1]); w.y = cvt_pk_bf16(v0[2], v0[3]); w.z = cvt_pk_bf16(v1[0], v1[1]); w.w = cvt_pk_bf16(v1[2], v1[3]);
                    *(u32x4*)(rowp + bj * HALF) = w; } }
    }
};
struct EpiHeadMajor {
    static constexpr bool PERM = true;
    bf16_t* O; int M; unsigned long long qmask; float qscale;
    __device__ __forceinline__ void operator()(const f32x4 (&acc)[2][2][4][2], const Unit& u, int wr, int wc, int fr, int fq) const {
        const int row0 = u.pm * BM + wr * 64 + fr; const int col0 = u.pn * BM + wc * 32 + 8 * fq;
#pragma unroll
        for (int ai = 0; ai < 2; ++ai)
#pragma unroll
            for (int m = 0; m < 4; ++m) { const int row = row0 + ai * HALF + m * 16;
#pragma unroll
                for (int bj = 0; bj < 2; ++bj) { const int col = col0 + bj * HALF; const float sc = ((qmask >> (col >> 6)) & 1ull) ? qscale : 1.f; const f32x4 v0 = acc[ai][bj][m][0] * sc, v1 = acc[ai][bj][m][1] * sc;
                    u32x4 w; w.x = cvt_pk_bf16(v0[0], v0[1]); w.y = cvt_pk_bf16(v0[2], v0[3]); w.z = cvt_pk_bf16(v1[0], v1[1]); w.w = cvt_pk_bf16(v1[2], v1[3]);
                    *(u32x4*)(O + ((size_t)(col >> 6) * M + row) * 64 + (col & 63)) = w; } }
    }
};
__device__ __forceinline__ float silu_mul(float g, float u) { return g * u * __builtin_amdgcn_rcpf(1.f + __builtin_amdgcn_exp2f(-g * LOG2E)); }
struct EpiBf16Scaled {
    static constexpr bool PERM = true;
    bf16_t* O; int ldc; float scale;
    __device__ __forceinline__ void operator()(const f32x4 (&acc)[2][2][4][2], const Unit& u, int wr, int wc, int fr, int fq) const {
        const int row0 = u.pm * BM + wr * 64 + fr; const int col0 = u.pn * BM + wc * 32 + 8 * fq;
#pragma unroll
        for (int ai = 0; ai < 2; ++ai)
#pragma unroll
            for (int m = 0; m < 4; ++m) { bf16_t* rowp = O + (size_t)(row0 + ai * HALF + m * 16) * ldc + col0;
#pragma unroll
                for (int bj = 0; bj < 2; ++bj) { const f32x4 v0 = acc[ai][bj][m][0] * scale, v1 = acc[ai][bj][m][1] * scale;
                    u32x4 w; w.x = cvt_pk_bf16(v0[0], v0[1]); w.y = cvt_pk_bf16(v0[2], v0[3]); w.z = cvt_pk_bf16(v1[0], v1[1]); w.w = cvt_pk_bf16(v1[2], v1[3]);
                    *(u32x4*)(rowp + bj * HALF) = w; } }
    }
};
struct EpiSwigluFp8 {
    static constexpr bool PERM = true;
    unsigned char* O; int ldc; float sin, sout;
    __device__ __forceinline__ void operator()(const f32x4 (&acc)[2][2][4][2], const Unit& u, int wr, int wc, int fr, int fq) const {
        const int row0 = u.pm * BM + wr * 64 + fr; const int col0 = u.pn * HALF + wc * 32 + 8 * fq;
#pragma unroll
        for (int ai = 0; ai < 2; ++ai)
#pragma unroll
            for (int m = 0; m < 4; ++m) { unsigned char* rowp = O + (size_t)(row0 + ai * HALF + m * 16) * ldc + col0;
                const f32x4 ag0 = acc[ai][0][m][0], ag1 = acc[ai][0][m][1];
                const f32x4 t0 = ag0 * (-sin * LOG2E), t1 = ag1 * (-sin * LOG2E);
                f32x4 d0, d1;
#pragma unroll
                for (int e = 0; e < 4; ++e) { d0[e] = __builtin_amdgcn_exp2f(t0[e]); d1[e] = __builtin_amdgcn_exp2f(t1[e]); }
                d0 = d0 + 1.f; d1 = d1 + 1.f;
                f32x4 r0, r1;
#pragma unroll
                for (int e = 0; e < 4; ++e) { r0[e] = __builtin_amdgcn_rcpf(d0[e]); r1[e] = __builtin_amdgcn_rcpf(d1[e]); }
                const f32x4 v0 = (ag0 * acc[ai][1][m][0]) * (sin * sin * sout) * r0, v1 = (ag1 * acc[ai][1][m][1]) * (sin * sin * sout) * r1;
                u32x2 w; w.x = pk4_fp8(clamp448(v0[0]), clamp448(v0[1]), clamp448(v0[2]), clamp448(v0[3]));
                w.y = pk4_fp8(clamp448(v1[0]), clamp448(v1[1]), clamp448(v1[2]), clamp448(v1[3]));
                *(u32x2*)rowp = w; __builtin_amdgcn_sched_barrier(0); }
    }
};
struct EpiSwiglu {
    static constexpr bool PERM = true;
    bf16_t* O; int ldc;
    __device__ __forceinline__ void operator()(const f32x4 (&acc)[2][2][4][2], const Unit& u, int wr, int wc, int fr, int fq) const {
        const int row0 = u.pm * BM + wr * 64 + fr; const int col0 = u.pn * HALF + wc * 32 + 8 * fq;
#pragma unroll
        for (int ai = 0; ai < 2; ++ai)
#pragma unroll
            for (int m = 0; m < 4; ++m) { bf16_t* rowp = O + (size_t)(row0 + ai * HALF + m * 16) * ldc + col0;
                const f32x4 g0 = acc[ai][0][m][0], g1 = acc[ai][0][m][1], u0 = acc[ai][1][m][0], u1 = acc[ai][1][m][1];
                u32x4 w; w.x = cvt_pk_bf16(silu_mul(g0[0], u0[0]), silu_mul(g0[1], u0[1])); w.y = cvt_pk_bf16(silu_mul(g0[2], u0[2]), silu_mul(g0[3], u0[3]));
                w.z = cvt_pk_bf16(silu_mul(g1[0], u1[0]), silu_mul(g1[1], u1[1])); w.w = cvt_pk_bf16(silu_mul(g1[2], u1[2]), silu_mul(g1[3], u1[3]));
                *(u32x4*)rowp = w; }
    }
};

__device__ __forceinline__ void glds16s(const void* sbase, unsigned voff, unsigned lds_dst) { unsigned keep;
    asm volatile("s_mov_b32 %0, m0\n\ts_mov_b32 m0, %3\n\ts_nop 0\n\tglobal_load_lds_dwordx4 %2, %1\n\ts_mov_b32 m0, %0" : "=&s"(keep) : "s"(sbase), "v"(voff), "s"(lds_dst) : "memory"); }
template <class Epi, class Sched, bool ALIGN_EPI = true, bool FP8 = false, int KC = 0>
__device__ __forceinline__ void gemm_phase(LAS unsigned char* lds, const Gemm g, const Sched& S, const Epi& E) {
    const int tid = threadIdx.x, wid = __builtin_amdgcn_readfirstlane(tid >> 6), lane = tid & 63, wr = wid >> 2, wc = wid & 3, fr = lane & 15, fq = lane >> 4;
    const int K = KC > 0 ? KC : g.K, nt = K / BK;
    unsigned voffA[2], voffB[2];
#pragma unroll
    for (int i = 0; i < 2; ++i) { int R, C; stage_rc(tid * 16 + i * 8192, R, C); const int Rb = Epi::PERM ? ((R & ~31) + perm32(R & 31)) : R;
        voffA[i] = (unsigned)(R * K + C) * 2u; voffB[i] = (unsigned)(Rb * K + C) * 2u; }
    const size_t kstep = (size_t)(BK * 2);
    const size_t hstep = (size_t)HALF * K * 2;
    const unsigned ldsw = (unsigned)wid * 1024u;
    const unsigned lds_u32 = (unsigned)(unsigned long long)lds;
    const int aoff = lds_byte(wr * 64 + fr, fq * 8), boff = lds_byte(wc * 32 + fr, fq * 8);
    const int aoff8 = lds_byte(wr * 64 + fr, (fq & 1) * 16) + (fq >> 1) * 1024, boff8 = lds_byte(wc * 32 + fr, (fq & 1) * 16) + (fq >> 1) * 1024;
#define PG8_SA(b, h) (((b) * 2 + (h)) * HTB)
#define PG8_SB(b, h) ((4 + (b) * 2 + (h)) * HTB)
#define PG8_STAGE(bufoff, gbase, voff) do { _Pragma("unroll") for (int _i = 0; _i < 2; ++_i) \
        glds16s((const void*)(gbase), (voff)[_i], lds_u32 + (unsigned)(bufoff) + ldsw + (unsigned)(_i * 8192)); } while (0)
#define PG8_LD8(p_) (*(const LAS v8i_t*)(p_))
#define PG8_LDA(dst, b, h) do { if constexpr (FP8) { _Pragma("unroll") for (int m = 0; m < 4; ++m) dst##8[m] = PG8_LD8(lds + PG8_SA(b, h) + aoff8 + m * 2048); } \
        else { _Pragma("unroll") for (int m = 0; m < 4; ++m) _Pragma("unroll") for (int k = 0; k < 2; ++k) dst[m][k] = *(const LAS bf16x8*)(lds + PG8_SA(b, h) + aoff + m * 2048 + k * 1024); } } while (0)
#define PG8_LDB(dst, b, h) do { if constexpr (FP8) { _Pragma("unroll") for (int n = 0; n < 2; ++n) dst##8[n] = PG8_LD8(lds + PG8_SB(b, h) + boff8 + n * 2048); } \
        else { _Pragma("unroll") for (int n = 0; n < 2; ++n) _Pragma("unroll") for (int k = 0; k < 2; ++k) dst[n][k] = *(const LAS bf16x8*)(lds + PG8_SB(b, h) + boff + n * 2048 + k * 1024); } } while (0)
#define PG8_MMA(ai, bj, At, Bt) do { __builtin_amdgcn_s_setprio(1); if constexpr (FP8) { _Pragma("unroll") for (int m = 0; m < 4; ++m) _Pragma("unroll") for (int n = 0; n < 2; ++n) \
            asm volatile("v_mfma_f32_16x16x128_f8f6f4 %0, %1, %2, %0" : "+v"(acc[ai][bj][m][n]) : "v"(Bt##8[n]), "v"(At##8[m])); } \
        else { _Pragma("unroll") for (int m = 0; m < 4; ++m) _Pragma("unroll") for (int n = 0; n < 2; ++n) _Pragma("unroll") for (int k = 0; k < 2; ++k) \
        acc[ai][bj][m][n] = __builtin_amdgcn_mfma_f32_16x16x32_bf16(Bt[n][k], At[m][k], acc[ai][bj][m][n], 0, 0, 0); } __builtin_amdgcn_s_setprio(0); } while (0)
#define PG8_WAIT_V(n) asm volatile("s_waitcnt vmcnt(" #n ")" ::: "memory")
#define PG8_WAIT_L(n) asm volatile("s_waitcnt lgkmcnt(" #n ")" ::: "memory")
#define PG8_BAR __builtin_amdgcn_s_barrier()
#define PG8_SCHED __builtin_amdgcn_sched_barrier(0)
    Unit cur, nxt; int ui = 0;
    if (!S.next(0, cur)) return;
    f32x4 acc[2][2][4][2];
#pragma unroll
    for (int a = 0; a < 2; ++a)
#pragma unroll
        for (int b = 0; b < 2; ++b)
#pragma unroll
            for (int m = 0; m < 4; ++m)
#pragma unroll
                for (int n = 0; n < 2; ++n) acc[a][b][m][n] = (f32x4){0.f, 0.f, 0.f, 0.f};
    bf16x8 At[4][2], B0[2][2], B1[2][2]; v8i_t At8[4], B08[2], B18[2];
    const char* cA = S.abase(g, cur); const char* cB = S.bbase(g, cur);
    PG8_STAGE(PG8_SB(0, 0), cB, voffB); PG8_STAGE(PG8_SB(0, 1), cB + hstep, voffB); PG8_STAGE(PG8_SA(0, 0), cA, voffA); PG8_STAGE(PG8_SA(0, 1), cA + hstep, voffA);
    if (wr == 1) PG8_BAR;
    PG8_WAIT_V(2); PG8_BAR;
    PG8_STAGE(PG8_SB(1, 0), cB + kstep, voffB); PG8_STAGE(PG8_SA(1, 0), cA + kstep, voffA); PG8_STAGE(PG8_SB(1, 1), cB + hstep + kstep, voffB);
    PG8_WAIT_V(6); PG8_BAR;
    for (;;) {
        const bool has_next = S.next(ui + 1, nxt);
        const char* nA = cA; const char* nB = cB;
        if (has_next) { nA = S.abase(g, nxt); nB = S.bbase(g, nxt); }
        for (int t = 0; t < nt; t += 2) {
            const bool last = (t == nt - 2);
            const char* a1 = cA + (size_t)(t + 1) * kstep;
            const char* a2 = last ? nA : cA + (size_t)(t + 2) * kstep; const char* b2 = last ? nB : cB + (size_t)(t + 2) * kstep;
            const char* a3 = a2 + kstep; const char* b3 = b2 + kstep;
            PG8_LDB(B0, 0, 0); PG8_LDB(B1, 0, 1); PG8_SCHED; PG8_LDA(At, 0, 0); PG8_STAGE(PG8_SA(1, 1), a1 + hstep, voffA);
            PG8_WAIT_V(8); PG8_WAIT_L(0); PG8_BAR; PG8_MMA(0, 0, At, B0); PG8_MMA(0, 1, At, B1); PG8_BAR; PG8_SCHED;
            PG8_LDA(At, 0, 1); PG8_STAGE(PG8_SB(0, 0), b2, voffB); PG8_STAGE(PG8_SB(0, 1), b2 + hstep, voffB); PG8_STAGE(PG8_SA(0, 0), a2, voffA);
            PG8_WAIT_V(8); PG8_WAIT_L(0); PG8_BAR; PG8_MMA(1, 0, At, B0); PG8_MMA(1, 1, At, B1); PG8_BAR; PG8_SCHED;
            PG8_LDB(B0, 1, 0); PG8_LDB(B1, 1, 1); PG8_SCHED; PG8_LDA(At, 1, 0); PG8_STAGE(PG8_SA(0, 1), a2 + hstep, voffA);
            PG8_WAIT_V(8); PG8_WAIT_L(0); PG8_BAR; PG8_MMA(0, 0, At, B0); PG8_MMA(0, 1, At, B1); PG8_BAR; PG8_SCHED;
            PG8_LDA(At, 1, 1); PG8_STAGE(PG8_SB(1, 0), b3, voffB); PG8_STAGE(PG8_SB(1, 1), b3 + hstep, voffB); PG8_STAGE(PG8_SA(1, 0), a3, voffA);
            PG8_WAIT_V(8); PG8_WAIT_L(0); PG8_BAR; PG8_MMA(1, 0, At, B0); PG8_MMA(1, 1, At, B1); PG8_BAR; PG8_SCHED;
        }
        if constexpr (ALIGN_EPI) { if (wr == 0) PG8_BAR; }
        if constexpr (FP8) asm volatile("s_nop 15\n\ts_nop 15" ::: "memory");
        E(acc, cur, wr, wc, fr, fq);
#if MK_DUP == 116
        if constexpr (FP8) { asm volatile("" ::: "memory"); E(acc, cur, wr, wc, fr, fq); }
#endif
        if (!has_next) break;
#pragma unroll
        for (int a = 0; a < 2; ++a)
#pragma unroll
            for (int b = 0; b < 2; ++b)
#pragma unroll
                for (int m = 0; m < 4; ++m)
#pragma unroll
                    for (int n = 0; n < 2; ++n) acc[a][b][m][n] = (f32x4){0.f, 0.f, 0.f, 0.f};
        cur = nxt; cA = nA; cB = nB; ++ui;
        if constexpr (ALIGN_EPI) { if (wr == 1) PG8_BAR; }
    }
    PG8_WAIT_V(0);
    if constexpr (!ALIGN_EPI) { if (wr == 0) PG8_BAR; }
    PG8_BAR;
#undef PG8_SA
#undef PG8_SB
#undef PG8_STAGE
#undef PG8_LDA
#undef PG8_LDB
#undef PG8_MMA
#undef PG8_WAIT_V
#undef PG8_WAIT_L
#undef PG8_BAR
#undef PG8_SCHED
}
}

namespace att {
constexpr int KS = 0, VS = 16384, TAB = 32768, KM = TAB + 4224 * 4, LDS_END = KM + 4096;
constexpr float C2 = 0.125f * LOG2E;
constexpr float NEG = -1e30f;
__device__ __forceinline__ int crow(int r, int hi) { return (r & 3) + 8 * (r >> 2) + 4 * hi; }
__device__ __forceinline__ int t5_bucket(int d) {
    if (d < 16) return d < 0 ? 0 : d;
    int b = 16;
    b += (d >= 22); b += (d >= 30); b += (d >= 40); b += (d >= 54); b += (d >= 73); b += (d >= 99); b += (d >= 134); b += (d >= 182);
    b += (d >= 246); b += (d >= 332); b += (d >= 450); b += (d >= 609); b += (d >= 825); b += (d >= 1117); b += (d >= 1513);
    return b;
}
__device__ __forceinline__ float swapmax(float m) { return fmaxf(m, __shfl_xor(m, 32)); }
__device__ __forceinline__ float swapsum(float m) { return m + __shfl_xor(m, 32); }
typedef short v4i16_t __attribute__((ext_vector_type(4)));
__device__ __forceinline__ s16x4 vtr(const LAS unsigned char* p) { return __builtin_bit_cast(s16x4, __builtin_amdgcn_ds_read_tr16_b64_v4i16((LAS v4i16_t*)p)); }

constexpr int R_K = 0, R_V = 32768, R_TAB = 65536, R_KM = R_TAB + 4288 * 4, R_TS = R_KM + 4096, R_END = R_TS + 64;
#define ATT_WAITBAR(N) asm volatile("s_waitcnt vmcnt(" #N ") lgkmcnt(0)\n\ts_barrier" ::: "memory")
__device__ __forceinline__ bf16x8 scale_q(bf16x8 q) { bf16x8 r;
#pragma unroll
    for (int e = 0; e < 8; ++e) r[e] = (short)f2bf(bf2f((unsigned short)q[e]) * C2);
    return r; }

#define ATT_QK(Ks) do { _Pragma("unroll") for (int d0 = 0; d0 < 4; ++d0) { const bf16x8 k0_ = *(const LAS bf16x8*)((Ks) + koff[d0]), k1_ = *(const LAS bf16x8*)((Ks) + koff[d0] + 4096); \
        p0 = __builtin_amdgcn_mfma_f32_32x32x16_bf16(k0_, qr[d0], p0, 0, 0, 0); p1 = __builtin_amdgcn_mfma_f32_32x32x16_bf16(k1_, qr[d0], p1, 0, 0, 0); } } while (0)
#define ATT_SOFTMAX_PV(vp) do { \
        float mx_ = fmaxf(p0[0], p1[0]); \
        _Pragma("unroll") for (int r = 1; r < 16; ++r) mx_ = fmaxf(mx_, fmaxf(p0[r], p1[r])); \
        mx_ = swapmax(mx_); \
        const float mn_ = fmaxf(m, mx_); \
        if (__any(mn_ > m)) { const float alpha_ = __builtin_amdgcn_exp2f(m - mn_); l *= alpha_; \
            _Pragma("unroll") for (int r = 0; r < 16; ++r) { o0[r] *= alpha_; o1[r] *= alpha_; } } \
        m = mn_; float rs_ = 0.f; \
        _Pragma("unroll") for (int r = 0; r < 16; ++r) { p0[r] = __builtin_amdgcn_exp2f(p0[r] - mn_); p1[r] = __builtin_amdgcn_exp2f(p1[r] - mn_); rs_ += p0[r] + p1[r]; } \
        l += rs_; \
        bf16x8 pa_[4]; \
        _Pragma("unroll") for (int ks = 0; ks < 4; ++ks) { u32x4 w_; \
            _Pragma("unroll") for (int e = 0; e < 4; ++e) { const int r = 8 * (ks & 1) + 2 * e; w_[e] = (ks < 2) ? pg8::cvt_pk_bf16(p0[r], p0[r + 1]) : pg8::cvt_pk_bf16(p1[r], p1[r + 1]); } \
            pa_[ks] = __builtin_bit_cast(bf16x8, w_); } \
        _Pragma("unroll") for (int ks = 0; ks < 4; ++ks) { \
            const s16x4 a0_ = vtr((vp) + ks * 1024), a1_ = vtr((vp) + ks * 1024 + 512), b0_ = vtr((vp) + 4096 + ks * 1024), b1_ = vtr((vp) + 4096 + ks * 1024 + 512); \
            const bf16x8 va_ = (bf16x8){a0_[0], a0_[1], a0_[2], a0_[3], a1_[0], a1_[1], a1_[2], a1_[3]}, vb_ = (bf16x8){b0_[0], b0_[1], b0_[2], b0_[3], b1_[0], b1_[1], b1_[2], b1_[3]}; \
            o0 = __builtin_amdgcn_mfma_f32_32x32x16_bf16(va_, pa_[ks], o0, 0, 0, 0); o1 = __builtin_amdgcn_mfma_f32_32x32x16_bf16(vb_, pa_[ks], o1, 0, 0, 0); } \
    } while (0)
#define ATT_FAST_PV(vp) do { \
        _Pragma("unroll") for (int r = 0; r < 16; ++r) { p0[r] = __builtin_amdgcn_exp2f(p0[r]); p1[r] = __builtin_amdgcn_exp2f(p1[r]); } \
        bf16x8 pa_[4]; \
        _Pragma("unroll") for (int ks = 0; ks < 4; ++ks) { u32x4 w_; \
            _Pragma("unroll") for (int e = 0; e < 4; ++e) { const int r = 8 * (ks & 1) + 2 * e; w_[e] = (ks < 2) ? pg8::cvt_pk_bf16(p0[r], p0[r + 1]) : pg8::cvt_pk_bf16(p1[r], p1[r + 1]); } \
            pa_[ks] = __builtin_bit_cast(bf16x8, w_); } \
        _Pragma("unroll") for (int ks = 0; ks < 4; ++ks) { \
            const s16x4 a0_ = vtr((vp) + ks * 1024), a1_ = vtr((vp) + ks * 1024 + 512), b0_ = vtr((vp) + 4096 + ks * 1024), b1_ = vtr((vp) + 4096 + ks * 1024 + 512); \
            const bf16x8 va_ = (bf16x8){a0_[0], a0_[1], a0_[2], a0_[3], a1_[0], a1_[1], a1_[2], a1_[3]}, vb_ = (bf16x8){b0_[0], b0_[1], b0_[2], b0_[3], b1_[0], b1_[1], b1_[2], b1_[3]}; \
            o0 = __builtin_amdgcn_mfma_f32_32x32x16_bf16(va_, pa_[ks], o0, 0, 0, 0); o1 = __builtin_amdgcn_mfma_f32_32x32x16_bf16(vb_, pa_[ks], o1, 0, 0, 0); \
            o2 = __builtin_amdgcn_mfma_f32_32x32x16_bf16(ones8, pa_[ks], o2, 0, 0, 0); } \
    } while (0)
#define ATT_STORE_O(orow, inv) do { _Pragma("unroll") for (int a = 0; a < 4; ++a) { \
        u32x2 w0_, w1_; w0_.x = pg8::cvt_pk_bf16(o0[4 * a] * (inv), o0[4 * a + 1] * (inv)); w0_.y = pg8::cvt_pk_bf16(o0[4 * a + 2] * (inv), o0[4 * a + 3] * (inv)); \
        w1_.x = pg8::cvt_pk_bf16(o1[4 * a] * (inv), o1[4 * a + 1] * (inv)); w1_.y = pg8::cvt_pk_bf16(o1[4 * a + 2] * (inv), o1[4 * a + 3] * (inv)); \
        *(u32x2*)((orow) + 8 * a) = w0_; *(u32x2*)((orow) + 32 + 8 * a) = w1_; } } while (0)

template <int MODE>
__device__ __forceinline__ void attn_unit_v2(LAS unsigned char* lds, const bf16* __restrict__ qkv, int b, int h, int qt,
                                             const float* __restrict__ cum, const float* __restrict__ kmean, const float* __restrict__ relb,
                                             bf16* __restrict__ O, const unsigned* __restrict__ qkn) {
    const int tid = threadIdx.x, lane = tid & 63, r32 = lane & 31, hi = lane >> 5; const int wid = __builtin_amdgcn_readfirstlane(tid >> 6);
    const int qs = (MODE == 0) ? h : 24 + (h - 8), ks = qs + 8, vs = qs + 16;
    const bf16* qb = qkv + ((size_t)qs * NTOK + (size_t)b * SEQ) * 64; const bf16* kb = qkv + ((size_t)ks * NTOK + (size_t)b * SEQ) * 64; const bf16* vb = qkv + ((size_t)vs * NTOK + (size_t)b * SEQ) * 64;
    const int pw = 256 * qt + 32 * wid, myq = pw + r32;
    bf16x8 qr[4];
    { const bf16* qrow = qb + (size_t)myq * 64 + hi * 8;
#pragma unroll
      for (int d0 = 0; d0 < 4; ++d0) qr[d0] = *(const bf16x8*)(qrow + d0 * 16); }
    LAS float* tab = (LAS float*)(lds + R_TAB); LAS float* kml = (LAS float*)(lds + R_KM); LAS int* tsl = (LAS int*)(lds + R_TS);
    const int thi = 4 * qt + 3; int tlo = 0; float fox_b2 = 0.f;
    if (MODE == 0) {
        fox_b2 = 2.f * __builtin_bit_cast(float, qkn[2 * (b * 16 + h)]) * __builtin_bit_cast(float, qkn[2 * (b * 16 + h) + 1]);
        const float* cp = cum + (size_t)(b * 8 + h) * SEQ; const int nk = 256 * (qt + 1);
        for (int s = tid; s < nk; s += 512) tab[s] = -cp[s] * LOG2E;
        if (tid == 0) tsl[0] = 4 * qt;
        __syncthreads();
        if (tid < 4 * qt) { const float qn = __builtin_bit_cast(float, qkn[2 * (b * 16 + h)]), kn = __builtin_bit_cast(float, qkn[2 * (b * 16 + h) + 1]);
            const float bound = 2.f * qn * kn + (cp[256 * qt] - cp[64 * tid + 63]) * LOG2E;
            if (bound >= -64.f) __hip_atomic_fetch_min(&tsl[0], tid, __ATOMIC_RELAXED, __HIP_MEMORY_SCOPE_WORKGROUP); }
        __syncthreads();
        tlo = __builtin_amdgcn_readfirstlane(tsl[0]);
    } else {
        for (int j = tid; j < 4288; j += 512) { const int rel = 4095 - j; tab[j] = rel >= 0 ? relb[t5_bucket(rel) * 16 + h] * LOG2E : NEG; }
        const float* kp = kmean + (size_t)(b * 8 + (h - 8)) * 16 * 64;
        for (int j = tid; j < qt * 64; j += 512) kml[j] = kp[j];
        __syncthreads();
    }
    unsigned sel = 0u;
    if (MODE == 1) {
        float v1 = -INFINITY, v2 = -INFINITY, v3 = -INFINITY; int i1 = -1, i2 = -1, i3 = -1;
        for (int n = 0; n < qt; ++n) {
            float part = 0.f;
#pragma unroll
            for (int d0 = 0; d0 < 4; ++d0) { const f32x4 ka = *(const LAS f32x4*)(kml + n * 64 + d0 * 16 + hi * 8), kb = *(const LAS f32x4*)(kml + n * 64 + d0 * 16 + hi * 8 + 4);
                part += bf2f((unsigned short)qr[d0][0]) * ka[0] + bf2f((unsigned short)qr[d0][1]) * ka[1] + bf2f((unsigned short)qr[d0][2]) * ka[2] + bf2f((unsigned short)qr[d0][3]) * ka[3];
                part += bf2f((unsigned short)qr[d0][4]) * kb[0] + bf2f((unsigned short)qr[d0][5]) * kb[1] + bf2f((unsigned short)qr[d0][6]) * kb[2] + bf2f((unsigned short)qr[d0][7]) * kb[3]; }
            const float gt = swapsum(part);
            if (gt > v1) { v3 = v2; i3 = i2; v2 = v1; i2 = i1; v1 = gt; i1 = n; }
            else if (gt > v2) { v3 = v2; i3 = i2; v2 = gt; i2 = n; }
            else if (gt > v3) { v3 = gt; i3 = n; }
        }
        if (i1 >= 0) sel |= 1u << i1; if (i2 >= 0) sel |= 1u << i2; if (i3 >= 0) sel |= 1u << i3;
    }
    bool fast = false; f32x16 o2 = {}; bf16x8 ones8;
#pragma unroll
    for (int e = 0; e < 8; ++e) ones8[e] = (short)0x3F80;
    if (MODE == 1) fast = true;
    const int vrow = 16 * (wid & 3) + (lane >> 2);
    const int krow = 8 * wid + (lane >> 3);
    const bf16* ksrc0 = kb + (size_t)krow * 64 + (((lane & 7) ^ ((krow >> 1) & 7)) * 8);
    const bf16* vsrc0 = vb + (size_t)vrow * 64 + (wid >> 2) * 32 + (lane & 3) * 8;
    int koff[4];
#pragma unroll
    for (int d0 = 0; d0 < 4; ++d0) koff[d0] = r32 * 128 + (((2 * d0 + hi) ^ ((r32 >> 1) & 7)) << 4);
#define ATT_DMA(t) do { const unsigned so_ = (unsigned)((((t) & 3) * 8192) + wid * 1024); \
        __builtin_amdgcn_global_load_lds((const unsigned*)(ksrc0 + (size_t)(t) * 4096), (LAS unsigned*)(lds + R_K + so_), 16, 0, 0); \
        __builtin_amdgcn_global_load_lds((const unsigned*)(vsrc0 + (size_t)(t) * 4096), (LAS unsigned*)(lds + R_V + so_), 16, 0, 0); } while (0)
    const LAS unsigned char* vp0 = lds + R_V + ((lane >> 4) & 1) * 32 + (lane & 3) * 8 + (4 * hi + ((lane & 15) >> 2)) * 64;
    float m = NEG, l = 0.f; f32x16 o0 = {}, o1 = {};
#pragma unroll 1
  for (int attempt = 0; attempt < (MODE == 1 ? 2 : 1); ++attempt) {
    if (attempt == 1) { fast = false; m = NEG; l = 0.f; o0 = f32x16{}; o1 = f32x16{}; }
    asm volatile("s_waitcnt vmcnt(0)" ::: "memory");
    ATT_DMA(tlo); ATT_DMA(tlo + 1); ATT_DMA(tlo + 2);
    ATT_WAITBAR(4);
    for (int t = tlo; t <= thi; ++t) {
        if (t + 3 <= thi) ATT_DMA(t + 3);
        bool active = (64 * t <= pw + 31);
        if (MODE == 1) { if (t < 4 * qt) active = (__ballot((sel >> (t >> 2)) & 1u) != 0ull); }
        if (MODE == 0) { if (64 * t + 63 < pw) active = active && !((fox_b2 + tab[64 * t + 63] - tab[pw]) < -64.f); }
        if (active) {
            const LAS unsigned char* Ks = lds + R_K + (t & 3) * 8192;
            f32x16 p0, p1;
            if (MODE == 0) {
                const LAS float* cn = tab + 64 * t + 4 * hi;
#pragma unroll
                for (int a = 0; a < 4; ++a) { const f32x4 c0 = *(const LAS f32x4*)(cn + 8 * a), c1 = *(const LAS f32x4*)(cn + 32 + 8 * a);
#pragma unroll
                    for (int e = 0; e < 4; ++e) { p0[4 * a + e] = c0[e]; p1[4 * a + e] = c1[e]; } }
            } else {
                const int relbase = myq - 64 * t - 4 * hi;
                const LAS float* tj = tab + (4095 - relbase);
                if (t < 4 * qt) { if (!((sel >> (t >> 2)) & 1u)) tj = tab + 4224; }
#pragma unroll
                for (int r = 0; r < 16; ++r) { const int cr = (r & 3) + 8 * (r >> 2); p0[r] = tj[cr]; p1[r] = tj[cr + 32]; }
            }
            ATT_QK(Ks);
            if (MODE == 0) { if (t >= 4 * qt) {
#pragma unroll
                    for (int r = 0; r < 16; ++r) { const int kp = 64 * t + crow(r, hi); if (kp > myq) p0[r] = NEG; if (kp + 32 > myq) p1[r] = NEG; } } }
            const LAS unsigned char* vp = vp0 + (t & 3) * 8192;
            if (MODE == 1 && fast) { ATT_FAST_PV(vp); } else { ATT_SOFTMAX_PV(vp); }
        }
        if (t + 3 <= thi) ATT_WAITBAR(4); else if (t + 2 <= thi) ATT_WAITBAR(2); else ATT_WAITBAR(0);
    }
    if (MODE == 1 && attempt == 0) {
        const float l0 = o2[0]; const bool bad = __any(!(l0 > 7.9e-31f && l0 < 1.3e36f));
        if (tid == 0) tsl[1] = 0;
        __syncthreads();
        if (bad && lane == 0) tsl[1] = 1;
        __syncthreads();
        const int redo = __builtin_amdgcn_readfirstlane(tsl[1]);
        __syncthreads();
        if (!redo) break;
    }
  }
#undef ATT_DMA
    const float lt = (MODE == 1 && fast) ? o2[0] : swapsum(l), inv = 1.f / lt;
    bf16* orow = O + ((size_t)b * SEQ + myq) * DM + h * 64 + 4 * hi;
    ATT_STORE_O(orow, inv);
}

constexpr int DL_K = 0, DL_V = 49152, DL_TAB = 98304, DL_END = DL_TAB + 1536 + 128 + 2048;
__device__ __forceinline__ void dil_params(int i, int j, int& h, int& gp, int& dil, int& cls, int& qt) { const int hp = i / 3, idx = j + 32 * (i % 3), h2 = idx / 48, rem = idx % 48, x = rem & 15;
    h = 2 * hp + h2; gp = rem >> 4; dil = gp == 0 ? 1 : (gp == 1 ? 4 : 16); qt = gp == 0 ? x : (gp == 1 ? (x >> 2) : 0); cls = gp == 0 ? 0 : (gp == 1 ? (x & 3) : x); }
__device__ __forceinline__ void dilated_phase(LAS unsigned char* lds, const bf16* __restrict__ qkv, int b, int j, const float* __restrict__ relb,
                                              bf16* O0, bf16* O1, bf16* O2, float* __restrict__ ml, const unsigned* __restrict__ knw  ) {
    const int tid = threadIdx.x, lane = tid & 63, r32 = lane & 31, hi = lane >> 5; const int wid = __builtin_amdgcn_readfirstlane(tid >> 6);
    const int vrow = 16 * (wid & 3) + (lane >> 2), krow = 8 * wid + (lane >> 3);
    int koff[4];
#pragma unroll
    for (int d0 = 0; d0 < 4; ++d0) koff[d0] = r32 * 128 + (((2 * d0 + hi) ^ ((r32 >> 1) & 7)) << 4);
    LAS float* tab = (LAS float*)(lds + DL_TAB);
    LAS float* rbl = (LAS float*)(lds + DL_TAB + 1536 + 128);
    if (tid < 512) rbl[tid] = relb[tid] * LOG2E;
    __syncthreads();
    u32x4 kv[12]; bf16x8 qn[4], qn2[4];
#define DIL_PREFETCH(h_, qt_, dil_, cls_) do { const int T0_ = 4 * (qt_) - 2; \
        const bf16* ksrc0 = qkv + ((size_t)(16 + (h_)) * NTOK + (size_t)b * SEQ) * 64 + (((lane & 7) ^ ((krow >> 1) & 7)) * 8); \
        const bf16* vsrc0 = qkv + ((size_t)(32 + (h_)) * NTOK + (size_t)b * SEQ) * 64 + (wid >> 2) * 32 + (lane & 3) * 8; \
        _Pragma("unroll") for (int s_ = 0; s_ < 6; ++s_) { int kp_ = 64 * (T0_ + s_) + krow, vq_ = 64 * (T0_ + s_) + vrow; kp_ = kp_ < 0 ? 0 : kp_; vq_ = vq_ < 0 ? 0 : vq_; \
            kv[2 * s_] = *(const u32x4*)(ksrc0 + (size_t)(kp_ * (dil_) + (cls_)) * 64); kv[2 * s_ + 1] = *(const u32x4*)(vsrc0 + (size_t)(vq_ * (dil_) + (cls_)) * 64); } \
        } while (0)
#define DIL_PREFETCH_Q2(h_, qt_, dil_, cls_) do { const bf16* qrow_ = qkv + ((size_t)(h_) * NTOK + (size_t)b * SEQ) * 64 + (size_t)((256 * (qt_) + 32 * wid + r32) * (dil_) + (cls_)) * 64 + hi * 8; \
          _Pragma("unroll") for (int d0 = 0; d0 < 4; ++d0) qn2[d0] = *(const bf16x8*)(qrow_ + d0 * 16); } while (0)
#define DIL_PREFETCH_Q(h_, qt_, dil_, cls_) do { const bf16* qrow_ = qkv + ((size_t)(h_) * NTOK + (size_t)b * SEQ) * 64 + (size_t)((256 * (qt_) + 32 * wid + r32) * (dil_) + (cls_)) * 64 + hi * 8; \
          _Pragma("unroll") for (int d0 = 0; d0 < 4; ++d0) qn[d0] = *(const bf16x8*)(qrow_ + d0 * 16); } while (0)
    bf16x8 ones8;
#pragma unroll
    for (int e = 0; e < 8; ++e) ones8[e] = (short)0x3F80;
    int h, gp, dil, cls, qt;
    const LAS unsigned char* vp0 = lds + DL_V + ((lane >> 4) & 1) * 32 + (lane & 3) * 8 + (4 * hi + ((lane & 15) >> 2)) * 64;
    dil_params(0, j, h, gp, dil, cls, qt);
    DIL_PREFETCH(h, qt, dil, cls); DIL_PREFETCH_Q(h, qt, dil, cls);
    constexpr int NIT = (MK_DUP == 113) ? 48 : 24;
#pragma unroll 1
    for (int i = 0; i < NIT; ++i) {
        dil_params(i % 24, j, h, gp, dil, cls, qt);
        if (i > 0) {
#pragma unroll
            for (int d0 = 0; d0 < 4; ++d0) qn[d0] = qn2[d0]; }
#pragma unroll
        for (int s_ = 0; s_ < 6; ++s_) { *(LAS u32x4*)(lds + DL_K + s_ * 8192 + wid * 1024 + lane * 16) = kv[2 * s_]; *(LAS u32x4*)(lds + DL_V + s_ * 8192 + wid * 1024 + lane * 16) = kv[2 * s_ + 1]; }
        { for (int j = tid; j < 384; j += 512) { const int rel = 255 - j; tab[j] = (rel >= 0 && rel <= 128) ? rbl[t5_bucket(rel * dil) * 16 + h] : NEG; } }
        __syncthreads();
        if (i + 1 < NIT) { int h2_, g2_, d2, c2, q2; dil_params((i + 1) % 24, j, h2_, g2_, d2, c2, q2); DIL_PREFETCH(h2_, q2, d2, c2); DIL_PREFETCH_Q2(h2_, q2, d2, c2); }
        f32x16 o0 = {}, o1 = {}, o2 = {};
        float cshift = 0.f;
#pragma unroll 1
        for (int attempt = 0; attempt < 2; ++attempt) {
            if (attempt == 1) { float mx = NEG; o0 = f32x16{}; o1 = f32x16{}; o2 = f32x16{};
#pragma unroll
                for (int jj = 0; jj < 3; ++jj) { const int slot = (wid >> 1) + jj;
                    if (4 * qt - 2 + slot >= 0) { const int relbase = 32 * (wid & 1) + r32 + 128 - 64 * jj - 4 * hi; const LAS float* tj = tab + (255 - relbase);
                        f32x16 p0, p1;
#pragma unroll
                        for (int r = 0; r < 16; ++r) { const int cr = (r & 3) + 8 * (r >> 2); p0[r] = tj[cr]; p1[r] = tj[cr + 32]; }
                        const LAS unsigned char* Ks = lds + DL_K + slot * 8192;
                        { bf16x8 (&qr)[4] = qn; ATT_QK(Ks); }
#pragma unroll
                        for (int r = 0; r < 16; ++r) mx = fmaxf(mx, fmaxf(p0[r], p1[r])); } }
                cshift = swapmax(mx); }
#pragma unroll
            for (int jj = 0; jj < 3; ++jj) { const int slot = (wid >> 1) + jj;
                if (4 * qt - 2 + slot >= 0) { const int relbase = 32 * (wid & 1) + r32 + 128 - 64 * jj - 4 * hi; const LAS float* tj = tab + (255 - relbase);
                    f32x16 p0, p1;
                    if (attempt == 0) {
#pragma unroll
                        for (int r = 0; r < 16; ++r) { const int cr = (r & 3) + 8 * (r >> 2); p0[r] = tj[cr]; p1[r] = tj[cr + 32]; } }
                    else {
#pragma unroll
                        for (int r = 0; r < 16; ++r) { const int cr = (r & 3) + 8 * (r >> 2); p0[r] = tj[cr] - cshift; p1[r] = tj[cr + 32] - cshift; } }
                    const LAS unsigned char* Ks = lds + DL_K + slot * 8192;
                    { bf16x8 (&qr)[4] = qn; ATT_QK(Ks); }
                    const LAS unsigned char* vp = vp0 + slot * 8192;
                    ATT_FAST_PV(vp); } }
            if (attempt == 0) { const float l0 = o2[0]; if (!__any(!(l0 > 7.9e-31f && l0 < 1.3e36f))) break; }
        }
        const float m = cshift;
        const float lt = o2[0], inv = 1.f / lt;
        bf16* Op = gp == 0 ? O0 : (gp == 1 ? O1 : O2);
        const int mytok = (256 * qt + 32 * wid + r32) * dil + cls;
        bf16* orow = Op + ((size_t)b * SEQ + mytok) * DM + h * 64 + 4 * hi;
        ATT_STORE_O(orow, inv);
        if (hi == 0) { f32x2 v; v.x = m; v.y = lt; *(f32x2*)(ml + (size_t)gp * NTOK * NH * 2 + (((size_t)b * SEQ + mytok) * NH + h) * 2) = v; }
        __syncthreads();
    }
#undef DIL_PREFETCH
#undef DIL_PREFETCH_Q
}
}

#define XB_TMO      128
#define XB_XCNT(j)  (256  + 64 * (j))
#define XB_XSUB(j)  (1280 + 64 * (j))
#define XB_XGEN(j)  (2304 + 64 * (j))
#define XB_TOP      3328
#define XB_TOPGEN   3392
#define XCD_BAR_WORDS 3456
#define XB_SPIN_CAP (1u << 18)
__device__ __forceinline__ unsigned xb_ld(unsigned* p)              { return __hip_atomic_load(p, __ATOMIC_RELAXED, __HIP_MEMORY_SCOPE_AGENT); }
__device__ __forceinline__ unsigned xb_add(unsigned* p, unsigned v) { return __hip_atomic_fetch_add(p, v, __ATOMIC_RELAXED, __HIP_MEMORY_SCOPE_AGENT); }
__device__ __forceinline__ unsigned xb_xcc_id() { return (unsigned)__builtin_amdgcn_s_getreg((3 << 11) | 20) & 0xFu; }
#define XB_SPIN(cond, bar) do { unsigned _sp = 0; while (cond) { __builtin_amdgcn_s_sleep(1); \
    if ((++_sp & 255u) == 0u) { if (xb_ld(&(bar)[XB_TMO])) break; if (_sp > XB_SPIN_CAP) { atomicAdd(&(bar)[XB_TMO], 1u); break; } } } } while (0)
struct XcdBarrier { unsigned* bar; unsigned x; volatile LAS unsigned* st; };
__device__ __forceinline__ XcdBarrier xcd_barrier_post(unsigned* bar, volatile LAS unsigned* st) {
    XcdBarrier b; b.bar = bar; b.x = xb_xcc_id(); b.st = st;
    if (threadIdx.x == 0) (void)xb_add(&bar[XB_XCNT(b.x)], 1u);
    return b;
}
__device__ __forceinline__ void xcd_barrier_complete(unsigned* bar, unsigned x, unsigned& nloc, unsigned& nx) {
    const unsigned G = gridDim.x * gridDim.y * gridDim.z;
    unsigned sum, cnt, mine, sp = 0u;
    for (;;) {
        sum = 0u; cnt = 0u; mine = 0u;
#pragma unroll
        for (unsigned j = 0; j < 16; ++j) { const unsigned c = xb_ld(&bar[XB_XCNT(j)]); sum += c; cnt += (c > 0u) ? 1u : 0u; mine = (j == x) ? c : mine; }
        if (sum == G) break;
        __builtin_amdgcn_s_sleep(1);
        if ((++sp & 255u) == 0u) { if (xb_ld(&bar[XB_TMO])) break; if (sp > XB_SPIN_CAP) { atomicAdd(&bar[XB_TMO], 1u); break; } }
    }
    nloc = mine > 0u ? mine : 1u; nx = cnt > 0u ? cnt : 1u;
}
__device__ __forceinline__ void xcd_barrier(const XcdBarrier& b) {
    asm volatile("s_waitcnt vmcnt(0)" ::: "memory");
    __syncthreads();
    if (threadIdx.x == 0) {
        unsigned* bar = b.bar;
        __builtin_amdgcn_s_waitcnt(0);
        unsigned nloc = b.st[0], nx = b.st[1];
        if (nloc == 0u) { xcd_barrier_complete(bar, b.x, nloc, nx); b.st[0] = nloc; b.st[1] = nx; }
        const unsigned old = xb_add(&bar[XB_XSUB(b.x)], 1u);
        const unsigned gen = old / nloc;
        if (old + 1u == (gen + 1u) * nloc) {
            __builtin_amdgcn_fence(__ATOMIC_RELEASE, "agent");
            asm volatile("s_waitcnt vmcnt(0)" ::: "memory");
            const unsigned og = xb_add(&bar[XB_TOP], 1u);
            const unsigned tg = og / nx;
            if (og + 1u == (tg + 1u) * nx) xb_add(&bar[XB_TOPGEN], 1u);
            else XB_SPIN(xb_ld(&bar[XB_TOPGEN]) == tg, bar);
            __builtin_amdgcn_fence(__ATOMIC_ACQUIRE, "agent");
            xb_add(&bar[XB_XGEN(b.x)], 1u);
            asm volatile("s_waitcnt vmcnt(0)" ::: "memory");
        } else {
            XB_SPIN(xb_ld(&bar[XB_XGEN(b.x)]) == gen, bar);
            __builtin_amdgcn_fence(__ATOMIC_ACQUIRE, "agent");
            asm volatile("s_waitcnt vmcnt(0)" ::: "memory");
        }
    }
    __syncthreads();
}

struct Args { const float* in[18]; float* out; unsigned char* ws; int ph_lo, ph_hi; };
struct Frame {
    LAS unsigned char* lds; int tid, lane, wave, vcu, G;
    const float *x, *c, *mod_w, *mod_b, *norm_g, *w_in0, *fox_bias, *w_out0, *w_in1, *w_out1, *relb, *ffn_g, *ffn_u, *ffn_d, *router_w, *ex_g, *ex_u, *ex_d;
    float* out; unsigned char* ws;
};

template <int MODE> __device__ __forceinline__ int dest_row(int n) {
    if (MODE == 0) return n;
    if (MODE == 1) return ((n >> 7) << 8) + (n & 127);
    return n < 1536 ? n : (n >= 1544 ? n - 8 : -1);
}
template <int MODE, bool FP8 = false>
__device__ __forceinline__ void transpose_item(const float* __restrict__ W, int K, int N, bf16* __restrict__ WT, int row_off, LAS float* scr, int item, int lane) {
    const int nblk = (N + 31) / 32, kb = item / nblk, nb = item % nblk, k0 = 64 * kb, n0 = 32 * nb;
    const int nc = n0 + (lane & 31); const bool okc = nc < N;
#pragma unroll 8
    for (int i = 0; i < 32; ++i) { const int kk = 2 * i + (lane >> 5); scr[kk * 33 + (lane & 31)] = okc ? W[(size_t)(k0 + kk) * N + nc] : 0.f; }
    LDS_WAIT(); asm volatile("" ::: "memory");
    const int c = lane & 7;
#pragma unroll
    for (int j = 0; j < 4; ++j) { const int n = (lane >> 3) + 8 * j; const int dr = dest_row<MODE>(n0 + n); const LAS float* s = scr + (8 * c) * 33 + n;
        if constexpr (FP8) { u32x2 o; o.x = pk4_fp8(s[0 * 33] * FP8_SW, s[1 * 33] * FP8_SW, s[2 * 33] * FP8_SW, s[3 * 33] * FP8_SW); o.y = pk4_fp8(s[4 * 33] * FP8_SW, s[5 * 33] * FP8_SW, s[6 * 33] * FP8_SW, s[7 * 33] * FP8_SW);
            if (n0 + n < N && dr >= 0) *(u32x2*)((unsigned char*)WT + (size_t)(row_off + dr) * K + k0 + 8 * c) = o; }
        else { u32x4 o; o.x = pk2(s[0 * 33], s[1 * 33]); o.y = pk2(s[2 * 33], s[3 * 33]); o.z = pk2(s[4 * 33], s[5 * 33]); o.w = pk2(s[6 * 33], s[7 * 33]);
        if (n0 + n < N && dr >= 0) *(u32x4*)(WT + (size_t)(row_off + dr) * K + k0 + 8 * c) = o; } }
    LDS_WAIT(); asm volatile("" ::: "memory");
}

__device__ __forceinline__ void weight_copies(Frame& F) {
    LAS float* scr = (LAS float*)(F.lds + F.wave * 16384);
    const int gw = F.vcu * NWAVES + F.wave, NGW = F.G * NWAVES;
    bf16* wo = (bf16*)(F.ws + WS_WOTHER);
    constexpr int I_IN0 = 16 * 97, I_OUT = 16 * 32, I_IN1 = 16 * 96, I_FG = 16 * 88, I_FD = 44 * 32;
    constexpr int NITEMS = I_IN0 + I_OUT + I_IN1 + I_OUT + 2 * I_FG + I_FD;
    for (int it = gw; it < NITEMS; it += NGW) {
        int r = it;
        if (r < I_IN0) { transpose_item<2>(F.w_in0, DM, DIN0, wo + WO_IN0 / 2, 0, scr, r, F.lane); continue; } r -= I_IN0;
        if (r < I_OUT) { transpose_item<0>(F.w_out0, DM, DM, wo + WO_OUT0 / 2, 0, scr, r, F.lane); continue; } r -= I_OUT;
        if (r < I_IN1) { transpose_item<0>(F.w_in1, DM, 3 * DM, wo + WO_IN1 / 2, 0, scr, r, F.lane); continue; } r -= I_IN1;
        if (r < I_OUT) { transpose_item<0>(F.w_out1, DM, DM, wo + WO_OUT1 / 2, 0, scr, r, F.lane); continue; } r -= I_OUT;
        if (r < I_FG) { transpose_item<1, true>(F.ffn_g, DM, DFF, wo + WO_FGU / 2, 0, scr, r, F.lane); continue; } r -= I_FG;
        if (r < I_FG) { transpose_item<1, true>(F.ffn_u, DM, DFF, wo + WO_FGU / 2, 128, scr, r, F.lane); continue; } r -= I_FG;
        transpose_item<0, true>(F.ffn_d, DFF, DM, wo + WO_FDN / 2, 0, scr, r, F.lane);
    }
    __syncthreads();
}

__device__ __forceinline__ void phase_prologue(Frame& F) {
    if (F.vcu < 192) {
        LAS float* sc = (LAS float*)F.lds;
        LAS float* red = (LAS float*)(F.lds + 32768);
        for (int i = F.tid; i < NB * DM; i += 512) { const float v = F.c[i]; sc[i] = v / (1.f + expf(-v)); }
        __syncthreads();
        const int l = F.vcu / 96, e0 = (F.vcu % 96) * 64, col = F.lane, kq = F.wave;
        float acc[8];
#pragma unroll
        for (int b = 0; b < 8; ++b) acc[b] = 0.f;
        const float* wp = F.mod_w + ((size_t)l * DM + kq * 128) * 6144 + e0 + col;
#pragma unroll 32
        for (int k = 0; k < 128; ++k) { const float w = wp[(size_t)k * 6144];
#pragma unroll
            for (int b = 0; b < 8; ++b) acc[b] += sc[b * DM + kq * 128 + k] * w; }
#pragma unroll
        for (int b = 0; b < 8; ++b) red[(kq * 8 + b) * 64 + col] = acc[b];
        __syncthreads();
        { const int b = F.tid >> 6; float s = 0.f;
#pragma unroll
          for (int q = 0; q < 8; ++q) s += red[(q * 8 + b) * 64 + col];
          ((float*)(F.ws + WS_MODS))[((size_t)l * NB + b) * 6144 + e0 + col] = s + F.mod_b[l * 6144 + e0 + col]; }
        __syncthreads();
    }
}

__device__ __forceinline__ void expert_weight_copies(Frame& F) {
    LAS float* scr = (LAS float*)(F.lds + F.wave * 16384);
    const int gw = F.vcu * NWAVES + F.wave, NGW = F.G * NWAVES;
    constexpr int I_GU = 16 * 112, I_DN = 56 * 32, PER_E = 2 * I_GU + I_DN;
    for (int it = gw; it < NEXP * PER_E; it += NGW) {
        const int e = it / PER_E; int r = it % PER_E;
        bf16* we = (bf16*)(F.ws + WS_WEXP + (size_t)e * WEXP_STRIDE);
        if (r < I_GU) { transpose_item<1, true>(F.ex_g + (size_t)e * DM * DFE, DM, DFE, we, 0, scr, r, F.lane); continue; } r -= I_GU;
        if (r < I_GU) { transpose_item<1, true>(F.ex_u + (size_t)e * DM * DFE, DM, DFE, we, 128, scr, r, F.lane); continue; } r -= I_GU;
        transpose_item<0, true>(F.ex_d + (size_t)e * DFE * DM, DFE, DM, (bf16*)((unsigned char*)we + WEXP_DN_OFF), 0, scr, r, F.lane);
    }
}

template <bool RES, int EXTRA, bool U8 = false, bool HB = false>
__device__ __forceinline__ void thin_phase(Frame& F, const float* hin, const bf16* y, const float* gy, const float* gatev  ,
                                           const float* gu, const float* shv, const float* scv, bf16* uout) {
    const int gw = F.vcu * NWAVES + F.wave;
    const int row0 = gw * 16, b = row0 >> 12;
    LAS float* w8 = (LAS float*)F.lds;
    LAS int* lcnt = (LAS int*)(F.lds + 32768);
    if (EXTRA == 1) { for (int i = F.tid; i < 8 * DM; i += 512) { const int k = i >> 3, j = i & 7; w8[j * DM + k] = F.w_in0[(size_t)k * DIN0 + 1536 + j]; } }
    if (EXTRA == 2) { for (int i = F.tid; i < 8 * DM; i += 512) { const int k = i >> 3, j = i & 7; w8[j * DM + k] = F.router_w[(size_t)k * NEXP + j]; }
        if (F.tid < 16) lcnt[F.tid] = 0; }
    if (EXTRA != 0) __syncthreads();
    f32x4 Gv[4], Av[4], Bv[4];
#pragma unroll
    for (int j = 0; j < 4; ++j) { const int c = 256 * j + 4 * F.lane;
        const f32x4 g = *(const f32x4*)(gu + c), s1 = *(const f32x4*)(scv + (size_t)b * 6144 + c); Av[j] = g * (s1 + 1.f); Bv[j] = *(const f32x4*)(shv + (size_t)b * 6144 + c);
        if (RES) Gv[j] = *(const f32x4*)(gatev + (size_t)b * 6144 + c) * *(const f32x4*)(gy + c); }
    for (int i = 0; i < 16; ++i) {
        const int row = row0 + i;
        f32x4 hv[4];
#pragma unroll
        for (int j = 0; j < 4; ++j) { if constexpr (HB) { const u32x2 w = *(const u32x2*)((const unsigned char*)hin + (size_t)row * 4096 + 512 * j + 8 * F.lane); hv[j] = (f32x4){bflo(w.x), bfhi(w.x), bflo(w.y), bfhi(w.y)}; }
            else hv[j] = *(const f32x4*)(hin + (size_t)row * DM + 256 * j + 4 * F.lane); }
        if (RES) {
            f32x4 yv[4]; float ss = 0.f;
#pragma unroll
            for (int j = 0; j < 4; ++j) { const u32x2 w = *(const u32x2*)(y + (size_t)row * DM + 256 * j + 4 * F.lane); yv[j] = (f32x4){bflo(w.x), bfhi(w.x), bflo(w.y), bfhi(w.y)};
#ifdef DBG_SANITIZE
                for (int e_ = 0; e_ < 4; ++e_) if (!(fabsf(yv[j][e_]) < 1e30f)) yv[j][e_] = 0.f;
#endif
                ss += (yv[j].x * yv[j].x + yv[j].y * yv[j].y) + (yv[j].z * yv[j].z + yv[j].w * yv[j].w); }
            const float rstd = 1.f / sqrtf(wave_sum(ss) * (1.f / DM) + NORM_EPS);
#pragma unroll
            for (int j = 0; j < 4; ++j) { hv[j] = hv[j] + Gv[j] * (yv[j] * rstd); u32x2 w; w.x = pg8::cvt_pk_bf16(hv[j].x, hv[j].y); w.y = pg8::cvt_pk_bf16(hv[j].z, hv[j].w);
                *(u32x2*)((unsigned char*)F.out + (size_t)row * 4096 + 512 * j + 8 * F.lane) = w; }
        }
        float s2 = 0.f;
#pragma unroll
        for (int j = 0; j < 4; ++j) s2 += (hv[j].x * hv[j].x + hv[j].y * hv[j].y) + (hv[j].z * hv[j].z + hv[j].w * hv[j].w);
        const float rs = 1.f / sqrtf(wave_sum(s2) * (1.f / DM) + NORM_EPS);
        f32x4 uv[4];
#pragma unroll
        for (int j = 0; j < 4; ++j) { uv[j] = hv[j] * rs * Av[j] + Bv[j];
            if constexpr (U8) { *(unsigned*)((unsigned char*)uout + (size_t)row * DM + 256 * j + 4 * F.lane) = pk4_fp8(clamp448(uv[j].x * FP8_SU), clamp448(uv[j].y * FP8_SU), clamp448(uv[j].z * FP8_SU), clamp448(uv[j].w * FP8_SU)); }
            else { u32x2 w; w.x = pk2(uv[j].x, uv[j].y); w.y = pk2(uv[j].z, uv[j].w); *(u32x2*)(uout + (size_t)row * DM + 256 * j + 4 * F.lane) = w; } }
        if (EXTRA != 0) {
            float d[8];
#pragma unroll
            for (int q = 0; q < 8; ++q) { float s = 0.f;
#pragma unroll
                for (int j = 0; j < 4; ++j) { const f32x4 w = *(const LAS f32x4*)(w8 + q * DM + 256 * j + 4 * F.lane); s += (uv[j].x * w.x + uv[j].y * w.y) + (uv[j].z * w.z + uv[j].w * w.w); }
                d[q] = wave_sum(s); }
            if (EXTRA == 1) {
                float z = d[0];
#pragma unroll
                for (int q = 1; q < 8; ++q) z = (F.lane == q) ? d[q] : z;
                if (F.lane < 8) { z += F.fox_bias[F.lane]; const float ls = fminf(z, 0.f) - log1pf(expf(-fabsf(z)));
                    ((float*)(F.ws + WS_LOGF))[((size_t)b * 8 + F.lane) * SEQ + (row & (SEQ - 1))] = ls; }
            } else {
                int i1 = 0; float v1 = d[0];
#pragma unroll
                for (int q = 1; q < 8; ++q) if (d[q] > v1) { v1 = d[q]; i1 = q; }
                int i2 = -1; float v2 = -INFINITY;
#pragma unroll
                for (int q = 0; q < 8; ++q) if (q != i1 && d[q] > v2) { v2 = d[q]; i2 = q; }
                if (i2 < 0) { i2 = (i1 + 1) & 7; v2 = v1; }
                const float p1 = 1.f / (1.f + expf(v2 - v1)), p2 = 1.f - p1;
                if (F.lane == 0) {
                    const int rl = row - F.vcu * 128;
                    const int k1 = __hip_atomic_fetch_add(&lcnt[i1], 1, __ATOMIC_RELAXED, __HIP_MEMORY_SCOPE_WORKGROUP);
                    const int k2 = __hip_atomic_fetch_add(&lcnt[i2], 1, __ATOMIC_RELAXED, __HIP_MEMORY_SCOPE_WORKGROUP);
                    lcnt[16 + rl * 2] = i1; lcnt[16 + rl * 2 + 1] = i2; lcnt[16 + 256 + rl * 2] = k1; lcnt[16 + 256 + rl * 2 + 1] = k2;
                    f32x2 pv; pv.x = p1; pv.y = p2; *(f32x2*)((float*)(F.ws + WS_TOKP) + (size_t)row * 2) = pv;
                }
            }
        }
    }
    if (EXTRA == 2) {
        __syncthreads();
        if (F.tid < 8) lcnt[8 + F.tid] = (int)__hip_atomic_fetch_add((unsigned*)(F.ws + WS_CTL) + CW_GCNT + 64 * F.tid, (unsigned)lcnt[F.tid], __ATOMIC_RELAXED, __HIP_MEMORY_SCOPE_AGENT);
        __syncthreads();
        if (F.tid < 256) { const int rl = F.tid >> 1, k = F.tid & 1, e = lcnt[16 + F.tid], rk = lcnt[16 + 256 + F.tid]; const size_t row = (size_t)F.vcu * 128 + rl;
            ((int*)(F.ws + WS_TOKE))[row * 2 + k] = e; ((int*)(F.ws + WS_TOKR))[row * 2 + k] = lcnt[8 + e] + rk; }
        __syncthreads();
    }
}

__device__ __forceinline__ void phase_cum_kmean(Frame& F) {
    if (F.vcu < 64) {
        const float* lf = (const float*)(F.ws + WS_LOGF) + (size_t)F.vcu * SEQ; float* cu = (float*)(F.ws + WS_CUM) + (size_t)F.vcu * SEQ;
        LAS float* wt = (LAS float*)F.lds;
        f32x4 a = *(const f32x4*)(lf + F.tid * 8), c = *(const f32x4*)(lf + F.tid * 8 + 4);
        float v[8] = {a.x, a.y, a.z, a.w, c.x, c.y, c.z, c.w};
#pragma unroll
        for (int i = 1; i < 8; ++i) v[i] += v[i - 1];
        float run = v[7];
#pragma unroll
        for (int o = 1; o < 64; o <<= 1) { const float t = __shfl_up(run, o); if (F.lane >= o) run += t; }
        if (F.lane == 63) wt[F.wave] = run;
        __syncthreads();
        float off = run - v[7];
        for (int w = 0; w < F.wave; ++w) off += wt[w];
        f32x4 o0 = {v[0] + off, v[1] + off, v[2] + off, v[3] + off}, o1 = {v[4] + off, v[5] + off, v[6] + off, v[7] + off};
        *(f32x4*)(cu + F.tid * 8) = o0; *(f32x4*)(cu + F.tid * 8 + 4) = o1;
        __syncthreads();
    }
    const int gw = F.vcu * NWAVES + F.wave, NGW = F.G * NWAVES;
    const bf16* qkv = (const bf16*)(F.ws + WS_RB);
    for (int it = gw; it < NB * 8 * 16; it += NGW) {
        const int blk = it & 15, hh = (it >> 4) & 7, b = it >> 7;
        const bf16* kp = qkv + ((size_t)(32 + hh) * NTOK + (size_t)b * SEQ + blk * 256) * 64 + (F.lane & 7) * 8;
        float s[8] = {0.f, 0.f, 0.f, 0.f, 0.f, 0.f, 0.f, 0.f};
#pragma unroll 8
        for (int i = 0; i < 32; ++i) { const u32x4 w = *(const u32x4*)(kp + (size_t)((F.lane >> 3) + 8 * i) * 64);
            s[0] += bflo(w.x); s[1] += bfhi(w.x); s[2] += bflo(w.y); s[3] += bfhi(w.y); s[4] += bflo(w.z); s[5] += bfhi(w.z); s[6] += bflo(w.w); s[7] += bfhi(w.w); }
#pragma unroll
        for (int q = 0; q < 8; ++q) { s[q] += __shfl_xor(s[q], 8); s[q] += __shfl_xor(s[q], 16); s[q] += __shfl_xor(s[q], 32); }
        if (F.lane < 8) { float* o = (float*)(F.ws + WS_KMEAN) + (size_t)it * 64 + F.lane * 8;
            f32x4 o0 = {s[0], s[1], s[2], s[3]}, o1 = {s[4], s[5], s[6], s[7]}; *(f32x4*)o = o0 * (1.f / 256.f); *(f32x4*)(o + 4) = o1 * (1.f / 256.f); }
    }
    for (int it = gw; it < NB * 8 * 16; it += NGW) {
        const int blk = it & 15, hx = (it >> 4) & 7, b = it >> 7; const int qs = hx;
        const bf16* qp = qkv + ((size_t)qs * NTOK + (size_t)b * SEQ + blk * 256) * 64 + (F.lane & 7) * 8;
        float mq = 0.f, mk = 0.f;
        for (int i0 = 0; i0 < 32; i0 += 8) {
            u32x4 wq[8], wk[8];
#pragma unroll
            for (int i = 0; i < 8; ++i) { wq[i] = *(const u32x4*)(qp + (size_t)((F.lane >> 3) + 8 * (i0 + i)) * 64); wk[i] = *(const u32x4*)(qp + (size_t)8 * NTOK * 64 + (size_t)((F.lane >> 3) + 8 * (i0 + i)) * 64); }
#pragma unroll
            for (int i = 0; i < 8; ++i) { float sq = 0.f, sk = 0.f;
#pragma unroll
                for (int e = 0; e < 4; ++e) { sq += bflo(wq[i][e]) * bflo(wq[i][e]) + bfhi(wq[i][e]) * bfhi(wq[i][e]); sk += bflo(wk[i][e]) * bflo(wk[i][e]) + bfhi(wk[i][e]) * bfhi(wk[i][e]); }
                sq += __shfl_xor(sq, 1); sq += __shfl_xor(sq, 2); sq += __shfl_xor(sq, 4); sk += __shfl_xor(sk, 1); sk += __shfl_xor(sk, 2); sk += __shfl_xor(sk, 4);
                mq = fmaxf(mq, sq); mk = fmaxf(mk, sk); } }
#pragma unroll
        for (int o = 8; o < 64; o <<= 1) { mq = fmaxf(mq, __shfl_xor(mq, o)); mk = fmaxf(mk, __shfl_xor(mk, o)); }
        if (F.lane == 0) { unsigned* w = (unsigned*)(F.ws + WS_CTL) + CW_QKN + 2 * (b * 16 + hx);
            __hip_atomic_fetch_max(w, __builtin_bit_cast(unsigned, sqrtf(mq)), __ATOMIC_RELAXED, __HIP_MEMORY_SCOPE_AGENT);
            __hip_atomic_fetch_max(w + 1, __builtin_bit_cast(unsigned, sqrtf(mk)), __ATOMIC_RELAXED, __HIP_MEMORY_SCOPE_AGENT); }
    }
}

__device__ __forceinline__ void phase_merge(Frame& F) {
    const int gw = F.vcu * NWAVES + F.wave;
    bf16* p0 = (bf16*)(F.ws + WS_RA); const bf16* p1 = (const bf16*)(F.ws + WS_RC); const bf16* p2 = (const bf16*)(F.ws + WS_RD);
    const float* ml = (const float*)(F.ws + WS_ML);
    for (int i = 0; i < 16; ++i) { const size_t row = (size_t)gw * 16 + i;
#pragma unroll
        for (int j = 0; j < 4; ++j) { const int head = 4 * j + (F.lane >> 4); const size_t mi = (row * NH + head) * 2;
            const f32x2 a = *(const f32x2*)(ml + mi), b = *(const f32x2*)(ml + (size_t)NTOK * NH * 2 + mi), c = *(const f32x2*)(ml + (size_t)2 * NTOK * NH * 2 + mi);
            const float M = fmaxf(a.x, fmaxf(b.x, c.x));
            float wa = a.y * __builtin_amdgcn_exp2f(a.x - M), wb = b.y * __builtin_amdgcn_exp2f(b.x - M), wc = c.y * __builtin_amdgcn_exp2f(c.x - M);
            const float inv = 1.f / (wa + wb + wc); wa *= inv; wb *= inv; wc *= inv;
            const size_t off = row * DM + 256 * j + 4 * F.lane;
            const u32x2 xa = *(const u32x2*)(p0 + off), xb = *(const u32x2*)(p1 + off), xc = *(const u32x2*)(p2 + off);
            u32x2 w; w.x = pk2(wa * bflo(xa.x) + wb * bflo(xb.x) + wc * bflo(xc.x), wa * bfhi(xa.x) + wb * bfhi(xb.x) + wc * bfhi(xc.x));
            w.y = pk2(wa * bflo(xa.y) + wb * bflo(xb.y) + wc * bflo(xc.y), wa * bfhi(xa.y) + wb * bfhi(xb.y) + wc * bfhi(xc.y));
            *(u32x2*)(p0 + off) = w; }
    }
}

__device__ __forceinline__ void phase_gather(Frame& F) {
    LAS int* so = (LAS int*)F.lds;
    if (F.tid == 0) { int acc = 0; for (int e = 0; e < 8; ++e) { so[e] = acc; const int c = (int)__hip_atomic_load((unsigned*)(F.ws + WS_CTL) + CW_GCNT + 64 * e, __ATOMIC_RELAXED, __HIP_MEMORY_SCOPE_AGENT); acc += (c + 255) & ~255; } so[8] = acc; }
    __syncthreads();
    if (F.vcu == 0) { int* te = (int*)(F.ws + WS_TILEE); const int nt = so[8] >> 8;
        for (int t = F.tid; t < MAXTILES; t += 512) { int e = 0; for (int q = 1; q < 8; ++q) if (t * 256 >= so[q]) e = q; te[t] = e; }
        if (F.tid == 0) te[MAXTILES] = nt < MAXTILES ? nt : MAXTILES; }
    const int gw = F.vcu * NWAVES + F.wave;
    const bf16* u = (const bf16*)(F.ws + WS_RA); unsigned char* us = F.ws + WS_USORT;
    const int* te = (const int*)(F.ws + WS_TOKE); const int* tr = (const int*)(F.ws + WS_TOKR); int* ts = (int*)(F.ws + WS_TOKS);
    int d_l = 0;
    if (F.lane < 32) { const int e = te[gw * 32 + F.lane] & 7; d_l = so[e] + tr[gw * 32 + F.lane]; d_l = d_l < 0 ? 0 : (d_l >= MAXTILES * 256 ? MAXTILES * 256 - 1 : d_l); ts[gw * 32 + F.lane] = d_l; }
#pragma unroll 1
    for (int i0 = 0; i0 < 16; i0 += 4) {
        u32x4 a[4], b[4];
#pragma unroll
        for (int r = 0; r < 4; ++r) { const size_t row = (size_t)gw * 16 + i0 + r; a[r] = *(const u32x4*)(u + row * DM + F.lane * 8); b[r] = *(const u32x4*)(u + row * DM + 512 + F.lane * 8); }
#pragma unroll
        for (int r = 0; r < 4; ++r) { u32x2 fa, fb;
            fa.x = pk4_fp8(bflo(a[r].x) * FP8_SU, bfhi(a[r].x) * FP8_SU, bflo(a[r].y) * FP8_SU, bfhi(a[r].y) * FP8_SU); fa.y = pk4_fp8(bflo(a[r].z) * FP8_SU, bfhi(a[r].z) * FP8_SU, bflo(a[r].w) * FP8_SU, bfhi(a[r].w) * FP8_SU);
            fb.x = pk4_fp8(bflo(b[r].x) * FP8_SU, bfhi(b[r].x) * FP8_SU, bflo(b[r].y) * FP8_SU, bfhi(b[r].y) * FP8_SU); fb.y = pk4_fp8(bflo(b[r].z) * FP8_SU, bfhi(b[r].z) * FP8_SU, bflo(b[r].w) * FP8_SU, bfhi(b[r].w) * FP8_SU);
#pragma unroll
            for (int k = 0; k < 2; ++k) { const int dst = __builtin_amdgcn_readlane(d_l, 2 * (i0 + r) + k);
                *(u32x2*)(us + (size_t)dst * DM + F.lane * 8) = fa; *(u32x2*)(us + (size_t)dst * DM + 512 + F.lane * 8) = fb; } }
    }
}

__device__ __forceinline__ void phase_final(Frame& F, const float* __restrict__ gy, const float* __restrict__ gatev) {
    const int gw = F.vcu * NWAVES + F.wave; const int row0 = gw * 16, b = row0 >> 12;
    const bf16* ys = (const bf16*)(F.ws + WS_YSLOT); const int* ts = (const int*)(F.ws + WS_TOKS); const float* tp = (const float*)(F.ws + WS_TOKP);
    f32x4 Gv[4];
#pragma unroll
    for (int j = 0; j < 4; ++j) { const int c = 256 * j + 4 * F.lane; Gv[j] = *(const f32x4*)(gatev + (size_t)b * 6144 + c) * *(const f32x4*)(gy + c); }
    for (int i = 0; i < 16; ++i) { const size_t row = (size_t)row0 + i;
        int s1 = ts[row * 2], s2 = ts[row * 2 + 1]; const float p1 = tp[row * 2], p2 = tp[row * 2 + 1];
        s1 = s1 < 0 ? 0 : (s1 >= MAXTILES * 256 ? MAXTILES * 256 - 1 : s1); s2 = s2 < 0 ? 0 : (s2 >= MAXTILES * 256 ? MAXTILES * 256 - 1 : s2);
        f32x4 yv[4], hv[4]; float ss = 0.f;
#pragma unroll
        for (int j = 0; j < 4; ++j) { const u32x2 w = *(const u32x2*)((const unsigned char*)F.out + row * 4096 + 512 * j + 8 * F.lane); hv[j] = (f32x4){bflo(w.x), bfhi(w.x), bflo(w.y), bfhi(w.y)}; }
#pragma unroll
        for (int j = 0; j < 4; ++j) { const u32x2 wa = *(const u32x2*)(ys + (size_t)s1 * DM + 256 * j + 4 * F.lane), wb = *(const u32x2*)(ys + (size_t)s2 * DM + 256 * j + 4 * F.lane);
            yv[j] = (f32x4){p1 * bflo(wa.x) + p2 * bflo(wb.x), p1 * bfhi(wa.x) + p2 * bfhi(wb.x), p1 * bflo(wa.y) + p2 * bflo(wb.y), p1 * bfhi(wa.y) + p2 * bfhi(wb.y)};
            ss += (yv[j].x * yv[j].x + yv[j].y * yv[j].y) + (yv[j].z * yv[j].z + yv[j].w * yv[j].w); }
        const float rstd = 1.f / sqrtf(wave_sum(ss) * (1.f / DM) + NORM_EPS);
        VM_WAIT();
#pragma unroll
        for (int j = 0; j < 4; ++j) { float* op = F.out + row * DM + 256 * j + 4 * F.lane; *(f32x4*)op = hv[j] + Gv[j] * (yv[j] * rstd); }
    }
}

constexpr int NPHASES = 21;
__global__ void __launch_bounds__(NWAVES * 64, 2) trunk_fwd(Args args) {
    extern __shared__ __attribute__((aligned(16))) unsigned char lds_raw[];
    Frame F;
    F.lds = (LAS unsigned char*)lds_raw;
    volatile LAS unsigned* MISC = (volatile LAS unsigned*)(F.lds + MISC_OFF);
    F.tid = threadIdx.x; F.lane = F.tid & 63; F.wave = __builtin_amdgcn_readfirstlane(F.tid >> 6);
    F.G = gridDim.x; { const int bx = blockIdx.x; F.vcu = (F.G % 8 == 0) ? (bx % 8) * (F.G / 8) + bx / 8 : bx; }
    F.x = args.in[0]; F.c = args.in[1]; F.mod_w = args.in[2]; F.mod_b = args.in[3]; F.norm_g = args.in[4]; F.w_in0 = args.in[5]; F.fox_bias = args.in[6]; F.w_out0 = args.in[7];
    F.w_in1 = args.in[8]; F.w_out1 = args.in[9]; F.relb = args.in[10]; F.ffn_g = args.in[11]; F.ffn_u = args.in[12]; F.ffn_d = args.in[13]; F.router_w = args.in[14];
    F.ex_g = args.in[15]; F.ex_u = args.in[16]; F.ex_d = args.in[17]; F.out = args.out; F.ws = args.ws;
    for (int u = F.tid; u < (LDS_BYTES - RING_BYTES) / 4; u += NWAVES * 64) ((LAS unsigned*)(F.lds + RING_BYTES))[u] = 0u;
    __syncthreads();
    const int lo = args.ph_lo, hi = args.ph_hi;
    XcdBarrier bar; bar.bar = (unsigned*)(F.ws + WS_CTL) + CW_BAR; bar.x = 0; bar.st = nullptr;
    if (hi - lo > 1) bar = xcd_barrier_post((unsigned*)(F.ws + WS_CTL) + CW_BAR, MISC + 8);
#define IN(k) (lo <= (k) && (k) < hi)
#define SEAM(k) do { if (IN(k) && IN((k) + 1)) xcd_barrier(bar); } while (0)
    const float* mods = (const float*)(F.ws + WS_MODS);
    const float* mods0 = mods, * mods1 = mods + (size_t)NB * 6144;
    const float* ng0 = F.norm_g, * ng1 = F.norm_g + 4 * DM;
    bf16* RA = (bf16*)(F.ws + WS_RA); bf16* RB = (bf16*)(F.ws + WS_RB); bf16* RC = (bf16*)(F.ws + WS_RC); bf16* RD = (bf16*)(F.ws + WS_RD);
    const bf16* wo = (const bf16*)(F.ws + WS_WOTHER);

    if (IN(0)) { phase_prologue(F); } SEAM(0);
    if (IN(1)) { thin_phase<false, 1>(F, F.x, nullptr, nullptr, nullptr, ng0, mods0 + 0, mods0 + 1024, RA); __syncthreads(); weight_copies(F); } SEAM(1);
    if (IN(2)) { pg8::Gemm g{RA, wo + WO_IN0 / 2, NTOK, 3072, DM}; pg8::StaticOrder S; S.init(NTOK, 3072, F.G, (int)blockIdx.x); pg8::EpiHeadMajor E{RB, NTOK, 0xFFull | (0xFFull << 24), att::C2};
        pg8::gemm_phase<pg8::EpiHeadMajor, pg8::StaticOrder>(F.lds, g, S, E); } SEAM(2);
    if (IN(3)) { phase_cum_kmean(F); } SEAM(3);
    if (IN(4)) {
        const int b = F.vcu >> 5, j = F.vcu & 31, a = j & 15;
        const float* cum = (const float*)(F.ws + WS_CUM); const float* km = (const float*)(F.ws + WS_KMEAN); const unsigned* qkn = (const unsigned*)(F.ws + WS_CTL) + CW_QKN;
        for (int r = 0; r < (MK_DUP == 41 ? 8 : 4); ++r) { const int r4 = r & 3; const int a8 = (a + 8) & 15; const int qt = (r4 == 0) ? a : (r4 == 1) ? 15 - a : (r4 == 2) ? a8 : 15 - a8;
            att::attn_unit_v2<1>(F.lds, RB, b, 8 + 2 * r4 + (j >> 4), qt, nullptr, km, F.relb, RA, qkn); }
        { const int hf = j >> 2, qq = j & 3;
          for (int i = 0; i < (MK_DUP == 40 ? 8 : 4); ++i) { const int i4 = i & 3; const int qt = (i4 == 0) ? 15 - qq : (i4 == 1) ? 8 + qq : (i4 == 2) ? 7 - qq : qq;
            att::attn_unit_v2<0>(F.lds, RB, b, hf, qt, cum, nullptr, nullptr, RA, qkn); } }
    } SEAM(4);
    if (IN(5)) { pg8::Gemm g{RA, wo + WO_OUT0 / 2, NTOK, DM, DM}; pg8::StaticOrder S; S.init(NTOK, DM, F.G, (int)blockIdx.x); pg8::EpiBf16 E{RC, DM};
        pg8::gemm_phase<pg8::EpiBf16, pg8::StaticOrder>(F.lds, g, S, E); } SEAM(5);
    if (IN(6)) { thin_phase<true, 0, true>(F, F.x, RC, ng0 + 1 * DM, mods0 + 2048, ng0 + 2 * DM, mods0 + 3072, mods0 + 4096, RA);
#if MK_DUP == 6
        xcd_barrier(bar); thin_phase<true, 0, true>(F, F.x, RC, ng0 + 1 * DM, mods0 + 2048, ng0 + 2 * DM, mods0 + 3072, mods0 + 4096, RA);
#endif
    } SEAM(6);
    if (IN(7)) { { pg8::Gemm g{RA, wo + WO_FGU / 2, NTOK, 2 * DFF, DM / 2}; pg8::StaticOrder S; S.init(NTOK, 2 * DFF, F.G, (int)blockIdx.x); pg8::EpiSwigluFp8 E{(unsigned char*)RB, DFF, 1.f / (FP8_SU * FP8_SW), FP8_SH};
        pg8::gemm_phase<pg8::EpiSwigluFp8, pg8::StaticOrder, true, true, DM / 2>(F.lds, g, S, E); }
#if MK_DUP == 7
        xcd_barrier(bar); { pg8::Gemm g{RA, wo + WO_FGU / 2, NTOK, 2 * DFF, DM / 2}; pg8::StaticOrder S; S.init(NTOK, 2 * DFF, F.G, (int)blockIdx.x); pg8::EpiSwigluFp8 E{(unsigned char*)RB, DFF, 1.f / (FP8_SU * FP8_SW), FP8_SH};
        pg8::gemm_phase<pg8::EpiSwigluFp8, pg8::StaticOrder, true, true, DM / 2>(F.lds, g, S, E); }
#endif
    } SEAM(7);
    if (IN(8)) { pg8::Gemm g{RB, wo + WO_FDN / 2, NTOK, DM, DFF / 2}; pg8::StaticOrder S; S.init(NTOK, DM, F.G, (int)blockIdx.x); pg8::EpiBf16Scaled E{RC, DM, 1.f / (FP8_SH * FP8_SW)};
        pg8::gemm_phase<pg8::EpiBf16Scaled, pg8::StaticOrder, true, true, DFF / 2>(F.lds, g, S, E); } SEAM(8);
    if (IN(9)) { thin_phase<true, 0, false, true>(F, F.out, RC, ng0 + 3 * DM, mods0 + 5120, ng1 + 0, mods1 + 0, mods1 + 1024, RA); } SEAM(9);
    if (IN(10)) { pg8::Gemm g{RA, wo + WO_IN1 / 2, NTOK, 3072, DM}; pg8::StaticOrder S; S.init(NTOK, 3072, F.G, (int)blockIdx.x); pg8::EpiHeadMajor E{RB, NTOK, 0xFFFFull, att::C2};
        pg8::gemm_phase<pg8::EpiHeadMajor, pg8::StaticOrder>(F.lds, g, S, E); } SEAM(10);
    if (IN(11)) {
        float* ml = (float*)(F.ws + WS_ML);
        att::dilated_phase(F.lds, RB, F.vcu >> 5, F.vcu & 31, F.relb, RA, RC, RD, ml, (const unsigned*)(F.ws + WS_CTL) + CW_KN1);
    } SEAM(11);
    if (IN(12)) { phase_merge(F); } SEAM(12);
    if (IN(13)) { pg8::Gemm g{RA, wo + WO_OUT1 / 2, NTOK, DM, DM}; pg8::StaticOrder S; S.init(NTOK, DM, F.G, (int)blockIdx.x); pg8::EpiBf16 E{RC, DM};
        pg8::gemm_phase<pg8::EpiBf16, pg8::StaticOrder>(F.lds, g, S, E); } SEAM(13);
    if (IN(14)) { thin_phase<true, 2, false, true>(F, F.out, RC, ng1 + 1 * DM, mods1 + 2048, ng1 + 2 * DM, mods1 + 3072, mods1 + 4096, RA); expert_weight_copies(F); } SEAM(14);
    if (IN(15)) { phase_gather(F); } SEAM(15);
    { int t_ = F.tid; asm volatile("" : "+v"(t_)); F.tid = t_; F.lane = t_ & 63; }
    {
        const int* te = (const int*)(F.ws + WS_TILEE);
        const unsigned char* us = F.ws + WS_USORT; unsigned char* hid = F.ws + WS_HID; bf16* ysl = (bf16*)(F.ws + WS_YSLOT);
        const unsigned char* wexp = F.ws + WS_WEXP;
        if (IN(16) || IN(17)) {
            int n = __builtin_amdgcn_readfirstlane(te[MAXTILES]); if (n > MAXTILES) n = MAXTILES;
            if (IN(16) && n > 0) { pg8::Gemm g{(const bf16*)us, (const bf16*)wexp, n * 256, 2 * DFE, DM / 2}; pg8::MoeOrder S; S.so.init(n * 256, 2 * DFE, F.G, (int)blockIdx.x); S.so.wgm = 16; S.tile_e = te; S.estride = WEXP_STRIDE;
                pg8::EpiSwigluFp8 E{hid, DFE, 1.f / (FP8_SU * FP8_SW), FP8_SH}; pg8::gemm_phase<pg8::EpiSwigluFp8, pg8::MoeOrder, true, true, DM / 2>(F.lds, g, S, E); }
            SEAM(16);
            if (IN(17) && n > 0) { pg8::Gemm g{(const bf16*)hid, (const bf16*)(wexp + WEXP_DN_OFF), n * 256, DM, DFE / 2}; pg8::MoeOrder S; S.so.init(n * 256, DM, F.G, (int)blockIdx.x); S.tile_e = te; S.estride = WEXP_STRIDE;
                pg8::EpiBf16Scaled E{ysl, DM, 1.f / (FP8_SH * FP8_SW)}; pg8::gemm_phase<pg8::EpiBf16Scaled, pg8::MoeOrder, true, true, DFE / 2>(F.lds, g, S, E); }
            SEAM(17);
        }
    }
    { int t_ = F.tid; asm volatile("" : "+v"(t_)); F.tid = t_; F.lane = t_ & 63; }
    if (IN(20)) { phase_final(F, ng1 + 3 * DM, mods1 + 5120); }
#undef IN
#undef SEAM
}

extern "C" void kernel_launch(void* const* d_in, const int* in_sizes, int n_in, void* d_out, int out_size, void* d_ws, size_t ws_size, hipStream_t stream) {
    static int grid = 0;
    if (grid == 0) {
        if (n_in != 18 || in_sizes[0] != NTOK * DM || out_size != NTOK * DM || ws_size < WS_END) { fprintf(stderr, "kernel_launch: unexpected shapes / workspace (%d inputs, ws %zu, need %zu); nothing launched\n", n_in, ws_size, (size_t)WS_END); grid = -1; return; }
        int dev = 0, cus = 0, per_cu = 0;
        if (hipGetDevice(&dev) != hipSuccess || hipDeviceGetAttribute(&cus, hipDeviceAttributeMultiprocessorCount, dev) != hipSuccess) { grid = -1; return; }
        if (hipFuncSetAttribute((const void*)trunk_fwd, hipFuncAttributeMaxDynamicSharedMemorySize, LDS_BYTES) != hipSuccess) { fprintf(stderr, "kernel_launch: hipFuncSetAttribute failed\n"); grid = -1; return; }
        if (hipOccupancyMaxActiveBlocksPerMultiprocessor(&per_cu, (const void*)trunk_fwd, NWAVES * 64, LDS_BYTES) != hipSuccess || per_cu < 1) { fprintf(stderr, "kernel_launch: occupancy query reports %d\n", per_cu); }
        (void)hipGetLastError();
        grid = cus;
        if (grid != 256) { fprintf(stderr, "kernel_launch: built for 256 CUs, found %d; nothing launched\n", grid); grid = -1; return; }
    }
    if (grid < 0) return;
    if (hipMemsetAsync((char*)d_ws + WS_CTL, 0, CTL_ZERO_BYTES, stream) != hipSuccess) return;
    Args a{};
    for (int i = 0; i < 18; ++i) a.in[i] = (const float*)d_in[i];
    a.out = (float*)d_out; a.ws = (unsigned char*)d_ws;
#if MK_ONE_LAUNCH
    a.ph_lo = 0; a.ph_hi = MK_LAST_PHASE;
    hipLaunchKernelGGL(trunk_fwd, dim3(grid), dim3(NWAVES * 64), LDS_BYTES, stream, a);
#else
    for (int p = 0; p < MK_LAST_PHASE; ++p) { a.ph_lo = p; a.ph_hi = p + 1; hipLaunchKernelGGL(trunk_fwd, dim3(grid), dim3(NWAVES * 64), LDS_BYTES, stream, a); }
#endif
}
```

```cpp
#include <hip/hip_runtime.h>
#include <cstdio>
#include <cstdint>

#ifndef MK_ONE_LAUNCH
#define MK_ONE_LAUNCH 1
#endif
#ifndef MK_DUP
#define MK_DUP 0
#endif
#ifndef MK_LAST_PHASE
#define MK_LAST_PHASE 21
#endif

#define GAS __attribute__((address_space(1)))
#define LAS __attribute__((address_space(3)))
typedef unsigned short bf16;
typedef unsigned u32x4 __attribute__((ext_vector_type(4)));
typedef unsigned u32x2 __attribute__((ext_vector_type(2)));
typedef float f32x4 __attribute__((ext_vector_type(4)));
typedef float f32x2 __attribute__((ext_vector_type(2)));
typedef float f32x16 __attribute__((ext_vector_type(16)));
typedef short bf16x8 __attribute__((ext_vector_type(8)));
typedef short s16x4 __attribute__((ext_vector_type(4)));
typedef GAS unsigned gu32;

constexpr int NB = 8, SEQ = 4096, DM = 1024, NTOK = NB * SEQ, NH = 16, HD = 64;
constexpr int DFF = 2816, NEXP = 8, DFE = 3584;
constexpr int QKVP = 3072;
constexpr int DIN0 = 3080;
constexpr float NORM_EPS = 1e-6f;
constexpr float LOG2E = 1.4426950408889634f;
constexpr int NWAVES = 8;
constexpr int MAXTILES = 264;
constexpr int PASS0_TILES = 128, PASS1_MAXTILES = MAXTILES - PASS0_TILES;

constexpr size_t MiB = 1u << 20;
constexpr size_t WS_CTL = 0, CTL_ZERO_BYTES = 1 * MiB;
constexpr size_t WS_MODS = 1 * MiB;
constexpr size_t WS_LOGF = 2 * MiB;
constexpr size_t WS_CUM = 3 * MiB;
constexpr size_t WS_KMEAN = 4 * MiB;
constexpr size_t WS_TOKE = 5 * MiB;
constexpr size_t WS_TOKP = WS_TOKE + 256 * 1024;
constexpr size_t WS_TOKR = WS_TOKP + 256 * 1024;
constexpr size_t WS_TOKS = WS_TOKR + 256 * 1024;
constexpr size_t WS_TILEE = 6 * MiB;
constexpr size_t WS_ML = 8 * MiB;
constexpr size_t WS_RA = 24 * MiB;
constexpr size_t WS_RC = 88 * MiB;
constexpr size_t WS_WOTHER = 152 * MiB;
constexpr size_t WS_RB = 185 * MiB;
constexpr size_t WS_RD = 377 * MiB;
constexpr size_t WS_HID = 24 * MiB;
constexpr size_t WS_USORT = 262 * MiB;
constexpr size_t WS_YSLOT = 328 * MiB;
constexpr size_t WS_WEXP = 460 * MiB;
constexpr size_t WS_END = 544 * MiB;
constexpr size_t WEXP_STRIDE = 10 * MiB + 512 * 1024, WEXP_DN_OFF = 7 * MiB;
constexpr float FP8_SW = 64.f, FP8_SU = 4.f, FP8_SH = 8.f;
constexpr size_t WO_IN0 = 0, WO_OUT0 = 6 * MiB, WO_IN1 = 8 * MiB, WO_OUT1 = 14 * MiB, WO_FGU = 16 * MiB, WO_FDN = 27 * MiB;
static_assert(WS_RB + (size_t)NTOK * QKVP * 2 <= WS_RD && WS_HID + (size_t)MAXTILES * 256 * DFE <= WS_USORT && WS_USORT + (size_t)MAXTILES * 256 * DM <= WS_YSLOT && WS_YSLOT + (size_t)MAXTILES * 256 * DM * 2 <= WS_WEXP && WS_WEXP + 8 * WEXP_STRIDE <= WS_END, "d_ws map");
constexpr int CW_GCNT = 1024;
constexpr int CW_QKN = 2048;
constexpr int CW_KN1 = 3072;
constexpr int CW_BAR = 4096;

constexpr int RING_BYTES = 131072;
constexpr int MISC_OFF = RING_BYTES + 320;
constexpr int LDS_BYTES = 147456;

__device__ __forceinline__ unsigned f2bf(float f) { unsigned u = __builtin_bit_cast(unsigned, f); return (u + 0x7fffu + ((u >> 16) & 1u)) >> 16; }
__device__ __forceinline__ unsigned pk2(float lo, float hi) { return f2bf(lo) | (f2bf(hi) << 16); }
__device__ __forceinline__ float bf2f(unsigned short b) { return __builtin_bit_cast(float, (unsigned)b << 16); }
__device__ __forceinline__ float bflo(unsigned w) { return __builtin_bit_cast(float, w << 16); }
__device__ __forceinline__ float bfhi(unsigned w) { return __builtin_bit_cast(float, w & 0xffff0000u); }
__device__ __forceinline__ float wave_sum(float v) {
#pragma unroll
    for (int o = 1; o < 64; o <<= 1) v += __shfl_xor(v, o);
    return v;
}
__device__ __forceinline__ unsigned pk4_fp8(float a, float b, float c, float d) { unsigned w = __builtin_amdgcn_cvt_pk_fp8_f32(a, b, 0u, false); return __builtin_amdgcn_cvt_pk_fp8_f32(c, d, w, true); }
__device__ __forceinline__ float clamp448(float v) { return __builtin_amdgcn_fmed3f(v, -448.f, 448.f); }
#define LDS_WAIT() asm volatile("s_waitcnt lgkmcnt(0)" ::: "memory")
#define VM_WAIT() asm volatile("s_waitcnt vmcnt(0)" ::: "memory")

namespace pg8 {
typedef unsigned short bf16_t;
typedef int v8i_t __attribute__((ext_vector_type(8)));
constexpr int BM = 256, BK = 64, HALF = 128, HTB = HALF * BK * 2, STAGE_BYTES = 8 * HTB, NXCD = 8, WGM = 8;
__host__ __device__ __forceinline__ int lds_byte(int r, int c) { const int st = (r >> 4) * 2 + (c >> 5), rr = r & 15, cc = c & 31, ob = rr * 64 + cc * 2; return st * 1024 + (ob ^ (((ob >> 9) & 1) << 5)); }
__host__ __device__ __forceinline__ void stage_rc(int b, int& R, int& C) { const int st = b / 1024, sb = b % 1024, swz = sb ^ (((sb >> 9) & 1) << 5); R = (st >> 1) * 16 + swz / 64; C = (st & 1) * 32 + (swz % 64) / 2; }
__host__ __device__ __forceinline__ int perm32(int rho) { const int n = rho >> 4, i = rho & 15; return 8 * (i >> 2) + 4 * n + (i & 3); }

struct Unit { int pm, pn; };
struct Gemm { const bf16_t* A; const bf16_t* Bt; int M, N, K; };

struct StaticOrder {
    int nM, nN, nwg, G, c, wgm = WGM;
    __device__ void init(int M, int N, int G_, int c_) { nM = M / BM; nN = N / BM; nwg = nM * nN; G = G_; c = c_; }
    __device__ bool next(int i, Unit& u) const {
        const long L = (long)i * G + c; if (L >= nwg) return false;
        int wgid = (int)L; { const int q = nwg / NXCD, r = nwg % NXCD, xcd = wgid % NXCD, off = wgid / NXCD; wgid = (xcd < r ? xcd * (q + 1) : r * (q + 1) + (xcd - r) * q) + off; }
        const int nig = wgm * nN, gid = wgid / nig, fm = gid * wgm, gsz = (nM - fm) < wgm ? (nM - fm) : wgm;
        u.pm = fm + ((wgid % nig) % gsz); u.pn = (wgid % nig) / gsz; return true;
    }
    __device__ __forceinline__ const char* abase(const Gemm& g, const Unit& u) const { return (const char*)g.A + (size_t)u.pm * ((size_t)BM * g.K * 2); }
    __device__ __forceinline__ const char* bbase(const Gemm& g, const Unit& u) const { return (const char*)g.Bt + (size_t)u.pn * ((size_t)BM * g.K * 2); }
};
struct MoeOrder {
    StaticOrder so; const int* tile_e; size_t estride;
    __device__ bool next(int i, Unit& u) const { return so.next(i, u); }
    __device__ __forceinline__ const char* abase(const Gemm& g, const Unit& u) const { return (const char*)g.A + (size_t)u.pm * ((size_t)BM * g.K * 2); }
    __device__ __forceinline__ const char* bbase(const Gemm& g, const Unit& u) const { const int e = __builtin_amdgcn_readfirstlane(tile_e[u.pm]); return (const char*)g.Bt + (size_t)e * estride + (size_t)u.pn * ((size_t)BM * g.K * 2); }
};

typedef float f32x2_t __attribute__((ext_vector_type(2))); typedef __bf16 bf16x2_t __attribute__((ext_vector_type(2)));
__device__ __forceinline__ unsigned cvt_pk_bf16(float lo, float hi) { f32x2_t v = {lo, hi}; bf16x2_t b = __builtin_convertvector(v, bf16x2_t); return __builtin_bit_cast(unsigned, b); }

struct EpiBf16 {
    static constexpr bool PERM = true;
    bf16_t* O; int ldc;
    __device__ __forceinline__ void operator()(const f32x4 (&acc)[2][2][4][2], const Unit& u, int wr, int wc, int fr, int fq) const {
        const int row0 = u.pm * BM + wr * 64 + fr; const int col0 = u.pn * BM + wc * 32 + 8 * fq;
#pragma unroll
        for (int ai = 0; ai < 2; ++ai)
#pragma unroll
            for (int m = 0; m < 4; ++m) { bf16_t* rowp = O + (size_t)(row0 + ai * HALF + m * 16) * ldc + col0;
#pragma unroll
                for (int bj = 0; bj < 2; ++bj) { const f32x4 v0 = acc[ai][bj][m][0], v1 = acc[ai][bj][m][1];
                    u32x4 w; w.x = cvt_pk_bf16(v0[0], v0[1]); w.y = cvt_pk_bf16(v0[2], v0[3]); w.z = cvt_pk_bf16(v1[0], v1[1]); w.w = cvt_pk_bf16(v1[2], v1[3]);
                    *(u32x4*)(rowp + bj * HALF) = w; } }
    }
};
struct EpiHeadMajor {
    static constexpr bool PERM = true;
    bf16_t* O; int M; unsigned long long qmask; float qscale;
    __device__ __forceinline__ void operator()(const f32x4 (&acc)[2][2][4][2], const Unit& u, int wr, int wc, int fr, int fq) const {
        const int row0 = u.pm * BM + wr * 64 + fr; const int col0 = u.pn * BM + wc * 32 + 8 * fq;
#pragma unroll
        for (int ai = 0; ai < 2; ++ai)
#pragma unroll
            for (int m = 0; m < 4; ++m) { const int row = row0 + ai * HALF + m * 16;
#pragma unroll
                for (int bj = 0; bj < 2; ++bj) { const int col = col0 + bj * HALF; const float sc = ((qmask >> (col >> 6)) & 1ull) ? qscale : 1.f; const f32x4 v0 = acc[ai][bj][m][0] * sc, v1 = acc[ai][bj][m][1] * sc;
                    u32x4 w; w.x = cvt_pk_bf16(v0[0], v0[1]); w.y = cvt_pk_bf16(v0[2], v0[3]); w.z = cvt_pk_bf16(v1[0], v1[1]); w.w = cvt_pk_bf16(v1[2], v1[3]);
                    *(u32x4*)(O + ((size_t)(col >> 6) * M + row) * 64 + (col & 63)) = w; } }
    }
};
__device__ __forceinline__ float silu_mul(float g, float u) { return g * u * __builtin_amdgcn_rcpf(1.f + __builtin_amdgcn_exp2f(-g * LOG2E)); }
struct EpiBf16Scaled {
    static constexpr bool PERM = true;
    bf16_t* O; int ldc; float scale;
    __device__ __forceinline__ void operator()(const f32x4 (&acc)[2][2][4][2], const Unit& u, int wr, int wc, int fr, int fq) const {
        const int row0 = u.pm * BM + wr * 64 + fr; const int col0 = u.pn * BM + wc * 32 + 8 * fq;
#pragma unroll
        for (int ai = 0; ai < 2; ++ai)
#pragma unroll
            for (int m = 0; m < 4; ++m) { bf16_t* rowp = O + (size_t)(row0 + ai * HALF + m * 16) * ldc + col0;
#pragma unroll
                for (int bj = 0; bj < 2; ++bj) { const f32x4 v0 = acc[ai][bj][m][0] * scale, v1 = acc[ai][bj][m][1] * scale;
                    u32x4 w; w.x = cvt_pk_bf16(v0[0], v0[1]); w.y = cvt_pk_bf16(v0[2], v0[3]); w.z = cvt_pk_bf16(v1[0], v1[1]); w.w = cvt_pk_bf16(v1[2], v1[3]);
                    *(u32x4*)(rowp + bj * HALF) = w; } }
    }
};
struct EpiSwigluFp8 {
    static constexpr bool PERM = true;
    unsigned char* O; int ldc; float sin, sout;
    __device__ __forceinline__ void operator()(const f32x4 (&acc)[2][2][4][2], const Unit& u, int wr, int wc, int fr, int fq) const {
        const int row0 = u.pm * BM + wr * 64 + fr; const int col0 = u.pn * HALF + wc * 32 + 8 * fq;
#pragma unroll
        for (int ai = 0; ai < 2; ++ai)
#pragma unroll
            for (int m = 0; m < 4; ++m) { unsigned char* rowp = O + (size_t)(row0 + ai * HALF + m * 16) * ldc + col0;
                const f32x4 ag0 = acc[ai][0][m][0], ag1 = acc[ai][0][m][1];
                const f32x4 t0 = ag0 * (-sin * LOG2E), t1 = ag1 * (-sin * LOG2E);
                f32x4 d0, d1;
#pragma unroll
                for (int e = 0; e < 4; ++e) { d0[e] = __builtin_amdgcn_exp2f(t0[e]); d1[e] = __builtin_amdgcn_exp2f(t1[e]); }
                d0 = d0 + 1.f; d1 = d1 + 1.f;
                f32x4 r0, r1;
#pragma unroll
                for (int e = 0; e < 4; ++e) { r0[e] = __builtin_amdgcn_rcpf(d0[e]); r1[e] = __builtin_amdgcn_rcpf(d1[e]); }
                const f32x4 v0 = (ag0 * acc[ai][1][m][0]) * (sin * sin * sout) * r0, v1 = (ag1 * acc[ai][1][m][1]) * (sin * sin * sout) * r1;
                u32x2 w; w.x = pk4_fp8(clamp448(v0[0]), clamp448(v0[1]), clamp448(v0[2]), clamp448(v0[3]));
                w.y = pk4_fp8(clamp448(v1[0]), clamp448(v1[1]), clamp448(v1[2]), clamp448(v1[3]));
                *(u32x2*)rowp = w; __builtin_amdgcn_sched_barrier(0); }
    }
};
struct EpiSwiglu {
    static constexpr bool PERM = true;
    bf16_t* O; int ldc;
    __device__ __forceinline__ void operator()(const f32x4 (&acc)[2][2][4][2], const Unit& u, int wr, int wc, int fr, int fq) const {
        const int row0 = u.pm * BM + wr * 64 + fr; const int col0 = u.pn * HALF + wc * 32 + 8 * fq;
#pragma unroll
        for (int ai = 0; ai < 2; ++ai)
#pragma unroll
            for (int m = 0; m < 4; ++m) { bf16_t* rowp = O + (size_t)(row0 + ai * HALF + m * 16) * ldc + col0;
                const f32x4 g0 = acc[ai][0][m][0], g1 = acc[ai][0][m][1], u0 = acc[ai][1][m][0], u1 = acc[ai][1][m][1];
                u32x4 w; w.x = cvt_pk_bf16(silu_mul(g0[0], u0[0]), silu_mul(g0[1], u0[1])); w.y = cvt_pk_bf16(silu_mul(g0[2], u0[2]), silu_mul(g0[3], u0[3]));
                w.z = cvt_pk_bf16(silu_mul(g1[0], u1[0]), silu_mul(g1[1], u1[1])); w.w = cvt_pk_bf16(silu_mul(g1[2], u1[2]), silu_mul(g1[3], u1[3]));
                *(u32x4*)rowp = w; }
    }
};

__device__ __forceinline__ void glds16s(const void* sbase, unsigned voff, unsigned lds_dst) { unsigned keep;
    asm volatile("s_mov_b32 %0, m0\n\ts_mov_b32 m0, %3\n\ts_nop 0\n\tglobal_load_lds_dwordx4 %2, %1\n\ts_mov_b32 m0, %0" : "=&s"(keep) : "s"(sbase), "v"(voff), "s"(lds_dst) : "memory"); }
template <class Epi, class Sched, bool ALIGN_EPI = true, bool FP8 = false, int KC = 0>
__device__ __forceinline__ void gemm_phase(LAS unsigned char* lds, const Gemm g, const Sched& S, const Epi& E) {
    const int tid = threadIdx.x, wid = __builtin_amdgcn_readfirstlane(tid >> 6), lane = tid & 63, wr = wid >> 2, wc = wid & 3, fr = lane & 15, fq = lane >> 4;
    const int K = KC > 0 ? KC : g.K, nt = K / BK;
    unsigned voffA[2], voffB[2];
#pragma unroll
    for (int i = 0; i < 2; ++i) { int R, C; stage_rc(tid * 16 + i * 8192, R, C); const int Rb = Epi::PERM ? ((R & ~31) + perm32(R & 31)) : R;
        voffA[i] = (unsigned)(R * K + C) * 2u; voffB[i] = (unsigned)(Rb * K + C) * 2u; }
    const size_t kstep = (size_t)(BK * 2);
    const size_t hstep = (size_t)HALF * K * 2;
    const unsigned ldsw = (unsigned)wid * 1024u;
    const unsigned lds_u32 = (unsigned)(unsigned long long)lds;
    const int aoff = lds_byte(wr * 64 + fr, fq * 8), boff = lds_byte(wc * 32 + fr, fq * 8);
    const int aoff8 = lds_byte(wr * 64 + fr, (fq & 1) * 16) + (fq >> 1) * 1024, boff8 = lds_byte(wc * 32 + fr, (fq & 1) * 16) + (fq >> 1) * 1024;
#define PG8_SA(b, h) (((b) * 2 + (h)) * HTB)
#define PG8_SB(b, h) ((4 + (b) * 2 + (h)) * HTB)
#define PG8_STAGE(bufoff, gbase, voff) do { _Pragma("unroll") for (int _i = 0; _i < 2; ++_i) \
        glds16s((const void*)(gbase), (voff)[_i], lds_u32 + (unsigned)(bufoff) + ldsw + (unsigned)(_i * 8192)); } while (0)
#define PG8_LD8(p_) (*(const LAS v8i_t*)(p_))
#define PG8_LDA(dst, b, h) do { if constexpr (FP8) { _Pragma("unroll") for (int m = 0; m < 4; ++m) dst##8[m] = PG8_LD8(lds + PG8_SA(b, h) + aoff8 + m * 2048); } \
        else { _Pragma("unroll") for (int m = 0; m < 4; ++m) _Pragma("unroll") for (int k = 0; k < 2; ++k) dst[m][k] = *(const LAS bf16x8*)(lds + PG8_SA(b, h) + aoff + m * 2048 + k * 1024); } } while (0)
#define PG8_LDB(dst, b, h) do { if constexpr (FP8) { _Pragma("unroll") for (int n = 0; n < 2; ++n) dst##8[n] = PG8_LD8(lds + PG8_SB(b, h) + boff8 + n * 2048); } \
        else { _Pragma("unroll") for (int n = 0; n < 2; ++n) _Pragma("unroll") for (int k = 0; k < 2; ++k) dst[n][k] = *(const LAS bf16x8*)(lds + PG8_SB(b, h) + boff + n * 2048 + k * 1024); } } while (0)
#define PG8_MMA(ai, bj, At, Bt) do { __builtin_amdgcn_s_setprio(1); if constexpr (FP8) { _Pragma("unroll") for (int m = 0; m < 4; ++m) _Pragma("unroll") for (int n = 0; n < 2; ++n) \
            asm volatile("v_mfma_f32_16x16x128_f8f6f4 %0, %1, %2, %0" : "+v"(acc[ai][bj][m][n]) : "v"(Bt##8[n]), "v"(At##8[m])); } \
        else { _Pragma("unroll") for (int m = 0; m < 4; ++m) _Pragma("unroll") for (int n = 0; n < 2; ++n) _Pragma("unroll") for (int k = 0; k < 2; ++k) \
        acc[ai][bj][m][n] = __builtin_amdgcn_mfma_f32_16x16x32_bf16(Bt[n][k], At[m][k], acc[ai][bj][m][n], 0, 0, 0); } __builtin_amdgcn_s_setprio(0); } while (0)
#define PG8_WAIT_V(n) asm volatile("s_waitcnt vmcnt(" #n ")" ::: "memory")
#define PG8_WAIT_L(n) asm volatile("s_waitcnt lgkmcnt(" #n ")" ::: "memory")
#define PG8_BAR __builtin_amdgcn_s_barrier()
#define PG8_SCHED __builtin_amdgcn_sched_barrier(0)
    Unit cur, nxt; int ui = 0;
    if (!S.next(0, cur)) return;
    f32x4 acc[2][2][4][2];
#pragma unroll
    for (int a = 0; a < 2; ++a)
#pragma unroll
        for (int b = 0; b < 2; ++b)
#pragma unroll
            for (int m = 0; m < 4; ++m)
#pragma unroll
                for (int n = 0; n < 2; ++n) acc[a][b][m][n] = (f32x4){0.f, 0.f, 0.f, 0.f};
    bf16x8 At[4][2], B0[2][2], B1[2][2]; v8i_t At8[4], B08[2], B18[2];
    const char* cA = S.abase(g, cur); const char* cB = S.bbase(g, cur);
    PG8_STAGE(PG8_SB(0, 0), cB, voffB); PG8_STAGE(PG8_SB(0, 1), cB + hstep, voffB); PG8_STAGE(PG8_SA(0, 0), cA, voffA); PG8_STAGE(PG8_SA(0, 1), cA + hstep, voffA);
    if (wr == 1) PG8_BAR;
    PG8_WAIT_V(2); PG8_BAR;
    PG8_STAGE(PG8_SB(1, 0), cB + kstep, voffB); PG8_STAGE(PG8_SA(1, 0), cA + kstep, voffA); PG8_STAGE(PG8_SB(1, 1), cB + hstep + kstep, voffB);
    PG8_WAIT_V(6); PG8_BAR;
    for (;;) {
        const bool has_next = S.next(ui + 1, nxt);
        const char* nA = cA; const char* nB = cB;
        if (has_next) { nA = S.abase(g, nxt); nB = S.bbase(g, nxt); }
        for (int t = 0; t < nt; t += 2) {
            const bool last = (t == nt - 2);
            const char* a1 = cA + (size_t)(t + 1) * kstep;
            const char* a2 = last ? nA : cA + (size_t)(t + 2) * kstep; const char* b2 = last ? nB : cB + (size_t)(t + 2) * kstep;
            const char* a3 = a2 + kstep; const char* b3 = b2 + kstep;
            PG8_LDB(B0, 0, 0); PG8_LDB(B1, 0, 1); PG8_SCHED; PG8_LDA(At, 0, 0); PG8_STAGE(PG8_SA(1, 1), a1 + hstep, voffA);
            PG8_WAIT_V(8); PG8_WAIT_L(0); PG8_BAR; PG8_MMA(0, 0, At, B0); PG8_MMA(0, 1, At, B1); PG8_BAR; PG8_SCHED;
            PG8_LDA(At, 0, 1); PG8_STAGE(PG8_SB(0, 0), b2, voffB); PG8_STAGE(PG8_SB(0, 1), b2 + hstep, voffB); PG8_STAGE(PG8_SA(0, 0), a2, voffA);
            PG8_WAIT_V(8); PG8_WAIT_L(0); PG8_BAR; PG8_MMA(1, 0, At, B0); PG8_MMA(1, 1, At, B1); PG8_BAR; PG8_SCHED;
            PG8_LDB(B0, 1, 0); PG8_LDB(B1, 1, 1); PG8_SCHED; PG8_LDA(At, 1, 0); PG8_STAGE(PG8_SA(0, 1), a2 + hstep, voffA);
            PG8_WAIT_V(8); PG8_WAIT_L(0); PG8_BAR; PG8_MMA(0, 0, At, B0); PG8_MMA(0, 1, At, B1); PG8_BAR; PG8_SCHED;
            PG8_LDA(At, 1, 1); PG8_STAGE(PG8_SB(1, 0), b3, voffB); PG8_STAGE(PG8_SB(1, 1), b3 + hstep, voffB); PG8_STAGE(PG8_SA(1, 0), a3, voffA);
            PG8_WAIT_V(8); PG8_WAIT_L(0); PG8_BAR; PG8_MMA(1, 0, At, B0); PG8_MMA(1, 1, At, B1); PG8_BAR; PG8_SCHED;
        }
        if constexpr (ALIGN_EPI) { if (wr == 0) PG8_BAR; }
        if constexpr (FP8) asm volatile("s_nop 15\n\ts_nop 15" ::: "memory");
        E(acc, cur, wr, wc, fr, fq);
#if MK_DUP == 116
        if constexpr (FP8) { asm volatile("" ::: "memory"); E(acc, cur, wr, wc, fr, fq); }
#endif
        if (!has_next) break;
#pragma unroll
        for (int a = 0; a < 2; ++a)
#pragma unroll
            for (int b = 0; b < 2; ++b)
#pragma unroll
                for (int m = 0; m < 4; ++m)
#pragma unroll
                    for (int n = 0; n < 2; ++n) acc[a][b][m][n] = (f32x4){0.f, 0.f, 0.f, 0.f};
        cur = nxt; cA = nA; cB = nB; ++ui;
        if constexpr (ALIGN_EPI) { if (wr == 1) PG8_BAR; }
    }
    PG8_WAIT_V(0);
    if constexpr (!ALIGN_EPI) { if (wr == 0) PG8_BAR; }
    PG8_BAR;
#undef PG8_SA
#undef PG8_SB
#undef PG8_STAGE
#undef PG8_LDA
#undef PG8_LDB
#undef PG8_MMA
#undef PG8_WAIT_V
#undef PG8_WAIT_L
#undef PG8_BAR
#undef PG8_SCHED
}
}

namespace att {
constexpr int KS = 0, VS = 16384, TAB = 32768, KM = TAB + 4224 * 4, LDS_END = KM + 4096;
constexpr float C2 = 0.125f * LOG2E;
constexpr float NEG = -1e30f;
__device__ __forceinline__ int crow(int r, int hi) { return (r & 3) + 8 * (r >> 2) + 4 * hi; }
__device__ __forceinline__ int t5_bucket(int d) {
    if (d < 16) return d < 0 ? 0 : d;
    int b = 16;
    b += (d >= 22); b += (d >= 30); b += (d >= 40); b += (d >= 54); b += (d >= 73); b += (d >= 99); b += (d >= 134); b += (d >= 182);
    b += (d >= 246); b += (d >= 332); b += (d >= 450); b += (d >= 609); b += (d >= 825); b += (d >= 1117); b += (d >= 1513);
    return b;
}
__device__ __forceinline__ float swapmax(float m) { return fmaxf(m, __shfl_xor(m, 32)); }
__device__ __forceinline__ float swapsum(float m) { return m + __shfl_xor(m, 32); }
typedef short v4i16_t __attribute__((ext_vector_type(4)));
__device__ __forceinline__ s16x4 vtr(const LAS unsigned char* p) { return __builtin_bit_cast(s16x4, __builtin_amdgcn_ds_read_tr16_b64_v4i16((LAS v4i16_t*)p)); }

constexpr int R_K = 0, R_V = 32768, R_TAB = 65536, R_KM = R_TAB + 4288 * 4, R_TS = R_KM + 4096, R_END = R_TS + 64;
#define ATT_WAITBAR(N) asm volatile("s_waitcnt vmcnt(" #N ") lgkmcnt(0)\n\ts_barrier" ::: "memory")
__device__ __forceinline__ bf16x8 scale_q(bf16x8 q) { bf16x8 r;
#pragma unroll
    for (int e = 0; e < 8; ++e) r[e] = (short)f2bf(bf2f((unsigned short)q[e]) * C2);
    return r; }

#define ATT_QK(Ks) do { _Pragma("unroll") for (int d0 = 0; d0 < 4; ++d0) { const bf16x8 k0_ = *(const LAS bf16x8*)((Ks) + koff[d0]), k1_ = *(const LAS bf16x8*)((Ks) + koff[d0] + 4096); \
        p0 = __builtin_amdgcn_mfma_f32_32x32x16_bf16(k0_, qr[d0], p0, 0, 0, 0); p1 = __builtin_amdgcn_mfma_f32_32x32x16_bf16(k1_, qr[d0], p1, 0, 0, 0); } } while (0)
#define ATT_SOFTMAX_PV(vp) do { \
        float mx_ = fmaxf(p0[0], p1[0]); \
        _Pragma("unroll") for (int r = 1; r < 16; ++r) mx_ = fmaxf(mx_, fmaxf(p0[r], p1[r])); \
        mx_ = swapmax(mx_); \
        const float mn_ = fmaxf(m, mx_); \
        if (__any(mn_ > m)) { const float alpha_ = __builtin_amdgcn_exp2f(m - mn_); l *= alpha_; \
            _Pragma("unroll") for (int r = 0; r < 16; ++r) { o0[r] *= alpha_; o1[r] *= alpha_; } } \
        m = mn_; float rs_ = 0.f; \
        _Pragma("unroll") for (int r = 0; r < 16; ++r) { p0[r] = __builtin_amdgcn_exp2f(p0[r] - mn_); p1[r] = __builtin_amdgcn_exp2f(p1[r] - mn_); rs_ += p0[r] + p1[r]; } \
        l += rs_; \
        bf16x8 pa_[4]; \
        _Pragma("unroll") for (int ks = 0; ks < 4; ++ks) { u32x4 w_; \
            _Pragma("unroll") for (int e = 0; e < 4; ++e) { const int r = 8 * (ks & 1) + 2 * e; w_[e] = (ks < 2) ? pg8::cvt_pk_bf16(p0[r], p0[r + 1]) : pg8::cvt_pk_bf16(p1[r], p1[r + 1]); } \
            pa_[ks] = __builtin_bit_cast(bf16x8, w_); } \
        _Pragma("unroll") for (int ks = 0; ks < 4; ++ks) { \
            const s16x4 a0_ = vtr((vp) + ks * 1024), a1_ = vtr((vp) + ks * 1024 + 512), b0_ = vtr((vp) + 4096 + ks * 1024), b1_ = vtr((vp) + 4096 + ks * 1024 + 512); \
            const bf16x8 va_ = (bf16x8){a0_[0], a0_[1], a0_[2], a0_[3], a1_[0], a1_[1], a1_[2], a1_[3]}, vb_ = (bf16x8){b0_[0], b0_[1], b0_[2], b0_[3], b1_[0], b1_[1], b1_[2], b1_[3]}; \
            o0 = __builtin_amdgcn_mfma_f32_32x32x16_bf16(va_, pa_[ks], o0, 0, 0, 0); o1 = __builtin_amdgcn_mfma_f32_32x32x16_bf16(vb_, pa_[ks], o1, 0, 0, 0); } \
    } while (0)
#define ATT_FAST_PV(vp) do { \
        _Pragma("unroll") for (int r = 0; r < 16; ++r) { p0[r] = __builtin_amdgcn_exp2f(p0[r]); p1[r] = __builtin_amdgcn_exp2f(p1[r]); } \
        bf16x8 pa_[4]; \
        _Pragma("unroll") for (int ks = 0; ks < 4; ++ks) { u32x4 w_; \
            _Pragma("unroll") for (int e = 0; e < 4; ++e) { const int r = 8 * (ks & 1) + 2 * e; w_[e] = (ks < 2) ? pg8::cvt_pk_bf16(p0[r], p0[r + 1]) : pg8::cvt_pk_bf16(p1[r], p1[r + 1]); } \
            pa_[ks] = __builtin_bit_cast(bf16x8, w_); } \
        _Pragma("unroll") for (int ks = 0; ks < 4; ++ks) { \
            const s16x4 a0_ = vtr((vp) + ks * 1024), a1_ = vtr((vp) + ks * 1024 + 512), b0_ = vtr((vp) + 4096 + ks * 1024), b1_ = vtr((vp) + 4096 + ks * 1024 + 512); \
            const bf16x8 va_ = (bf16x8){a0_[0], a0_[1], a0_[2], a0_[3], a1_[0], a1_[1], a1_[2], a1_[3]}, vb_ = (bf16x8){b0_[0], b0_[1], b0_[2], b0_[3], b1_[0], b1_[1], b1_[2], b1_[3]}; \
            o0 = __builtin_amdgcn_mfma_f32_32x32x16_bf16(va_, pa_[ks], o0, 0, 0, 0); o1 = __builtin_amdgcn_mfma_f32_32x32x16_bf16(vb_, pa_[ks], o1, 0, 0, 0); \
            o2 = __builtin_amdgcn_mfma_f32_32x32x16_bf16(ones8, pa_[ks], o2, 0, 0, 0); } \
    } while (0)
#define ATT_STORE_O(orow, inv) do { _Pragma("unroll") for (int a = 0; a < 4; ++a) { \
        u32x2 w0_, w1_; w0_.x = pg8::cvt_pk_bf16(o0[4 * a] * (inv), o0[4 * a + 1] * (inv)); w0_.y = pg8::cvt_pk_bf16(o0[4 * a + 2] * (inv), o0[4 * a + 3] * (inv)); \
        w1_.x = pg8::cvt_pk_bf16(o1[4 * a] * (inv), o1[4 * a + 1] * (inv)); w1_.y = pg8::cvt_pk_bf16(o1[4 * a + 2] * (inv), o1[4 * a + 3] * (inv)); \
        *(u32x2*)((orow) + 8 * a) = w0_; *(u32x2*)((orow) + 32 + 8 * a) = w1_; } } while (0)

template <int MODE>
__device__ __forceinline__ void attn_unit_v2(LAS unsigned char* lds, const bf16* __restrict__ qkv, int b, int h, int qt,
                                             const float* __restrict__ cum, const float* __restrict__ kmean, const float* __restrict__ relb,
                                             bf16* __restrict__ O, const unsigned* __restrict__ qkn) {
    const int tid = threadIdx.x, lane = tid & 63, r32 = lane & 31, hi = lane >> 5; const int wid = __builtin_amdgcn_readfirstlane(tid >> 6);
    const int qs = (MODE == 0) ? h : 24 + (h - 8), ks = qs + 8, vs = qs + 16;
    const bf16* qb = qkv + ((size_t)qs * NTOK + (size_t)b * SEQ) * 64; const bf16* kb = qkv + ((size_t)ks * NTOK + (size_t)b * SEQ) * 64; const bf16* vb = qkv + ((size_t)vs * NTOK + (size_t)b * SEQ) * 64;
    const int pw = 256 * qt + 32 * wid, myq = pw + r32;
    bf16x8 qr[4];
    { const bf16* qrow = qb + (size_t)myq * 64 + hi * 8;
#pragma unroll
      for (int d0 = 0; d0 < 4; ++d0) qr[d0] = *(const bf16x8*)(qrow + d0 * 16); }
    LAS float* tab = (LAS float*)(lds + R_TAB); LAS float* kml = (LAS float*)(lds + R_KM); LAS int* tsl = (LAS int*)(lds + R_TS);
    const int thi = 4 * qt + 3; int tlo = 0; float fox_b2 = 0.f;
    if (MODE == 0) {
        fox_b2 = 2.f * __builtin_bit_cast(float, qkn[2 * (b * 16 + h)]) * __builtin_bit_cast(float, qkn[2 * (b * 16 + h) + 1]);
        const float* cp = cum + (size_t)(b * 8 + h) * SEQ; const int nk = 256 * (qt + 1);
        for (int s = tid; s < nk; s += 512) tab[s] = -cp[s] * LOG2E;
        if (tid == 0) tsl[0] = 4 * qt;
        __syncthreads();
        if (tid < 4 * qt) { const float qn = __builtin_bit_cast(float, qkn[2 * (b * 16 + h)]), kn = __builtin_bit_cast(float, qkn[2 * (b * 16 + h) + 1]);
            const float bound = 2.f * qn * kn + (cp[256 * qt] - cp[64 * tid + 63]) * LOG2E;
            if (bound >= -64.f) __hip_atomic_fetch_min(&tsl[0], tid, __ATOMIC_RELAXED, __HIP_MEMORY_SCOPE_WORKGROUP); }
        __syncthreads();
        tlo = __builtin_amdgcn_readfirstlane(tsl[0]);
    } else {
        for (int j = tid; j < 4288; j += 512) { const int rel = 4095 - j; tab[j] = rel >= 0 ? relb[t5_bucket(rel) * 16 + h] * LOG2E : NEG; }
        const float* kp = kmean + (size_t)(b * 8 + (h - 8)) * 16 * 64;
        for (int j = tid; j < qt * 64; j += 512) kml[j] = kp[j];
        __syncthreads();
    }
    unsigned sel = 0u;
    if (MODE == 1) {
        float v1 = -INFINITY, v2 = -INFINITY, v3 = -INFINITY; int i1 = -1, i2 = -1, i3 = -1;
        for (int n = 0; n < qt; ++n) {
            float part = 0.f;
#pragma unroll
            for (int d0 = 0; d0 < 4; ++d0) { const f32x4 ka = *(const LAS f32x4*)(kml + n * 64 + d0 * 16 + hi * 8), kb = *(const LAS f32x4*)(kml + n * 64 + d0 * 16 + hi * 8 + 4);
                part += bf2f((unsigned short)qr[d0][0]) * ka[0] + bf2f((unsigned short)qr[d0][1]) * ka[1] + bf2f((unsigned short)qr[d0][2]) * ka[2] + bf2f((unsigned short)qr[d0][3]) * ka[3];
                part += bf2f((unsigned short)qr[d0][4]) * kb[0] + bf2f((unsigned short)qr[d0][5]) * kb[1] + bf2f((unsigned short)qr[d0][6]) * kb[2] + bf2f((unsigned short)qr[d0][7]) * kb[3]; }
            const float gt = swapsum(part);
            if (gt > v1) { v3 = v2; i3 = i2; v2 = v1; i2 = i1; v1 = gt; i1 = n; }
            else if (gt > v2) { v3 = v2; i3 = i2; v2 = gt; i2 = n; }
            else if (gt > v3) { v3 = gt; i3 = n; }
        }
        if (i1 >= 0) sel |= 1u << i1; if (i2 >= 0) sel |= 1u << i2; if (i3 >= 0) sel |= 1u << i3;
    }
    bool fast = false; f32x16 o2 = {}; bf16x8 ones8;
#pragma unroll
    for (int e = 0; e < 8; ++e) ones8[e] = (short)0x3F80;
    if (MODE == 1) fast = true;
    const int vrow = 16 * (wid & 3) + (lane >> 2);
    const int krow = 8 * wid + (lane >> 3);
    const bf16* ksrc0 = kb + (size_t)krow * 64 + (((lane & 7) ^ ((krow >> 1) & 7)) * 8);
    const bf16* vsrc0 = vb + (size_t)vrow * 64 + (wid >> 2) * 32 + (lane & 3) * 8;
    int koff[4];
#pragma unroll
    for (int d0 = 0; d0 < 4; ++d0) koff[d0] = r32 * 128 + (((2 * d0 + hi) ^ ((r32 >> 1) & 7)) << 4);
#define ATT_DMA(t) do { const unsigned so_ = (unsigned)((((t) & 3) * 8192) + wid * 1024); \
        __builtin_amdgcn_global_load_lds((const unsigned*)(ksrc0 + (size_t)(t) * 4096), (LAS unsigned*)(lds + R_K + so_), 16, 0, 0); \
        __builtin_amdgcn_global_load_lds((const unsigned*)(vsrc0 + (size_t)(t) * 4096), (LAS unsigned*)(lds + R_V + so_), 16, 0, 0); } while (0)
    const LAS unsigned char* vp0 = lds + R_V + ((lane >> 4) & 1) * 32 + (lane & 3) * 8 + (4 * hi + ((lane & 15) >> 2)) * 64;
    float m = NEG, l = 0.f; f32x16 o0 = {}, o1 = {};
#pragma unroll 1
  for (int attempt = 0; attempt < (MODE == 1 ? 2 : 1); ++attempt) {
    if (attempt == 1) { fast = false; m = NEG; l = 0.f; o0 = f32x16{}; o1 = f32x16{}; }
    asm volatile("s_waitcnt vmcnt(0)" ::: "memory");
    ATT_DMA(tlo); ATT_DMA(tlo + 1); ATT_DMA(tlo + 2);
    ATT_WAITBAR(4);
    for (int t = tlo; t <= thi; ++t) {
        if (t + 3 <= thi) ATT_DMA(t + 3);
        bool active = (64 * t <= pw + 31);
        if (MODE == 1) { if (t < 4 * qt) active = (__ballot((sel >> (t >> 2)) & 1u) != 0ull); }
        if (MODE == 0) { if (64 * t + 63 < pw) active = active && !((fox_b2 + tab[64 * t + 63] - tab[pw]) < -64.f); }
        if (active) {
            const LAS unsigned char* Ks = lds + R_K + (t & 3) * 8192;
            f32x16 p0, p1;
            if (MODE == 0) {
                const LAS float* cn = tab + 64 * t + 4 * hi;
#pragma unroll
                for (int a = 0; a < 4; ++a) { const f32x4 c0 = *(const LAS f32x4*)(cn + 8 * a), c1 = *(const LAS f32x4*)(cn + 32 + 8 * a);
#pragma unroll
                    for (int e = 0; e < 4; ++e) { p0[4 * a + e] = c0[e]; p1[4 * a + e] = c1[e]; } }
            } else {
                const int relbase = myq - 64 * t - 4 * hi;
                const LAS float* tj = tab + (4095 - relbase);
                if (t < 4 * qt) { if (!((sel >> (t >> 2)) & 1u)) tj = tab + 4224; }
#pragma unroll
                for (int r = 0; r < 16; ++r) { const int cr = (r & 3) + 8 * (r >> 2); p0[r] = tj[cr]; p1[r] = tj[cr + 32]; }
            }
            ATT_QK(Ks);
            if (MODE == 0) { if (t >= 4 * qt) {
#pragma unroll
                    for (int r = 0; r < 16; ++r) { const int kp = 64 * t + crow(r, hi); if (kp > myq) p0[r] = NEG; if (kp + 32 > myq) p1[r] = NEG; } } }
            const LAS unsigned char* vp = vp0 + (t & 3) * 8192;
            if (MODE == 1 && fast) { ATT_FAST_PV(vp); } else { ATT_SOFTMAX_PV(vp); }
        }
        if (t + 3 <= thi) ATT_WAITBAR(4); else if (t + 2 <= thi) ATT_WAITBAR(2); else ATT_WAITBAR(0);
    }
    if (MODE == 1 && attempt == 0) {
        const float l0 = o2[0]; const bool bad = __any(!(l0 > 7.9e-31f && l0 < 1.3e36f));
        if (tid == 0) tsl[1] = 0;
        __syncthreads();
        if (bad && lane == 0) tsl[1] = 1;
        __syncthreads();
        const int redo = __builtin_amdgcn_readfirstlane(tsl[1]);
        __syncthreads();
        if (!redo) break;
    }
  }
#undef ATT_DMA
    const float lt = (MODE == 1 && fast) ? o2[0] : swapsum(l), inv = 1.f / lt;
    bf16* orow = O + ((size_t)b * SEQ + myq) * DM + h * 64 + 4 * hi;
    ATT_STORE_O(orow, inv);
}

constexpr int DL_K = 0, DL_V = 49152, DL_TAB = 98304, DL_END = DL_TAB + 1536 + 128 + 2048;
__device__ __forceinline__ void dil_params(int i, int j, int& h, int& gp, int& dil, int& cls, int& qt) { const int hp = i / 3, idx = j + 32 * (i % 3), h2 = idx / 48, rem = idx % 48, x = rem & 15;
    h = 2 * hp + h2; gp = rem >> 4; dil = gp == 0 ? 1 : (gp == 1 ? 4 : 16); qt = gp == 0 ? x : (gp == 1 ? (x >> 2) : 0); cls = gp == 0 ? 0 : (gp == 1 ? (x & 3) : x); }
__device__ __forceinline__ void dilated_phase(LAS unsigned char* lds, const bf16* __restrict__ qkv, int b, int j, const float* __restrict__ relb,
                                              bf16* O0, bf16* O1, bf16* O2, float* __restrict__ ml, const unsigned* __restrict__ knw  ) {
    const int tid = threadIdx.x, lane = tid & 63, r32 = lane & 31, hi = lane >> 5; const int wid = __builtin_amdgcn_readfirstlane(tid >> 6);
    const int vrow = 16 * (wid & 3) + (lane >> 2), krow = 8 * wid + (lane >> 3);
    int koff[4];
#pragma unroll
    for (int d0 = 0; d0 < 4; ++d0) koff[d0] = r32 * 128 + (((2 * d0 + hi) ^ ((r32 >> 1) & 7)) << 4);
    LAS float* tab = (LAS float*)(lds + DL_TAB);
    LAS float* rbl = (LAS float*)(lds + DL_TAB + 1536 + 128);
    if (tid < 512) rbl[tid] = relb[tid] * LOG2E;
    __syncthreads();
    u32x4 kv[12]; bf16x8 qn[4], qn2[4];
#define DIL_PREFETCH(h_, qt_, dil_, cls_) do { const int T0_ = 4 * (qt_) - 2; \
        const bf16* ksrc0 = qkv + ((size_t)(16 + (h_)) * NTOK + (size_t)b * SEQ) * 64 + (((lane & 7) ^ ((krow >> 1) & 7)) * 8); \
        const bf16* vsrc0 = qkv + ((size_t)(32 + (h_)) * NTOK + (size_t)b * SEQ) * 64 + (wid >> 2) * 32 + (lane & 3) * 8; \
        _Pragma("unroll") for (int s_ = 0; s_ < 6; ++s_) { int kp_ = 64 * (T0_ + s_) + krow, vq_ = 64 * (T0_ + s_) + vrow; kp_ = kp_ < 0 ? 0 : kp_; vq_ = vq_ < 0 ? 0 : vq_; \
            kv[2 * s_] = *(const u32x4*)(ksrc0 + (size_t)(kp_ * (dil_) + (cls_)) * 64); kv[2 * s_ + 1] = *(const u32x4*)(vsrc0 + (size_t)(vq_ * (dil_) + (cls_)) * 64); } \
        } while (0)
#define DIL_PREFETCH_Q2(h_, qt_, dil_, cls_) do { const bf16* qrow_ = qkv + ((size_t)(h_) * NTOK + (size_t)b * SEQ) * 64 + (size_t)((256 * (qt_) + 32 * wid + r32) * (dil_) + (cls_)) * 64 + hi * 8; \
          _Pragma("unroll") for (int d0 = 0; d0 < 4; ++d0) qn2[d0] = *(const bf16x8*)(qrow_ + d0 * 16); } while (0)
#define DIL_PREFETCH_Q(h_, qt_, dil_, cls_) do { const bf16* qrow_ = qkv + ((size_t)(h_) * NTOK + (size_t)b * SEQ) * 64 + (size_t)((256 * (qt_) + 32 * wid + r32) * (dil_) + (cls_)) * 64 + hi * 8; \
          _Pragma("unroll") for (int d0 = 0; d0 < 4; ++d0) qn[d0] = *(const bf16x8*)(qrow_ + d0 * 16); } while (0)
    bf16x8 ones8;
#pragma unroll
    for (int e = 0; e < 8; ++e) ones8[e] = (short)0x3F80;
    int h, gp, dil, cls, qt;
    const LAS unsigned char* vp0 = lds + DL_V + ((lane >> 4) & 1) * 32 + (lane & 3) * 8 + (4 * hi + ((lane & 15) >> 2)) * 64;
    dil_params(0, j, h, gp, dil, cls, qt);
    DIL_PREFETCH(h, qt, dil, cls); DIL_PREFETCH_Q(h, qt, dil, cls);
    constexpr int NIT = (MK_DUP == 113) ? 48 : 24;
#pragma unroll 1
    for (int i = 0; i < NIT; ++i) {
        dil_params(i % 24, j, h, gp, dil, cls, qt);
        if (i > 0) {
#pragma unroll
            for (int d0 = 0; d0 < 4; ++d0) qn[d0] = qn2[d0]; }
#pragma unroll
        for (int s_ = 0; s_ < 6; ++s_) { *(LAS u32x4*)(lds + DL_K + s_ * 8192 + wid * 1024 + lane * 16) = kv[2 * s_]; *(LAS u32x4*)(lds + DL_V + s_ * 8192 + wid * 1024 + lane * 16) = kv[2 * s_ + 1]; }
        { for (int j = tid; j < 384; j += 512) { const int rel = 255 - j; tab[j] = (rel >= 0 && rel <= 128) ? rbl[t5_bucket(rel * dil) * 16 + h] : NEG; } }
        __syncthreads();
        if (i + 1 < NIT) { int h2_, g2_, d2, c2, q2; dil_params((i + 1) % 24, j, h2_, g2_, d2, c2, q2); DIL_PREFETCH(h2_, q2, d2, c2); DIL_PREFETCH_Q2(h2_, q2, d2, c2); }
        f32x16 o0 = {}, o1 = {}, o2 = {};
        float cshift = 0.f;
#pragma unroll 1
        for (int attempt = 0; attempt < 2; ++attempt) {
            if (attempt == 1) { float mx = NEG; o0 = f32x16{}; o1 = f32x16{}; o2 = f32x16{};
#pragma unroll
                for (int jj = 0; jj < 3; ++jj) { const int slot = (wid >> 1) + jj;
                    if (4 * qt - 2 + slot >= 0) { const int relbase = 32 * (wid & 1) + r32 + 128 - 64 * jj - 4 * hi; const LAS float* tj = tab + (255 - relbase);
                        f32x16 p0, p1;
#pragma unroll
                        for (int r = 0; r < 16; ++r) { const int cr = (r & 3) + 8 * (r >> 2); p0[r] = tj[cr]; p1[r] = tj[cr + 32]; }
                        const LAS unsigned char* Ks = lds + DL_K + slot * 8192;
                        { bf16x8 (&qr)[4] = qn; ATT_QK(Ks); }
#pragma unroll
                        for (int r = 0; r < 16; ++r) mx = fmaxf(mx, fmaxf(p0[r], p1[r])); } }
                cshift = swapmax(mx); }
#pragma unroll
            for (int jj = 0; jj < 3; ++jj) { const int slot = (wid >> 1) + jj;
                if (4 * qt - 2 + slot >= 0) { const int relbase = 32 * (wid & 1) + r32 + 128 - 64 * jj - 4 * hi; const LAS float* tj = tab + (255 - relbase);
                    f32x16 p0, p1;
                    if (attempt == 0) {
#pragma unroll
                        for (int r = 0; r < 16; ++r) { const int cr = (r & 3) + 8 * (r >> 2); p0[r] = tj[cr]; p1[r] = tj[cr + 32]; } }
                    else {
#pragma unroll
                        for (int r = 0; r < 16; ++r) { const int cr = (r & 3) + 8 * (r >> 2); p0[r] = tj[cr] - cshift; p1[r] = tj[cr + 32] - cshift; } }
                    const LAS unsigned char* Ks = lds + DL_K + slot * 8192;
                    { bf16x8 (&qr)[4] = qn; ATT_QK(Ks); }
                    const LAS unsigned char* vp = vp0 + slot * 8192;
                    ATT_FAST_PV(vp); } }
            if (attempt == 0) { const float l0 = o2[0]; if (!__any(!(l0 > 7.9e-31f && l0 < 1.3e36f))) break; }
        }
        const float m = cshift;
        const float lt = o2[0], inv = 1.f / lt;
        bf16* Op = gp == 0 ? O0 : (gp == 1 ? O1 : O2);
        const int mytok = (256 * qt + 32 * wid + r32) * dil + cls;
        bf16* orow = Op + ((size_t)b * SEQ + mytok) * DM + h * 64 + 4 * hi;
        ATT_STORE_O(orow, inv);
        if (hi == 0) { f32x2 v; v.x = m; v.y = lt; *(f32x2*)(ml + (size_t)gp * NTOK * NH * 2 + (((size_t)b * SEQ + mytok) * NH + h) * 2) = v; }
        __syncthreads();
    }
#undef DIL_PREFETCH
#undef DIL_PREFETCH_Q
}
}

#define XB_TMO      128
#define XB_XCNT(j)  (256  + 64 * (j))
#define XB_XSUB(j)  (1280 + 64 * (j))
#define XB_XGEN(j)  (2304 + 64 * (j))
#define XB_TOP      3328
#define XB_TOPGEN   3392
#define XCD_BAR_WORDS 3456
#define XB_SPIN_CAP (1u << 18)
__device__ __forceinline__ unsigned xb_ld(unsigned* p)              { return __hip_atomic_load(p, __ATOMIC_RELAXED, __HIP_MEMORY_SCOPE_AGENT); }
__device__ __forceinline__ unsigned xb_add(unsigned* p, unsigned v) { return __hip_atomic_fetch_add(p, v, __ATOMIC_RELAXED, __HIP_MEMORY_SCOPE_AGENT); }
__device__ __forceinline__ unsigned xb_xcc_id() { return (unsigned)__builtin_amdgcn_s_getreg((3 << 11) | 20) & 0xFu; }
#define XB_SPIN(cond, bar) do { unsigned _sp = 0; while (cond) { __builtin_amdgcn_s_sleep(1); \
    if ((++_sp & 255u) == 0u) { if (xb_ld(&(bar)[XB_TMO])) break; if (_sp > XB_SPIN_CAP) { atomicAdd(&(bar)[XB_TMO], 1u); break; } } } } while (0)
struct XcdBarrier { unsigned* bar; unsigned x; volatile LAS unsigned* st; };
__device__ __forceinline__ XcdBarrier xcd_barrier_post(unsigned* bar, volatile LAS unsigned* st) {
    XcdBarrier b; b.bar = bar; b.x = xb_xcc_id(); b.st = st;
    if (threadIdx.x == 0) (void)xb_add(&bar[XB_XCNT(b.x)], 1u);
    return b;
}
__device__ __forceinline__ void xcd_barrier_complete(unsigned* bar, unsigned x, unsigned& nloc, unsigned& nx) {
    const unsigned G = gridDim.x * gridDim.y * gridDim.z;
    unsigned sum, cnt, mine, sp = 0u;
    for (;;) {
        sum = 0u; cnt = 0u; mine = 0u;
#pragma unroll
        for (unsigned j = 0; j < 16; ++j) { const unsigned c = xb_ld(&bar[XB_XCNT(j)]); sum += c; cnt += (c > 0u) ? 1u : 0u; mine = (j == x) ? c : mine; }
        if (sum == G) break;
        __builtin_amdgcn_s_sleep(1);
        if ((++sp & 255u) == 0u) { if (xb_ld(&bar[XB_TMO])) break; if (sp > XB_SPIN_CAP) { atomicAdd(&bar[XB_TMO], 1u); break; } }
    }
    nloc = mine > 0u ? mine : 1u; nx = cnt > 0u ? cnt : 1u;
}
__device__ __forceinline__ void xcd_barrier(const XcdBarrier& b) {
    asm volatile("s_waitcnt vmcnt(0)" ::: "memory");
    __syncthreads();
    if (threadIdx.x == 0) {
        unsigned* bar = b.bar;
        __builtin_amdgcn_s_waitcnt(0);
        unsigned nloc = b.st[0], nx = b.st[1];
        if (nloc == 0u) { xcd_barrier_complete(bar, b.x, nloc, nx); b.st[0] = nloc; b.st[1] = nx; }
        const unsigned old = xb_add(&bar[XB_XSUB(b.x)], 1u);
        const unsigned gen = old / nloc;
        if (old + 1u == (gen + 1u) * nloc) {
            __builtin_amdgcn_fence(__ATOMIC_RELEASE, "agent");
            asm volatile("s_waitcnt vmcnt(0)" ::: "memory");
            const unsigned og = xb_add(&bar[XB_TOP], 1u);
            const unsigned tg = og / nx;
            if (og + 1u == (tg + 1u) * nx) xb_add(&bar[XB_TOPGEN], 1u);
            else XB_SPIN(xb_ld(&bar[XB_TOPGEN]) == tg, bar);
            __builtin_amdgcn_fence(__ATOMIC_ACQUIRE, "agent");
            xb_add(&bar[XB_XGEN(b.x)], 1u);
            asm volatile("s_waitcnt vmcnt(0)" ::: "memory");
        } else {
            XB_SPIN(xb_ld(&bar[XB_XGEN(b.x)]) == gen, bar);
            __builtin_amdgcn_fence(__ATOMIC_ACQUIRE, "agent");
            asm volatile("s_waitcnt vmcnt(0)" ::: "memory");
        }
    }
    __syncthreads();
}

struct Args { const float* in[18]; float* out; unsigned char* ws; int ph_lo, ph_hi; };
struct Frame {
    LAS unsigned char* lds; int tid, lane, wave, vcu, G;
    const float *x, *c, *mod_w, *mod_b, *norm_g, *w_in0, *fox_bias, *w_out0, *w_in1, *w_out1, *relb, *ffn_g, *ffn_u, *ffn_d, *router_w, *ex_g, *ex_u, *ex_d;
    float* out; unsigned char* ws;
};

struct TMat { const float* W; unsigned char* WT; int K, N, row_off, mode, fp8; };
__device__ __forceinline__ int t_dest_row(int mode, int n) {
    if (mode == 0) return n;
    if (mode == 1) return ((n >> 7) << 8) + (n & 127);
    return n < 1536 ? n : (n >= 1544 ? n - 8 : -1);
}
__device__ __forceinline__ void t_load(const TMat& m, int item, int lane, f32x4 (&r)[8], int& k0, int& n0) {
    const int kblocks = m.K >> 5, nb = item / kblocks, kb = item - nb * kblocks; k0 = kb * 32; n0 = nb * 64;
    const int n = n0 + 4 * (lane & 15); const bool ok = n < m.N;
    const float* p = m.W + (size_t)(k0 + (lane >> 4)) * m.N + n;
#pragma unroll
    for (int i = 0; i < 8; ++i) r[i] = ok ? *(const f32x4*)(p + (size_t)(4 * i) * m.N) : (f32x4){0.f, 0.f, 0.f, 0.f};
}
__device__ __forceinline__ void t_to_lds(const f32x4 (&r)[8], LAS float* scr, int lane) {
#pragma unroll
    for (int i = 0; i < 8; ++i) *(LAS f32x4*)(scr + (4 * i + (lane >> 4)) * 68 + 4 * (lane & 15)) = r[i];
}
__device__ __forceinline__ void t_store(const TMat& m, int k0, int n0, int lane, const LAS float* scr) {
    const int n = n0 + lane, dr = t_dest_row(m.mode, n); const bool ok = n < m.N && dr >= 0;
    float v[32];
#pragma unroll
    for (int k = 0; k < 32; ++k) v[k] = scr[k * 68 + lane];
    if (m.fp8) { u32x4 o[2];
#pragma unroll
        for (int q = 0; q < 2; ++q) { o[q].x = pk4_fp8(v[16 * q + 0] * FP8_SW, v[16 * q + 1] * FP8_SW, v[16 * q + 2] * FP8_SW, v[16 * q + 3] * FP8_SW); o[q].y = pk4_fp8(v[16 * q + 4] * FP8_SW, v[16 * q + 5] * FP8_SW, v[16 * q + 6] * FP8_SW, v[16 * q + 7] * FP8_SW);
            o[q].z = pk4_fp8(v[16 * q + 8] * FP8_SW, v[16 * q + 9] * FP8_SW, v[16 * q + 10] * FP8_SW, v[16 * q + 11] * FP8_SW); o[q].w = pk4_fp8(v[16 * q + 12] * FP8_SW, v[16 * q + 13] * FP8_SW, v[16 * q + 14] * FP8_SW, v[16 * q + 15] * FP8_SW); }
        if (ok) { unsigned char* d = m.WT + (size_t)(m.row_off + dr) * m.K + k0; *(u32x4*)d = o[0]; *(u32x4*)(d + 16) = o[1]; }
    } else { u32x4 o[4];
#pragma unroll
        for (int q = 0; q < 4; ++q) { o[q].x = pg8::cvt_pk_bf16(v[8 * q + 0], v[8 * q + 1]); o[q].y = pg8::cvt_pk_bf16(v[8 * q + 2], v[8 * q + 3]); o[q].z = pg8::cvt_pk_bf16(v[8 * q + 4], v[8 * q + 5]); o[q].w = pg8::cvt_pk_bf16(v[8 * q + 6], v[8 * q + 7]); }
        if (ok) { unsigned char* d = m.WT + ((size_t)(m.row_off + dr) * m.K + k0) * 2;
#pragma unroll
            for (int q = 0; q < 4; ++q) *(u32x4*)(d + 16 * q) = o[q]; }
    }
}
template <class Dec> __device__ __forceinline__ void t_run(int i0, int i1, int lane, LAS float* scr, const Dec& dec) {
    if (i0 >= i1) return;
    f32x4 r[8]; int k0, n0, loc; TMat m;
    dec(i0, m, loc); t_load(m, loc, lane, r, k0, n0);
    for (int it = i0; it < i1; ++it) {
        t_to_lds(r, scr, lane); asm volatile("" ::: "memory");
        const TMat mc = m; const int k0c = k0, n0c = n0;
        if (it + 1 < i1) { dec(it + 1, m, loc); t_load(m, loc, lane, r, k0, n0); }
        asm volatile("" ::: "memory"); LDS_WAIT(); asm volatile("" ::: "memory");
        t_store(mc, k0c, n0c, lane, scr);
        LDS_WAIT(); asm volatile("" ::: "memory");
    }
}
__device__ __forceinline__ void t_split(int nitems, int gw, int ngw, int& i0, int& i1) { const int q = nitems / ngw, rem = nitems % ngw; i0 = gw * q + (gw < rem ? gw : rem); i1 = i0 + q + (gw < rem ? 1 : 0); }

__device__ __forceinline__ void weight_copies(Frame& F) {
    LAS float* scr = (LAS float*)(F.lds + F.wave * 16384);
    const int gw = F.vcu * NWAVES + F.wave, NGW = F.G * NWAVES;
    unsigned char* wo = F.ws + WS_WOTHER;
    constexpr int I_IN0 = 32 * 49, I_OUT = 32 * 16, I_IN1 = 32 * 48, I_FG = 32 * 44, I_FD = 88 * 16;
    constexpr int NITEMS = I_IN0 + I_OUT + I_IN1 + I_OUT + 2 * I_FG + I_FD;
    auto dec = [&](int it, TMat& m, int& loc) { int r = it;
        if (r < I_IN0) { m = TMat{F.w_in0, wo + WO_IN0, DM, DIN0, 0, 2, 0}; loc = r; return; } r -= I_IN0;
        if (r < I_OUT) { m = TMat{F.w_out0, wo + WO_OUT0, DM, DM, 0, 0, 0}; loc = r; return; } r -= I_OUT;
        if (r < I_IN1) { m = TMat{F.w_in1, wo + WO_IN1, DM, 3 * DM, 0, 0, 0}; loc = r; return; } r -= I_IN1;
        if (r < I_OUT) { m = TMat{F.w_out1, wo + WO_OUT1, DM, DM, 0, 0, 0}; loc = r; return; } r -= I_OUT;
        if (r < I_FG) { m = TMat{F.ffn_g, wo + WO_FGU, DM, DFF, 0, 1, 1}; loc = r; return; } r -= I_FG;
        if (r < I_FG) { m = TMat{F.ffn_u, wo + WO_FGU, DM, DFF, 128, 1, 1}; loc = r; return; } r -= I_FG;
        m = TMat{F.ffn_d, wo + WO_FDN, DFF, DM, 0, 0, 1}; loc = r; };
    int i0, i1; t_split(NITEMS, gw, NGW, i0, i1);
    t_run(i0, i1, F.lane, scr, dec);
    __syncthreads();
}

__device__ __forceinline__ void phase_prologue(Frame& F) {
    if (F.vcu < 192) {
        LAS float* sc = (LAS float*)F.lds;
        LAS float* red = (LAS float*)(F.lds + 32768);
        for (int i = F.tid; i < NB * DM; i += 512) { const float v = F.c[i]; sc[i] = v / (1.f + expf(-v)); }
        __syncthreads();
        const int l = F.vcu / 96, e0 = (F.vcu % 96) * 64, col = F.lane, kq = F.wave;
        float acc[8];
#pragma unroll
        for (int b = 0; b < 8; ++b) acc[b] = 0.f;
        const float* wp = F.mod_w + ((size_t)l * DM + kq * 128) * 6144 + e0 + col;
#pragma unroll 32
        for (int k = 0; k < 128; ++k) { const float w = wp[(size_t)k * 6144];
#pragma unroll
            for (int b = 0; b < 8; ++b) acc[b] += sc[b * DM + kq * 128 + k] * w; }
#pragma unroll
        for (int b = 0; b < 8; ++b) red[(kq * 8 + b) * 64 + col] = acc[b];
        __syncthreads();
        { const int b = F.tid >> 6; float s = 0.f;
#pragma unroll
          for (int q = 0; q < 8; ++q) s += red[(q * 8 + b) * 64 + col];
          ((float*)(F.ws + WS_MODS))[((size_t)l * NB + b) * 6144 + e0 + col] = s + F.mod_b[l * 6144 + e0 + col]; }
        __syncthreads();
    }
}

__device__ __forceinline__ void expert_weight_copies(Frame& F) {
    LAS float* scr = (LAS float*)(F.lds + F.wave * 16384);
    const int gw = F.vcu * NWAVES + F.wave, NGW = F.G * NWAVES;
    constexpr int I_GU = 32 * 56, I_DN = 112 * 16, PER_E = 2 * I_GU + I_DN;
    auto dec = [&](int it, TMat& m, int& loc) { const int e = it / PER_E; int r = it - e * PER_E;
        unsigned char* we = F.ws + WS_WEXP + (size_t)e * WEXP_STRIDE;
        if (r < I_GU) { m = TMat{F.ex_g + (size_t)e * DM * DFE, we, DM, DFE, 0, 1, 1}; loc = r; return; } r -= I_GU;
        if (r < I_GU) { m = TMat{F.ex_u + (size_t)e * DM * DFE, we, DM, DFE, 128, 1, 1}; loc = r; return; } r -= I_GU;
        m = TMat{F.ex_d + (size_t)e * DFE * DM, we + WEXP_DN_OFF, DFE, DM, 0, 0, 1}; loc = r; };
    int i0, i1; t_split(NEXP * PER_E, gw, NGW, i0, i1);
    t_run(i0, i1, F.lane, scr, dec);
}

template <bool RES, int EXTRA, bool U8 = false, bool HB = false>
__device__ __forceinline__ void thin_phase(Frame& F, const float* hin, const bf16* y, const float* gy, const float* gatev  ,
                                           const float* gu, const float* shv, const float* scv, bf16* uout) {
    const int gw = F.vcu * NWAVES + F.wave;
    const int row0 = gw * 16, b = row0 >> 12;
    LAS float* w8 = (LAS float*)F.lds;
    LAS int* lcnt = (LAS int*)(F.lds + 32768);
    if (EXTRA == 1) { for (int i = F.tid; i < 8 * DM; i += 512) { const int k = i >> 3, j = i & 7; w8[j * DM + k] = F.w_in0[(size_t)k * DIN0 + 1536 + j]; } }
    if (EXTRA == 2) { for (int i = F.tid; i < 8 * DM; i += 512) { const int k = i >> 3, j = i & 7; w8[j * DM + k] = F.router_w[(size_t)k * NEXP + j]; }
        if (F.tid < 16) lcnt[F.tid] = 0; }
    if (EXTRA != 0) __syncthreads();
    f32x4 Gv[4], Av[4], Bv[4];
#pragma unroll
    for (int j = 0; j < 4; ++j) { const int c = 256 * j + 4 * F.lane;
        const f32x4 g = *(const f32x4*)(gu + c), s1 = *(const f32x4*)(scv + (size_t)b * 6144 + c); Av[j] = g * (s1 + 1.f); Bv[j] = *(const f32x4*)(shv + (size_t)b * 6144 + c);
        if (RES) Gv[j] = *(const f32x4*)(gatev + (size_t)b * 6144 + c) * *(const f32x4*)(gy + c); }
    for (int i = 0; i < 16; ++i) {
        const int row = row0 + i;
        f32x4 hv[4];
#pragma unroll
        for (int j = 0; j < 4; ++j) { if constexpr (HB) { const u32x2 w = *(const u32x2*)((const unsigned char*)hin + (size_t)row * 4096 + 512 * j + 8 * F.lane); hv[j] = (f32x4){bflo(w.x), bfhi(w.x), bflo(w.y), bfhi(w.y)}; }
            else hv[j] = *(const f32x4*)(hin + (size_t)row * DM + 256 * j + 4 * F.lane); }
        if (RES) {
            f32x4 yv[4]; float ss = 0.f;
#pragma unroll
            for (int j = 0; j < 4; ++j) { const u32x2 w = *(const u32x2*)(y + (size_t)row * DM + 256 * j + 4 * F.lane); yv[j] = (f32x4){bflo(w.x), bfhi(w.x), bflo(w.y), bfhi(w.y)};
#ifdef DBG_SANITIZE
                for (int e_ = 0; e_ < 4; ++e_) if (!(fabsf(yv[j][e_]) < 1e30f)) yv[j][e_] = 0.f;
#endif
                ss += (yv[j].x * yv[j].x + yv[j].y * yv[j].y) + (yv[j].z * yv[j].z + yv[j].w * yv[j].w); }
            const float rstd = 1.f / sqrtf(wave_sum(ss) * (1.f / DM) + NORM_EPS);
#pragma unroll
            for (int j = 0; j < 4; ++j) { hv[j] = hv[j] + Gv[j] * (yv[j] * rstd); u32x2 w; w.x = pg8::cvt_pk_bf16(hv[j].x, hv[j].y); w.y = pg8::cvt_pk_bf16(hv[j].z, hv[j].w);
                *(u32x2*)((unsigned char*)F.out + (size_t)row * 4096 + 512 * j + 8 * F.lane) = w; }
        }
        float s2 = 0.f;
#pragma unroll
        for (int j = 0; j < 4; ++j) s2 += (hv[j].x * hv[j].x + hv[j].y * hv[j].y) + (hv[j].z * hv[j].z + hv[j].w * hv[j].w);
        const float rs = 1.f / sqrtf(wave_sum(s2) * (1.f / DM) + NORM_EPS);
        f32x4 uv[4];
#pragma unroll
        for (int j = 0; j < 4; ++j) { uv[j] = hv[j] * rs * Av[j] + Bv[j];
            if constexpr (U8) { *(unsigned*)((unsigned char*)uout + (size_t)row * DM + 256 * j + 4 * F.lane) = pk4_fp8(clamp448(uv[j].x * FP8_SU), clamp448(uv[j].y * FP8_SU), clamp448(uv[j].z * FP8_SU), clamp448(uv[j].w * FP8_SU)); }
            else { u32x2 w; w.x = pk2(uv[j].x, uv[j].y); w.y = pk2(uv[j].z, uv[j].w); *(u32x2*)(uout + (size_t)row * DM + 256 * j + 4 * F.lane) = w; } }
        if (EXTRA != 0) {
            float d[8];
#pragma unroll
            for (int q = 0; q < 8; ++q) { float s = 0.f;
#pragma unroll
                for (int j = 0; j < 4; ++j) { const f32x4 w = *(const LAS f32x4*)(w8 + q * DM + 256 * j + 4 * F.lane); s += (uv[j].x * w.x + uv[j].y * w.y) + (uv[j].z * w.z + uv[j].w * w.w); }
                d[q] = wave_sum(s); }
            if (EXTRA == 1) {
                float z = d[0];
#pragma unroll
                for (int q = 1; q < 8; ++q) z = (F.lane == q) ? d[q] : z;
                if (F.lane < 8) { z += F.fox_bias[F.lane]; const float ls = fminf(z, 0.f) - log1pf(expf(-fabsf(z)));
                    ((float*)(F.ws + WS_LOGF))[((size_t)b * 8 + F.lane) * SEQ + (row & (SEQ - 1))] = ls; }
            } else {
                int i1 = 0; float v1 = d[0];
#pragma unroll
                for (int q = 1; q < 8; ++q) if (d[q] > v1) { v1 = d[q]; i1 = q; }
                int i2 = -1; float v2 = -INFINITY;
#pragma unroll
                for (int q = 0; q < 8; ++q) if (q != i1 && d[q] > v2) { v2 = d[q]; i2 = q; }
                if (i2 < 0) { i2 = (i1 + 1) & 7; v2 = v1; }
                const float p1 = 1.f / (1.f + expf(v2 - v1)), p2 = 1.f - p1;
                if (F.lane == 0) {
                    const int rl = row - F.vcu * 128;
                    const int k1 = __hip_atomic_fetch_add(&lcnt[i1], 1, __ATOMIC_RELAXED, __HIP_MEMORY_SCOPE_WORKGROUP);
                    const int k2 = __hip_atomic_fetch_add(&lcnt[i2], 1, __ATOMIC_RELAXED, __HIP_MEMORY_SCOPE_WORKGROUP);
                    lcnt[16 + rl * 2] = i1; lcnt[16 + rl * 2 + 1] = i2; lcnt[16 + 256 + rl * 2] = k1; lcnt[16 + 256 + rl * 2 + 1] = k2;
                    f32x2 pv; pv.x = p1; pv.y = p2; *(f32x2*)((float*)(F.ws + WS_TOKP) + (size_t)row * 2) = pv;
                }
            }
        }
    }
    if (EXTRA == 2) {
        __syncthreads();
        if (F.tid < 8) lcnt[8 + F.tid] = (int)__hip_atomic_fetch_add((unsigned*)(F.ws + WS_CTL) + CW_GCNT + 64 * F.tid, (unsigned)lcnt[F.tid], __ATOMIC_RELAXED, __HIP_MEMORY_SCOPE_AGENT);
        __syncthreads();
        if (F.tid < 256) { const int rl = F.tid >> 1, k = F.tid & 1, e = lcnt[16 + F.tid], rk = lcnt[16 + 256 + F.tid]; const size_t row = (size_t)F.vcu * 128 + rl;
            ((int*)(F.ws + WS_TOKE))[row * 2 + k] = e; ((int*)(F.ws + WS_TOKR))[row * 2 + k] = lcnt[8 + e] + rk; }
        __syncthreads();
    }
}

__device__ __forceinline__ void phase_cum_kmean(Frame& F) {
    if (F.vcu < 64) {
        const float* lf = (const float*)(F.ws + WS_LOGF) + (size_t)F.vcu * SEQ; float* cu = (float*)(F.ws + WS_CUM) + (size_t)F.vcu * SEQ;
        LAS float* wt = (LAS float*)F.lds;
        f32x4 a = *(const f32x4*)(lf + F.tid * 8), c = *(const f32x4*)(lf + F.tid * 8 + 4);
        float v[8] = {a.x, a.y, a.z, a.w, c.x, c.y, c.z, c.w};
#pragma unroll
        for (int i = 1; i < 8; ++i) v[i] += v[i - 1];
        float run = v[7];
#pragma unroll
        for (int o = 1; o < 64; o <<= 1) { const float t = __shfl_up(run, o); if (F.lane >= o) run += t; }
        if (F.lane == 63) wt[F.wave] = run;
        __syncthreads();
        float off = run - v[7];
        for (int w = 0; w < F.wave; ++w) off += wt[w];
        f32x4 o0 = {v[0] + off, v[1] + off, v[2] + off, v[3] + off}, o1 = {v[4] + off, v[5] + off, v[6] + off, v[7] + off};
        *(f32x4*)(cu + F.tid * 8) = o0; *(f32x4*)(cu + F.tid * 8 + 4) = o1;
        __syncthreads();
    }
    const int gw = F.vcu * NWAVES + F.wave, NGW = F.G * NWAVES;
    const bf16* qkv = (const bf16*)(F.ws + WS_RB);
    for (int it = gw; it < NB * 8 * 16; it += NGW) {
        const int blk = it & 15, hh = (it >> 4) & 7, b = it >> 7;
        const bf16* kp = qkv + ((size_t)(32 + hh) * NTOK + (size_t)b * SEQ + blk * 256) * 64 + (F.lane & 7) * 8;
        float s[8] = {0.f, 0.f, 0.f, 0.f, 0.f, 0.f, 0.f, 0.f};
#pragma unroll 8
        for (int i = 0; i < 32; ++i) { const u32x4 w = *(const u32x4*)(kp + (size_t)((F.lane >> 3) + 8 * i) * 64);
            s[0] += bflo(w.x); s[1] += bfhi(w.x); s[2] += bflo(w.y); s[3] += bfhi(w.y); s[4] += bflo(w.z); s[5] += bfhi(w.z); s[6] += bflo(w.w); s[7] += bfhi(w.w); }
#pragma unroll
        for (int q = 0; q < 8; ++q) { s[q] += __shfl_xor(s[q], 8); s[q] += __shfl_xor(s[q], 16); s[q] += __shfl_xor(s[q], 32); }
        if (F.lane < 8) { float* o = (float*)(F.ws + WS_KMEAN) + (size_t)it * 64 + F.lane * 8;
            f32x4 o0 = {s[0], s[1], s[2], s[3]}, o1 = {s[4], s[5], s[6], s[7]}; *(f32x4*)o = o0 * (1.f / 256.f); *(f32x4*)(o + 4) = o1 * (1.f / 256.f); }
    }
    for (int it = gw; it < NB * 8 * 16; it += NGW) {
        const int blk = it & 15, hx = (it >> 4) & 7, b = it >> 7; const int qs = hx;
        const bf16* qp = qkv + ((size_t)qs * NTOK + (size_t)b * SEQ + blk * 256) * 64 + (F.lane & 7) * 8;
        float mq = 0.f, mk = 0.f;
        for (int i0 = 0; i0 < 32; i0 += 8) {
            u32x4 wq[8], wk[8];
#pragma unroll
            for (int i = 0; i < 8; ++i) { wq[i] = *(const u32x4*)(qp + (size_t)((F.lane >> 3) + 8 * (i0 + i)) * 64); wk[i] = *(const u32x4*)(qp + (size_t)8 * NTOK * 64 + (size_t)((F.lane >> 3) + 8 * (i0 + i)) * 64); }
#pragma unroll
            for (int i = 0; i < 8; ++i) { float sq = 0.f, sk = 0.f;
#pragma unroll
                for (int e = 0; e < 4; ++e) { sq += bflo(wq[i][e]) * bflo(wq[i][e]) + bfhi(wq[i][e]) * bfhi(wq[i][e]); sk += bflo(wk[i][e]) * bflo(wk[i][e]) + bfhi(wk[i][e]) * bfhi(wk[i][e]); }
                sq += __shfl_xor(sq, 1); sq += __shfl_xor(sq, 2); sq += __shfl_xor(sq, 4); sk += __shfl_xor(sk, 1); sk += __shfl_xor(sk, 2); sk += __shfl_xor(sk, 4);
                mq = fmaxf(mq, sq); mk = fmaxf(mk, sk); } }
#pragma unroll
        for (int o = 8; o < 64; o <<= 1) { mq = fmaxf(mq, __shfl_xor(mq, o)); mk = fmaxf(mk, __shfl_xor(mk, o)); }
        if (F.lane == 0) { unsigned* w = (unsigned*)(F.ws + WS_CTL) + CW_QKN + 2 * (b * 16 + hx);
            __hip_atomic_fetch_max(w, __builtin_bit_cast(unsigned, sqrtf(mq)), __ATOMIC_RELAXED, __HIP_MEMORY_SCOPE_AGENT);
            __hip_atomic_fetch_max(w + 1, __builtin_bit_cast(unsigned, sqrtf(mk)), __ATOMIC_RELAXED, __HIP_MEMORY_SCOPE_AGENT); }
    }
}

__device__ __forceinline__ void phase_merge(Frame& F) {
    const int gw = F.vcu * NWAVES + F.wave;
    bf16* p0 = (bf16*)(F.ws + WS_RA); const bf16* p1 = (const bf16*)(F.ws + WS_RC); const bf16* p2 = (const bf16*)(F.ws + WS_RD);
    const float* ml = (const float*)(F.ws + WS_ML);
    for (int i = 0; i < 16; ++i) { const size_t row = (size_t)gw * 16 + i;
#pragma unroll
        for (int j = 0; j < 4; ++j) { const int head = 4 * j + (F.lane >> 4); const size_t mi = (row * NH + head) * 2;
            const f32x2 a = *(const f32x2*)(ml + mi), b = *(const f32x2*)(ml + (size_t)NTOK * NH * 2 + mi), c = *(const f32x2*)(ml + (size_t)2 * NTOK * NH * 2 + mi);
            const float M = fmaxf(a.x, fmaxf(b.x, c.x));
            float wa = a.y * __builtin_amdgcn_exp2f(a.x - M), wb = b.y * __builtin_amdgcn_exp2f(b.x - M), wc = c.y * __builtin_amdgcn_exp2f(c.x - M);
            const float inv = 1.f / (wa + wb + wc); wa *= inv; wb *= inv; wc *= inv;
            const size_t off = row * DM + 256 * j + 4 * F.lane;
            const u32x2 xa = *(const u32x2*)(p0 + off), xb = *(const u32x2*)(p1 + off), xc = *(const u32x2*)(p2 + off);
            u32x2 w; w.x = pk2(wa * bflo(xa.x) + wb * bflo(xb.x) + wc * bflo(xc.x), wa * bfhi(xa.x) + wb * bfhi(xb.x) + wc * bfhi(xc.x));
            w.y = pk2(wa * bflo(xa.y) + wb * bflo(xb.y) + wc * bflo(xc.y), wa * bfhi(xa.y) + wb * bfhi(xb.y) + wc * bfhi(xc.y));
            *(u32x2*)(p0 + off) = w; }
    }
}

__device__ __forceinline__ void phase_gather(Frame& F) {
    LAS int* so = (LAS int*)F.lds;
    if (F.tid == 0) { int acc = 0; for (int e = 0; e < 8; ++e) { so[e] = acc; const int c = (int)__hip_atomic_load((unsigned*)(F.ws + WS_CTL) + CW_GCNT + 64 * e, __ATOMIC_RELAXED, __HIP_MEMORY_SCOPE_AGENT); acc += (c + 255) & ~255; } so[8] = acc; }
    __syncthreads();
    if (F.vcu == 0) { int* te = (int*)(F.ws + WS_TILEE); const int nt = so[8] >> 8;
        for (int t = F.tid; t < MAXTILES; t += 512) { int e = 0; for (int q = 1; q < 8; ++q) if (t * 256 >= so[q]) e = q; te[t] = e; }
        if (F.tid == 0) te[MAXTILES] = nt < MAXTILES ? nt : MAXTILES; }
    const int gw = F.vcu * NWAVES + F.wave;
    const bf16* u = (const bf16*)(F.ws + WS_RA); unsigned char* us = F.ws + WS_USORT;
    const int* te = (const int*)(F.ws + WS_TOKE); const int* tr = (const int*)(F.ws + WS_TOKR); int* ts = (int*)(F.ws + WS_TOKS);
    int d_l = 0;
    if (F.lane < 32) { const int e = te[gw * 32 + F.lane] & 7; d_l = so[e] + tr[gw * 32 + F.lane]; d_l = d_l < 0 ? 0 : (d_l >= MAXTILES * 256 ? MAXTILES * 256 - 1 : d_l); ts[gw * 32 + F.lane] = d_l; }
#pragma unroll 1
    for (int i0 = 0; i0 < 16; i0 += 4) {
        u32x4 a[4], b[4];
#pragma unroll
        for (int r = 0; r < 4; ++r) { const size_t row = (size_t)gw * 16 + i0 + r; a[r] = *(const u32x4*)(u + row * DM + F.lane * 8); b[r] = *(const u32x4*)(u + row * DM + 512 + F.lane * 8); }
#pragma unroll
        for (int r = 0; r < 4; ++r) { u32x2 fa, fb;
            fa.x = pk4_fp8(bflo(a[r].x) * FP8_SU, bfhi(a[r].x) * FP8_SU, bflo(a[r].y) * FP8_SU, bfhi(a[r].y) * FP8_SU); fa.y = pk4_fp8(bflo(a[r].z) * FP8_SU, bfhi(a[r].z) * FP8_SU, bflo(a[r].w) * FP8_SU, bfhi(a[r].w) * FP8_SU);
            fb.x = pk4_fp8(bflo(b[r].x) * FP8_SU, bfhi(b[r].x) * FP8_SU, bflo(b[r].y) * FP8_SU, bfhi(b[r].y) * FP8_SU); fb.y = pk4_fp8(bflo(b[r].z) * FP8_SU, bfhi(b[r].z) * FP8_SU, bflo(b[r].w) * FP8_SU, bfhi(b[r].w) * FP8_SU);
#pragma unroll
            for (int k = 0; k < 2; ++k) { const int dst = __builtin_amdgcn_readlane(d_l, 2 * (i0 + r) + k);
                *(u32x2*)(us + (size_t)dst * DM + F.lane * 8) = fa; *(u32x2*)(us + (size_t)dst * DM + 512 + F.lane * 8) = fb; } }
    }
}

__device__ __forceinline__ void phase_final(Frame& F, const float* __restrict__ gy, const float* __restrict__ gatev) {
    const int gw = F.vcu * NWAVES + F.wave; const int row0 = gw * 16, b = row0 >> 12;
    const bf16* ys = (const bf16*)(F.ws + WS_YSLOT); const int* ts = (const int*)(F.ws + WS_TOKS); const float* tp = (const float*)(F.ws + WS_TOKP);
    f32x4 Gv[4];
#pragma unroll
    for (int j = 0; j < 4; ++j) { const int c = 256 * j + 4 * F.lane; Gv[j] = *(const f32x4*)(gatev + (size_t)b * 6144 + c) * *(const f32x4*)(gy + c); }
    for (int i = 0; i < 16; ++i) { const size_t row = (size_t)row0 + i;
        int s1 = ts[row * 2], s2 = ts[row * 2 + 1]; const float p1 = tp[row * 2], p2 = tp[row * 2 + 1];
        s1 = s1 < 0 ? 0 : (s1 >= MAXTILES * 256 ? MAXTILES * 256 - 1 : s1); s2 = s2 < 0 ? 0 : (s2 >= MAXTILES * 256 ? MAXTILES * 256 - 1 : s2);
        f32x4 yv[4], hv[4]; float ss = 0.f;
#pragma unroll
        for (int j = 0; j < 4; ++j) { const u32x2 w = *(const u32x2*)((const unsigned char*)F.out + row * 4096 + 512 * j + 8 * F.lane); hv[j] = (f32x4){bflo(w.x), bfhi(w.x), bflo(w.y), bfhi(w.y)}; }
#pragma unroll
        for (int j = 0; j < 4; ++j) { const u32x2 wa = *(const u32x2*)(ys + (size_t)s1 * DM + 256 * j + 4 * F.lane), wb = *(const u32x2*)(ys + (size_t)s2 * DM + 256 * j + 4 * F.lane);
            yv[j] = (f32x4){p1 * bflo(wa.x) + p2 * bflo(wb.x), p1 * bfhi(wa.x) + p2 * bfhi(wb.x), p1 * bflo(wa.y) + p2 * bflo(wb.y), p1 * bfhi(wa.y) + p2 * bfhi(wb.y)};
            ss += (yv[j].x * yv[j].x + yv[j].y * yv[j].y) + (yv[j].z * yv[j].z + yv[j].w * yv[j].w); }
        const float rstd = 1.f / sqrtf(wave_sum(ss) * (1.f / DM) + NORM_EPS);
        VM_WAIT();
#pragma unroll
        for (int j = 0; j < 4; ++j) { float* op = F.out + row * DM + 256 * j + 4 * F.lane; *(f32x4*)op = hv[j] + Gv[j] * (yv[j] * rstd); }
    }
}

constexpr int NPHASES = 21;
__global__ void __launch_bounds__(NWAVES * 64, 2) trunk_fwd(Args args) {
    extern __shared__ __attribute__((aligned(16))) unsigned char lds_raw[];
    Frame F;
    F.lds = (LAS unsigned char*)lds_raw;
    volatile LAS unsigned* MISC = (volatile LAS unsigned*)(F.lds + MISC_OFF);
    F.tid = threadIdx.x; F.lane = F.tid & 63; F.wave = __builtin_amdgcn_readfirstlane(F.tid >> 6);
    F.G = gridDim.x; { const int bx = blockIdx.x; F.vcu = (F.G % 8 == 0) ? (bx % 8) * (F.G / 8) + bx / 8 : bx; }
    F.x = args.in[0]; F.c = args.in[1]; F.mod_w = args.in[2]; F.mod_b = args.in[3]; F.norm_g = args.in[4]; F.w_in0 = args.in[5]; F.fox_bias = args.in[6]; F.w_out0 = args.in[7];
    F.w_in1 = args.in[8]; F.w_out1 = args.in[9]; F.relb = args.in[10]; F.ffn_g = args.in[11]; F.ffn_u = args.in[12]; F.ffn_d = args.in[13]; F.router_w = args.in[14];
    F.ex_g = args.in[15]; F.ex_u = args.in[16]; F.ex_d = args.in[17]; F.out = args.out; F.ws = args.ws;
    for (int u = F.tid; u < (LDS_BYTES - RING_BYTES) / 4; u += NWAVES * 64) ((LAS unsigned*)(F.lds + RING_BYTES))[u] = 0u;
    __syncthreads();
    const int lo = args.ph_lo, hi = args.ph_hi;
    XcdBarrier bar; bar.bar = (unsigned*)(F.ws + WS_CTL) + CW_BAR; bar.x = 0; bar.st = nullptr;
    if (hi - lo > 1) bar = xcd_barrier_post((unsigned*)(F.ws + WS_CTL) + CW_BAR, MISC + 8);
#define IN(k) (lo <= (k) && (k) < hi)
#define SEAM(k) do { if (IN(k) && IN((k) + 1)) xcd_barrier(bar); } while (0)
    const float* mods = (const float*)(F.ws + WS_MODS);
    const float* mods0 = mods, * mods1 = mods + (size_t)NB * 6144;
    const float* ng0 = F.norm_g, * ng1 = F.norm_g + 4 * DM;
    bf16* RA = (bf16*)(F.ws + WS_RA); bf16* RB = (bf16*)(F.ws + WS_RB); bf16* RC = (bf16*)(F.ws + WS_RC); bf16* RD = (bf16*)(F.ws + WS_RD);
    const bf16* wo = (const bf16*)(F.ws + WS_WOTHER);

    if (IN(0)) { phase_prologue(F); } SEAM(0);
    if (IN(1)) { thin_phase<false, 1>(F, F.x, nullptr, nullptr, nullptr, ng0, mods0 + 0, mods0 + 1024, RA); __syncthreads(); weight_copies(F); } SEAM(1);
    if (IN(2)) { pg8::Gemm g{RA, wo + WO_IN0 / 2, NTOK, 3072, DM}; pg8::StaticOrder S; S.init(NTOK, 3072, F.G, (int)blockIdx.x); pg8::EpiHeadMajor E{RB, NTOK, 0xFFull | (0xFFull << 24), att::C2};
        pg8::gemm_phase<pg8::EpiHeadMajor, pg8::StaticOrder>(F.lds, g, S, E); } SEAM(2);
    if (IN(3)) { phase_cum_kmean(F); } SEAM(3);
    if (IN(4)) {
        const int b = F.vcu >> 5, j = F.vcu & 31, a = j & 15;
        const float* cum = (const float*)(F.ws + WS_CUM); const float* km = (const float*)(F.ws + WS_KMEAN); const unsigned* qkn = (const unsigned*)(F.ws + WS_CTL) + CW_QKN;
        for (int r = 0; r < (MK_DUP == 41 ? 8 : 4); ++r) { const int r4 = r & 3; const int a8 = (a + 8) & 15; const int qt = (r4 == 0) ? a : (r4 == 1) ? 15 - a : (r4 == 2) ? a8 : 15 - a8;
            att::attn_unit_v2<1>(F.lds, RB, b, 8 + 2 * r4 + (j >> 4), qt, nullptr, km, F.relb, RA, qkn); }
        { const int hf = j >> 2, qq = j & 3;
          for (int i = 0; i < (MK_DUP == 40 ? 8 : 4); ++i) { const int i4 = i & 3; const int qt = (i4 == 0) ? 15 - qq : (i4 == 1) ? 8 + qq : (i4 == 2) ? 7 - qq : qq;
            att::attn_unit_v2<0>(F.lds, RB, b, hf, qt, cum, nullptr, nullptr, RA, qkn); } }
    } SEAM(4);
    if (IN(5)) { pg8::Gemm g{RA, wo + WO_OUT0 / 2, NTOK, DM, DM}; pg8::StaticOrder S; S.init(NTOK, DM, F.G, (int)blockIdx.x); pg8::EpiBf16 E{RC, DM};
        pg8::gemm_phase<pg8::EpiBf16, pg8::StaticOrder>(F.lds, g, S, E); } SEAM(5);
    if (IN(6)) { thin_phase<true, 0, true>(F, F.x, RC, ng0 + 1 * DM, mods0 + 2048, ng0 + 2 * DM, mods0 + 3072, mods0 + 4096, RA);
#if MK_DUP == 6
        xcd_barrier(bar); thin_phase<true, 0, true>(F, F.x, RC, ng0 + 1 * DM, mods0 + 2048, ng0 + 2 * DM, mods0 + 3072, mods0 + 4096, RA);
#endif
    } SEAM(6);
    if (IN(7)) { { pg8::Gemm g{RA, wo + WO_FGU / 2, NTOK, 2 * DFF, DM / 2}; pg8::StaticOrder S; S.init(NTOK, 2 * DFF, F.G, (int)blockIdx.x); pg8::EpiSwigluFp8 E{(unsigned char*)RB, DFF, 1.f / (FP8_SU * FP8_SW), FP8_SH};
        pg8::gemm_phase<pg8::EpiSwigluFp8, pg8::StaticOrder, true, true, DM / 2>(F.lds, g, S, E); }
#if MK_DUP == 7
        xcd_barrier(bar); { pg8::Gemm g{RA, wo + WO_FGU / 2, NTOK, 2 * DFF, DM / 2}; pg8::StaticOrder S; S.init(NTOK, 2 * DFF, F.G, (int)blockIdx.x); pg8::EpiSwigluFp8 E{(unsigned char*)RB, DFF, 1.f / (FP8_SU * FP8_SW), FP8_SH};
        pg8::gemm_phase<pg8::EpiSwigluFp8, pg8::StaticOrder, true, true, DM / 2>(F.lds, g, S, E); }
#endif
    } SEAM(7);
    if (IN(8)) { pg8::Gemm g{RB, wo + WO_FDN / 2, NTOK, DM, DFF / 2}; pg8::StaticOrder S; S.init(NTOK, DM, F.G, (int)blockIdx.x); pg8::EpiBf16Scaled E{RC, DM, 1.f / (FP8_SH * FP8_SW)};
        pg8::gemm_phase<pg8::EpiBf16Scaled, pg8::StaticOrder, true, true, DFF / 2>(F.lds, g, S, E); } SEAM(8);
    if (IN(9)) { thin_phase<true, 0, false, true>(F, F.out, RC, ng0 + 3 * DM, mods0 + 5120, ng1 + 0, mods1 + 0, mods1 + 1024, RA); } SEAM(9);
    if (IN(10)) { pg8::Gemm g{RA, wo + WO_IN1 / 2, NTOK, 3072, DM}; pg8::StaticOrder S; S.init(NTOK, 3072, F.G, (int)blockIdx.x); pg8::EpiHeadMajor E{RB, NTOK, 0xFFFFull, att::C2};
        pg8::gemm_phase<pg8::EpiHeadMajor, pg8::StaticOrder>(F.lds, g, S, E); } SEAM(10);
    if (IN(11)) {
        float* ml = (float*)(F.ws + WS_ML);
        att::dilated_phase(F.lds, RB, F.vcu >> 5, F.vcu & 31, F.relb, RA, RC, RD, ml, (const unsigned*)(F.ws + WS_CTL) + CW_KN1);
    } SEAM(11);
    if (IN(12)) { phase_merge(F); } SEAM(12);
    if (IN(13)) { pg8::Gemm g{RA, wo + WO_OUT1 / 2, NTOK, DM, DM}; pg8::StaticOrder S; S.init(NTOK, DM, F.G, (int)blockIdx.x); pg8::EpiBf16 E{RC, DM};
        pg8::gemm_phase<pg8::EpiBf16, pg8::StaticOrder>(F.lds, g, S, E); } SEAM(13);
    if (IN(14)) { thin_phase<true, 2, false, true>(F, F.out, RC, ng1 + 1 * DM, mods1 + 2048, ng1 + 2 * DM, mods1 + 3072, mods1 + 4096, RA); expert_weight_copies(F); } SEAM(14);
    if (IN(15)) { phase_gather(F); } SEAM(15);
    { int t_ = F.tid; asm volatile("" : "+v"(t_)); F.tid = t_; F.lane = t_ & 63; }
    {
        const int* te = (const int*)(F.ws + WS_TILEE);
        const unsigned char* us = F.ws + WS_USORT; unsigned char* hid = F.ws + WS_HID; bf16* ysl = (bf16*)(F.ws + WS_YSLOT);
        const unsigned char* wexp = F.ws + WS_WEXP;
        if (IN(16) || IN(17)) {
            int n = __builtin_amdgcn_readfirstlane(te[MAXTILES]); if (n > MAXTILES) n = MAXTILES;
            if (IN(16) && n > 0) { pg8::Gemm g{(const bf16*)us, (const bf16*)wexp, n * 256, 2 * DFE, DM / 2}; pg8::MoeOrder S; S.so.init(n * 256, 2 * DFE, F.G, (int)blockIdx.x); S.so.wgm = 16; S.tile_e = te; S.estride = WEXP_STRIDE;
                pg8::EpiSwigluFp8 E{hid, DFE, 1.f / (FP8_SU * FP8_SW), FP8_SH}; pg8::gemm_phase<pg8::EpiSwigluFp8, pg8::MoeOrder, true, true, DM / 2>(F.lds, g, S, E); }
            SEAM(16);
            if (IN(17) && n > 0) { pg8::Gemm g{(const bf16*)hid, (const bf16*)(wexp + WEXP_DN_OFF), n * 256, DM, DFE / 2}; pg8::MoeOrder S; S.so.init(n * 256, DM, F.G, (int)blockIdx.x); S.tile_e = te; S.estride = WEXP_STRIDE;
                pg8::EpiBf16Scaled E{ysl, DM, 1.f / (FP8_SH * FP8_SW)}; pg8::gemm_phase<pg8::EpiBf16Scaled, pg8::MoeOrder, true, true, DFE / 2>(F.lds, g, S, E); }
            SEAM(17);
        }
    }
    { int t_ = F.tid; asm volatile("" : "+v"(t_)); F.tid = t_; F.lane = t_ & 63; }
    if (IN(20)) { phase_final(F, ng1 + 3 * DM, mods1 + 5120); }
#undef IN
#undef SEAM
}

extern "C" void kernel_launch(void* const* d_in, const int* in_sizes, int n_in, void* d_out, int out_size, void* d_ws, size_t ws_size, hipStream_t stream) {
    static int grid = 0;
    if (grid == 0) {
        if (n_in != 18 || in_sizes[0] != NTOK * DM || out_size != NTOK * DM || ws_size < WS_END) { fprintf(stderr, "kernel_launch: unexpected shapes / workspace (%d inputs, ws %zu, need %zu); nothing launched\n", n_in, ws_size, (size_t)WS_END); grid = -1; return; }
        int dev = 0, cus = 0, per_cu = 0;
        if (hipGetDevice(&dev) != hipSuccess || hipDeviceGetAttribute(&cus, hipDeviceAttributeMultiprocessorCount, dev) != hipSuccess) { grid = -1; return; }
        if (hipFuncSetAttribute((const void*)trunk_fwd, hipFuncAttributeMaxDynamicSharedMemorySize, LDS_BYTES) != hipSuccess) { fprintf(stderr, "kernel_launch: hipFuncSetAttribute failed\n"); grid = -1; return; }
        if (hipOccupancyMaxActiveBlocksPerMultiprocessor(&per_cu, (const void*)trunk_fwd, NWAVES * 64, LDS_BYTES) != hipSuccess || per_cu < 1) { fprintf(stderr, "kernel_launch: occupancy query reports %d\n", per_cu); }
        (void)hipGetLastError();
        grid = cus;
        if (grid != 256) { fprintf(stderr, "kernel_launch: built for 256 CUs, found %d; nothing launched\n", grid); grid = -1; return; }
    }
    if (grid < 0) return;
    if (hipMemsetAsync((char*)d_ws + WS_CTL, 0, CTL_ZERO_BYTES, stream) != hipSuccess) return;
    Args a{};
    for (int i = 0; i < 18; ++i) a.in[i] = (const float*)d_in[i];
    a.out = (float*)d_out; a.ws = (unsigned char*)d_ws;
#if MK_ONE_LAUNCH
    a.ph_lo = 0; a.ph_hi = MK_LAST_PHASE;
    hipLaunchKernelGGL(trunk_fwd, dim3(grid), dim3(NWAVES * 64), LDS_BYTES, stream, a);
#else
    for (int p = 0; p < MK_LAST_PHASE; ++p) { a.ph_lo = p; a.ph_hi = p + 1; hipLaunchKernelGGL(trunk_fwd, dim3(grid), dim3(NWAVES * 64), LDS_BYTES, stream, a); }
#endif
}
```

```cpp
#include <hip/hip_runtime.h>
#include <cstdio>
#include <cstdint>

#ifndef MK_ONE_LAUNCH
#define MK_ONE_LAUNCH 1
#endif
#ifndef MK_DUP
#define MK_DUP 0
#endif
#ifndef MK_LAST_PHASE
#define MK_LAST_PHASE 21
#endif

#define GAS __attribute__((address_space(1)))
#define LAS __attribute__((address_space(3)))
typedef unsigned short bf16;
typedef unsigned u32x4 __attribute__((ext_vector_type(4)));
typedef unsigned u32x2 __attribute__((ext_vector_type(2)));
typedef float f32x4 __attribute__((ext_vector_type(4)));
typedef float f32x2 __attribute__((ext_vector_type(2)));
typedef float f32x16 __attribute__((ext_vector_type(16)));
typedef short bf16x8 __attribute__((ext_vector_type(8)));
typedef short s16x4 __attribute__((ext_vector_type(4)));
typedef GAS unsigned gu32;

constexpr int NB = 8, SEQ = 4096, DM = 1024, NTOK = NB * SEQ, NH = 16, HD = 64;
constexpr int DFF = 2816, NEXP = 8, DFE = 3584;
constexpr int QKVP = 3072;
constexpr int DIN0 = 3080;
constexpr float NORM_EPS = 1e-6f;
constexpr float LOG2E = 1.4426950408889634f;
constexpr int NWAVES = 8;
constexpr int MAXTILES = 264;
constexpr int PASS0_TILES = 128, PASS1_MAXTILES = MAXTILES - PASS0_TILES;

constexpr size_t MiB = 1u << 20;
constexpr size_t WS_CTL = 0, CTL_ZERO_BYTES = 1 * MiB;
constexpr size_t WS_MODS = 1 * MiB;
constexpr size_t WS_LOGF = 2 * MiB;
constexpr size_t WS_CUM = 3 * MiB;
constexpr size_t WS_KMEAN = 4 * MiB;
constexpr size_t WS_TOKE = 5 * MiB;
constexpr size_t WS_TOKP = WS_TOKE + 256 * 1024;
constexpr size_t WS_TOKR = WS_TOKP + 256 * 1024;
constexpr size_t WS_TOKS = WS_TOKR + 256 * 1024;
constexpr size_t WS_TILEE = 6 * MiB;
constexpr size_t WS_ML = 8 * MiB;
constexpr size_t WS_RA = 24 * MiB;
constexpr size_t WS_RC = 88 * MiB;
constexpr size_t WS_WOTHER = 152 * MiB;
constexpr size_t WS_RB = 185 * MiB;
constexpr size_t WS_RD = 377 * MiB;
constexpr size_t WS_HID = 24 * MiB;
constexpr size_t WS_USORT = 262 * MiB;
constexpr size_t WS_YSLOT = 328 * MiB;
constexpr size_t WS_WEXP = 460 * MiB;
constexpr size_t WS_END = 544 * MiB;
constexpr size_t WEXP_STRIDE = 10 * MiB + 512 * 1024, WEXP_DN_OFF = 7 * MiB;
constexpr float FP8_SW = 64.f, FP8_SU = 4.f, FP8_SH = 8.f;
constexpr size_t WO_IN0 = 0, WO_OUT0 = 6 * MiB, WO_IN1 = 8 * MiB, WO_OUT1 = 14 * MiB, WO_FGU = 16 * MiB, WO_FDN = 27 * MiB;
static_assert(WS_RB + (size_t)NTOK * QKVP * 2 <= WS_RD && WS_HID + (size_t)MAXTILES * 256 * DFE <= WS_USORT && WS_USORT + (size_t)MAXTILES * 256 * DM <= WS_YSLOT && WS_YSLOT + (size_t)MAXTILES * 256 * DM * 2 <= WS_WEXP && WS_WEXP + 8 * WEXP_STRIDE <= WS_END, "d_ws map");
constexpr int CW_GCNT = 1024;
constexpr int CW_QKN = 2048;
constexpr int CW_KN1 = 3072;
constexpr int CW_BAR = 4096;

constexpr int RING_BYTES = 131072;
constexpr int MISC_OFF = RING_BYTES + 320;
constexpr int LDS_BYTES = 147456;

__device__ __forceinline__ unsigned f2bf(float f) { unsigned u = __builtin_bit_cast(unsigned, f); return (u + 0x7fffu + ((u >> 16) & 1u)) >> 16; }
__device__ __forceinline__ unsigned pk2(float lo, float hi) { return f2bf(lo) | (f2bf(hi) << 16); }
__device__ __forceinline__ float bf2f(unsigned short b) { return __builtin_bit_cast(float, (unsigned)b << 16); }
__device__ __forceinline__ float bflo(unsigned w) { return __builtin_bit_cast(float, w << 16); }
__device__ __forceinline__ float bfhi(unsigned w) { return __builtin_bit_cast(float, w & 0xffff0000u); }
__device__ __forceinline__ float wave_sum(float v) {
#pragma unroll
    for (int o = 1; o < 64; o <<= 1) v += __shfl_xor(v, o);
    return v;
}
__device__ __forceinline__ unsigned pk4_fp8(float a, float b, float c, float d) { unsigned w = __builtin_amdgcn_cvt_pk_fp8_f32(a, b, 0u, false); return __builtin_amdgcn_cvt_pk_fp8_f32(c, d, w, true); }
__device__ __forceinline__ float clamp448(float v) { return __builtin_amdgcn_fmed3f(v, -448.f, 448.f); }
#define LDS_WAIT() asm volatile("s_waitcnt lgkmcnt(0)" ::: "memory")
#define VM_WAIT() asm volatile("s_waitcnt vmcnt(0)" ::: "memory")

namespace pg8 {
typedef unsigned short bf16_t;
typedef int v8i_t __attribute__((ext_vector_type(8)));
constexpr int BM = 256, BK = 64, HALF = 128, HTB = HALF * BK * 2, STAGE_BYTES = 8 * HTB, NXCD = 8, WGM = 8;
__host__ __device__ __forceinline__ int lds_byte(int r, int c) { const int st = (r >> 4) * 2 + (c >> 5), rr = r & 15, cc = c & 31, ob = rr * 64 + cc * 2; return st * 1024 + (ob ^ (((ob >> 9) & 1) << 5)); }
__host__ __device__ __forceinline__ void stage_rc(int b, int& R, int& C) { const int st = b / 1024, sb = b % 1024, swz = sb ^ (((sb >> 9) & 1) << 5); R = (st >> 1) * 16 + swz / 64; C = (st & 1) * 32 + (swz % 64) / 2; }
__host__ __device__ __forceinline__ int perm32(int rho) { const int n = rho >> 4, i = rho & 15; return 8 * (i >> 2) + 4 * n + (i & 3); }

struct Unit { int pm, pn; };
struct Gemm { const bf16_t* A; const bf16_t* Bt; int M, N, K; };

struct StaticOrder {
    int nM, nN, nwg, G, c, wgm = WGM;
    __device__ void init(int M, int N, int G_, int c_) { nM = M / BM; nN = N / BM; nwg = nM * nN; G = G_; c = c_; }
    __device__ bool next(int i, Unit& u) const {
        const long L = (long)i * G + c; if (L >= nwg) return false;
        int wgid = (int)L; { const int q = nwg / NXCD, r = nwg % NXCD, xcd = wgid % NXCD, off = wgid / NXCD; wgid = (xcd < r ? xcd * (q + 1) : r * (q + 1) + (xcd - r) * q) + off; }
        const int nig = wgm * nN, gid = wgid / nig, fm = gid * wgm, gsz = (nM - fm) < wgm ? (nM - fm) : wgm;
        u.pm = fm + ((wgid % nig) % gsz); u.pn = (wgid % nig) / gsz; return true;
    }
    __device__ __forceinline__ const char* abase(const Gemm& g, const Unit& u) const { return (const char*)g.A + (size_t)u.pm * ((size_t)BM * g.K * 2); }
    __device__ __forceinline__ const char* bbase(const Gemm& g, const Unit& u) const { return (const char*)g.Bt + (size_t)u.pn * ((size_t)BM * g.K * 2); }
};
struct MoeOrder {
    StaticOrder so; const int* tile_e; size_t estride;
    __device__ bool next(int i, Unit& u) const { return so.next(i, u); }
    __device__ __forceinline__ const char* abase(const Gemm& g, const Unit& u) const { return (const char*)g.A + (size_t)u.pm * ((size_t)BM * g.K * 2); }
    __device__ __forceinline__ const char* bbase(const Gemm& g, const Unit& u) const { const int e = __builtin_amdgcn_readfirstlane(tile_e[u.pm]); return (const char*)g.Bt + (size_t)e * estride + (size_t)u.pn * ((size_t)BM * g.K * 2); }
};

typedef float f32x2_t __attribute__((ext_vector_type(2))); typedef __bf16 bf16x2_t __attribute__((ext_vector_type(2)));
__device__ __forceinline__ unsigned cvt_pk_bf16(float lo, float hi) { f32x2_t v = {lo, hi}; bf16x2_t b = __builtin_convertvector(v, bf16x2_t); return __builtin_bit_cast(unsigned, b); }

struct EpiBf16 {
    static constexpr bool PERM = true;
    bf16_t* O; int ldc;
    __device__ __forceinline__ void operator()(const f32x4 (&acc)[2][2][4][2], const Unit& u, int wr, int wc, int fr, int fq) const {
        const int row0 = u.pm * BM + wr * 64 + fr; const int col0 = u.pn * BM + wc * 32 + 8 * fq;
#pragma unroll
        for (int ai = 0; ai < 2; ++ai)
#pragma unroll
            for (int m = 0; m < 4; ++m) { bf16_t* rowp = O + (size_t)(row0 + ai * HALF + m * 16) * ldc + col0;
#pragma unroll
                for (int bj = 0; bj < 2; ++bj) { const f32x4 v0 = acc[ai][bj][m][0], v1 = acc[ai][bj][m][1];
                    u32x4 w; w.x = cvt_pk_bf16(v0[0], v0[1]); w.y = cvt_pk_bf16(v0[2], v0[3]); w.z = cvt_pk_bf16(v1[0], v1[1]); w.w = cvt_pk_bf16(v1[2], v1[3]);
                    *(u32x4*)(rowp + bj * HALF) = w; } }
    }
};
struct EpiHeadMajor {
    static constexpr bool PERM = true;
    bf16_t* O; int M; unsigned long long qmask; float qscale;
    __device__ __forceinline__ void operator()(const f32x4 (&acc)[2][2][4][2], const Unit& u, int wr, int wc, int fr, int fq) const {
        const int row0 = u.pm * BM + wr * 64 + fr; const int col0 = u.pn * BM + wc * 32 + 8 * fq;
#pragma unroll
        for (int ai = 0; ai < 2; ++ai)
#pragma unroll
            for (int m = 0; m < 4; ++m) { const int row = row0 + ai * HALF + m * 16;
#pragma unroll
                for (int bj = 0; bj < 2; ++bj) { const int col = col0 + bj * HALF; const float sc = ((qmask >> (col >> 6)) & 1ull) ? qscale : 1.f; const f32x4 v0 = acc[ai][bj][m][0] * sc, v1 = acc[ai][bj][m][1] * sc;
                    u32x4 w; w.x = cvt_pk_bf16(v0[0], v0[1]); w.y = cvt_pk_bf16(v0[2], v0[3]); w.z = cvt_pk_bf16(v1[0], v1[1]); w.w = cvt_pk_bf16(v1[2], v1[3]);
                    *(u32x4*)(O + ((size_t)(col >> 6) * M + row) * 64 + (col & 63)) = w; } }
    }
};
__device__ __forceinline__ float silu_mul(float g, float u) { return g * u * __builtin_amdgcn_rcpf(1.f + __builtin_amdgcn_exp2f(-g * LOG2E)); }
struct EpiBf16Scaled {
    static constexpr bool PERM = true;
    bf16_t* O; int ldc; float scale;
    __device__ __forceinline__ void operator()(const f32x4 (&acc)[2][2][4][2], const Unit& u, int wr, int wc, int fr, int fq) const {
        const int row0 = u.pm * BM + wr * 64 + fr; const int col0 = u.pn * BM + wc * 32 + 8 * fq;
#pragma unroll
        for (int ai = 0; ai < 2; ++ai)
#pragma unroll
            for (int m = 0; m < 4; ++m) { bf16_t* rowp = O + (size_t)(row0 + ai * HALF + m * 16) * ldc + col0;
#pragma unroll
                for (int bj = 0; bj < 2; ++bj) { const f32x4 v0 = acc[ai][bj][m][0] * scale, v1 = acc[ai][bj][m][1] * scale;
                    u32x4 w; w.x = cvt_pk_bf16(v0[0], v0[1]); w.y = cvt_pk_bf16(v0[2], v0[3]); w.z = cvt_pk_bf16(v1[0], v1[1]); w.w = cvt_pk_bf16(v1[2], v1[3]);
                    *(u32x4*)(rowp + bj * HALF) = w; } }
    }
};
struct EpiSwigluFp8 {
    static constexpr bool PERM = true;
    unsigned char* O; int ldc; float sin, sout;
    __device__ __forceinline__ void operator()(const f32x4 (&acc)[2][2][4][2], const Unit& u, int wr, int wc, int fr, int fq) const {
        const int row0 = u.pm * BM + wr * 64 + fr; const int col0 = u.pn * HALF + wc * 32 + 8 * fq;
#pragma unroll
        for (int ai = 0; ai < 2; ++ai)
#pragma unroll
            for (int m = 0; m < 4; ++m) { unsigned char* rowp = O + (size_t)(row0 + ai * HALF + m * 16) * ldc + col0;
                const f32x4 ag0 = acc[ai][0][m][0], ag1 = acc[ai][0][m][1];
                const f32x4 t0 = ag0 * (-sin * LOG2E), t1 = ag1 * (-sin * LOG2E);
                f32x4 d0, d1;
#pragma unroll
                for (int e = 0; e < 4; ++e) { d0[e] = __builtin_amdgcn_exp2f(t0[e]); d1[e] = __builtin_amdgcn_exp2f(t1[e]); }
                d0 = d0 + 1.f; d1 = d1 + 1.f;
                f32x4 r0, r1;
#pragma unroll
                for (int e = 0; e < 4; ++e) { r0[e] = __builtin_amdgcn_rcpf(d0[e]); r1[e] = __builtin_amdgcn_rcpf(d1[e]); }
                const f32x4 v0 = (ag0 * acc[ai][1][m][0]) * (sin * sin * sout) * r0, v1 = (ag1 * acc[ai][1][m][1]) * (sin * sin * sout) * r1;
                u32x2 w; w.x = pk4_fp8(clamp448(v0[0]), clamp448(v0[1]), clamp448(v0[2]), clamp448(v0[3]));
                w.y = pk4_fp8(clamp448(v1[0]), clamp448(v1[1]), clamp448(v1[2]), clamp448(v1[3]));
                *(u32x2*)rowp = w; __builtin_amdgcn_sched_barrier(0); }
    }
};
struct EpiSwiglu {
    static constexpr bool PERM = true;
    bf16_t* O; int ldc;
    __device__ __forceinline__ void operator()(const f32x4 (&acc)[2][2][4][2], const Unit& u, int wr, int wc, int fr, int fq) const {
        const int row0 = u.pm * BM + wr * 64 + fr; const int col0 = u.pn * HALF + wc * 32 + 8 * fq;
#pragma unroll
        for (int ai = 0; ai < 2; ++ai)
#pragma unroll
            for (int m = 0; m < 4; ++m) { bf16_t* rowp = O + (size_t)(row0 + ai * HALF + m * 16) * ldc + col0;
                const f32x4 g0 = acc[ai][0][m][0], g1 = acc[ai][0][m][1], u0 = acc[ai][1][m][0], u1 = acc[ai][1][m][1];
                u32x4 w; w.x = cvt_pk_bf16(silu_mul(g0[0], u0[0]), silu_mul(g0[1], u0[1])); w.y = cvt_pk_bf16(silu_mul(g0[2], u0[2]), silu_mul(g0[3], u0[3]));
                w.z = cvt_pk_bf16(silu_mul(g1[0], u1[0]), silu_mul(g1[1], u1[1])); w.w = cvt_pk_bf16(silu_mul(g1[2], u1[2]), silu_mul(g1[3], u1[3]));
                *(u32x4*)rowp = w; }
    }
};

__device__ __forceinline__ void glds16s(const void* sbase, unsigned voff, unsigned lds_dst) { unsigned keep;
    asm volatile("s_mov_b32 %0, m0\n\ts_mov_b32 m0, %3\n\ts_nop 0\n\tglobal_load_lds_dwordx4 %2, %1\n\ts_mov_b32 m0, %0" : "=&s"(keep) : "s"(sbase), "v"(voff), "s"(lds_dst) : "memory"); }
template <class Epi, class Sched, bool ALIGN_EPI = true, bool FP8 = false, int KC = 0>
__device__ __forceinline__ void gemm_phase(LAS unsigned char* lds, const Gemm g, const Sched& S, const Epi& E) {
    const int tid = threadIdx.x, wid = __builtin_amdgcn_readfirstlane(tid >> 6), lane = tid & 63, wr = wid >> 2, wc = wid & 3, fr = lane & 15, fq = lane >> 4;
    const int K = KC > 0 ? KC : g.K, nt = K / BK;
    unsigned voffA[2], voffB[2];
#pragma unroll
    for (int i = 0; i < 2; ++i) { int R, C; stage_rc(tid * 16 + i * 8192, R, C); const int Rb = Epi::PERM ? ((R & ~31) + perm32(R & 31)) : R;
        voffA[i] = (unsigned)(R * K + C) * 2u; voffB[i] = (unsigned)(Rb * K + C) * 2u; }
    const size_t kstep = (size_t)(BK * 2);
    const size_t hstep = (size_t)HALF * K * 2;
    const unsigned ldsw = (unsigned)wid * 1024u;
    const unsigned lds_u32 = (unsigned)(unsigned long long)lds;
    const int aoff = lds_byte(wr * 64 + fr, fq * 8), boff = lds_byte(wc * 32 + fr, fq * 8);
    const int aoff8 = lds_byte(wr * 64 + fr, (fq & 1) * 16) + (fq >> 1) * 1024, boff8 = lds_byte(wc * 32 + fr, (fq & 1) * 16) + (fq >> 1) * 1024;
#define PG8_SA(b, h) (((b) * 2 + (h)) * HTB)
#define PG8_SB(b, h) ((4 + (b) * 2 + (h)) * HTB)
#define PG8_STAGE(bufoff, gbase, voff) do { _Pragma("unroll") for (int _i = 0; _i < 2; ++_i) \
        glds16s((const void*)(gbase), (voff)[_i], lds_u32 + (unsigned)(bufoff) + ldsw + (unsigned)(_i * 8192)); } while (0)
#define PG8_LD8(p_) (*(const LAS v8i_t*)(p_))
#define PG8_LDA(dst, b, h) do { if constexpr (FP8) { _Pragma("unroll") for (int m = 0; m < 4; ++m) dst##8[m] = PG8_LD8(lds + PG8_SA(b, h) + aoff8 + m * 2048); } \
        else { _Pragma("unroll") for (int m = 0; m < 4; ++m) _Pragma("unroll") for (int k = 0; k < 2; ++k) dst[m][k] = *(const LAS bf16x8*)(lds + PG8_SA(b, h) + aoff + m * 2048 + k * 1024); } } while (0)
#define PG8_LDB(dst, b, h) do { if constexpr (FP8) { _Pragma("unroll") for (int n = 0; n < 2; ++n) dst##8[n] = PG8_LD8(lds + PG8_SB(b, h) + boff8 + n * 2048); } \
        else { _Pragma("unroll") for (int n = 0; n < 2; ++n) _Pragma("unroll") for (int k = 0; k < 2; ++k) dst[n][k] = *(const LAS bf16x8*)(lds + PG8_SB(b, h) + boff + n * 2048 + k * 1024); } } while (0)
#define PG8_MMA(ai, bj, At, Bt) do { __builtin_amdgcn_s_setprio(1); if constexpr (FP8) { _Pragma("unroll") for (int m = 0; m < 4; ++m) _Pragma("unroll") for (int n = 0; n < 2; ++n) \
            asm volatile("v_mfma_f32_16x16x128_f8f6f4 %0, %1, %2, %0" : "+v"(acc[ai][bj][m][n]) : "v"(Bt##8[n]), "v"(At##8[m])); } \
        else { _Pragma("unroll") for (int m = 0; m < 4; ++m) _Pragma("unroll") for (int n = 0; n < 2; ++n) _Pragma("unroll") for (int k = 0; k < 2; ++k) \
        acc[ai][bj][m][n] = __builtin_amdgcn_mfma_f32_16x16x32_bf16(Bt[n][k], At[m][k], acc[ai][bj][m][n], 0, 0, 0); } __builtin_amdgcn_s_setprio(0); } while (0)
#define PG8_WAIT_V(n) asm volatile("s_waitcnt vmcnt(" #n ")" ::: "memory")
#define PG8_WAIT_L(n) asm volatile("s_waitcnt lgkmcnt(" #n ")" ::: "memory")
#define PG8_BAR __builtin_amdgcn_s_barrier()
#define PG8_SCHED __builtin_amdgcn_sched_barrier(0)
    Unit cur, nxt; int ui = 0;
    if (!S.next(0, cur)) return;
    f32x4 acc[2][2][4][2];
#pragma unroll
    for (int a = 0; a < 2; ++a)
#pragma unroll
        for (int b = 0; b < 2; ++b)
#pragma unroll
            for (int m = 0; m < 4; ++m)
#pragma unroll
                for (int n = 0; n < 2; ++n) acc[a][b][m][n] = (f32x4){0.f, 0.f, 0.f, 0.f};
    bf16x8 At[4][2], B0[2][2], B1[2][2]; v8i_t At8[4], B08[2], B18[2];
    const char* cA = S.abase(g, cur); const char* cB = S.bbase(g, cur);
    PG8_STAGE(PG8_SB(0, 0), cB, voffB); PG8_STAGE(PG8_SB(0, 1), cB + hstep, voffB); PG8_STAGE(PG8_SA(0, 0), cA, voffA); PG8_STAGE(PG8_SA(0, 1), cA + hstep, voffA);
    if (wr == 1) PG8_BAR;
    PG8_WAIT_V(2); PG8_BAR;
    PG8_STAGE(PG8_SB(1, 0), cB + kstep, voffB); PG8_STAGE(PG8_SA(1, 0), cA + kstep, voffA); PG8_STAGE(PG8_SB(1, 1), cB + hstep + kstep, voffB);
    PG8_WAIT_V(6); PG8_BAR;
    for (;;) {
        const bool has_next = S.next(ui + 1, nxt);
        const char* nA = cA; const char* nB = cB;
        if (has_next) { nA = S.abase(g, nxt); nB = S.bbase(g, nxt); }
        for (int t = 0; t < nt; t += 2) {
            const bool last = (t == nt - 2);
            const char* a1 = cA + (size_t)(t + 1) * kstep;
            const char* a2 = last ? nA : cA + (size_t)(t + 2) * kstep; const char* b2 = last ? nB : cB + (size_t)(t + 2) * kstep;
            const char* a3 = a2 + kstep; const char* b3 = b2 + kstep;
            PG8_LDB(B0, 0, 0); PG8_LDB(B1, 0, 1); PG8_SCHED; PG8_LDA(At, 0, 0); PG8_STAGE(PG8_SA(1, 1), a1 + hstep, voffA);
            PG8_WAIT_V(8); PG8_WAIT_L(0); PG8_BAR; PG8_MMA(0, 0, At, B0); PG8_MMA(0, 1, At, B1); PG8_BAR; PG8_SCHED;
            PG8_LDA(At, 0, 1); PG8_STAGE(PG8_SB(0, 0), b2, voffB); PG8_STAGE(PG8_SB(0, 1), b2 + hstep, voffB); PG8_STAGE(PG8_SA(0, 0), a2, voffA);
            PG8_WAIT_V(8); PG8_WAIT_L(0); PG8_BAR; PG8_MMA(1, 0, At, B0); PG8_MMA(1, 1, At, B1); PG8_BAR; PG8_SCHED;
            PG8_LDB(B0, 1, 0); PG8_LDB(B1, 1, 1); PG8_SCHED; PG8_LDA(At, 1, 0); PG8_STAGE(PG8_SA(0, 1), a2 + hstep, voffA);
            PG8_WAIT_V(8); PG8_WAIT_L(0); PG8_BAR; PG8_MMA(0, 0, At, B0); PG8_MMA(0, 1, At, B1); PG8_BAR; PG8_SCHED;
            PG8_LDA(At, 1, 1); PG8_STAGE(PG8_SB(1, 0), b3, voffB); PG8_STAGE(PG8_SB(1, 1), b3 + hstep, voffB); PG8_STAGE(PG8_SA(1, 0), a3, voffA);
            PG8_WAIT_V(8); PG8_WAIT_L(0); PG8_BAR; PG8_MMA(1, 0, At, B0); PG8_MMA(1, 1, At, B1); PG8_BAR; PG8_SCHED;
        }
        if constexpr (ALIGN_EPI) { if (wr == 0) PG8_BAR; }
        if constexpr (FP8) asm volatile("s_nop 15\n\ts_nop 15" ::: "memory");
        E(acc, cur, wr, wc, fr, fq);
#if MK_DUP == 116
        if constexpr (FP8) { asm volatile("" ::: "memory"); E(acc, cur, wr, wc, fr, fq); }
#endif
        if (!has_next) break;
#pragma unroll
        for (int a = 0; a < 2; ++a)
#pragma unroll
            for (int b = 0; b < 2; ++b)
#pragma unroll
                for (int m = 0; m < 4; ++m)
#pragma unroll
                    for (int n = 0; n < 2; ++n) acc[a][b][m][n] = (f32x4){0.f, 0.f, 0.f, 0.f};
        cur = nxt; cA = nA; cB = nB; ++ui;
        if constexpr (ALIGN_EPI) { if (wr == 1) PG8_BAR; }
    }
    PG8_WAIT_V(0);
    if constexpr (!ALIGN_EPI) { if (wr == 0) PG8_BAR; }
    PG8_BAR;
#undef PG8_SA
#undef PG8_SB
#undef PG8_STAGE
#undef PG8_LDA
#undef PG8_LDB
#undef PG8_MMA
#undef PG8_WAIT_V
#undef PG8_WAIT_L
#undef PG8_BAR
#undef PG8_SCHED
}
}

namespace att {
constexpr int KS = 0, VS = 16384, TAB = 32768, KM = TAB + 4224 * 4, LDS_END = KM + 4096;
constexpr float C2 = 0.125f * LOG2E;
constexpr float NEG = -1e30f;
__device__ __forceinline__ int crow(int r, int hi) { return (r & 3) + 8 * (r >> 2) + 4 * hi; }
__device__ __forceinline__ int t5_bucket(int d) {
    if (d < 16) return d < 0 ? 0 : d;
    int b = 16;
    b += (d >= 22); b += (d >= 30); b += (d >= 40); b += (d >= 54); b += (d >= 73); b += (d >= 99); b += (d >= 134); b += (d >= 182);
    b += (d >= 246); b += (d >= 332); b += (d >= 450); b += (d >= 609); b += (d >= 825); b += (d >= 1117); b += (d >= 1513);
    return b;
}
__device__ __forceinline__ float swapmax(float m) { return fmaxf(m, __shfl_xor(m, 32)); }
__device__ __forceinline__ float swapsum(float m) { return m + __shfl_xor(m, 32); }
typedef short v4i16_t __attribute__((ext_vector_type(4)));
__device__ __forceinline__ s16x4 vtr(const LAS unsigned char* p) { return __builtin_bit_cast(s16x4, __builtin_amdgcn_ds_read_tr16_b64_v4i16((LAS v4i16_t*)p)); }

constexpr int R_K = 0, R_V = 32768, R_TAB = 65536, R_KM = R_TAB + 4288 * 4, R_TS = R_KM + 4096, R_END = R_TS + 64;
#define ATT_WAITBAR(N) asm volatile("s_waitcnt vmcnt(" #N ") lgkmcnt(0)\n\ts_barrier" ::: "memory")
__device__ __forceinline__ bf16x8 scale_q(bf16x8 q) { bf16x8 r;
#pragma unroll
    for (int e = 0; e < 8; ++e) r[e] = (short)f2bf(bf2f((unsigned short)q[e]) * C2);
    return r; }

#define ATT_QK(Ks) do { _Pragma("unroll") for (int d0 = 0; d0 < 4; ++d0) { const bf16x8 k0_ = *(const LAS bf16x8*)((Ks) + koff[d0]), k1_ = *(const LAS bf16x8*)((Ks) + koff[d0] + 4096); \
        p0 = __builtin_amdgcn_mfma_f32_32x32x16_bf16(k0_, qr[d0], p0, 0, 0, 0); p1 = __builtin_amdgcn_mfma_f32_32x32x16_bf16(k1_, qr[d0], p1, 0, 0, 0); } } while (0)
#define ATT_SOFTMAX_PV(vp) do { \
        float mx_ = fmaxf(p0[0], p1[0]); \
        _Pragma("unroll") for (int r = 1; r < 16; ++r) mx_ = fmaxf(mx_, fmaxf(p0[r], p1[r])); \
        mx_ = swapmax(mx_); \
        const float mn_ = fmaxf(m, mx_); \
        if (__any(mn_ > m)) { const float alpha_ = __builtin_amdgcn_exp2f(m - mn_); l *= alpha_; \
            _Pragma("unroll") for (int r = 0; r < 16; ++r) { o0[r] *= alpha_; o1[r] *= alpha_; } } \
        m = mn_; float rs_ = 0.f; \
        _Pragma("unroll") for (int r = 0; r < 16; ++r) { p0[r] = __builtin_amdgcn_exp2f(p0[r] - mn_); p1[r] = __builtin_amdgcn_exp2f(p1[r] - mn_); rs_ += p0[r] + p1[r]; } \
        l += rs_; \
        bf16x8 pa_[4]; \
        _Pragma("unroll") for (int ks = 0; ks < 4; ++ks) { u32x4 w_; \
            _Pragma("unroll") for (int e = 0; e < 4; ++e) { const int r = 8 * (ks & 1) + 2 * e; w_[e] = (ks < 2) ? pg8::cvt_pk_bf16(p0[r], p0[r + 1]) : pg8::cvt_pk_bf16(p1[r], p1[r + 1]); } \
            pa_[ks] = __builtin_bit_cast(bf16x8, w_); } \
        _Pragma("unroll") for (int ks = 0; ks < 4; ++ks) { \
            const s16x4 a0_ = vtr((vp) + ks * 1024), a1_ = vtr((vp) + ks * 1024 + 512), b0_ = vtr((vp) + 4096 + ks * 1024), b1_ = vtr((vp) + 4096 + ks * 1024 + 512); \
            const bf16x8 va_ = (bf16x8){a0_[0], a0_[1], a0_[2], a0_[3], a1_[0], a1_[1], a1_[2], a1_[3]}, vb_ = (bf16x8){b0_[0], b0_[1], b0_[2], b0_[3], b1_[0], b1_[1], b1_[2], b1_[3]}; \
            o0 = __builtin_amdgcn_mfma_f32_32x32x16_bf16(va_, pa_[ks], o0, 0, 0, 0); o1 = __builtin_amdgcn_mfma_f32_32x32x16_bf16(vb_, pa_[ks], o1, 0, 0, 0); } \
    } while (0)
#define ATT_FAST_PV(vp) do { \
        _Pragma("unroll") for (int r = 0; r < 16; ++r) { p0[r] = __builtin_amdgcn_exp2f(p0[r]); p1[r] = __builtin_amdgcn_exp2f(p1[r]); } \
        bf16x8 pa_[4]; \
        _Pragma("unroll") for (int ks = 0; ks < 4; ++ks) { u32x4 w_; \
            _Pragma("unroll") for (int e = 0; e < 4; ++e) { const int r = 8 * (ks & 1) + 2 * e; w_[e] = (ks < 2) ? pg8::cvt_pk_bf16(p0[r], p0[r + 1]) : pg8::cvt_pk_bf16(p1[r], p1[r + 1]); } \
            pa_[ks] = __builtin_bit_cast(bf16x8, w_); } \
        _Pragma("unroll") for (int ks = 0; ks < 4; ++ks) { \
            const s16x4 a0_ = vtr((vp) + ks * 1024), a1_ = vtr((vp) + ks * 1024 + 512), b0_ = vtr((vp) + 4096 + ks * 1024), b1_ = vtr((vp) + 4096 + ks * 1024 + 512); \
            const bf16x8 va_ = (bf16x8){a0_[0], a0_[1], a0_[2], a0_[3], a1_[0], a1_[1], a1_[2], a1_[3]}, vb_ = (bf16x8){b0_[0], b0_[1], b0_[2], b0_[3], b1_[0], b1_[1], b1_[2], b1_[3]}; \
            o0 = __builtin_amdgcn_mfma_f32_32x32x16_bf16(va_, pa_[ks], o0, 0, 0, 0); o1 = __builtin_amdgcn_mfma_f32_32x32x16_bf16(vb_, pa_[ks], o1, 0, 0, 0); \
            o2 = __builtin_amdgcn_mfma_f32_32x32x16_bf16(ones8, pa_[ks], o2, 0, 0, 0); } \
    } while (0)
#define ATT_STORE_O(orow, inv) do { _Pragma("unroll") for (int a = 0; a < 4; ++a) { \
        u32x2 w0_, w1_; w0_.x = pg8::cvt_pk_bf16(o0[4 * a] * (inv), o0[4 * a + 1] * (inv)); w0_.y = pg8::cvt_pk_bf16(o0[4 * a + 2] * (inv), o0[4 * a + 3] * (inv)); \
        w1_.x = pg8::cvt_pk_bf16(o1[4 * a] * (inv), o1[4 * a + 1] * (inv)); w1_.y = pg8::cvt_pk_bf16(o1[4 * a + 2] * (inv), o1[4 * a + 3] * (inv)); \
        *(u32x2*)((orow) + 8 * a) = w0_; *(u32x2*)((orow) + 32 + 8 * a) = w1_; } } while (0)

template <int MODE>
__device__ __forceinline__ void attn_unit_v2(LAS unsigned char* lds, const bf16* __restrict__ qkv, int b, int h, int qt,
                                             const float* __restrict__ cum, const float* __restrict__ kmean, const float* __restrict__ relb,
                                             bf16* __restrict__ O, const unsigned* __restrict__ qkn) {
    const int tid = threadIdx.x, lane = tid & 63, r32 = lane & 31, hi = lane >> 5; const int wid = __builtin_amdgcn_readfirstlane(tid >> 6);
    const int qs = (MODE == 0) ? h : 24 + (h - 8), ks = qs + 8, vs = qs + 16;
    const bf16* qb = qkv + ((size_t)qs * NTOK + (size_t)b * SEQ) * 64; const bf16* kb = qkv + ((size_t)ks * NTOK + (size_t)b * SEQ) * 64; const bf16* vb = qkv + ((size_t)vs * NTOK + (size_t)b * SEQ) * 64;
    const int pw = 256 * qt + 32 * wid, myq = pw + r32;
    bf16x8 qr[4];
    { const bf16* qrow = qb + (size_t)myq * 64 + hi * 8;
#pragma unroll
      for (int d0 = 0; d0 < 4; ++d0) qr[d0] = *(const bf16x8*)(qrow + d0 * 16); }
    LAS float* tab = (LAS float*)(lds + R_TAB); LAS float* kml = (LAS float*)(lds + R_KM); LAS int* tsl = (LAS int*)(lds + R_TS);
    const int thi = 4 * qt + 3; int tlo = 0; float fox_b2 = 0.f;
    if (MODE == 0) {
        fox_b2 = 2.f * __builtin_bit_cast(float, qkn[2 * (b * 16 + h)]) * __builtin_bit_cast(float, qkn[2 * (b * 16 + h) + 1]);
        const float* cp = cum + (size_t)(b * 8 + h) * SEQ; const int nk = 256 * (qt + 1);
        for (int s = tid; s < nk; s += 512) tab[s] = -cp[s] * LOG2E;
        if (tid == 0) tsl[0] = 4 * qt;
        __syncthreads();
        if (tid < 4 * qt) { const float qn = __builtin_bit_cast(float, qkn[2 * (b * 16 + h)]), kn = __builtin_bit_cast(float, qkn[2 * (b * 16 + h) + 1]);
            const float bound = 2.f * qn * kn + (cp[256 * qt] - cp[64 * tid + 63]) * LOG2E;
            if (bound >= -64.f) __hip_atomic_fetch_min(&tsl[0], tid, __ATOMIC_RELAXED, __HIP_MEMORY_SCOPE_WORKGROUP); }
        __syncthreads();
        tlo = __builtin_amdgcn_readfirstlane(tsl[0]);
    } else {
        for (int j = tid; j < 4288; j += 512) { const int rel = 4095 - j; tab[j] = rel >= 0 ? relb[t5_bucket(rel) * 16 + h] * LOG2E : NEG; }
        const float* kp = kmean + (size_t)(b * 8 + (h - 8)) * 16 * 64;
        for (int j = tid; j < qt * 64; j += 512) kml[j] = kp[j];
        __syncthreads();
    }
    unsigned sel = 0u;
    if (MODE == 1) {
        float v1 = -INFINITY, v2 = -INFINITY, v3 = -INFINITY; int i1 = -1, i2 = -1, i3 = -1;
        for (int n = 0; n < qt; ++n) {
            float part = 0.f;
#pragma unroll
            for (int d0 = 0; d0 < 4; ++d0) { const f32x4 ka = *(const LAS f32x4*)(kml + n * 64 + d0 * 16 + hi * 8), kb = *(const LAS f32x4*)(kml + n * 64 + d0 * 16 + hi * 8 + 4);
                part += bf2f((unsigned short)qr[d0][0]) * ka[0] + bf2f((unsigned short)qr[d0][1]) * ka[1] + bf2f((unsigned short)qr[d0][2]) * ka[2] + bf2f((unsigned short)qr[d0][3]) * ka[3];
                part += bf2f((unsigned short)qr[d0][4]) * kb[0] + bf2f((unsigned short)qr[d0][5]) * kb[1] + bf2f((unsigned short)qr[d0][6]) * kb[2] + bf2f((unsigned short)qr[d0][7]) * kb[3]; }
            const float gt = swapsum(part);
            if (gt > v1) { v3 = v2; i3 = i2; v2 = v1; i2 = i1; v1 = gt; i1 = n; }
            else if (gt > v2) { v3 = v2; i3 = i2; v2 = gt; i2 = n; }
            else if (gt > v3) { v3 = gt; i3 = n; }
        }
        if (i1 >= 0) sel |= 1u << i1; if (i2 >= 0) sel |= 1u << i2; if (i3 >= 0) sel |= 1u << i3;
    }
    bool fast = false; f32x16 o2 = {}; bf16x8 ones8;
#pragma unroll
    for (int e = 0; e < 8; ++e) ones8[e] = (short)0x3F80;
    if (MODE == 1) fast = true;
    const int vrow = 16 * (wid & 3) + (lane >> 2);
    const int krow = 8 * wid + (lane >> 3);
    const bf16* ksrc0 = kb + (size_t)krow * 64 + (((lane & 7) ^ ((krow >> 1) & 7)) * 8);
    const bf16* vsrc0 = vb + (size_t)vrow * 64 + (wid >> 2) * 32 + (lane & 3) * 8;
    int koff[4];
#pragma unroll
    for (int d0 = 0; d0 < 4; ++d0) koff[d0] = r32 * 128 + (((2 * d0 + hi) ^ ((r32 >> 1) & 7)) << 4);
#define ATT_DMA(t) do { const unsigned so_ = (unsigned)((((t) & 3) * 8192) + wid * 1024); \
        __builtin_amdgcn_global_load_lds((const unsigned*)(ksrc0 + (size_t)(t) * 4096), (LAS unsigned*)(lds + R_K + so_), 16, 0, 0); \
        __builtin_amdgcn_global_load_lds((const unsigned*)(vsrc0 + (size_t)(t) * 4096), (LAS unsigned*)(lds + R_V + so_), 16, 0, 0); } while (0)
    const LAS unsigned char* vp0 = lds + R_V + ((lane >> 4) & 1) * 32 + (lane & 3) * 8 + (4 * hi + ((lane & 15) >> 2)) * 64;
    float m = NEG, l = 0.f; f32x16 o0 = {}, o1 = {};
#pragma unroll 1
  for (int attempt = 0; attempt < (MODE == 1 ? 2 : 1); ++attempt) {
    if (attempt == 1) { fast = false; m = NEG; l = 0.f; o0 = f32x16{}; o1 = f32x16{}; }
    asm volatile("s_waitcnt vmcnt(0)" ::: "memory");
    ATT_DMA(tlo); ATT_DMA(tlo + 1); ATT_DMA(tlo + 2);
    ATT_WAITBAR(4);
    for (int t = tlo; t <= thi; ++t) {
        if (t + 3 <= thi) ATT_DMA(t + 3);
        bool active = (64 * t <= pw + 31);
        if (MODE == 1) { if (t < 4 * qt) active = (__ballot((sel >> (t >> 2)) & 1u) != 0ull); }
        if (MODE == 0) { if (64 * t + 63 < pw) active = active && !((fox_b2 + tab[64 * t + 63] - tab[pw]) < -64.f); }
        if (active) {
            const LAS unsigned char* Ks = lds + R_K + (t & 3) * 8192;
            f32x16 p0, p1;
            if (MODE == 0) {
                const LAS float* cn = tab + 64 * t + 4 * hi;
#pragma unroll
                for (int a = 0; a < 4; ++a) { const f32x4 c0 = *(const LAS f32x4*)(cn + 8 * a), c1 = *(const LAS f32x4*)(cn + 32 + 8 * a);
#pragma unroll
                    for (int e = 0; e < 4; ++e) { p0[4 * a + e] = c0[e]; p1[4 * a + e] = c1[e]; } }
            } else {
                const int relbase = myq - 64 * t - 4 * hi;
                const LAS float* tj = tab + (4095 - relbase);
                if (t < 4 * qt) { if (!((sel >> (t >> 2)) & 1u)) tj = tab + 4224; }
#pragma unroll
                for (int r = 0; r < 16; ++r) { const int cr = (r & 3) + 8 * (r >> 2); p0[r] = tj[cr]; p1[r] = tj[cr + 32]; }
            }
            ATT_QK(Ks);
            if (MODE == 0) { if (t >= 4 * qt) {
#pragma unroll
                    for (int r = 0; r < 16; ++r) { const int kp = 64 * t + crow(r, hi); if (kp > myq) p0[r] = NEG; if (kp + 32 > myq) p1[r] = NEG; } } }
            const LAS unsigned char* vp = vp0 + (t & 3) * 8192;
            if (MODE == 1 && fast) { ATT_FAST_PV(vp); } else { ATT_SOFTMAX_PV(vp); }
        }
        if (t + 3 <= thi) ATT_WAITBAR(4); else if (t + 2 <= thi) ATT_WAITBAR(2); else ATT_WAITBAR(0);
    }
    if (MODE == 1 && attempt == 0) {
        const float l0 = o2[0]; const bool bad = __any(!(l0 > 7.9e-31f && l0 < 1.3e36f));
        if (tid == 0) tsl[1] = 0;
        __syncthreads();
        if (bad && lane == 0) tsl[1] = 1;
        __syncthreads();
        const int redo = __builtin_amdgcn_readfirstlane(tsl[1]);
        __syncthreads();
        if (!redo) break;
    }
  }
#undef ATT_DMA
    const float lt = (MODE == 1 && fast) ? o2[0] : swapsum(l), inv = 1.f / lt;
    bf16* orow = O + ((size_t)b * SEQ + myq) * DM + h * 64 + 4 * hi;
    ATT_STORE_O(orow, inv);
}

constexpr int DL_K = 0, DL_V = 49152, DL_TAB = 98304, DL_END = DL_TAB + 1536 + 128 + 2048;
__device__ __forceinline__ void dil_params(int i, int j, int& h, int& gp, int& dil, int& cls, int& qt) { const int hp = i / 3, idx = j + 32 * (i % 3), h2 = idx / 48, rem = idx % 48, x = rem & 15;
    h = 2 * hp + h2; gp = rem >> 4; dil = gp == 0 ? 1 : (gp == 1 ? 4 : 16); qt = gp == 0 ? x : (gp == 1 ? (x >> 2) : 0); cls = gp == 0 ? 0 : (gp == 1 ? (x & 3) : x); }
__device__ __forceinline__ void dilated_phase(LAS unsigned char* lds, const bf16* __restrict__ qkv, int b, int j, const float* __restrict__ relb,
                                              bf16* O0, bf16* O1, bf16* O2, float* __restrict__ ml, const unsigned* __restrict__ knw  ) {
    const int tid = threadIdx.x, lane = tid & 63, r32 = lane & 31, hi = lane >> 5; const int wid = __builtin_amdgcn_readfirstlane(tid >> 6);
    const int vrow = 16 * (wid & 3) + (lane >> 2), krow = 8 * wid + (lane >> 3);
    int koff[4];
#pragma unroll
    for (int d0 = 0; d0 < 4; ++d0) koff[d0] = r32 * 128 + (((2 * d0 + hi) ^ ((r32 >> 1) & 7)) << 4);
    LAS float* tab = (LAS float*)(lds + DL_TAB);
    LAS float* rbl = (LAS float*)(lds + DL_TAB + 1536 + 128);
    if (tid < 512) rbl[tid] = relb[tid] * LOG2E;
    __syncthreads();
    u32x4 kv[12]; bf16x8 qn[4], qn2[4];
#define DIL_PREFETCH(h_, qt_, dil_, cls_) do { const int T0_ = 4 * (qt_) - 2; \
        const bf16* ksrc0 = qkv + ((size_t)(16 + (h_)) * NTOK + (size_t)b * SEQ) * 64 + (((lane & 7) ^ ((krow >> 1) & 7)) * 8); \
        const bf16* vsrc0 = qkv + ((size_t)(32 + (h_)) * NTOK + (size_t)b * SEQ) * 64 + (wid >> 2) * 32 + (lane & 3) * 8; \
        _Pragma("unroll") for (int s_ = 0; s_ < 6; ++s_) { int kp_ = 64 * (T0_ + s_) + krow, vq_ = 64 * (T0_ + s_) + vrow; kp_ = kp_ < 0 ? 0 : kp_; vq_ = vq_ < 0 ? 0 : vq_; \
            kv[2 * s_] = *(const u32x4*)(ksrc0 + (size_t)(kp_ * (dil_) + (cls_)) * 64); kv[2 * s_ + 1] = *(const u32x4*)(vsrc0 + (size_t)(vq_ * (dil_) + (cls_)) * 64); } \
        } while (0)
#define DIL_PREFETCH_Q2(h_, qt_, dil_, cls_) do { const bf16* qrow_ = qkv + ((size_t)(h_) * NTOK + (size_t)b * SEQ) * 64 + (size_t)((256 * (qt_) + 32 * wid + r32) * (dil_) + (cls_)) * 64 + hi * 8; \
          _Pragma("unroll") for (int d0 = 0; d0 < 4; ++d0) qn2[d0] = *(const bf16x8*)(qrow_ + d0 * 16); } while (0)
#define DIL_PREFETCH_Q(h_, qt_, dil_, cls_) do { const bf16* qrow_ = qkv + ((size_t)(h_) * NTOK + (size_t)b * SEQ) * 64 + (size_t)((256 * (qt_) + 32 * wid + r32) * (dil_) + (cls_)) * 64 + hi * 8; \
          _Pragma("unroll") for (int d0 = 0; d0 < 4; ++d0) qn[d0] = *(const bf16x8*)(qrow_ + d0 * 16); } while (0)
    bf16x8 ones8;
#pragma unroll
    for (int e = 0; e < 8; ++e) ones8[e] = (short)0x3F80;
    int h, gp, dil, cls, qt;
    const LAS unsigned char* vp0 = lds + DL_V + ((lane >> 4) & 1) * 32 + (lane & 3) * 8 + (4 * hi + ((lane & 15) >> 2)) * 64;
    dil_params(0, j, h, gp, dil, cls, qt);
    DIL_PREFETCH(h, qt, dil, cls); DIL_PREFETCH_Q(h, qt, dil, cls);
    constexpr int NIT = (MK_DUP == 113) ? 48 : 24;
#pragma unroll 1
    for (int i = 0; i < NIT; ++i) {
        dil_params(i % 24, j, h, gp, dil, cls, qt);
        if (i > 0) {
#pragma unroll
            for (int d0 = 0; d0 < 4; ++d0) qn[d0] = qn2[d0]; }
#pragma unroll
        for (int s_ = 0; s_ < 6; ++s_) { *(LAS u32x4*)(lds + DL_K + s_ * 8192 + wid * 1024 + lane * 16) = kv[2 * s_]; *(LAS u32x4*)(lds + DL_V + s_ * 8192 + wid * 1024 + lane * 16) = kv[2 * s_ + 1]; }
        { for (int j = tid; j < 384; j += 512) { const int rel = 255 - j; tab[j] = (rel >= 0 && rel <= 128) ? rbl[t5_bucket(rel * dil) * 16 + h] : NEG; } }
        __syncthreads();
        if (i + 1 < NIT) { int h2_, g2_, d2, c2, q2; dil_params((i + 1) % 24, j, h2_, g2_, d2, c2, q2); DIL_PREFETCH(h2_, q2, d2, c2); DIL_PREFETCH_Q2(h2_, q2, d2, c2); }
        f32x16 o0 = {}, o1 = {}, o2 = {};
        float cshift = 0.f;
#pragma unroll 1
        for (int attempt = 0; attempt < 2; ++attempt) {
            if (attempt == 1) { float mx = NEG; o0 = f32x16{}; o1 = f32x16{}; o2 = f32x16{};
#pragma unroll
                for (int jj = 0; jj < 3; ++jj) { const int slot = (wid >> 1) + jj;
                    if (4 * qt - 2 + slot >= 0) { const int relbase = 32 * (wid & 1) + r32 + 128 - 64 * jj - 4 * hi; const LAS float* tj = tab + (255 - relbase);
                        f32x16 p0, p1;
#pragma unroll
                        for (int r = 0; r < 16; ++r) { const int cr = (r & 3) + 8 * (r >> 2); p0[r] = tj[cr]; p1[r] = tj[cr + 32]; }
                        const LAS unsigned char* Ks = lds + DL_K + slot * 8192;
                        { bf16x8 (&qr)[4] = qn; ATT_QK(Ks); }
#pragma unroll
                        for (int r = 0; r < 16; ++r) mx = fmaxf(mx, fmaxf(p0[r], p1[r])); } }
                cshift = swapmax(mx); }
#pragma unroll
            for (int jj = 0; jj < 3; ++jj) { const int slot = (wid >> 1) + jj;
                if (4 * qt - 2 + slot >= 0) { const int relbase = 32 * (wid & 1) + r32 + 128 - 64 * jj - 4 * hi; const LAS float* tj = tab + (255 - relbase);
                    f32x16 p0, p1;
                    if (attempt == 0) {
#pragma unroll
                        for (int r = 0; r < 16; ++r) { const int cr = (r & 3) + 8 * (r >> 2); p0[r] = tj[cr]; p1[r] = tj[cr + 32]; } }
                    else {
#pragma unroll
                        for (int r = 0; r < 16; ++r) { const int cr = (r & 3) + 8 * (r >> 2); p0[r] = tj[cr] - cshift; p1[r] = tj[cr + 32] - cshift; } }
                    const LAS unsigned char* Ks = lds + DL_K + slot * 8192;
                    { bf16x8 (&qr)[4] = qn; ATT_QK(Ks); }
                    const LAS unsigned char* vp = vp0 + slot * 8192;
                    ATT_FAST_PV(vp); } }
            if (attempt == 0) { const float l0 = o2[0]; if (!__any(!(l0 > 7.9e-31f && l0 < 1.3e36f))) break; }
        }
        const float m = cshift;
        const float lt = o2[0], inv = 1.f / lt;
        bf16* Op = gp == 0 ? O0 : (gp == 1 ? O1 : O2);
        const int mytok = (256 * qt + 32 * wid + r32) * dil + cls;
        bf16* orow = Op + ((size_t)b * SEQ + mytok) * DM + h * 64 + 4 * hi;
        ATT_STORE_O(orow, inv);
        if (hi == 0) { f32x2 v; v.x = m; v.y = lt; *(f32x2*)(ml + (size_t)gp * NTOK * NH * 2 + (((size_t)b * SEQ + mytok) * NH + h) * 2) = v; }
        __syncthreads();
    }
#undef DIL_PREFETCH
#undef DIL_PREFETCH_Q
}
}

#define XB_TMO      128
#define XB_XCNT(j)  (256  + 64 * (j))
#define XB_XSUB(j)  (1280 + 64 * (j))
#define XB_XGEN(j)  (2304 + 64 * (j))
#define XB_TOP      3328
#define XB_TOPGEN   3392
#define XCD_BAR_WORDS 3456
#define XB_SPIN_CAP (1u << 18)
__device__ __forceinline__ unsigned xb_ld(unsigned* p)              { return __hip_atomic_load(p, __ATOMIC_RELAXED, __HIP_MEMORY_SCOPE_AGENT); }
__device__ __forceinline__ unsigned xb_add(unsigned* p, unsigned v) { return __hip_atomic_fetch_add(p, v, __ATOMIC_RELAXED, __HIP_MEMORY_SCOPE_AGENT); }
__device__ __forceinline__ unsigned xb_xcc_id() { return (unsigned)__builtin_amdgcn_s_getreg((3 << 11) | 20) & 0xFu; }
#define XB_SPIN(cond, bar) do { unsigned _sp = 0; while (cond) { __builtin_amdgcn_s_sleep(1); \
    if ((++_sp & 255u) == 0u) { if (xb_ld(&(bar)[XB_TMO])) break; if (_sp > XB_SPIN_CAP) { atomicAdd(&(bar)[XB_TMO], 1u); break; } } } } while (0)
struct XcdBarrier { unsigned* bar; unsigned x; volatile LAS unsigned* st; };
__device__ __forceinline__ XcdBarrier xcd_barrier_post(unsigned* bar, volatile LAS unsigned* st) {
    XcdBarrier b; b.bar = bar; b.x = xb_xcc_id(); b.st = st;
    if (threadIdx.x == 0) (void)xb_add(&bar[XB_XCNT(b.x)], 1u);
    return b;
}
__device__ __forceinline__ void xcd_barrier_complete(unsigned* bar, unsigned x, unsigned& nloc, unsigned& nx) {
    const unsigned G = gridDim.x * gridDim.y * gridDim.z;
    unsigned sum, cnt, mine, sp = 0u;
    for (;;) {
        sum = 0u; cnt = 0u; mine = 0u;
#pragma unroll
        for (unsigned j = 0; j < 16; ++j) { const unsigned c = xb_ld(&bar[XB_XCNT(j)]); sum += c; cnt += (c > 0u) ? 1u : 0u; mine = (j == x) ? c : mine; }
        if (sum == G) break;
        __builtin_amdgcn_s_sleep(1);
        if ((++sp & 255u) == 0u) { if (xb_ld(&bar[XB_TMO])) break; if (sp > XB_SPIN_CAP) { atomicAdd(&bar[XB_TMO], 1u); break; } }
    }
    nloc = mine > 0u ? mine : 1u; nx = cnt > 0u ? cnt : 1u;
}
__device__ __forceinline__ void xcd_barrier(const XcdBarrier& b) {
    asm volatile("s_waitcnt vmcnt(0)" ::: "memory");
    __syncthreads();
    if (threadIdx.x == 0) {
        unsigned* bar = b.bar;
        __builtin_amdgcn_s_waitcnt(0);
        unsigned nloc = b.st[0], nx = b.st[1];
        if (nloc == 0u) { xcd_barrier_complete(bar, b.x, nloc, nx); b.st[0] = nloc; b.st[1] = nx; }
        const unsigned old = xb_add(&bar[XB_XSUB(b.x)], 1u);
        const unsigned gen = old / nloc;
        if (old + 1u == (gen + 1u) * nloc) {
            __builtin_amdgcn_fence(__ATOMIC_RELEASE, "agent");
            asm volatile("s_waitcnt vmcnt(0)" ::: "memory");
            const unsigned og = xb_add(&bar[XB_TOP], 1u);
            const unsigned tg = og / nx;
            if (og + 1u == (tg + 1u) * nx) xb_add(&bar[XB_TOPGEN], 1u);
            else XB_SPIN(xb_ld(&bar[XB_TOPGEN]) == tg, bar);
            __builtin_amdgcn_fence(__ATOMIC_ACQUIRE, "agent");
            xb_add(&bar[XB_XGEN(b.x)], 1u);
            asm volatile("s_waitcnt vmcnt(0)" ::: "memory");
        } else {
            XB_SPIN(xb_ld(&bar[XB_XGEN(b.x)]) == gen, bar);
            __builtin_amdgcn_fence(__ATOMIC_ACQUIRE, "agent");
            asm volatile("s_waitcnt vmcnt(0)" ::: "memory");
        }
    }
    __syncthreads();
}

struct Args { const float* in[18]; float* out; unsigned char* ws; int ph_lo, ph_hi; };
struct Frame {
    LAS unsigned char* lds; int tid, lane, wave, vcu, G;
    const float *x, *c, *mod_w, *mod_b, *norm_g, *w_in0, *fox_bias, *w_out0, *w_in1, *w_out1, *relb, *ffn_g, *ffn_u, *ffn_d, *router_w, *ex_g, *ex_u, *ex_d;
    float* out; unsigned char* ws;
};

struct TMat { const float* W; unsigned char* WT; int K, N, row_off, mode, fp8; };
__device__ __forceinline__ int t_dest_row(int mode, int n) {
    if (mode == 0) return n;
    if (mode == 1) return ((n >> 7) << 8) + (n & 127);
    return n < 1536 ? n : (n >= 1544 ? n - 8 : -1);
}
__device__ __forceinline__ void t_load(const TMat& m, int item, int lane, f32x4 (&r)[8], int& k0, int& n0) {
    const int kblocks = m.K >> 5, nb = item / kblocks, kb = item - nb * kblocks; k0 = kb * 32; n0 = nb * 64;
    const int n = n0 + 4 * (lane & 15); const bool ok = n < m.N;
    const float* p = m.W + (size_t)(k0 + 8 * (lane >> 4)) * m.N + n;
#pragma unroll
    for (int i = 0; i < 8; ++i) r[i] = ok ? *(const f32x4*)(p + (size_t)i * m.N) : (f32x4){0.f, 0.f, 0.f, 0.f};
}
__device__ __forceinline__ void t_pack(int fp8, const f32x4 (&r)[8], LAS unsigned char* stage, int lane, int k0) {
    const int kr = lane >> 4, n4 = 4 * (lane & 15);
    if (fp8) {
#pragma unroll
        for (int e = 0; e < 4; ++e) { u32x2 w; w.x = pk4_fp8(r[0][e] * FP8_SW, r[1][e] * FP8_SW, r[2][e] * FP8_SW, r[3][e] * FP8_SW); w.y = pk4_fp8(r[4][e] * FP8_SW, r[5][e] * FP8_SW, r[6][e] * FP8_SW, r[7][e] * FP8_SW);
            *(LAS u32x2*)(stage + (n4 + e) * 144 + (k0 & 127) + 8 * kr) = w; }
    } else {
#pragma unroll
        for (int e = 0; e < 4; ++e) { u32x4 w; w.x = pg8::cvt_pk_bf16(r[0][e], r[1][e]); w.y = pg8::cvt_pk_bf16(r[2][e], r[3][e]); w.z = pg8::cvt_pk_bf16(r[4][e], r[5][e]); w.w = pg8::cvt_pk_bf16(r[6][e], r[7][e]);
            *(LAS u32x4*)(stage + (n4 + e) * 144 + (k0 & 63) * 2 + 16 * kr) = w; }
    }
}
__device__ __forceinline__ void t_flush(const TMat& m, int n0, int gk, int cfirst, int clast, const LAS unsigned char* stage, int lane) {
    const int c = lane & 7; const bool okc = c >= cfirst && c <= clast;
#pragma unroll
    for (int j = 0; j < 8; ++j) { const int nl = (lane >> 3) + 8 * j, n = n0 + nl, dr = t_dest_row(m.mode, n);
        const u32x4 w = *(const LAS u32x4*)(stage + nl * 144 + 16 * c);
        if (okc && n < m.N && dr >= 0) *(u32x4*)(m.WT + ((size_t)(m.row_off + dr) * m.K + gk) * (m.fp8 ? 1 : 2) + 16 * c) = w; }
}
template <class Dec> __device__ __forceinline__ void t_run(int i0, int i1, int lane, LAS unsigned char* stage, const Dec& dec) {
    if (i0 >= i1) return;
    f32x4 r[8]; int k0, n0, loc; TMat m;
    dec(i0, m, loc); t_load(m, loc, lane, r, k0, n0);
    int cfirst = -1;
    for (int it = i0; it < i1; ++it) {
        const TMat mc = m; const int k0c = k0, n0c = n0;
        const int gk = mc.fp8 ? (k0c & ~127) : (k0c & ~63);
        const int cs = mc.fp8 ? ((k0c & 127) >> 4) : ((k0c & 63) >> 3), ce = cs + (mc.fp8 ? 1 : 3);
        t_pack(mc.fp8, r, stage, lane, k0c);
        asm volatile("" ::: "memory");
        if (cfirst < 0) cfirst = cs;
        bool flush = true;
        if (it + 1 < i1) { dec(it + 1, m, loc); t_load(m, loc, lane, r, k0, n0);
            const int gkn = m.fp8 ? (k0 & ~127) : (k0 & ~63);
            flush = !(m.W == mc.W && n0 == n0c && gkn == gk); }
        asm volatile("" ::: "memory");
        if (flush) { LDS_WAIT(); t_flush(mc, n0c, gk, cfirst, ce, stage, lane); cfirst = -1; LDS_WAIT(); asm volatile("" ::: "memory"); }
    }
}
__device__ __forceinline__ void t_split(int nitems, int gw, int ngw, int& i0, int& i1) { const int q = nitems / ngw, rem = nitems % ngw; i0 = gw * q + (gw < rem ? gw : rem); i1 = i0 + q + (gw < rem ? 1 : 0); }

__device__ __forceinline__ void weight_copies(Frame& F) {
    LAS unsigned char* scr = F.lds + F.wave * 16384;
    const int gw = F.vcu * NWAVES + F.wave, NGW = F.G * NWAVES;
    unsigned char* wo = F.ws + WS_WOTHER;
    constexpr int I_IN0 = 32 * 49, I_OUT = 32 * 16, I_IN1 = 32 * 48, I_FG = 32 * 44, I_FD = 88 * 16;
    constexpr int NITEMS = I_IN0 + I_OUT + I_IN1 + I_OUT + 2 * I_FG + I_FD;
    auto dec = [&](int it, TMat& m, int& loc) { int r = it;
        if (r < I_IN0) { m = TMat{F.w_in0, wo + WO_IN0, DM, DIN0, 0, 2, 0}; loc = r; return; } r -= I_IN0;
        if (r < I_OUT) { m = TMat{F.w_out0, wo + WO_OUT0, DM, DM, 0, 0, 0}; loc = r; return; } r -= I_OUT;
        if (r < I_IN1) { m = TMat{F.w_in1, wo + WO_IN1, DM, 3 * DM, 0, 0, 0}; loc = r; return; } r -= I_IN1;
        if (r < I_OUT) { m = TMat{F.w_out1, wo + WO_OUT1, DM, DM, 0, 0, 0}; loc = r; return; } r -= I_OUT;
        if (r < I_FG) { m = TMat{F.ffn_g, wo + WO_FGU, DM, DFF, 0, 1, 1}; loc = r; return; } r -= I_FG;
        if (r < I_FG) { m = TMat{F.ffn_u, wo + WO_FGU, DM, DFF, 128, 1, 1}; loc = r; return; } r -= I_FG;
        m = TMat{F.ffn_d, wo + WO_FDN, DFF, DM, 0, 0, 1}; loc = r; };
    int i0, i1; t_split(NITEMS, gw, NGW, i0, i1);
    t_run(i0, i1, F.lane, scr, dec);
    __syncthreads();
}

__device__ __forceinline__ void phase_prologue(Frame& F) {
    if (F.vcu < 192) {
        LAS float* sc = (LAS float*)F.lds;
        LAS float* red = (LAS float*)(F.lds + 32768);
        for (int i = F.tid; i < NB * DM; i += 512) { const float v = F.c[i]; sc[i] = v / (1.f + expf(-v)); }
        __syncthreads();
        const int l = F.vcu / 96, e0 = (F.vcu % 96) * 64, col = F.lane, kq = F.wave;
        float acc[8];
#pragma unroll
        for (int b = 0; b < 8; ++b) acc[b] = 0.f;
        const float* wp = F.mod_w + ((size_t)l * DM + kq * 128) * 6144 + e0 + col;
#pragma unroll 32
        for (int k = 0; k < 128; ++k) { const float w = wp[(size_t)k * 6144];
#pragma unroll
            for (int b = 0; b < 8; ++b) acc[b] += sc[b * DM + kq * 128 + k] * w; }
#pragma unroll
        for (int b = 0; b < 8; ++b) red[(kq * 8 + b) * 64 + col] = acc[b];
        __syncthreads();
        { const int b = F.tid >> 6; float s = 0.f;
#pragma unroll
          for (int q = 0; q < 8; ++q) s += red[(q * 8 + b) * 64 + col];
          ((float*)(F.ws + WS_MODS))[((size_t)l * NB + b) * 6144 + e0 + col] = s + F.mod_b[l * 6144 + e0 + col]; }
        __syncthreads();
    }
}

__device__ __forceinline__ void expert_weight_copies(Frame& F) {
    LAS unsigned char* scr = F.lds + F.wave * 16384;
    const int gw = F.vcu * NWAVES + F.wave, NGW = F.G * NWAVES;
    constexpr int I_GU = 32 * 56, I_DN = 112 * 16, PER_E = 2 * I_GU + I_DN;
    auto dec = [&](int it, TMat& m, int& loc) { const int e = it / PER_E; int r = it - e * PER_E;
        unsigned char* we = F.ws + WS_WEXP + (size_t)e * WEXP_STRIDE;
        if (r < I_GU) { m = TMat{F.ex_g + (size_t)e * DM * DFE, we, DM, DFE, 0, 1, 1}; loc = r; return; } r -= I_GU;
        if (r < I_GU) { m = TMat{F.ex_u + (size_t)e * DM * DFE, we, DM, DFE, 128, 1, 1}; loc = r; return; } r -= I_GU;
        m = TMat{F.ex_d + (size_t)e * DFE * DM, we + WEXP_DN_OFF, DFE, DM, 0, 0, 1}; loc = r; };
    int i0, i1; t_split(NEXP * PER_E, gw, NGW, i0, i1);
    t_run(i0, i1, F.lane, scr, dec);
}

template <bool RES, int EXTRA, bool U8 = false, bool HB = false>
__device__ __forceinline__ void thin_phase(Frame& F, const float* hin, const bf16* y, const float* gy, const float* gatev  ,
                                           const float* gu, const float* shv, const float* scv, bf16* uout) {
    const int gw = F.vcu * NWAVES + F.wave;
    const int row0 = gw * 16, b = row0 >> 12;
    LAS float* w8 = (LAS float*)F.lds;
    LAS int* lcnt = (LAS int*)(F.lds + 32768);
    if (EXTRA == 1) { for (int i = F.tid; i < 8 * DM; i += 512) { const int k = i >> 3, j = i & 7; w8[j * DM + k] = F.w_in0[(size_t)k * DIN0 + 1536 + j]; } }
    if (EXTRA == 2) { for (int i = F.tid; i < 8 * DM; i += 512) { const int k = i >> 3, j = i & 7; w8[j * DM + k] = F.router_w[(size_t)k * NEXP + j]; }
        if (F.tid < 16) lcnt[F.tid] = 0; }
    if (EXTRA != 0) __syncthreads();
    f32x4 Gv[4], Av[4], Bv[4];
#pragma unroll
    for (int j = 0; j < 4; ++j) { const int c = 256 * j + 4 * F.lane;
        const f32x4 g = *(const f32x4*)(gu + c), s1 = *(const f32x4*)(scv + (size_t)b * 6144 + c); Av[j] = g * (s1 + 1.f); Bv[j] = *(const f32x4*)(shv + (size_t)b * 6144 + c);
        if (RES) Gv[j] = *(const f32x4*)(gatev + (size_t)b * 6144 + c) * *(const f32x4*)(gy + c); }
    for (int i = 0; i < 16; ++i) {
        const int row = row0 + i;
        f32x4 hv[4];
#pragma unroll
        for (int j = 0; j < 4; ++j) { if constexpr (HB) { const u32x2 w = *(const u32x2*)((const unsigned char*)hin + (size_t)row * 4096 + 512 * j + 8 * F.lane); hv[j] = (f32x4){bflo(w.x), bfhi(w.x), bflo(w.y), bfhi(w.y)}; }
            else hv[j] = *(const f32x4*)(hin + (size_t)row * DM + 256 * j + 4 * F.lane); }
        if (RES) {
            f32x4 yv[4]; float ss = 0.f;
#pragma unroll
            for (int j = 0; j < 4; ++j) { const u32x2 w = *(const u32x2*)(y + (size_t)row * DM + 256 * j + 4 * F.lane); yv[j] = (f32x4){bflo(w.x), bfhi(w.x), bflo(w.y), bfhi(w.y)};
#ifdef DBG_SANITIZE
                for (int e_ = 0; e_ < 4; ++e_) if (!(fabsf(yv[j][e_]) < 1e30f)) yv[j][e_] = 0.f;
#endif
                ss += (yv[j].x * yv[j].x + yv[j].y * yv[j].y) + (yv[j].z * yv[j].z + yv[j].w * yv[j].w); }
            const float rstd = 1.f / sqrtf(wave_sum(ss) * (1.f / DM) + NORM_EPS);
#pragma unroll
            for (int j = 0; j < 4; ++j) { hv[j] = hv[j] + Gv[j] * (yv[j] * rstd); u32x2 w; w.x = pg8::cvt_pk_bf16(hv[j].x, hv[j].y); w.y = pg8::cvt_pk_bf16(hv[j].z, hv[j].w);
                *(u32x2*)((unsigned char*)F.out + (size_t)row * 4096 + 512 * j + 8 * F.lane) = w; }
        }
        float s2 = 0.f;
#pragma unroll
        for (int j = 0; j < 4; ++j) s2 += (hv[j].x * hv[j].x + hv[j].y * hv[j].y) + (hv[j].z * hv[j].z + hv[j].w * hv[j].w);
        const float rs = 1.f / sqrtf(wave_sum(s2) * (1.f / DM) + NORM_EPS);
        f32x4 uv[4];
#pragma unroll
        for (int j = 0; j < 4; ++j) { uv[j] = hv[j] * rs * Av[j] + Bv[j];
            if constexpr (U8) { *(unsigned*)((unsigned char*)uout + (size_t)row * DM + 256 * j + 4 * F.lane) = pk4_fp8(clamp448(uv[j].x * FP8_SU), clamp448(uv[j].y * FP8_SU), clamp448(uv[j].z * FP8_SU), clamp448(uv[j].w * FP8_SU)); }
            else { u32x2 w; w.x = pk2(uv[j].x, uv[j].y); w.y = pk2(uv[j].z, uv[j].w); *(u32x2*)(uout + (size_t)row * DM + 256 * j + 4 * F.lane) = w; } }
        if (EXTRA != 0) {
            float d[8];
#pragma unroll
            for (int q = 0; q < 8; ++q) { float s = 0.f;
#pragma unroll
                for (int j = 0; j < 4; ++j) { const f32x4 w = *(const LAS f32x4*)(w8 + q * DM + 256 * j + 4 * F.lane); s += (uv[j].x * w.x + uv[j].y * w.y) + (uv[j].z * w.z + uv[j].w * w.w); }
                d[q] = wave_sum(s); }
            if (EXTRA == 1) {
                float z = d[0];
#pragma unroll
                for (int q = 1; q < 8; ++q) z = (F.lane == q) ? d[q] : z;
                if (F.lane < 8) { z += F.fox_bias[F.lane]; const float ls = fminf(z, 0.f) - log1pf(expf(-fabsf(z)));
                    ((float*)(F.ws + WS_LOGF))[((size_t)b * 8 + F.lane) * SEQ + (row & (SEQ - 1))] = ls; }
            } else {
                int i1 = 0; float v1 = d[0];
#pragma unroll
                for (int q = 1; q < 8; ++q) if (d[q] > v1) { v1 = d[q]; i1 = q; }
                int i2 = -1; float v2 = -INFINITY;
#pragma unroll
                for (int q = 0; q < 8; ++q) if (q != i1 && d[q] > v2) { v2 = d[q]; i2 = q; }
                if (i2 < 0) { i2 = (i1 + 1) & 7; v2 = v1; }
                const float p1 = 1.f / (1.f + expf(v2 - v1)), p2 = 1.f - p1;
                if (F.lane == 0) {
                    const int rl = row - F.vcu * 128;
                    const int k1 = __hip_atomic_fetch_add(&lcnt[i1], 1, __ATOMIC_RELAXED, __HIP_MEMORY_SCOPE_WORKGROUP);
                    const int k2 = __hip_atomic_fetch_add(&lcnt[i2], 1, __ATOMIC_RELAXED, __HIP_MEMORY_SCOPE_WORKGROUP);
                    lcnt[16 + rl * 2] = i1; lcnt[16 + rl * 2 + 1] = i2; lcnt[16 + 256 + rl * 2] = k1; lcnt[16 + 256 + rl * 2 + 1] = k2;
                    f32x2 pv; pv.x = p1; pv.y = p2; *(f32x2*)((float*)(F.ws + WS_TOKP) + (size_t)row * 2) = pv;
                }
            }
        }
    }
    if (EXTRA == 2) {
        __syncthreads();
        if (F.tid < 8) lcnt[8 + F.tid] = (int)__hip_atomic_fetch_add((unsigned*)(F.ws + WS_CTL) + CW_GCNT + 64 * F.tid, (unsigned)lcnt[F.tid], __ATOMIC_RELAXED, __HIP_MEMORY_SCOPE_AGENT);
        __syncthreads();
        if (F.tid < 256) { const int rl = F.tid >> 1, k = F.tid & 1, e = lcnt[16 + F.tid], rk = lcnt[16 + 256 + F.tid]; const size_t row = (size_t)F.vcu * 128 + rl;
            ((int*)(F.ws + WS_TOKE))[row * 2 + k] = e; ((int*)(F.ws + WS_TOKR))[row * 2 + k] = lcnt[8 + e] + rk; }
        __syncthreads();
    }
}

__device__ __forceinline__ void phase_cum_kmean(Frame& F) {
    if (F.vcu < 64) {
        const float* lf = (const float*)(F.ws + WS_LOGF) + (size_t)F.vcu * SEQ; float* cu = (float*)(F.ws + WS_CUM) + (size_t)F.vcu * SEQ;
        LAS float* wt = (LAS float*)F.lds;
        f32x4 a = *(const f32x4*)(lf + F.tid * 8), c = *(const f32x4*)(lf + F.tid * 8 + 4);
        float v[8] = {a.x, a.y, a.z, a.w, c.x, c.y, c.z, c.w};
#pragma unroll
        for (int i = 1; i < 8; ++i) v[i] += v[i - 1];
        float run = v[7];
#pragma unroll
        for (int o = 1; o < 64; o <<= 1) { const float t = __shfl_up(run, o); if (F.lane >= o) run += t; }
        if (F.lane == 63) wt[F.wave] = run;
        __syncthreads();
        float off = run - v[7];
        for (int w = 0; w < F.wave; ++w) off += wt[w];
        f32x4 o0 = {v[0] + off, v[1] + off, v[2] + off, v[3] + off}, o1 = {v[4] + off, v[5] + off, v[6] + off, v[7] + off};
        *(f32x4*)(cu + F.tid * 8) = o0; *(f32x4*)(cu + F.tid * 8 + 4) = o1;
        __syncthreads();
    }
    const int gw = F.vcu * NWAVES + F.wave, NGW = F.G * NWAVES;
    const bf16* qkv = (const bf16*)(F.ws + WS_RB);
    for (int it = gw; it < NB * 8 * 16; it += NGW) {
        const int blk = it & 15, hh = (it >> 4) & 7, b = it >> 7;
        const bf16* kp = qkv + ((size_t)(32 + hh) * NTOK + (size_t)b * SEQ + blk * 256) * 64 + (F.lane & 7) * 8;
        float s[8] = {0.f, 0.f, 0.f, 0.f, 0.f, 0.f, 0.f, 0.f};
#pragma unroll 8
        for (int i = 0; i < 32; ++i) { const u32x4 w = *(const u32x4*)(kp + (size_t)((F.lane >> 3) + 8 * i) * 64);
            s[0] += bflo(w.x); s[1] += bfhi(w.x); s[2] += bflo(w.y); s[3] += bfhi(w.y); s[4] += bflo(w.z); s[5] += bfhi(w.z); s[6] += bflo(w.w); s[7] += bfhi(w.w); }
#pragma unroll
        for (int q = 0; q < 8; ++q) { s[q] += __shfl_xor(s[q], 8); s[q] += __shfl_xor(s[q], 16); s[q] += __shfl_xor(s[q], 32); }
        if (F.lane < 8) { float* o = (float*)(F.ws + WS_KMEAN) + (size_t)it * 64 + F.lane * 8;
            f32x4 o0 = {s[0], s[1], s[2], s[3]}, o1 = {s[4], s[5], s[6], s[7]}; *(f32x4*)o = o0 * (1.f / 256.f); *(f32x4*)(o + 4) = o1 * (1.f / 256.f); }
    }
    for (int it = gw; it < NB * 8 * 16; it += NGW) {
        const int blk = it & 15, hx = (it >> 4) & 7, b = it >> 7; const int qs = hx;
        const bf16* qp = qkv + ((size_t)qs * NTOK + (size_t)b * SEQ + blk * 256) * 64 + (F.lane & 7) * 8;
        float mq = 0.f, mk = 0.f;
        for (int i0 = 0; i0 < 32; i0 += 8) {
            u32x4 wq[8], wk[8];
#pragma unroll
            for (int i = 0; i < 8; ++i) { wq[i] = *(const u32x4*)(qp + (size_t)((F.lane >> 3) + 8 * (i0 + i)) * 64); wk[i] = *(const u32x4*)(qp + (size_t)8 * NTOK * 64 + (size_t)((F.lane >> 3) + 8 * (i0 + i)) * 64); }
#pragma unroll
            for (int i = 0; i < 8; ++i) { float sq = 0.f, sk = 0.f;
#pragma unroll
                for (int e = 0; e < 4; ++e) { sq += bflo(wq[i][e]) * bflo(wq[i][e]) + bfhi(wq[i][e]) * bfhi(wq[i][e]); sk += bflo(wk[i][e]) * bflo(wk[i][e]) + bfhi(wk[i][e]) * bfhi(wk[i][e]); }
                sq += __shfl_xor(sq, 1); sq += __shfl_xor(sq, 2); sq += __shfl_xor(sq, 4); sk += __shfl_xor(sk, 1); sk += __shfl_xor(sk, 2); sk += __shfl_xor(sk, 4);
                mq = fmaxf(mq, sq); mk = fmaxf(mk, sk); } }
#pragma unroll
        for (int o = 8; o < 64; o <<= 1) { mq = fmaxf(mq, __shfl_xor(mq, o)); mk = fmaxf(mk, __shfl_xor(mk, o)); }
        if (F.lane == 0) { unsigned* w = (unsigned*)(F.ws + WS_CTL) + CW_QKN + 2 * (b * 16 + hx);
            __hip_atomic_fetch_max(w, __builtin_bit_cast(unsigned, sqrtf(mq)), __ATOMIC_RELAXED, __HIP_MEMORY_SCOPE_AGENT);
            __hip_atomic_fetch_max(w + 1, __builtin_bit_cast(unsigned, sqrtf(mk)), __ATOMIC_RELAXED, __HIP_MEMORY_SCOPE_AGENT); }
    }
}

__device__ __forceinline__ void phase_merge(Frame& F) {
    const int gw = F.vcu * NWAVES + F.wave;
    bf16* p0 = (bf16*)(F.ws + WS_RA); const bf16* p1 = (const bf16*)(F.ws + WS_RC); const bf16* p2 = (const bf16*)(F.ws + WS_RD);
    const float* ml = (const float*)(F.ws + WS_ML);
    for (int i = 0; i < 16; ++i) { const size_t row = (size_t)gw * 16 + i;
#pragma unroll
        for (int j = 0; j < 4; ++j) { const int head = 4 * j + (F.lane >> 4); const size_t mi = (row * NH + head) * 2;
            const f32x2 a = *(const f32x2*)(ml + mi), b = *(const f32x2*)(ml + (size_t)NTOK * NH * 2 + mi), c = *(const f32x2*)(ml + (size_t)2 * NTOK * NH * 2 + mi);
            const float M = fmaxf(a.x, fmaxf(b.x, c.x));
            float wa = a.y * __builtin_amdgcn_exp2f(a.x - M), wb = b.y * __builtin_amdgcn_exp2f(b.x - M), wc = c.y * __builtin_amdgcn_exp2f(c.x - M);
            const float inv = 1.f / (wa + wb + wc); wa *= inv; wb *= inv; wc *= inv;
            const size_t off = row * DM + 256 * j + 4 * F.lane;
            const u32x2 xa = *(const u32x2*)(p0 + off), xb = *(const u32x2*)(p1 + off), xc = *(const u32x2*)(p2 + off);
            u32x2 w; w.x = pk2(wa * bflo(xa.x) + wb * bflo(xb.x) + wc * bflo(xc.x), wa * bfhi(xa.x) + wb * bfhi(xb.x) + wc * bfhi(xc.x));
            w.y = pk2(wa * bflo(xa.y) + wb * bflo(xb.y) + wc * bflo(xc.y), wa * bfhi(xa.y) + wb * bfhi(xb.y) + wc * bfhi(xc.y));
            *(u32x2*)(p0 + off) = w; }
    }
}

__device__ __forceinline__ void phase_gather(Frame& F) {
    LAS int* so = (LAS int*)F.lds;
    if (F.tid == 0) { int acc = 0; for (int e = 0; e < 8; ++e) { so[e] = acc; const int c = (int)__hip_atomic_load((unsigned*)(F.ws + WS_CTL) + CW_GCNT + 64 * e, __ATOMIC_RELAXED, __HIP_MEMORY_SCOPE_AGENT); acc += (c + 255) & ~255; } so[8] = acc; }
    __syncthreads();
    if (F.vcu == 0) { int* te = (int*)(F.ws + WS_TILEE); const int nt = so[8] >> 8;
        for (int t = F.tid; t < MAXTILES; t += 512) { int e = 0; for (int q = 1; q < 8; ++q) if (t * 256 >= so[q]) e = q; te[t] = e; }
        if (F.tid == 0) te[MAXTILES] = nt < MAXTILES ? nt : MAXTILES; }
    const int gw = F.vcu * NWAVES + F.wave;
    const bf16* u = (const bf16*)(F.ws + WS_RA); unsigned char* us = F.ws + WS_USORT;
    const int* te = (const int*)(F.ws + WS_TOKE); const int* tr = (const int*)(F.ws + WS_TOKR); int* ts = (int*)(F.ws + WS_TOKS);
    int d_l = 0;
    if (F.lane < 32) { const int e = te[gw * 32 + F.lane] & 7; d_l = so[e] + tr[gw * 32 + F.lane]; d_l = d_l < 0 ? 0 : (d_l >= MAXTILES * 256 ? MAXTILES * 256 - 1 : d_l); ts[gw * 32 + F.lane] = d_l; }
#pragma unroll 1
    for (int i0 = 0; i0 < 16; i0 += 4) {
        u32x4 a[4], b[4];
#pragma unroll
        for (int r = 0; r < 4; ++r) { const size_t row = (size_t)gw * 16 + i0 + r; a[r] = *(const u32x4*)(u + row * DM + F.lane * 8); b[r] = *(const u32x4*)(u + row * DM + 512 + F.lane * 8); }
#pragma unroll
        for (int r = 0; r < 4; ++r) { u32x2 fa, fb;
            fa.x = pk4_fp8(bflo(a[r].x) * FP8_SU, bfhi(a[r].x) * FP8_SU, bflo(a[r].y) * FP8_SU, bfhi(a[r].y) * FP8_SU); fa.y = pk4_fp8(bflo(a[r].z) * FP8_SU, bfhi(a[r].z) * FP8_SU, bflo(a[r].w) * FP8_SU, bfhi(a[r].w) * FP8_SU);
            fb.x = pk4_fp8(bflo(b[r].x) * FP8_SU, bfhi(b[r].x) * FP8_SU, bflo(b[r].y) * FP8_SU, bfhi(b[r].y) * FP8_SU); fb.y = pk4_fp8(bflo(b[r].z) * FP8_SU, bfhi(b[r].z) * FP8_SU, bflo(b[r].w) * FP8_SU, bfhi(b[r].w) * FP8_SU);
#pragma unroll
            for (int k = 0; k < 2; ++k) { const int dst = __builtin_amdgcn_readlane(d_l, 2 * (i0 + r) + k);
                *(u32x2*)(us + (size_t)dst * DM + F.lane * 8) = fa; *(u32x2*)(us + (size_t)dst * DM + 512 + F.lane * 8) = fb; } }
    }
}

__device__ __forceinline__ void phase_final(Frame& F, const float* __restrict__ gy, const float* __restrict__ gatev) {
    const int gw = F.vcu * NWAVES + F.wave; const int row0 = gw * 16, b = row0 >> 12;
    const bf16* ys = (const bf16*)(F.ws + WS_YSLOT); const int* ts = (const int*)(F.ws + WS_TOKS); const float* tp = (const float*)(F.ws + WS_TOKP);
    f32x4 Gv[4];
#pragma unroll
    for (int j = 0; j < 4; ++j) { const int c = 256 * j + 4 * F.lane; Gv[j] = *(const f32x4*)(gatev + (size_t)b * 6144 + c) * *(const f32x4*)(gy + c); }
    for (int i = 0; i < 16; ++i) { const size_t row = (size_t)row0 + i;
        int s1 = ts[row * 2], s2 = ts[row * 2 + 1]; const float p1 = tp[row * 2], p2 = tp[row * 2 + 1];
        s1 = s1 < 0 ? 0 : (s1 >= MAXTILES * 256 ? MAXTILES * 256 - 1 : s1); s2 = s2 < 0 ? 0 : (s2 >= MAXTILES * 256 ? MAXTILES * 256 - 1 : s2);
        f32x4 yv[4], hv[4]; float ss = 0.f;
#pragma unroll
        for (int j = 0; j < 4; ++j) { const u32x2 w = *(const u32x2*)((const unsigned char*)F.out + row * 4096 + 512 * j + 8 * F.lane); hv[j] = (f32x4){bflo(w.x), bfhi(w.x), bflo(w.y), bfhi(w.y)}; }
#pragma unroll
        for (int j = 0; j < 4; ++j) { const u32x2 wa = *(const u32x2*)(ys + (size_t)s1 * DM + 256 * j + 4 * F.lane), wb = *(const u32x2*)(ys + (size_t)s2 * DM + 256 * j + 4 * F.lane);
            yv[j] = (f32x4){p1 * bflo(wa.x) + p2 * bflo(wb.x), p1 * bfhi(wa.x) + p2 * bfhi(wb.x), p1 * bflo(wa.y) + p2 * bflo(wb.y), p1 * bfhi(wa.y) + p2 * bfhi(wb.y)};
            ss += (yv[j].x * yv[j].x + yv[j].y * yv[j].y) + (yv[j].z * yv[j].z + yv[j].w * yv[j].w); }
        const float rstd = 1.f / sqrtf(wave_sum(ss) * (1.f / DM) + NORM_EPS);
        VM_WAIT();
#pragma unroll
        for (int j = 0; j < 4; ++j) { float* op = F.out + row * DM + 256 * j + 4 * F.lane; *(f32x4*)op = hv[j] + Gv[j] * (yv[j] * rstd); }
    }
}

constexpr int NPHASES = 21;
__global__ void __launch_bounds__(NWAVES * 64, 2) trunk_fwd(Args args) {
    extern __shared__ __attribute__((aligned(16))) unsigned char lds_raw[];
    Frame F;
    F.lds = (LAS unsigned char*)lds_raw;
    volatile LAS unsigned* MISC = (volatile LAS unsigned*)(F.lds + MISC_OFF);
    F.tid = threadIdx.x; F.lane = F.tid & 63; F.wave = __builtin_amdgcn_readfirstlane(F.tid >> 6);
    F.G = gridDim.x; { const int bx = blockIdx.x; F.vcu = (F.G % 8 == 0) ? (bx % 8) * (F.G / 8) + bx / 8 : bx; }
    F.x = args.in[0]; F.c = args.in[1]; F.mod_w = args.in[2]; F.mod_b = args.in[3]; F.norm_g = args.in[4]; F.w_in0 = args.in[5]; F.fox_bias = args.in[6]; F.w_out0 = args.in[7];
    F.w_in1 = args.in[8]; F.w_out1 = args.in[9]; F.relb = args.in[10]; F.ffn_g = args.in[11]; F.ffn_u = args.in[12]; F.ffn_d = args.in[13]; F.router_w = args.in[14];
    F.ex_g = args.in[15]; F.ex_u = args.in[16]; F.ex_d = args.in[17]; F.out = args.out; F.ws = args.ws;
    for (int u = F.tid; u < (LDS_BYTES - RING_BYTES) / 4; u += NWAVES * 64) ((LAS unsigned*)(F.lds + RING_BYTES))[u] = 0u;
    __syncthreads();
    const int lo = args.ph_lo, hi = args.ph_hi;
    XcdBarrier bar; bar.bar = (unsigned*)(F.ws + WS_CTL) + CW_BAR; bar.x = 0; bar.st = nullptr;
    if (hi - lo > 1) bar = xcd_barrier_post((unsigned*)(F.ws + WS_CTL) + CW_BAR, MISC + 8);
#define IN(k) (lo <= (k) && (k) < hi)
#define SEAM(k) do { if (IN(k) && IN((k) + 1)) xcd_barrier(bar); } while (0)
    const float* mods = (const float*)(F.ws + WS_MODS);
    const float* mods0 = mods, * mods1 = mods + (size_t)NB * 6144;
    const float* ng0 = F.norm_g, * ng1 = F.norm_g + 4 * DM;
    bf16* RA = (bf16*)(F.ws + WS_RA); bf16* RB = (bf16*)(F.ws + WS_RB); bf16* RC = (bf16*)(F.ws + WS_RC); bf16* RD = (bf16*)(F.ws + WS_RD);
    const bf16* wo = (const bf16*)(F.ws + WS_WOTHER);

    if (IN(0)) { phase_prologue(F); } SEAM(0);
    if (IN(1)) { thin_phase<false, 1>(F, F.x, nullptr, nullptr, nullptr, ng0, mods0 + 0, mods0 + 1024, RA); __syncthreads(); weight_copies(F); } SEAM(1);
    if (IN(2)) { pg8::Gemm g{RA, wo + WO_IN0 / 2, NTOK, 3072, DM}; pg8::StaticOrder S; S.init(NTOK, 3072, F.G, (int)blockIdx.x); pg8::EpiHeadMajor E{RB, NTOK, 0xFFull | (0xFFull << 24), att::C2};
        pg8::gemm_phase<pg8::EpiHeadMajor, pg8::StaticOrder>(F.lds, g, S, E); } SEAM(2);
    if (IN(3)) { phase_cum_kmean(F); } SEAM(3);
    if (IN(4)) {
        const int b = F.vcu >> 5, j = F.vcu & 31, a = j & 15;
        const float* cum = (const float*)(F.ws + WS_CUM); const float* km = (const float*)(F.ws + WS_KMEAN); const unsigned* qkn = (const unsigned*)(F.ws + WS_CTL) + CW_QKN;
        for (int r = 0; r < (MK_DUP == 41 ? 8 : 4); ++r) { const int r4 = r & 3; const int a8 = (a + 8) & 15; const int qt = (r4 == 0) ? a : (r4 == 1) ? 15 - a : (r4 == 2) ? a8 : 15 - a8;
            att::attn_unit_v2<1>(F.lds, RB, b, 8 + 2 * r4 + (j >> 4), qt, nullptr, km, F.relb, RA, qkn); }
        { const int hf = j >> 2, qq = j & 3;
          for (int i = 0; i < (MK_DUP == 40 ? 8 : 4); ++i) { const int i4 = i & 3; const int qt = (i4 == 0) ? 15 - qq : (i4 == 1) ? 8 + qq : (i4 == 2) ? 7 - qq : qq;
            att::attn_unit_v2<0>(F.lds, RB, b, hf, qt, cum, nullptr, nullptr, RA, qkn); } }
    } SEAM(4);
    if (IN(5)) { pg8::Gemm g{RA, wo + WO_OUT0 / 2, NTOK, DM, DM}; pg8::StaticOrder S; S.init(NTOK, DM, F.G, (int)blockIdx.x); pg8::EpiBf16 E{RC, DM};
        pg8::gemm_phase<pg8::EpiBf16, pg8::StaticOrder>(F.lds, g, S, E); } SEAM(5);
    if (IN(6)) { thin_phase<true, 0, true>(F, F.x, RC, ng0 + 1 * DM, mods0 + 2048, ng0 + 2 * DM, mods0 + 3072, mods0 + 4096, RA);
#if MK_DUP == 6
        xcd_barrier(bar); thin_phase<true, 0, true>(F, F.x, RC, ng0 + 1 * DM, mods0 + 2048, ng0 + 2 * DM, mods0 + 3072, mods0 + 4096, RA);
#endif
    } SEAM(6);
    if (IN(7)) { { pg8::Gemm g{RA, wo + WO_FGU / 2, NTOK, 2 * DFF, DM / 2}; pg8::StaticOrder S; S.init(NTOK, 2 * DFF, F.G, (int)blockIdx.x); pg8::EpiSwigluFp8 E{(unsigned char*)RB, DFF, 1.f / (FP8_SU * FP8_SW), FP8_SH};
        pg8::gemm_phase<pg8::EpiSwigluFp8, pg8::StaticOrder, true, true, DM / 2>(F.lds, g, S, E); }
#if MK_DUP == 7
        xcd_barrier(bar); { pg8::Gemm g{RA, wo + WO_FGU / 2, NTOK, 2 * DFF, DM / 2}; pg8::StaticOrder S; S.init(NTOK, 2 * DFF, F.G, (int)blockIdx.x); pg8::EpiSwigluFp8 E{(unsigned char*)RB, DFF, 1.f / (FP8_SU * FP8_SW), FP8_SH};
        pg8::gemm_phase<pg8::EpiSwigluFp8, pg8::StaticOrder, true, true, DM / 2>(F.lds, g, S, E); }
#endif
    } SEAM(7);
    if (IN(8)) { pg8::Gemm g{RB, wo + WO_FDN / 2, NTOK, DM, DFF / 2}; pg8::StaticOrder S; S.init(NTOK, DM, F.G, (int)blockIdx.x); pg8::EpiBf16Scaled E{RC, DM, 1.f / (FP8_SH * FP8_SW)};
        pg8::gemm_phase<pg8::EpiBf16Scaled, pg8::StaticOrder, true, true, DFF / 2>(F.lds, g, S, E); } SEAM(8);
    if (IN(9)) { thin_phase<true, 0, false, true>(F, F.out, RC, ng0 + 3 * DM, mods0 + 5120, ng1 + 0, mods1 + 0, mods1 + 1024, RA); } SEAM(9);
    if (IN(10)) { pg8::Gemm g{RA, wo + WO_IN1 / 2, NTOK, 3072, DM}; pg8::StaticOrder S; S.init(NTOK, 3072, F.G, (int)blockIdx.x); pg8::EpiHeadMajor E{RB, NTOK, 0xFFFFull, att::C2};
        pg8::gemm_phase<pg8::EpiHeadMajor, pg8::StaticOrder>(F.lds, g, S, E); } SEAM(10);
    if (IN(11)) {
        float* ml = (float*)(F.ws + WS_ML);
        att::dilated_phase(F.lds, RB, F.vcu >> 5, F.vcu & 31, F.relb, RA, RC, RD, ml, (const unsigned*)(F.ws + WS_CTL) + CW_KN1);
    } SEAM(11);
    if (IN(12)) { phase_merge(F); } SEAM(12);
    if (IN(13)) { pg8::Gemm g{RA, wo + WO_OUT1 / 2, NTOK, DM, DM}; pg8::StaticOrder S; S.init(NTOK, DM, F.G, (int)blockIdx.x); pg8::EpiBf16 E{RC, DM};
        pg8::gemm_phase<pg8::EpiBf16, pg8::StaticOrder>(F.lds, g, S, E); } SEAM(13);
    if (IN(14)) { thin_phase<true, 2, false, true>(F, F.out, RC, ng1 + 1 * DM, mods1 + 2048, ng1 + 2 * DM, mods1 + 3072, mods1 + 4096, RA); expert_weight_copies(F); } SEAM(14);
    if (IN(15)) { phase_gather(F); } SEAM(15);
    { int t_ = F.tid; asm volatile("" : "+v"(t_)); F.tid = t_; F.lane = t_ & 63; }
    {
        const int* te = (const int*)(F.ws + WS_TILEE);
        const unsigned char* us = F.ws + WS_USORT; unsigned char* hid = F.ws + WS_HID; bf16* ysl = (bf16*)(F.ws + WS_YSLOT);
        const unsigned char* wexp = F.ws + WS_WEXP;
        if (IN(16) || IN(17)) {
            int n = __builtin_amdgcn_readfirstlane(te[MAXTILES]); if (n > MAXTILES) n = MAXTILES;
            if (IN(16) && n > 0) { pg8::Gemm g{(const bf16*)us, (const bf16*)wexp, n * 256, 2 * DFE, DM / 2}; pg8::MoeOrder S; S.so.init(n * 256, 2 * DFE, F.G, (int)blockIdx.x); S.so.wgm = 16; S.tile_e = te; S.estride = WEXP_STRIDE;
                pg8::EpiSwigluFp8 E{hid, DFE, 1.f / (FP8_SU * FP8_SW), FP8_SH}; pg8::gemm_phase<pg8::EpiSwigluFp8, pg8::MoeOrder, true, true, DM / 2>(F.lds, g, S, E); }
            SEAM(16);
            if (IN(17) && n > 0) { pg8::Gemm g{(const bf16*)hid, (const bf16*)(wexp + WEXP_DN_OFF), n * 256, DM, DFE / 2}; pg8::MoeOrder S; S.so.init(n * 256, DM, F.G, (int)blockIdx.x); S.tile_e = te; S.estride = WEXP_STRIDE;
                pg8::EpiBf16Scaled E{ysl, DM, 1.f / (FP8_SH * FP8_SW)}; pg8::gemm_phase<pg8::EpiBf16Scaled, pg8::MoeOrder, true, true, DFE / 2>(F.lds, g, S, E); }
            SEAM(17);
        }
    }
    { int t_ = F.tid; asm volatile("" : "+v"(t_)); F.tid = t_; F.lane = t_ & 63; }
    if (IN(20)) { phase_final(F, ng1 + 3 * DM, mods1 + 5120); }
#undef IN
#undef SEAM
}

extern "C" void kernel_launch(void* const* d_in, const int* in_sizes, int n_in, void* d_out, int out_size, void* d_ws, size_t ws_size, hipStream_t stream) {
    static int grid = 0;
    if (grid == 0) {
        if (n_in != 18 || in_sizes[0] != NTOK * DM || out_size != NTOK * DM || ws_size < WS_END) { fprintf(stderr, "kernel_launch: unexpected shapes / workspace (%d inputs, ws %zu, need %zu); nothing launched\n", n_in, ws_size, (size_t)WS_END); grid = -1; return; }
        int dev = 0, cus = 0, per_cu = 0;
        if (hipGetDevice(&dev) != hipSuccess || hipDeviceGetAttribute(&cus, hipDeviceAttributeMultiprocessorCount, dev) != hipSuccess) { grid = -1; return; }
        if (hipFuncSetAttribute((const void*)trunk_fwd, hipFuncAttributeMaxDynamicSharedMemorySize, LDS_BYTES) != hipSuccess) { fprintf(stderr, "kernel_launch: hipFuncSetAttribute failed\n"); grid = -1; return; }
        if (hipOccupancyMaxActiveBlocksPerMultiprocessor(&per_cu, (const void*)trunk_fwd, NWAVES * 64, LDS_BYTES) != hipSuccess || per_cu < 1) { fprintf(stderr, "kernel_launch: occupancy query reports %d\n", per_cu); }
        (void)hipGetLastError();
        grid = cus;
        if (grid != 256) { fprintf(stderr, "kernel_launch: built for 256 CUs, found %d; nothing launched\n", grid); grid = -1; return; }
    }
    if (grid < 0) return;
    if (hipMemsetAsync((char*)d_ws + WS_CTL, 0, CTL_ZERO_BYTES, stream) != hipSuccess) return;
    Args a{};
    for (int i = 0; i < 18; ++i) a.in[i] = (const float*)d_in[i];
    a.out = (float*)d_out; a.ws = (unsigned char*)d_ws;
#if MK_ONE_LAUNCH
    a.ph_lo = 0; a.ph_hi = MK_LAST_PHASE;
    hipLaunchKernelGGL(trunk_fwd, dim3(grid), dim3(NWAVES * 64), LDS_BYTES, stream, a);
#else
    for (int p = 0; p < MK_LAST_PHASE; ++p) { a.ph_lo = p; a.ph_hi = p + 1; hipLaunchKernelGGL(trunk_fwd, dim3(grid), dim3(NWAVES * 64), LDS_BYTES, stream, a); }
#endif
}
```

```cpp
#include <hip/hip_runtime.h>
#include <cstdio>
#include <cstdint>

#ifndef MK_ONE_LAUNCH
#define MK_ONE_LAUNCH 1
#endif
#ifndef MK_DUP
#define MK_DUP 0
#endif
#ifndef MK_LAST_PHASE
#define MK_LAST_PHASE 21
#endif

#define GAS __attribute__((address_space(1)))
#define LAS __attribute__((address_space(3)))
typedef unsigned short bf16;
typedef unsigned u32x4 __attribute__((ext_vector_type(4)));
typedef unsigned u32x2 __attribute__((ext_vector_type(2)));
typedef float f32x4 __attribute__((ext_vector_type(4)));
typedef float f32x2 __attribute__((ext_vector_type(2)));
typedef float f32x16 __attribute__((ext_vector_type(16)));
typedef short bf16x8 __attribute__((ext_vector_type(8)));
typedef short s16x4 __attribute__((ext_vector_type(4)));
typedef GAS unsigned gu32;

constexpr int NB = 8, SEQ = 4096, DM = 1024, NTOK = NB * SEQ, NH = 16, HD = 64;
constexpr int DFF = 2816, NEXP = 8, DFE = 3584;
constexpr int QKVP = 3072;
constexpr int DIN0 = 3080;
constexpr float NORM_EPS = 1e-6f;
constexpr float LOG2E = 1.4426950408889634f;
constexpr int NWAVES = 8;
constexpr int MAXTILES = 264;
constexpr int PASS0_TILES = 128, PASS1_MAXTILES = MAXTILES - PASS0_TILES;

constexpr size_t MiB = 1u << 20;
constexpr size_t WS_CTL = 0, CTL_ZERO_BYTES = 1 * MiB;
constexpr size_t WS_MODS = 1 * MiB;
constexpr size_t WS_LOGF = 2 * MiB;
constexpr size_t WS_CUM = 3 * MiB;
constexpr size_t WS_KMEAN = 512 * 1024;
constexpr size_t WS_TOKE = 5 * MiB;
constexpr size_t WS_TOKP = WS_TOKE + 256 * 1024;
constexpr size_t WS_TOKR = WS_TOKP + 256 * 1024;
constexpr size_t WS_TOKS = WS_TOKR + 256 * 1024;
constexpr size_t WS_TILEE = 6 * MiB;
constexpr size_t WS_ML = 8 * MiB;
constexpr size_t WS_RA = 24 * MiB;
constexpr size_t WS_RC = 88 * MiB;
constexpr size_t WS_WOTHER = 152 * MiB;
constexpr size_t WS_RB = 185 * MiB;
constexpr size_t WS_RD = 377 * MiB;
constexpr size_t WS_HID = 24 * MiB;
constexpr size_t WS_USORT = 262 * MiB;
constexpr size_t WS_YSLOT = 328 * MiB;
constexpr size_t WS_WEXP = 460 * MiB;
constexpr size_t WS_END = 544 * MiB;
constexpr size_t WEXP_STRIDE = 10 * MiB + 512 * 1024, WEXP_DN_OFF = 7 * MiB;
constexpr float FP8_SW = 64.f, FP8_SU = 4.f, FP8_SH = 8.f;
constexpr size_t WO_IN0 = 0, WO_OUT0 = 6 * MiB, WO_IN1 = 8 * MiB, WO_OUT1 = 14 * MiB, WO_FGU = 16 * MiB, WO_FDN = 27 * MiB;
static_assert(WS_RB + (size_t)NTOK * QKVP * 2 <= WS_RD && WS_HID + (size_t)MAXTILES * 256 * DFE <= WS_USORT && WS_USORT + (size_t)MAXTILES * 256 * DM <= WS_YSLOT && WS_YSLOT + (size_t)MAXTILES * 256 * DM * 2 <= WS_WEXP && WS_WEXP + 8 * WEXP_STRIDE <= WS_END, "d_ws map");
constexpr int CW_GCNT = 1024;
constexpr int CW_QKN = 2048;
constexpr int CW_KN1 = 3072;
constexpr int CW_BAR = 4096;

constexpr int RING_BYTES = 131072;
constexpr int MISC_OFF = RING_BYTES + 320;
constexpr int LDS_BYTES = 147456;

__device__ __forceinline__ unsigned f2bf(float f) { unsigned u = __builtin_bit_cast(unsigned, f); return (u + 0x7fffu + ((u >> 16) & 1u)) >> 16; }
__device__ __forceinline__ unsigned pk2(float lo, float hi) { return f2bf(lo) | (f2bf(hi) << 16); }
__device__ __forceinline__ float bf2f(unsigned short b) { return __builtin_bit_cast(float, (unsigned)b << 16); }
__device__ __forceinline__ float bflo(unsigned w) { return __builtin_bit_cast(float, w << 16); }
__device__ __forceinline__ float bfhi(unsigned w) { return __builtin_bit_cast(float, w & 0xffff0000u); }
__device__ __forceinline__ float wave_sum(float v) {
#pragma unroll
    for (int o = 1; o < 64; o <<= 1) v += __shfl_xor(v, o);
    return v;
}
__device__ __forceinline__ unsigned pk4_fp8(float a, float b, float c, float d) { unsigned w = __builtin_amdgcn_cvt_pk_fp8_f32(a, b, 0u, false); return __builtin_amdgcn_cvt_pk_fp8_f32(c, d, w, true); }
__device__ __forceinline__ float clamp448(float v) { return __builtin_amdgcn_fmed3f(v, -448.f, 448.f); }
#define LDS_WAIT() asm volatile("s_waitcnt lgkmcnt(0)" ::: "memory")
#define VM_WAIT() asm volatile("s_waitcnt vmcnt(0)" ::: "memory")

namespace pg8 {
typedef unsigned short bf16_t;
typedef int v8i_t __attribute__((ext_vector_type(8)));
constexpr int BM = 256, BK = 64, HALF = 128, HTB = HALF * BK * 2, STAGE_BYTES = 8 * HTB, NXCD = 8, WGM = 8;
__host__ __device__ __forceinline__ int lds_byte(int r, int c) { const int st = (r >> 4) * 2 + (c >> 5), rr = r & 15, cc = c & 31, ob = rr * 64 + cc * 2; return st * 1024 + (ob ^ (((ob >> 9) & 1) << 5)); }
__host__ __device__ __forceinline__ void stage_rc(int b, int& R, int& C) { const int st = b / 1024, sb = b % 1024, swz = sb ^ (((sb >> 9) & 1) << 5); R = (st >> 1) * 16 + swz / 64; C = (st & 1) * 32 + (swz % 64) / 2; }
__host__ __device__ __forceinline__ int perm32(int rho) { const int n = rho >> 4, i = rho & 15; return 8 * (i >> 2) + 4 * n + (i & 3); }

struct Unit { int pm, pn; };
struct Gemm { const bf16_t* A; const bf16_t* Bt; int M, N, K; };

struct StaticOrder {
    int nM, nN, nwg, G, c, wgm = WGM;
    __device__ void init(int M, int N, int G_, int c_) { nM = M / BM; nN = N / BM; nwg = nM * nN; G = G_; c = c_; }
    __device__ bool next(int i, Unit& u) const {
        const long L = (long)i * G + c; if (L >= nwg) return false;
        int wgid = (int)L; { const int q = nwg / NXCD, r = nwg % NXCD, xcd = wgid % NXCD, off = wgid / NXCD; wgid = (xcd < r ? xcd * (q + 1) : r * (q + 1) + (xcd - r) * q) + off; }
        const int nig = wgm * nN, gid = wgid / nig, fm = gid * wgm, gsz = (nM - fm) < wgm ? (nM - fm) : wgm;
        u.pm = fm + ((wgid % nig) % gsz); u.pn = (wgid % nig) / gsz; return true;
    }
    __device__ __forceinline__ const char* abase(const Gemm& g, const Unit& u) const { return (const char*)g.A + (size_t)u.pm * ((size_t)BM * g.K * 2); }
    __device__ __forceinline__ const char* bbase(const Gemm& g, const Unit& u) const { return (const char*)g.Bt + (size_t)u.pn * ((size_t)BM * g.K * 2); }
};
struct MoeOrder {
    StaticOrder so; const int* tile_e; size_t estride;
    __device__ bool next(int i, Unit& u) const { return so.next(i, u); }
    __device__ __forceinline__ const char* abase(const Gemm& g, const Unit& u) const { return (const char*)g.A + (size_t)u.pm * ((size_t)BM * g.K * 2); }
    __device__ __forceinline__ const char* bbase(const Gemm& g, const Unit& u) const { const int e = __builtin_amdgcn_readfirstlane(tile_e[u.pm]); return (const char*)g.Bt + (size_t)e * estride + (size_t)u.pn * ((size_t)BM * g.K * 2); }
};

typedef float f32x2_t __attribute__((ext_vector_type(2))); typedef __bf16 bf16x2_t __attribute__((ext_vector_type(2)));
__device__ __forceinline__ unsigned cvt_pk_bf16(float lo, float hi) { f32x2_t v = {lo, hi}; bf16x2_t b = __builtin_convertvector(v, bf16x2_t); return __builtin_bit_cast(unsigned, b); }

struct EpiBf16 {
    static constexpr bool PERM = true;
    bf16_t* O; int ldc;
    __device__ __forceinline__ void operator()(const f32x4 (&acc)[2][2][4][2], const Unit& u, int wr, int wc, int fr, int fq) const {
        const int row0 = u.pm * BM + wr * 64 + fr; const int col0 = u.pn * BM + wc * 32 + 8 * fq;
#pragma unroll
        for (int ai = 0; ai < 2; ++ai)
#pragma unroll
            for (int m = 0; m < 4; ++m) { bf16_t* rowp = O + (size_t)(row0 + ai * HALF + m * 16) * ldc + col0;
#pragma unroll
                for (int bj = 0; bj < 2; ++bj) { const f32x4 v0 = acc[ai][bj][m][0], v1 = acc[ai][bj][m][1];
                    u32x4 w; w.x = cvt_pk_bf16(v0[0], v0[1]); w.y = cvt_pk_bf16(v0[2], v0[3]); w.z = cvt_pk_bf16(v1[0], v1[1]); w.w = cvt_pk_bf16(v1[2], v1[3]);
                    *(u32x4*)(rowp + bj * HALF) = w; } }
    }
};
struct EpiHeadMajor {
    static constexpr bool PERM = true;
    bf16_t* O; int M; unsigned long long qmask; float qscale;
    unsigned* nrm; float* kmean;
    __device__ __forceinline__ void operator()(const f32x4 (&acc)[2][2][4][2], const Unit& u, int wr, int wc, int fr, int fq) const {
        const int row0 = u.pm * BM + wr * 64 + fr; const int col0 = u.pn * BM + wc * 32 + 8 * fq;
        const bool donorm = nrm != nullptr && u.pn < 4, dokm = kmean != nullptr && (u.pn == 8 || u.pn == 9);
        float mx[2] = {0.f, 0.f}; float cs[2][8];
#pragma unroll
        for (int bj = 0; bj < 2; ++bj)
#pragma unroll
            for (int q = 0; q < 8; ++q) cs[bj][q] = 0.f;
#pragma unroll
        for (int ai = 0; ai < 2; ++ai)
#pragma unroll
            for (int m = 0; m < 4; ++m) { const int row = row0 + ai * HALF + m * 16;
#pragma unroll
                for (int bj = 0; bj < 2; ++bj) { const int col = col0 + bj * HALF; const float sc = ((qmask >> (col >> 6)) & 1ull) ? qscale : 1.f; const f32x4 v0 = acc[ai][bj][m][0] * sc, v1 = acc[ai][bj][m][1] * sc;
                    u32x4 w; w.x = cvt_pk_bf16(v0[0], v0[1]); w.y = cvt_pk_bf16(v0[2], v0[3]); w.z = cvt_pk_bf16(v1[0], v1[1]); w.w = cvt_pk_bf16(v1[2], v1[3]);
                    *(u32x4*)(O + ((size_t)(col >> 6) * M + row) * 64 + (col & 63)) = w;
                    if (donorm || dokm) {
                        float x[8];
#pragma unroll
                        for (int e = 0; e < 4; ++e) { x[2 * e] = __builtin_bit_cast(float, w[e] << 16); x[2 * e + 1] = __builtin_bit_cast(float, w[e] & 0xffff0000u); }
                        if (donorm) { float s2 = ((x[0] * x[0] + x[1] * x[1]) + (x[2] * x[2] + x[3] * x[3])) + ((x[4] * x[4] + x[5] * x[5]) + (x[6] * x[6] + x[7] * x[7]));
                            s2 += __shfl_xor(s2, 16); s2 += __shfl_xor(s2, 32); mx[bj] = fmaxf(mx[bj], s2); }
                        if (dokm) {
#pragma unroll
                            for (int q = 0; q < 8; ++q) cs[bj][q] += x[q]; }
                    } } }
        if (donorm) {
#pragma unroll
            for (int bj = 0; bj < 2; ++bj) { float v = mx[bj];
#pragma unroll
                for (int o = 1; o < 16; o <<= 1) v = fmaxf(v, __shfl_xor(v, o));
                const int col = u.pn * BM + bj * HALF + wc * 32, slot = col >> 6, half = (col >> 5) & 1, b = u.pm >> 4;
                if ((fr | fq) == 0) __hip_atomic_fetch_max(nrm + ((b * 16 + (slot & 7)) * 2 + (slot >> 3)) * 2 + half, __builtin_bit_cast(unsigned, v), __ATOMIC_RELAXED, __HIP_MEMORY_SCOPE_AGENT); }
        }
        if (dokm) {
#pragma unroll
            for (int bj = 0; bj < 2; ++bj) {
#pragma unroll
                for (int q = 0; q < 8; ++q) { float v = cs[bj][q];
#pragma unroll
                    for (int o = 1; o < 16; o <<= 1) v += __shfl_xor(v, o);
                    cs[bj][q] = v; }
                const int col = col0 + bj * HALF, hh = (col >> 6) - 32, b = u.pm >> 4, blk = u.pm & 15;
                if (fr == 0) { float* kp = kmean + ((size_t)(b * 8 + hh) * 16 + blk) * 64 + (col & 63);
#pragma unroll
                    for (int q = 0; q < 8; ++q) __hip_atomic_fetch_add(kp + q, cs[bj][q] * (1.f / 256.f), __ATOMIC_RELAXED, __HIP_MEMORY_SCOPE_AGENT); }
            }
        }
    }
};
__device__ __forceinline__ float silu_mul(float g, float u) { return g * u * __builtin_amdgcn_rcpf(1.f + __builtin_amdgcn_exp2f(-g * LOG2E)); }
struct EpiBf16Scaled {
    static constexpr bool PERM = true;
    bf16_t* O; int ldc; float scale;
    __device__ __forceinline__ void operator()(const f32x4 (&acc)[2][2][4][2], const Unit& u, int wr, int wc, int fr, int fq) const {
        const int row0 = u.pm * BM + wr * 64 + fr; const int col0 = u.pn * BM + wc * 32 + 8 * fq;
#pragma unroll
        for (int ai = 0; ai < 2; ++ai)
#pragma unroll
            for (int m = 0; m < 4; ++m) { bf16_t* rowp = O + (size_t)(row0 + ai * HALF + m * 16) * ldc + col0;
#pragma unroll
                for (int bj = 0; bj < 2; ++bj) { const f32x4 v0 = acc[ai][bj][m][0] * scale, v1 = acc[ai][bj][m][1] * scale;
                    u32x4 w; w.x = cvt_pk_bf16(v0[0], v0[1]); w.y = cvt_pk_bf16(v0[2], v0[3]); w.z = cvt_pk_bf16(v1[0], v1[1]); w.w = cvt_pk_bf16(v1[2], v1[3]);
                    *(u32x4*)(rowp + bj * HALF) = w; } }
    }
};
struct EpiSwigluFp8 {
    static constexpr bool PERM = true;
    unsigned char* O; int ldc; float sin, sout;
    __device__ __forceinline__ void operator()(const f32x4 (&acc)[2][2][4][2], const Unit& u, int wr, int wc, int fr, int fq) const {
        const int row0 = u.pm * BM + wr * 64 + fr; const int col0 = u.pn * HALF + wc * 32 + 8 * fq;
#pragma unroll
        for (int ai = 0; ai < 2; ++ai)
#pragma unroll
            for (int m = 0; m < 4; ++m) { unsigned char* rowp = O + (size_t)(row0 + ai * HALF + m * 16) * ldc + col0;
                const f32x4 ag0 = acc[ai][0][m][0], ag1 = acc[ai][0][m][1];
                const f32x4 t0 = ag0 * (-sin * LOG2E), t1 = ag1 * (-sin * LOG2E);
                f32x4 d0, d1;
#pragma unroll
                for (int e = 0; e < 4; ++e) { d0[e] = __builtin_amdgcn_exp2f(t0[e]); d1[e] = __builtin_amdgcn_exp2f(t1[e]); }
                d0 = d0 + 1.f; d1 = d1 + 1.f;
                f32x4 r0, r1;
#pragma unroll
                for (int e = 0; e < 4; ++e) { r0[e] = __builtin_amdgcn_rcpf(d0[e]); r1[e] = __builtin_amdgcn_rcpf(d1[e]); }
                const f32x4 v0 = (ag0 * acc[ai][1][m][0]) * (sin * sin * sout) * r0, v1 = (ag1 * acc[ai][1][m][1]) * (sin * sin * sout) * r1;
                u32x2 w; w.x = pk4_fp8(clamp448(v0[0]), clamp448(v0[1]), clamp448(v0[2]), clamp448(v0[3]));
                w.y = pk4_fp8(clamp448(v1[0]), clamp448(v1[1]), clamp448(v1[2]), clamp448(v1[3]));
                *(u32x2*)rowp = w; __builtin_amdgcn_sched_barrier(0); }
    }
};
struct EpiSwiglu {
    static constexpr bool PERM = true;
    bf16_t* O; int ldc;
    __device__ __forceinline__ void operator()(const f32x4 (&acc)[2][2][4][2], const Unit& u, int wr, int wc, int fr, int fq) const {
        const int row0 = u.pm * BM + wr * 64 + fr; const int col0 = u.pn * HALF + wc * 32 + 8 * fq;
#pragma unroll
        for (int ai = 0; ai < 2; ++ai)
#pragma unroll
            for (int m = 0; m < 4; ++m) { bf16_t* rowp = O + (size_t)(row0 + ai * HALF + m * 16) * ldc + col0;
                const f32x4 g0 = acc[ai][0][m][0], g1 = acc[ai][0][m][1], u0 = acc[ai][1][m][0], u1 = acc[ai][1][m][1];
                u32x4 w; w.x = cvt_pk_bf16(silu_mul(g0[0], u0[0]), silu_mul(g0[1], u0[1])); w.y = cvt_pk_bf16(silu_mul(g0[2], u0[2]), silu_mul(g0[3], u0[3]));
                w.z = cvt_pk_bf16(silu_mul(g1[0], u1[0]), silu_mul(g1[1], u1[1])); w.w = cvt_pk_bf16(silu_mul(g1[2], u1[2]), silu_mul(g1[3], u1[3]));
                *(u32x4*)rowp = w; }
    }
};

__device__ __forceinline__ void glds16s(const void* sbase, unsigned voff, unsigned lds_dst) { unsigned keep;
    asm volatile("s_mov_b32 %0, m0\n\ts_mov_b32 m0, %3\n\ts_nop 0\n\tglobal_load_lds_dwordx4 %2, %1\n\ts_mov_b32 m0, %0" : "=&s"(keep) : "s"(sbase), "v"(voff), "s"(lds_dst) : "memory"); }
template <class Epi, class Sched, bool ALIGN_EPI = true, bool FP8 = false, int KC = 0>
__device__ __forceinline__ void gemm_phase(LAS unsigned char* lds, const Gemm g, const Sched& S, const Epi& E) {
    const int tid = threadIdx.x, wid = __builtin_amdgcn_readfirstlane(tid >> 6), lane = tid & 63, wr = wid >> 2, wc = wid & 3, fr = lane & 15, fq = lane >> 4;
    const int K = KC > 0 ? KC : g.K, nt = K / BK;
    unsigned voffA[2], voffB[2];
#pragma unroll
    for (int i = 0; i < 2; ++i) { int R, C; stage_rc(tid * 16 + i * 8192, R, C); const int Rb = Epi::PERM ? ((R & ~31) + perm32(R & 31)) : R;
        voffA[i] = (unsigned)(R * K + C) * 2u; voffB[i] = (unsigned)(Rb * K + C) * 2u; }
    const size_t kstep = (size_t)(BK * 2);
    const size_t hstep = (size_t)HALF * K * 2;
    const unsigned ldsw = (unsigned)wid * 1024u;
    const unsigned lds_u32 = (unsigned)(unsigned long long)lds;
    const int aoff = lds_byte(wr * 64 + fr, fq * 8), boff = lds_byte(wc * 32 + fr, fq * 8);
    const int aoff8 = lds_byte(wr * 64 + fr, (fq & 1) * 16) + (fq >> 1) * 1024, boff8 = lds_byte(wc * 32 + fr, (fq & 1) * 16) + (fq >> 1) * 1024;
#define PG8_SA(b, h) (((b) * 2 + (h)) * HTB)
#define PG8_SB(b, h) ((4 + (b) * 2 + (h)) * HTB)
#define PG8_STAGE(bufoff, gbase, voff) do { _Pragma("unroll") for (int _i = 0; _i < 2; ++_i) \
        glds16s((const void*)(gbase), (voff)[_i], lds_u32 + (unsigned)(bufoff) + ldsw + (unsigned)(_i * 8192)); } while (0)
#define PG8_LD8(p_) (*(const LAS v8i_t*)(p_))
#define PG8_LDA(dst, b, h) do { if constexpr (FP8) { _Pragma("unroll") for (int m = 0; m < 4; ++m) dst##8[m] = PG8_LD8(lds + PG8_SA(b, h) + aoff8 + m * 2048); } \
        else { _Pragma("unroll") for (int m = 0; m < 4; ++m) _Pragma("unroll") for (int k = 0; k < 2; ++k) dst[m][k] = *(const LAS bf16x8*)(lds + PG8_SA(b, h) + aoff + m * 2048 + k * 1024); } } while (0)
#define PG8_LDB(dst, b, h) do { if constexpr (FP8) { _Pragma("unroll") for (int n = 0; n < 2; ++n) dst##8[n] = PG8_LD8(lds + PG8_SB(b, h) + boff8 + n * 2048); } \
        else { _Pragma("unroll") for (int n = 0; n < 2; ++n) _Pragma("unroll") for (int k = 0; k < 2; ++k) dst[n][k] = *(const LAS bf16x8*)(lds + PG8_SB(b, h) + boff + n * 2048 + k * 1024); } } while (0)
#define PG8_MMA(ai, bj, At, Bt) do { __builtin_amdgcn_s_setprio(1); if constexpr (FP8) { _Pragma("unroll") for (int m = 0; m < 4; ++m) _Pragma("unroll") for (int n = 0; n < 2; ++n) \
            asm volatile("v_mfma_f32_16x16x128_f8f6f4 %0, %1, %2, %0" : "+v"(acc[ai][bj][m][n]) : "v"(Bt##8[n]), "v"(At##8[m])); } \
        else { _Pragma("unroll") for (int m = 0; m < 4; ++m) _Pragma("unroll") for (int n = 0; n < 2; ++n) _Pragma("unroll") for (int k = 0; k < 2; ++k) \
        acc[ai][bj][m][n] = __builtin_amdgcn_mfma_f32_16x16x32_bf16(Bt[n][k], At[m][k], acc[ai][bj][m][n], 0, 0, 0); } __builtin_amdgcn_s_setprio(0); } while (0)
#define PG8_WAIT_V(n) asm volatile("s_waitcnt vmcnt(" #n ")" ::: "memory")
#define PG8_WAIT_L(n) asm volatile("s_waitcnt lgkmcnt(" #n ")" ::: "memory")
#define PG8_BAR __builtin_amdgcn_s_barrier()
#define PG8_SCHED __builtin_amdgcn_sched_barrier(0)
    Unit cur, nxt; int ui = 0;
    if (!S.next(0, cur)) return;
    f32x4 acc[2][2][4][2];
#pragma unroll
    for (int a = 0; a < 2; ++a)
#pragma unroll
        for (int b = 0; b < 2; ++b)
#pragma unroll
            for (int m = 0; m < 4; ++m)
#pragma unroll
                for (int n = 0; n < 2; ++n) acc[a][b][m][n] = (f32x4){0.f, 0.f, 0.f, 0.f};
    bf16x8 At[4][2], B0[2][2], B1[2][2]; v8i_t At8[4], B08[2], B18[2];
    const char* cA = S.abase(g, cur); const char* cB = S.bbase(g, cur);
    PG8_STAGE(PG8_SB(0, 0), cB, voffB); PG8_STAGE(PG8_SB(0, 1), cB + hstep, voffB); PG8_STAGE(PG8_SA(0, 0), cA, voffA); PG8_STAGE(PG8_SA(0, 1), cA + hstep, voffA);
    if (wr == 1) PG8_BAR;
    PG8_WAIT_V(2); PG8_BAR;
    PG8_STAGE(PG8_SB(1, 0), cB + kstep, voffB); PG8_STAGE(PG8_SA(1, 0), cA + kstep, voffA); PG8_STAGE(PG8_SB(1, 1), cB + hstep + kstep, voffB);
    PG8_WAIT_V(6); PG8_BAR;
    for (;;) {
        const bool has_next = S.next(ui + 1, nxt);
        const char* nA = cA; const char* nB = cB;
        if (has_next) { nA = S.abase(g, nxt); nB = S.bbase(g, nxt); }
        for (int t = 0; t < nt; t += 2) {
            const bool last = (t == nt - 2);
            const char* a1 = cA + (size_t)(t + 1) * kstep;
            const char* a2 = last ? nA : cA + (size_t)(t + 2) * kstep; const char* b2 = last ? nB : cB + (size_t)(t + 2) * kstep;
            const char* a3 = a2 + kstep; const char* b3 = b2 + kstep;
            PG8_LDB(B0, 0, 0); PG8_LDB(B1, 0, 1); PG8_SCHED; PG8_LDA(At, 0, 0); PG8_STAGE(PG8_SA(1, 1), a1 + hstep, voffA);
            PG8_WAIT_V(8); PG8_WAIT_L(0); PG8_BAR; PG8_MMA(0, 0, At, B0); PG8_MMA(0, 1, At, B1); PG8_BAR; PG8_SCHED;
            PG8_LDA(At, 0, 1); PG8_STAGE(PG8_SB(0, 0), b2, voffB); PG8_STAGE(PG8_SB(0, 1), b2 + hstep, voffB); PG8_STAGE(PG8_SA(0, 0), a2, voffA);
            PG8_WAIT_V(8); PG8_WAIT_L(0); PG8_BAR; PG8_MMA(1, 0, At, B0); PG8_MMA(1, 1, At, B1); PG8_BAR; PG8_SCHED;
            PG8_LDB(B0, 1, 0); PG8_LDB(B1, 1, 1); PG8_SCHED; PG8_LDA(At, 1, 0); PG8_STAGE(PG8_SA(0, 1), a2 + hstep, voffA);
            PG8_WAIT_V(8); PG8_WAIT_L(0); PG8_BAR; PG8_MMA(0, 0, At, B0); PG8_MMA(0, 1, At, B1); PG8_BAR; PG8_SCHED;
            PG8_LDA(At, 1, 1); PG8_STAGE(PG8_SB(1, 0), b3, voffB); PG8_STAGE(PG8_SB(1, 1), b3 + hstep, voffB); PG8_STAGE(PG8_SA(1, 0), a3, voffA);
            PG8_WAIT_V(8); PG8_WAIT_L(0); PG8_BAR; PG8_MMA(1, 0, At, B0); PG8_MMA(1, 1, At, B1); PG8_BAR; PG8_SCHED;
        }
        if constexpr (ALIGN_EPI) { if (wr == 0) PG8_BAR; }
        if constexpr (FP8) asm volatile("s_nop 15\n\ts_nop 15" ::: "memory");
        E(acc, cur, wr, wc, fr, fq);
#if MK_DUP == 116
        if constexpr (FP8) { asm volatile("" ::: "memory"); E(acc, cur, wr, wc, fr, fq); }
#endif
        if (!has_next) break;
#pragma unroll
        for (int a = 0; a < 2; ++a)
#pragma unroll
            for (int b = 0; b < 2; ++b)
#pragma unroll
                for (int m = 0; m < 4; ++m)
#pragma unroll
                    for (int n = 0; n < 2; ++n) acc[a][b][m][n] = (f32x4){0.f, 0.f, 0.f, 0.f};
        cur = nxt; cA = nA; cB = nB; ++ui;
        if constexpr (ALIGN_EPI) { if (wr == 1) PG8_BAR; }
    }
    PG8_WAIT_V(0);
    if constexpr (!ALIGN_EPI) { if (wr == 0) PG8_BAR; }
    PG8_BAR;
#undef PG8_SA
#undef PG8_SB
#undef PG8_STAGE
#undef PG8_LDA
#undef PG8_LDB
#undef PG8_MMA
#undef PG8_WAIT_V
#undef PG8_WAIT_L
#undef PG8_BAR
#undef PG8_SCHED
}
}

namespace att {
constexpr int KS = 0, VS = 16384, TAB = 32768, KM = TAB + 4224 * 4, LDS_END = KM + 4096;
constexpr float C2 = 0.125f * LOG2E;
constexpr float NEG = -1e30f;
__device__ __forceinline__ int crow(int r, int hi) { return (r & 3) + 8 * (r >> 2) + 4 * hi; }
__device__ __forceinline__ int t5_bucket(int d) {
    if (d < 16) return d < 0 ? 0 : d;
    int b = 16;
    b += (d >= 22); b += (d >= 30); b += (d >= 40); b += (d >= 54); b += (d >= 73); b += (d >= 99); b += (d >= 134); b += (d >= 182);
    b += (d >= 246); b += (d >= 332); b += (d >= 450); b += (d >= 609); b += (d >= 825); b += (d >= 1117); b += (d >= 1513);
    return b;
}
__device__ __forceinline__ float swapmax(float m) { return fmaxf(m, __shfl_xor(m, 32)); }
__device__ __forceinline__ float swapsum(float m) { return m + __shfl_xor(m, 32); }
typedef short v4i16_t __attribute__((ext_vector_type(4)));
__device__ __forceinline__ s16x4 vtr(const LAS unsigned char* p) { return __builtin_bit_cast(s16x4, __builtin_amdgcn_ds_read_tr16_b64_v4i16((LAS v4i16_t*)p)); }

constexpr int R_K = 0, R_V = 32768, R_TAB = 65536, R_KM = R_TAB + 4288 * 4, R_TS = R_KM + 4096, R_END = R_TS + 64;
#define ATT_WAITBAR(N) asm volatile("s_waitcnt vmcnt(" #N ") lgkmcnt(0)\n\ts_barrier" ::: "memory")
__device__ __forceinline__ bf16x8 scale_q(bf16x8 q) { bf16x8 r;
#pragma unroll
    for (int e = 0; e < 8; ++e) r[e] = (short)f2bf(bf2f((unsigned short)q[e]) * C2);
    return r; }

#define ATT_QK(Ks) do { _Pragma("unroll") for (int d0 = 0; d0 < 4; ++d0) { const bf16x8 k0_ = *(const LAS bf16x8*)((Ks) + koff[d0]), k1_ = *(const LAS bf16x8*)((Ks) + koff[d0] + 4096); \
        p0 = __builtin_amdgcn_mfma_f32_32x32x16_bf16(k0_, qr[d0], p0, 0, 0, 0); p1 = __builtin_amdgcn_mfma_f32_32x32x16_bf16(k1_, qr[d0], p1, 0, 0, 0); } } while (0)
#define ATT_SOFTMAX_PV(vp) do { \
        float mx_ = fmaxf(p0[0], p1[0]); \
        _Pragma("unroll") for (int r = 1; r < 16; ++r) mx_ = fmaxf(mx_, fmaxf(p0[r], p1[r])); \
        mx_ = swapmax(mx_); \
        const float mn_ = fmaxf(m, mx_); \
        if (__any(mn_ > m)) { const float alpha_ = __builtin_amdgcn_exp2f(m - mn_); l *= alpha_; \
            _Pragma("unroll") for (int r = 0; r < 16; ++r) { o0[r] *= alpha_; o1[r] *= alpha_; } } \
        m = mn_; float rs_ = 0.f; \
        _Pragma("unroll") for (int r = 0; r < 16; ++r) { p0[r] = __builtin_amdgcn_exp2f(p0[r] - mn_); p1[r] = __builtin_amdgcn_exp2f(p1[r] - mn_); rs_ += p0[r] + p1[r]; } \
        l += rs_; \
        bf16x8 pa_[4]; \
        _Pragma("unroll") for (int ks = 0; ks < 4; ++ks) { u32x4 w_; \
            _Pragma("unroll") for (int e = 0; e < 4; ++e) { const int r = 8 * (ks & 1) + 2 * e; w_[e] = (ks < 2) ? pg8::cvt_pk_bf16(p0[r], p0[r + 1]) : pg8::cvt_pk_bf16(p1[r], p1[r + 1]); } \
            pa_[ks] = __builtin_bit_cast(bf16x8, w_); } \
        _Pragma("unroll") for (int ks = 0; ks < 4; ++ks) { \
            const s16x4 a0_ = vtr((vp) + ks * 1024), a1_ = vtr((vp) + ks * 1024 + 512), b0_ = vtr((vp) + 4096 + ks * 1024), b1_ = vtr((vp) + 4096 + ks * 1024 + 512); \
            const bf16x8 va_ = (bf16x8){a0_[0], a0_[1], a0_[2], a0_[3], a1_[0], a1_[1], a1_[2], a1_[3]}, vb_ = (bf16x8){b0_[0], b0_[1], b0_[2], b0_[3], b1_[0], b1_[1], b1_[2], b1_[3]}; \
            o0 = __builtin_amdgcn_mfma_f32_32x32x16_bf16(va_, pa_[ks], o0, 0, 0, 0); o1 = __builtin_amdgcn_mfma_f32_32x32x16_bf16(vb_, pa_[ks], o1, 0, 0, 0); } \
    } while (0)
#define ATT_FAST_PV(vp) do { \
        _Pragma("unroll") for (int r = 0; r < 16; ++r) { p0[r] = __builtin_amdgcn_exp2f(p0[r]); p1[r] = __builtin_amdgcn_exp2f(p1[r]); } \
        bf16x8 pa_[4]; \
        _Pragma("unroll") for (int ks = 0; ks < 4; ++ks) { u32x4 w_; \
            _Pragma("unroll") for (int e = 0; e < 4; ++e) { const int r = 8 * (ks & 1) + 2 * e; w_[e] = (ks < 2) ? pg8::cvt_pk_bf16(p0[r], p0[r + 1]) : pg8::cvt_pk_bf16(p1[r], p1[r + 1]); } \
            pa_[ks] = __builtin_bit_cast(bf16x8, w_); } \
        _Pragma("unroll") for (int ks = 0; ks < 4; ++ks) { \
            const s16x4 a0_ = vtr((vp) + ks * 1024), a1_ = vtr((vp) + ks * 1024 + 512), b0_ = vtr((vp) + 4096 + ks * 1024), b1_ = vtr((vp) + 4096 + ks * 1024 + 512); \
            const bf16x8 va_ = (bf16x8){a0_[0], a0_[1], a0_[2], a0_[3], a1_[0], a1_[1], a1_[2], a1_[3]}, vb_ = (bf16x8){b0_[0], b0_[1], b0_[2], b0_[3], b1_[0], b1_[1], b1_[2], b1_[3]}; \
            o0 = __builtin_amdgcn_mfma_f32_32x32x16_bf16(va_, pa_[ks], o0, 0, 0, 0); o1 = __builtin_amdgcn_mfma_f32_32x32x16_bf16(vb_, pa_[ks], o1, 0, 0, 0); \
            o2 = __builtin_amdgcn_mfma_f32_32x32x16_bf16(ones8, pa_[ks], o2, 0, 0, 0); } \
    } while (0)
#define ATT_STORE_O(orow, inv) do { _Pragma("unroll") for (int a = 0; a < 4; ++a) { \
        u32x2 w0_, w1_; w0_.x = pg8::cvt_pk_bf16(o0[4 * a] * (inv), o0[4 * a + 1] * (inv)); w0_.y = pg8::cvt_pk_bf16(o0[4 * a + 2] * (inv), o0[4 * a + 3] * (inv)); \
        w1_.x = pg8::cvt_pk_bf16(o1[4 * a] * (inv), o1[4 * a + 1] * (inv)); w1_.y = pg8::cvt_pk_bf16(o1[4 * a + 2] * (inv), o1[4 * a + 3] * (inv)); \
        *(u32x2*)((orow) + 8 * a) = w0_; *(u32x2*)((orow) + 32 + 8 * a) = w1_; } } while (0)

template <int MODE>
__device__ __forceinline__ void attn_unit_v2(LAS unsigned char* lds, const bf16* __restrict__ qkv, int b, int h, int qt,
                                             const float* __restrict__ cum, const float* __restrict__ kmean, const float* __restrict__ relb,
                                             bf16* __restrict__ O, const unsigned* __restrict__ qkn) {
    const int tid = threadIdx.x, lane = tid & 63, r32 = lane & 31, hi = lane >> 5; const int wid = __builtin_amdgcn_readfirstlane(tid >> 6);
    const int qs = (MODE == 0) ? h : 24 + (h - 8), ks = qs + 8, vs = qs + 16;
    const bf16* qb = qkv + ((size_t)qs * NTOK + (size_t)b * SEQ) * 64; const bf16* kb = qkv + ((size_t)ks * NTOK + (size_t)b * SEQ) * 64; const bf16* vb = qkv + ((size_t)vs * NTOK + (size_t)b * SEQ) * 64;
    const int pw = 256 * qt + 32 * wid, myq = pw + r32;
    bf16x8 qr[4];
    { const bf16* qrow = qb + (size_t)myq * 64 + hi * 8;
#pragma unroll
      for (int d0 = 0; d0 < 4; ++d0) qr[d0] = *(const bf16x8*)(qrow + d0 * 16); }
    LAS float* tab = (LAS float*)(lds + R_TAB); LAS float* kml = (LAS float*)(lds + R_KM); LAS int* tsl = (LAS int*)(lds + R_TS);
    const int thi = 4 * qt + 3; int tlo = 0; float fox_b2 = 0.f;
    if (MODE == 0) {
        const unsigned* nq = qkn + (b * 16 + h) * 4;
        const float qn_ = sqrtf(__builtin_bit_cast(float, nq[0]) + __builtin_bit_cast(float, nq[1])), kn_ = sqrtf(__builtin_bit_cast(float, nq[2]) + __builtin_bit_cast(float, nq[3]));
        fox_b2 = 2.f * qn_ * kn_;
        const float* cp = cum + (size_t)(b * 8 + h) * SEQ; const int nk = 256 * (qt + 1);
        for (int s = tid; s < nk; s += 512) tab[s] = -cp[s] * LOG2E;
        if (tid == 0) tsl[0] = 4 * qt;
        __syncthreads();
        if (tid < 4 * qt) {
            const float bound = fox_b2 + (cp[256 * qt] - cp[64 * tid + 63]) * LOG2E;
            if (bound >= -64.f) __hip_atomic_fetch_min(&tsl[0], tid, __ATOMIC_RELAXED, __HIP_MEMORY_SCOPE_WORKGROUP); }
        __syncthreads();
        tlo = __builtin_amdgcn_readfirstlane(tsl[0]);
    } else {
        for (int j = tid; j < 4288; j += 512) { const int rel = 4095 - j; tab[j] = rel >= 0 ? relb[t5_bucket(rel) * 16 + h] * LOG2E : NEG; }
        const float* kp = kmean + (size_t)(b * 8 + (h - 8)) * 16 * 64;
        for (int j = tid; j < qt * 64; j += 512) kml[j] = kp[j];
        __syncthreads();
    }
    unsigned sel = 0u;
    if (MODE == 1) {
        float v1 = -INFINITY, v2 = -INFINITY, v3 = -INFINITY; int i1 = -1, i2 = -1, i3 = -1;
        for (int n = 0; n < qt; ++n) {
            float part = 0.f;
#pragma unroll
            for (int d0 = 0; d0 < 4; ++d0) { const f32x4 ka = *(const LAS f32x4*)(kml + n * 64 + d0 * 16 + hi * 8), kb = *(const LAS f32x4*)(kml + n * 64 + d0 * 16 + hi * 8 + 4);
                part += bf2f((unsigned short)qr[d0][0]) * ka[0] + bf2f((unsigned short)qr[d0][1]) * ka[1] + bf2f((unsigned short)qr[d0][2]) * ka[2] + bf2f((unsigned short)qr[d0][3]) * ka[3];
                part += bf2f((unsigned short)qr[d0][4]) * kb[0] + bf2f((unsigned short)qr[d0][5]) * kb[1] + bf2f((unsigned short)qr[d0][6]) * kb[2] + bf2f((unsigned short)qr[d0][7]) * kb[3]; }
            const float gt = swapsum(part);
            if (gt > v1) { v3 = v2; i3 = i2; v2 = v1; i2 = i1; v1 = gt; i1 = n; }
            else if (gt > v2) { v3 = v2; i3 = i2; v2 = gt; i2 = n; }
            else if (gt > v3) { v3 = gt; i3 = n; }
        }
        if (i1 >= 0) sel |= 1u << i1; if (i2 >= 0) sel |= 1u << i2; if (i3 >= 0) sel |= 1u << i3;
    }
    bool fast = false; f32x16 o2 = {}; bf16x8 ones8;
#pragma unroll
    for (int e = 0; e < 8; ++e) ones8[e] = (short)0x3F80;
    if (MODE == 1) fast = true;
    const int vrow = 16 * (wid & 3) + (lane >> 2);
    const int krow = 8 * wid + (lane >> 3);
    const bf16* ksrc0 = kb + (size_t)krow * 64 + (((lane & 7) ^ ((krow >> 1) & 7)) * 8);
    const bf16* vsrc0 = vb + (size_t)vrow * 64 + (wid >> 2) * 32 + (lane & 3) * 8;
    int koff[4];
#pragma unroll
    for (int d0 = 0; d0 < 4; ++d0) koff[d0] = r32 * 128 + (((2 * d0 + hi) ^ ((r32 >> 1) & 7)) << 4);
#define ATT_DMA(t) do { const unsigned so_ = (unsigned)((((t) & 3) * 8192) + wid * 1024); \
        __builtin_amdgcn_global_load_lds((const unsigned*)(ksrc0 + (size_t)(t) * 4096), (LAS unsigned*)(lds + R_K + so_), 16, 0, 0); \
        __builtin_amdgcn_global_load_lds((const unsigned*)(vsrc0 + (size_t)(t) * 4096), (LAS unsigned*)(lds + R_V + so_), 16, 0, 0); } while (0)
    const LAS unsigned char* vp0 = lds + R_V + ((lane >> 4) & 1) * 32 + (lane & 3) * 8 + (4 * hi + ((lane & 15) >> 2)) * 64;
    float m = NEG, l = 0.f; f32x16 o0 = {}, o1 = {};
#pragma unroll 1
  for (int attempt = 0; attempt < (MODE == 1 ? 2 : 1); ++attempt) {
    if (attempt == 1) { fast = false; m = NEG; l = 0.f; o0 = f32x16{}; o1 = f32x16{}; }
    asm volatile("s_waitcnt vmcnt(0)" ::: "memory");
    ATT_DMA(tlo); ATT_DMA(tlo + 1); ATT_DMA(tlo + 2);
    ATT_WAITBAR(4);
    for (int t = tlo; t <= thi; ++t) {
        if (t + 3 <= thi) ATT_DMA(t + 3);
        bool active = (64 * t <= pw + 31);
        if (MODE == 1) { if (t < 4 * qt) active = (__ballot((sel >> (t >> 2)) & 1u) != 0ull); }
        if (MODE == 0) { if (64 * t + 63 < pw) active = active && !((fox_b2 + tab[64 * t + 63] - tab[pw]) < -64.f); }
        if (active) {
            const LAS unsigned char* Ks = lds + R_K + (t & 3) * 8192;
            f32x16 p0, p1;
            if (MODE == 0) {
                const LAS float* cn = tab + 64 * t + 4 * hi;
#pragma unroll
                for (int a = 0; a < 4; ++a) { const f32x4 c0 = *(const LAS f32x4*)(cn + 8 * a), c1 = *(const LAS f32x4*)(cn + 32 + 8 * a);
#pragma unroll
                    for (int e = 0; e < 4; ++e) { p0[4 * a + e] = c0[e]; p1[4 * a + e] = c1[e]; } }
            } else {
                const int relbase = myq - 64 * t - 4 * hi;
                const LAS float* tj = tab + (4095 - relbase);
                if (t < 4 * qt) { if (!((sel >> (t >> 2)) & 1u)) tj = tab + 4224; }
#pragma unroll
                for (int r = 0; r < 16; ++r) { const int cr = (r & 3) + 8 * (r >> 2); p0[r] = tj[cr]; p1[r] = tj[cr + 32]; }
            }
            ATT_QK(Ks);
            if (MODE == 0) { if (t >= 4 * qt) {
#pragma unroll
                    for (int r = 0; r < 16; ++r) { const int kp = 64 * t + crow(r, hi); if (kp > myq) p0[r] = NEG; if (kp + 32 > myq) p1[r] = NEG; } } }
            const LAS unsigned char* vp = vp0 + (t & 3) * 8192;
            if (MODE == 1 && fast) { ATT_FAST_PV(vp); } else { ATT_SOFTMAX_PV(vp); }
        }
        if (t + 3 <= thi) ATT_WAITBAR(4); else if (t + 2 <= thi) ATT_WAITBAR(2); else ATT_WAITBAR(0);
    }
    if (MODE == 1 && attempt == 0) {
        const float l0 = o2[0]; const bool bad = __any(!(l0 > 7.9e-31f && l0 < 1.3e36f));
        if (tid == 0) tsl[1] = 0;
        __syncthreads();
        if (bad && lane == 0) tsl[1] = 1;
        __syncthreads();
        const int redo = __builtin_amdgcn_readfirstlane(tsl[1]);
        __syncthreads();
        if (!redo) break;
    }
  }
#undef ATT_DMA
    const float lt = (MODE == 1 && fast) ? o2[0] : swapsum(l), inv = 1.f / lt;
    bf16* orow = O + ((size_t)b * SEQ + myq) * DM + h * 64 + 4 * hi;
    ATT_STORE_O(orow, inv);
}

constexpr int DL_K = 0, DL_V = 49152, DL_TAB = 98304, DL_END = DL_TAB + 1536 + 128 + 2048;
__device__ __forceinline__ void dil_params(int i, int j, int& h, int& gp, int& dil, int& cls, int& qt) { const int hp = i / 3, idx = j + 32 * (i % 3), h2 = idx / 48, rem = idx % 48, x = rem & 15;
    h = 2 * hp + h2; gp = rem >> 4; dil = gp == 0 ? 1 : (gp == 1 ? 4 : 16); qt = gp == 0 ? x : (gp == 1 ? (x >> 2) : 0); cls = gp == 0 ? 0 : (gp == 1 ? (x & 3) : x); }
__device__ __forceinline__ void dilated_phase(LAS unsigned char* lds, const bf16* __restrict__ qkv, int b, int j, const float* __restrict__ relb,
                                              bf16* O0, bf16* O1, bf16* O2, float* __restrict__ ml, const unsigned* __restrict__ knw  ) {
    const int tid = threadIdx.x, lane = tid & 63, r32 = lane & 31, hi = lane >> 5; const int wid = __builtin_amdgcn_readfirstlane(tid >> 6);
    const int vrow = 16 * (wid & 3) + (lane >> 2), krow = 8 * wid + (lane >> 3);
    int koff[4];
#pragma unroll
    for (int d0 = 0; d0 < 4; ++d0) koff[d0] = r32 * 128 + (((2 * d0 + hi) ^ ((r32 >> 1) & 7)) << 4);
    LAS float* tab = (LAS float*)(lds + DL_TAB);
    LAS float* rbl = (LAS float*)(lds + DL_TAB + 1536 + 128);
    if (tid < 512) rbl[tid] = relb[tid] * LOG2E;
    __syncthreads();
    u32x4 kv[12]; bf16x8 qn[4], qn2[4];
#define DIL_PREFETCH(h_, qt_, dil_, cls_) do { const int T0_ = 4 * (qt_) - 2; \
        const bf16* ksrc0 = qkv + ((size_t)(16 + (h_)) * NTOK + (size_t)b * SEQ) * 64 + (((lane & 7) ^ ((krow >> 1) & 7)) * 8); \
        const bf16* vsrc0 = qkv + ((size_t)(32 + (h_)) * NTOK + (size_t)b * SEQ) * 64 + (wid >> 2) * 32 + (lane & 3) * 8; \
        _Pragma("unroll") for (int s_ = 0; s_ < 6; ++s_) { int kp_ = 64 * (T0_ + s_) + krow, vq_ = 64 * (T0_ + s_) + vrow; kp_ = kp_ < 0 ? 0 : kp_; vq_ = vq_ < 0 ? 0 : vq_; \
            kv[2 * s_] = *(const u32x4*)(ksrc0 + (size_t)(kp_ * (dil_) + (cls_)) * 64); kv[2 * s_ + 1] = *(const u32x4*)(vsrc0 + (size_t)(vq_ * (dil_) + (cls_)) * 64); } \
        } while (0)
#define DIL_PREFETCH_Q2(h_, qt_, dil_, cls_) do { const bf16* qrow_ = qkv + ((size_t)(h_) * NTOK + (size_t)b * SEQ) * 64 + (size_t)((256 * (qt_) + 32 * wid + r32) * (dil_) + (cls_)) * 64 + hi * 8; \
          _Pragma("unroll") for (int d0 = 0; d0 < 4; ++d0) qn2[d0] = *(const bf16x8*)(qrow_ + d0 * 16); } while (0)
#define DIL_PREFETCH_Q(h_, qt_, dil_, cls_) do { const bf16* qrow_ = qkv + ((size_t)(h_) * NTOK + (size_t)b * SEQ) * 64 + (size_t)((256 * (qt_) + 32 * wid + r32) * (dil_) + (cls_)) * 64 + hi * 8; \
          _Pragma("unroll") for (int d0 = 0; d0 < 4; ++d0) qn[d0] = *(const bf16x8*)(qrow_ + d0 * 16); } while (0)
    bf16x8 ones8;
#pragma unroll
    for (int e = 0; e < 8; ++e) ones8[e] = (short)0x3F80;
    int h, gp, dil, cls, qt;
    const LAS unsigned char* vp0 = lds + DL_V + ((lane >> 4) & 1) * 32 + (lane & 3) * 8 + (4 * hi + ((lane & 15) >> 2)) * 64;
    dil_params(0, j, h, gp, dil, cls, qt);
    DIL_PREFETCH(h, qt, dil, cls); DIL_PREFETCH_Q(h, qt, dil, cls);
    constexpr int NIT = (MK_DUP == 113) ? 48 : 24;
#pragma unroll 1
    for (int i = 0; i < NIT; ++i) {
        dil_params(i % 24, j, h, gp, dil, cls, qt);
        if (i > 0) {
#pragma unroll
            for (int d0 = 0; d0 < 4; ++d0) qn[d0] = qn2[d0]; }
#pragma unroll
        for (int s_ = 0; s_ < 6; ++s_) { *(LAS u32x4*)(lds + DL_K + s_ * 8192 + wid * 1024 + lane * 16) = kv[2 * s_]; *(LAS u32x4*)(lds + DL_V + s_ * 8192 + wid * 1024 + lane * 16) = kv[2 * s_ + 1]; }
        { for (int j = tid; j < 384; j += 512) { const int rel = 255 - j; tab[j] = (rel >= 0 && rel <= 128) ? rbl[t5_bucket(rel * dil) * 16 + h] : NEG; } }
        __syncthreads();
        if (i + 1 < NIT) { int h2_, g2_, d2, c2, q2; dil_params((i + 1) % 24, j, h2_, g2_, d2, c2, q2); DIL_PREFETCH(h2_, q2, d2, c2); DIL_PREFETCH_Q2(h2_, q2, d2, c2); }
        f32x16 o0 = {}, o1 = {}, o2 = {};
        float cshift = 0.f;
#pragma unroll 1
        for (int attempt = 0; attempt < 2; ++attempt) {
            if (attempt == 1) { float mx = NEG; o0 = f32x16{}; o1 = f32x16{}; o2 = f32x16{};
#pragma unroll
                for (int jj = 0; jj < 3; ++jj) { const int slot = (wid >> 1) + jj;
                    if (4 * qt - 2 + slot >= 0) { const int relbase = 32 * (wid & 1) + r32 + 128 - 64 * jj - 4 * hi; const LAS float* tj = tab + (255 - relbase);
                        f32x16 p0, p1;
#pragma unroll
                        for (int r = 0; r < 16; ++r) { const int cr = (r & 3) + 8 * (r >> 2); p0[r] = tj[cr]; p1[r] = tj[cr + 32]; }
                        const LAS unsigned char* Ks = lds + DL_K + slot * 8192;
                        { bf16x8 (&qr)[4] = qn; ATT_QK(Ks); }
#pragma unroll
                        for (int r = 0; r < 16; ++r) mx = fmaxf(mx, fmaxf(p0[r], p1[r])); } }
                cshift = swapmax(mx); }
#pragma unroll
            for (int jj = 0; jj < 3; ++jj) { const int slot = (wid >> 1) + jj;
                if (4 * qt - 2 + slot >= 0) { const int relbase = 32 * (wid & 1) + r32 + 128 - 64 * jj - 4 * hi; const LAS float* tj = tab + (255 - relbase);
                    f32x16 p0, p1;
                    if (attempt == 0) {
#pragma unroll
                        for (int r = 0; r < 16; ++r) { const int cr = (r & 3) + 8 * (r >> 2); p0[r] = tj[cr]; p1[r] = tj[cr + 32]; } }
                    else {
#pragma unroll
                        for (int r = 0; r < 16; ++r) { const int cr = (r & 3) + 8 * (r >> 2); p0[r] = tj[cr] - cshift; p1[r] = tj[cr + 32] - cshift; } }
                    const LAS unsigned char* Ks = lds + DL_K + slot * 8192;
                    { bf16x8 (&qr)[4] = qn; ATT_QK(Ks); }
                    const LAS unsigned char* vp = vp0 + slot * 8192;
                    ATT_FAST_PV(vp); } }
            if (attempt == 0) { const float l0 = o2[0]; if (!__any(!(l0 > 7.9e-31f && l0 < 1.3e36f))) break; }
        }
        const float m = cshift;
        const float lt = o2[0], inv = 1.f / lt;
        bf16* Op = gp == 0 ? O0 : (gp == 1 ? O1 : O2);
        const int mytok = (256 * qt + 32 * wid + r32) * dil + cls;
        bf16* orow = Op + ((size_t)b * SEQ + mytok) * DM + h * 64 + 4 * hi;
        ATT_STORE_O(orow, inv);
        if (hi == 0) { f32x2 v; v.x = m; v.y = lt; *(f32x2*)(ml + (size_t)gp * NTOK * NH * 2 + (((size_t)b * SEQ + mytok) * NH + h) * 2) = v; }
        __syncthreads();
    }
#undef DIL_PREFETCH
#undef DIL_PREFETCH_Q
}
}

#define XB_TMO      128
#define XB_XCNT(j)  (256  + 64 * (j))
#define XB_XSUB(j)  (1280 + 64 * (j))
#define XB_XGEN(j)  (2304 + 64 * (j))
#define XB_TOP      3328
#define XB_TOPGEN   3392
#define XCD_BAR_WORDS 3456
#define XB_SPIN_CAP (1u << 18)
__device__ __forceinline__ unsigned xb_ld(unsigned* p)              { return __hip_atomic_load(p, __ATOMIC_RELAXED, __HIP_MEMORY_SCOPE_AGENT); }
__device__ __forceinline__ unsigned xb_add(unsigned* p, unsigned v) { return __hip_atomic_fetch_add(p, v, __ATOMIC_RELAXED, __HIP_MEMORY_SCOPE_AGENT); }
__device__ __forceinline__ unsigned xb_xcc_id() { return (unsigned)__builtin_amdgcn_s_getreg((3 << 11) | 20) & 0xFu; }
#define XB_SPIN(cond, bar) do { unsigned _sp = 0; while (cond) { __builtin_amdgcn_s_sleep(1); \
    if ((++_sp & 255u) == 0u) { if (xb_ld(&(bar)[XB_TMO])) break; if (_sp > XB_SPIN_CAP) { atomicAdd(&(bar)[XB_TMO], 1u); break; } } } } while (0)
struct XcdBarrier { unsigned* bar; unsigned x; volatile LAS unsigned* st; };
__device__ __forceinline__ XcdBarrier xcd_barrier_post(unsigned* bar, volatile LAS unsigned* st) {
    XcdBarrier b; b.bar = bar; b.x = xb_xcc_id(); b.st = st;
    if (threadIdx.x == 0) (void)xb_add(&bar[XB_XCNT(b.x)], 1u);
    return b;
}
__device__ __forceinline__ void xcd_barrier_complete(unsigned* bar, unsigned x, unsigned& nloc, unsigned& nx) {
    const unsigned G = gridDim.x * gridDim.y * gridDim.z;
    unsigned sum, cnt, mine, sp = 0u;
    for (;;) {
        sum = 0u; cnt = 0u; mine = 0u;
#pragma unroll
        for (unsigned j = 0; j < 16; ++j) { const unsigned c = xb_ld(&bar[XB_XCNT(j)]); sum += c; cnt += (c > 0u) ? 1u : 0u; mine = (j == x) ? c : mine; }
        if (sum == G) break;
        __builtin_amdgcn_s_sleep(1);
        if ((++sp & 255u) == 0u) { if (xb_ld(&bar[XB_TMO])) break; if (sp > XB_SPIN_CAP) { atomicAdd(&bar[XB_TMO], 1u); break; } }
    }
    nloc = mine > 0u ? mine : 1u; nx = cnt > 0u ? cnt : 1u;
}
__device__ __forceinline__ void xcd_barrier(const XcdBarrier& b) {
    asm volatile("s_waitcnt vmcnt(0)" ::: "memory");
    __syncthreads();
    if (threadIdx.x == 0) {
        unsigned* bar = b.bar;
        __builtin_amdgcn_s_waitcnt(0);
        unsigned nloc = b.st[0], nx = b.st[1];
        if (nloc == 0u) { xcd_barrier_complete(bar, b.x, nloc, nx); b.st[0] = nloc; b.st[1] = nx; }
        const unsigned old = xb_add(&bar[XB_XSUB(b.x)], 1u);
        const unsigned gen = old / nloc;
        if (old + 1u == (gen + 1u) * nloc) {
            __builtin_amdgcn_fence(__ATOMIC_RELEASE, "agent");
            asm volatile("s_waitcnt vmcnt(0)" ::: "memory");
            const unsigned og = xb_add(&bar[XB_TOP], 1u);
            const unsigned tg = og / nx;
            if (og + 1u == (tg + 1u) * nx) xb_add(&bar[XB_TOPGEN], 1u);
            else XB_SPIN(xb_ld(&bar[XB_TOPGEN]) == tg, bar);
            __builtin_amdgcn_fence(__ATOMIC_ACQUIRE, "agent");
            xb_add(&bar[XB_XGEN(b.x)], 1u);
            asm volatile("s_waitcnt vmcnt(0)" ::: "memory");
        } else {
            XB_SPIN(xb_ld(&bar[XB_XGEN(b.x)]) == gen, bar);
            __builtin_amdgcn_fence(__ATOMIC_ACQUIRE, "agent");
            asm volatile("s_waitcnt vmcnt(0)" ::: "memory");
        }
    }
    __syncthreads();
}

struct Args { const float* in[18]; float* out; unsigned char* ws; int ph_lo, ph_hi; };
struct Frame {
    LAS unsigned char* lds; int tid, lane, wave, vcu, G;
    const float *x, *c, *mod_w, *mod_b, *norm_g, *w_in0, *fox_bias, *w_out0, *w_in1, *w_out1, *relb, *ffn_g, *ffn_u, *ffn_d, *router_w, *ex_g, *ex_u, *ex_d;
    float* out; unsigned char* ws;
};

struct TMat { const float* W; unsigned char* WT; int K, N, row_off, mode, fp8; };
__device__ __forceinline__ int t_dest_row(int mode, int n) {
    if (mode == 0) return n;
    if (mode == 1) return ((n >> 7) << 8) + (n & 127);
    return n < 1536 ? n : (n >= 1544 ? n - 8 : -1);
}
__device__ __forceinline__ void t_load(const TMat& m, int item, int lane, f32x4 (&r)[8], int& k0, int& n0) {
    const int kblocks = m.K >> 5, nb = item / kblocks, kb = item - nb * kblocks; k0 = kb * 32; n0 = nb * 64;
    const int n = n0 + 4 * (lane & 15); const bool ok = n < m.N;
    const float* p = m.W + (size_t)(k0 + 8 * (lane >> 4)) * m.N + n;
#pragma unroll
    for (int i = 0; i < 8; ++i) r[i] = ok ? *(const f32x4*)(p + (size_t)i * m.N) : (f32x4){0.f, 0.f, 0.f, 0.f};
}
__device__ __forceinline__ void t_pack(int fp8, const f32x4 (&r)[8], LAS unsigned char* stage, int lane, int k0) {
    const int kr = lane >> 4, n4 = 4 * (lane & 15);
    if (fp8) {
#pragma unroll
        for (int e = 0; e < 4; ++e) { u32x2 w; w.x = pk4_fp8(r[0][e] * FP8_SW, r[1][e] * FP8_SW, r[2][e] * FP8_SW, r[3][e] * FP8_SW); w.y = pk4_fp8(r[4][e] * FP8_SW, r[5][e] * FP8_SW, r[6][e] * FP8_SW, r[7][e] * FP8_SW);
            *(LAS u32x2*)(stage + (n4 + e) * 144 + (k0 & 127) + 8 * kr) = w; }
    } else {
#pragma unroll
        for (int e = 0; e < 4; ++e) { u32x4 w; w.x = pg8::cvt_pk_bf16(r[0][e], r[1][e]); w.y = pg8::cvt_pk_bf16(r[2][e], r[3][e]); w.z = pg8::cvt_pk_bf16(r[4][e], r[5][e]); w.w = pg8::cvt_pk_bf16(r[6][e], r[7][e]);
            *(LAS u32x4*)(stage + (n4 + e) * 144 + (k0 & 63) * 2 + 16 * kr) = w; }
    }
}
__device__ __forceinline__ void t_flush(const TMat& m, int n0, int gk, int cfirst, int clast, const LAS unsigned char* stage, int lane) {
    const int c = lane & 7; const bool okc = c >= cfirst && c <= clast;
#pragma unroll
    for (int j = 0; j < 8; ++j) { const int nl = (lane >> 3) + 8 * j, n = n0 + nl, dr = t_dest_row(m.mode, n);
        const u32x4 w = *(const LAS u32x4*)(stage + nl * 144 + 16 * c);
        if (okc && n < m.N && dr >= 0) *(u32x4*)(m.WT + ((size_t)(m.row_off + dr) * m.K + gk) * (m.fp8 ? 1 : 2) + 16 * c) = w; }
}
template <class Dec> __device__ __forceinline__ void t_run(int i0, int i1, int lane, LAS unsigned char* stage, const Dec& dec) {
    if (i0 >= i1) return;
    f32x4 r[8]; int k0, n0, loc; TMat m;
    dec(i0, m, loc); t_load(m, loc, lane, r, k0, n0);
    int cfirst = -1;
    for (int it = i0; it < i1; ++it) {
        const TMat mc = m; const int k0c = k0, n0c = n0;
        const int gk = mc.fp8 ? (k0c & ~127) : (k0c & ~63);
        const int cs = mc.fp8 ? ((k0c & 127) >> 4) : ((k0c & 63) >> 3), ce = cs + (mc.fp8 ? 1 : 3);
        t_pack(mc.fp8, r, stage, lane, k0c);
        asm volatile("" ::: "memory");
        if (cfirst < 0) cfirst = cs;
        bool flush = true;
        if (it + 1 < i1) { dec(it + 1, m, loc); t_load(m, loc, lane, r, k0, n0);
            const int gkn = m.fp8 ? (k0 & ~127) : (k0 & ~63);
            flush = !(m.W == mc.W && n0 == n0c && gkn == gk); }
        asm volatile("" ::: "memory");
        if (flush) { LDS_WAIT(); t_flush(mc, n0c, gk, cfirst, ce, stage, lane); cfirst = -1; LDS_WAIT(); asm volatile("" ::: "memory"); }
    }
}
__device__ __forceinline__ void t_split(int nitems, int gw, int ngw, int& i0, int& i1) { const int q = nitems / ngw, rem = nitems % ngw; i0 = gw * q + (gw < rem ? gw : rem); i1 = i0 + q + (gw < rem ? 1 : 0); }

__device__ __forceinline__ void weight_copies(Frame& F) {
    LAS unsigned char* scr = F.lds + F.wave * 16384;
    const int gw = F.vcu * NWAVES + F.wave, NGW = F.G * NWAVES;
    unsigned char* wo = F.ws + WS_WOTHER;
    constexpr int I_IN0 = 32 * 49, I_OUT = 32 * 16, I_IN1 = 32 * 48, I_FG = 32 * 44, I_FD = 88 * 16;
    constexpr int NITEMS = I_IN0 + I_OUT + I_IN1 + I_OUT + 2 * I_FG + I_FD;
    auto dec = [&](int it, TMat& m, int& loc) { int r = it;
        if (r < I_IN0) { m = TMat{F.w_in0, wo + WO_IN0, DM, DIN0, 0, 2, 0}; loc = r; return; } r -= I_IN0;
        if (r < I_OUT) { m = TMat{F.w_out0, wo + WO_OUT0, DM, DM, 0, 0, 0}; loc = r; return; } r -= I_OUT;
        if (r < I_IN1) { m = TMat{F.w_in1, wo + WO_IN1, DM, 3 * DM, 0, 0, 0}; loc = r; return; } r -= I_IN1;
        if (r < I_OUT) { m = TMat{F.w_out1, wo + WO_OUT1, DM, DM, 0, 0, 0}; loc = r; return; } r -= I_OUT;
        if (r < I_FG) { m = TMat{F.ffn_g, wo + WO_FGU, DM, DFF, 0, 1, 1}; loc = r; return; } r -= I_FG;
        if (r < I_FG) { m = TMat{F.ffn_u, wo + WO_FGU, DM, DFF, 128, 1, 1}; loc = r; return; } r -= I_FG;
        m = TMat{F.ffn_d, wo + WO_FDN, DFF, DM, 0, 0, 1}; loc = r; };
    int i0, i1; t_split(NITEMS, gw, NGW, i0, i1);
    t_run(i0, i1, F.lane, scr, dec);
    __syncthreads();
}

__device__ __forceinline__ void phase_prologue(Frame& F) {
    if (F.vcu < 192) {
        LAS float* sc = (LAS float*)F.lds;
        LAS float* red = (LAS float*)(F.lds + 32768);
        for (int i = F.tid; i < NB * DM; i += 512) { const float v = F.c[i]; sc[i] = v / (1.f + expf(-v)); }
        __syncthreads();
        const int l = F.vcu / 96, e0 = (F.vcu % 96) * 64, col = F.lane, kq = F.wave;
        float acc[8];
#pragma unroll
        for (int b = 0; b < 8; ++b) acc[b] = 0.f;
        const float* wp = F.mod_w + ((size_t)l * DM + kq * 128) * 6144 + e0 + col;
#pragma unroll 32
        for (int k = 0; k < 128; ++k) { const float w = wp[(size_t)k * 6144];
#pragma unroll
            for (int b = 0; b < 8; ++b) acc[b] += sc[b * DM + kq * 128 + k] * w; }
#pragma unroll
        for (int b = 0; b < 8; ++b) red[(kq * 8 + b) * 64 + col] = acc[b];
        __syncthreads();
        { const int b = F.tid >> 6; float s = 0.f;
#pragma unroll
          for (int q = 0; q < 8; ++q) s += red[(q * 8 + b) * 64 + col];
          ((float*)(F.ws + WS_MODS))[((size_t)l * NB + b) * 6144 + e0 + col] = s + F.mod_b[l * 6144 + e0 + col]; }
        __syncthreads();
    }
}

__device__ __forceinline__ void expert_weight_copies(Frame& F) {
    LAS unsigned char* scr = F.lds + F.wave * 16384;
    const int gw = F.vcu * NWAVES + F.wave, NGW = F.G * NWAVES;
    constexpr int I_GU = 32 * 56, I_DN = 112 * 16, PER_E = 2 * I_GU + I_DN;
    auto dec = [&](int it, TMat& m, int& loc) { const int e = it / PER_E; int r = it - e * PER_E;
        unsigned char* we = F.ws + WS_WEXP + (size_t)e * WEXP_STRIDE;
        if (r < I_GU) { m = TMat{F.ex_g + (size_t)e * DM * DFE, we, DM, DFE, 0, 1, 1}; loc = r; return; } r -= I_GU;
        if (r < I_GU) { m = TMat{F.ex_u + (size_t)e * DM * DFE, we, DM, DFE, 128, 1, 1}; loc = r; return; } r -= I_GU;
        m = TMat{F.ex_d + (size_t)e * DFE * DM, we + WEXP_DN_OFF, DFE, DM, 0, 0, 1}; loc = r; };
    int i0, i1; t_split(NEXP * PER_E, gw, NGW, i0, i1);
    t_run(i0, i1, F.lane, scr, dec);
}

template <bool RES, int EXTRA, bool U8 = false, bool HB = false>
__device__ __forceinline__ void thin_phase(Frame& F, const float* hin, const bf16* y, const float* gy, const float* gatev  ,
                                           const float* gu, const float* shv, const float* scv, bf16* uout) {
    const int gw = F.vcu * NWAVES + F.wave;
    const int row0 = gw * 16, b = row0 >> 12;
    LAS float* w8 = (LAS float*)F.lds;
    LAS int* lcnt = (LAS int*)(F.lds + 32768);
    if (EXTRA == 1) { for (int i = F.tid; i < 8 * DM; i += 512) { const int k = i >> 3, j = i & 7; w8[j * DM + k] = F.w_in0[(size_t)k * DIN0 + 1536 + j]; } }
    if (EXTRA == 2) { for (int i = F.tid; i < 8 * DM; i += 512) { const int k = i >> 3, j = i & 7; w8[j * DM + k] = F.router_w[(size_t)k * NEXP + j]; }
        if (F.tid < 16) lcnt[F.tid] = 0; }
    if (EXTRA != 0) __syncthreads();
    f32x4 Gv[4], Av[4], Bv[4];
#pragma unroll
    for (int j = 0; j < 4; ++j) { const int c = 256 * j + 4 * F.lane;
        const f32x4 g = *(const f32x4*)(gu + c), s1 = *(const f32x4*)(scv + (size_t)b * 6144 + c); Av[j] = g * (s1 + 1.f); Bv[j] = *(const f32x4*)(shv + (size_t)b * 6144 + c);
        if (RES) Gv[j] = *(const f32x4*)(gatev + (size_t)b * 6144 + c) * *(const f32x4*)(gy + c); }
    for (int i = 0; i < 16; ++i) {
        const int row = row0 + i;
        f32x4 hv[4];
#pragma unroll
        for (int j = 0; j < 4; ++j) { if constexpr (HB) { const u32x2 w = *(const u32x2*)((const unsigned char*)hin + (size_t)row * 4096 + 512 * j + 8 * F.lane); hv[j] = (f32x4){bflo(w.x), bfhi(w.x), bflo(w.y), bfhi(w.y)}; }
            else hv[j] = *(const f32x4*)(hin + (size_t)row * DM + 256 * j + 4 * F.lane); }
        if (RES) {
            f32x4 yv[4]; float ss = 0.f;
#pragma unroll
            for (int j = 0; j < 4; ++j) { const u32x2 w = *(const u32x2*)(y + (size_t)row * DM + 256 * j + 4 * F.lane); yv[j] = (f32x4){bflo(w.x), bfhi(w.x), bflo(w.y), bfhi(w.y)};
#ifdef DBG_SANITIZE
                for (int e_ = 0; e_ < 4; ++e_) if (!(fabsf(yv[j][e_]) < 1e30f)) yv[j][e_] = 0.f;
#endif
                ss += (yv[j].x * yv[j].x + yv[j].y * yv[j].y) + (yv[j].z * yv[j].z + yv[j].w * yv[j].w); }
            const float rstd = 1.f / sqrtf(wave_sum(ss) * (1.f / DM) + NORM_EPS);
#pragma unroll
            for (int j = 0; j < 4; ++j) { hv[j] = hv[j] + Gv[j] * (yv[j] * rstd); u32x2 w; w.x = pg8::cvt_pk_bf16(hv[j].x, hv[j].y); w.y = pg8::cvt_pk_bf16(hv[j].z, hv[j].w);
                *(u32x2*)((unsigned char*)F.out + (size_t)row * 4096 + 512 * j + 8 * F.lane) = w; }
        }
        float s2 = 0.f;
#pragma unroll
        for (int j = 0; j < 4; ++j) s2 += (hv[j].x * hv[j].x + hv[j].y * hv[j].y) + (hv[j].z * hv[j].z + hv[j].w * hv[j].w);
        const float rs = 1.f / sqrtf(wave_sum(s2) * (1.f / DM) + NORM_EPS);
        f32x4 uv[4];
#pragma unroll
        for (int j = 0; j < 4; ++j) { uv[j] = hv[j] * rs * Av[j] + Bv[j];
            if constexpr (U8) { *(unsigned*)((unsigned char*)uout + (size_t)row * DM + 256 * j + 4 * F.lane) = pk4_fp8(clamp448(uv[j].x * FP8_SU), clamp448(uv[j].y * FP8_SU), clamp448(uv[j].z * FP8_SU), clamp448(uv[j].w * FP8_SU)); }
            else { u32x2 w; w.x = pk2(uv[j].x, uv[j].y); w.y = pk2(uv[j].z, uv[j].w); *(u32x2*)(uout + (size_t)row * DM + 256 * j + 4 * F.lane) = w; } }
        if (EXTRA != 0) {
            float d[8];
#pragma unroll
            for (int q = 0; q < 8; ++q) { float s = 0.f;
#pragma unroll
                for (int j = 0; j < 4; ++j) { const f32x4 w = *(const LAS f32x4*)(w8 + q * DM + 256 * j + 4 * F.lane); s += (uv[j].x * w.x + uv[j].y * w.y) + (uv[j].z * w.z + uv[j].w * w.w); }
                d[q] = wave_sum(s); }
            if (EXTRA == 1) {
                float z = d[0];
#pragma unroll
                for (int q = 1; q < 8; ++q) z = (F.lane == q) ? d[q] : z;
                if (F.lane < 8) { z += F.fox_bias[F.lane]; const float ls = fminf(z, 0.f) - log1pf(expf(-fabsf(z)));
                    ((float*)(F.ws + WS_LOGF))[((size_t)b * 8 + F.lane) * SEQ + (row & (SEQ - 1))] = ls; }
            } else {
                int i1 = 0; float v1 = d[0];
#pragma unroll
                for (int q = 1; q < 8; ++q) if (d[q] > v1) { v1 = d[q]; i1 = q; }
                int i2 = -1; float v2 = -INFINITY;
#pragma unroll
                for (int q = 0; q < 8; ++q) if (q != i1 && d[q] > v2) { v2 = d[q]; i2 = q; }
                if (i2 < 0) { i2 = (i1 + 1) & 7; v2 = v1; }
                const float p1 = 1.f / (1.f + expf(v2 - v1)), p2 = 1.f - p1;
                if (F.lane == 0) {
                    const int rl = row - F.vcu * 128;
                    const int k1 = __hip_atomic_fetch_add(&lcnt[i1], 1, __ATOMIC_RELAXED, __HIP_MEMORY_SCOPE_WORKGROUP);
                    const int k2 = __hip_atomic_fetch_add(&lcnt[i2], 1, __ATOMIC_RELAXED, __HIP_MEMORY_SCOPE_WORKGROUP);
                    lcnt[16 + rl * 2] = i1; lcnt[16 + rl * 2 + 1] = i2; lcnt[16 + 256 + rl * 2] = k1; lcnt[16 + 256 + rl * 2 + 1] = k2;
                    f32x2 pv; pv.x = p1; pv.y = p2; *(f32x2*)((float*)(F.ws + WS_TOKP) + (size_t)row * 2) = pv;
                }
            }
        }
    }
    if (EXTRA == 2) {
        __syncthreads();
        if (F.tid < 8) lcnt[8 + F.tid] = (int)__hip_atomic_fetch_add((unsigned*)(F.ws + WS_CTL) + CW_GCNT + 64 * F.tid, (unsigned)lcnt[F.tid], __ATOMIC_RELAXED, __HIP_MEMORY_SCOPE_AGENT);
        __syncthreads();
        if (F.tid < 256) { const int rl = F.tid >> 1, k = F.tid & 1, e = lcnt[16 + F.tid], rk = lcnt[16 + 256 + F.tid]; const size_t row = (size_t)F.vcu * 128 + rl;
            ((int*)(F.ws + WS_TOKE))[row * 2 + k] = e; ((int*)(F.ws + WS_TOKR))[row * 2 + k] = lcnt[8 + e] + rk; }
        __syncthreads();
    }
}

__device__ __forceinline__ void fox_cumsum(Frame& F, int bh) {
    const float* lf = (const float*)(F.ws + WS_LOGF) + (size_t)bh * SEQ; float* cu = (float*)(F.ws + WS_CUM) + (size_t)bh * SEQ;
    LAS float* wt = (LAS float*)(F.lds + RING_BYTES);
    __syncthreads();
    f32x4 a = *(const f32x4*)(lf + F.tid * 8), c = *(const f32x4*)(lf + F.tid * 8 + 4);
    float v[8] = {a.x, a.y, a.z, a.w, c.x, c.y, c.z, c.w};
#pragma unroll
    for (int i = 1; i < 8; ++i) v[i] += v[i - 1];
    float run = v[7];
#pragma unroll
    for (int o = 1; o < 64; o <<= 1) { const float t = __shfl_up(run, o); if (F.lane >= o) run += t; }
    if (F.lane == 63) wt[F.wave] = run;
    __syncthreads();
    float off = run - v[7];
    for (int w = 0; w < F.wave; ++w) off += wt[w];
    f32x4 o0 = {v[0] + off, v[1] + off, v[2] + off, v[3] + off}, o1 = {v[4] + off, v[5] + off, v[6] + off, v[7] + off};
    *(f32x4*)(cu + F.tid * 8) = o0; *(f32x4*)(cu + F.tid * 8 + 4) = o1;
    VM_WAIT();
    __syncthreads();
}

__device__ __forceinline__ void phase_merge(Frame& F) {
    const int gw = F.vcu * NWAVES + F.wave;
    bf16* p0 = (bf16*)(F.ws + WS_RA); const bf16* p1 = (const bf16*)(F.ws + WS_RC); const bf16* p2 = (const bf16*)(F.ws + WS_RD);
    const float* ml = (const float*)(F.ws + WS_ML);
    for (int i = 0; i < 16; ++i) { const size_t row = (size_t)gw * 16 + i;
#pragma unroll
        for (int j = 0; j < 4; ++j) { const int head = 4 * j + (F.lane >> 4); const size_t mi = (row * NH + head) * 2;
            const f32x2 a = *(const f32x2*)(ml + mi), b = *(const f32x2*)(ml + (size_t)NTOK * NH * 2 + mi), c = *(const f32x2*)(ml + (size_t)2 * NTOK * NH * 2 + mi);
            const float M = fmaxf(a.x, fmaxf(b.x, c.x));
            float wa = a.y * __builtin_amdgcn_exp2f(a.x - M), wb = b.y * __builtin_amdgcn_exp2f(b.x - M), wc = c.y * __builtin_amdgcn_exp2f(c.x - M);
            const float inv = 1.f / (wa + wb + wc); wa *= inv; wb *= inv; wc *= inv;
            const size_t off = row * DM + 256 * j + 4 * F.lane;
            const u32x2 xa = *(const u32x2*)(p0 + off), xb = *(const u32x2*)(p1 + off), xc = *(const u32x2*)(p2 + off);
            u32x2 w; w.x = pk2(wa * bflo(xa.x) + wb * bflo(xb.x) + wc * bflo(xc.x), wa * bfhi(xa.x) + wb * bfhi(xb.x) + wc * bfhi(xc.x));
            w.y = pk2(wa * bflo(xa.y) + wb * bflo(xb.y) + wc * bflo(xc.y), wa * bfhi(xa.y) + wb * bfhi(xb.y) + wc * bfhi(xc.y));
            *(u32x2*)(p0 + off) = w; }
    }
}

__device__ __forceinline__ void phase_gather(Frame& F) {
    LAS int* so = (LAS int*)F.lds;
    if (F.tid == 0) { int acc = 0; for (int e = 0; e < 8; ++e) { so[e] = acc; const int c = (int)__hip_atomic_load((unsigned*)(F.ws + WS_CTL) + CW_GCNT + 64 * e, __ATOMIC_RELAXED, __HIP_MEMORY_SCOPE_AGENT); acc += (c + 255) & ~255; } so[8] = acc; }
    __syncthreads();
    if (F.vcu == 0) { int* te = (int*)(F.ws + WS_TILEE); const int nt = so[8] >> 8;
        for (int t = F.tid; t < MAXTILES; t += 512) { int e = 0; for (int q = 1; q < 8; ++q) if (t * 256 >= so[q]) e = q; te[t] = e; }
        if (F.tid == 0) te[MAXTILES] = nt < MAXTILES ? nt : MAXTILES; }
    const int gw = F.vcu * NWAVES + F.wave;
    const bf16* u = (const bf16*)(F.ws + WS_RA); unsigned char* us = F.ws + WS_USORT;
    const int* te = (const int*)(F.ws + WS_TOKE); const int* tr = (const int*)(F.ws + WS_TOKR); int* ts = (int*)(F.ws + WS_TOKS);
    int d_l = 0;
    if (F.lane < 32) { const int e = te[gw * 32 + F.lane] & 7; d_l = so[e] + tr[gw * 32 + F.lane]; d_l = d_l < 0 ? 0 : (d_l >= MAXTILES * 256 ? MAXTILES * 256 - 1 : d_l); ts[gw * 32 + F.lane] = d_l; }
    const unsigned char* u8 = (const unsigned char*)u;
#pragma unroll 1
    for (int i0 = 0; i0 < 16; i0 += 8) {
        u32x4 a[8];
#pragma unroll
        for (int r = 0; r < 8; ++r) { const size_t row = (size_t)gw * 16 + i0 + r; a[r] = *(const u32x4*)(u8 + row * DM + F.lane * 16); }
#pragma unroll
        for (int r = 0; r < 8; ++r) {
#pragma unroll
            for (int k = 0; k < 2; ++k) { const int dst = __builtin_amdgcn_readlane(d_l, 2 * (i0 + r) + k); *(u32x4*)(us + (size_t)dst * DM + F.lane * 16) = a[r]; } }
    }
}

__device__ __forceinline__ void phase_final(Frame& F, const float* __restrict__ gy, const float* __restrict__ gatev) {
    const int gw = F.vcu * NWAVES + F.wave; const int row0 = gw * 16, b = row0 >> 12;
    const bf16* ys = (const bf16*)(F.ws + WS_YSLOT); const int* ts = (const int*)(F.ws + WS_TOKS); const float* tp = (const float*)(F.ws + WS_TOKP);
    f32x4 Gv[4];
#pragma unroll
    for (int j = 0; j < 4; ++j) { const int c = 256 * j + 4 * F.lane; Gv[j] = *(const f32x4*)(gatev + (size_t)b * 6144 + c) * *(const f32x4*)(gy + c); }
    for (int i = 0; i < 16; ++i) { const size_t row = (size_t)row0 + i;
        int s1 = ts[row * 2], s2 = ts[row * 2 + 1]; const float p1 = tp[row * 2], p2 = tp[row * 2 + 1];
        s1 = s1 < 0 ? 0 : (s1 >= MAXTILES * 256 ? MAXTILES * 256 - 1 : s1); s2 = s2 < 0 ? 0 : (s2 >= MAXTILES * 256 ? MAXTILES * 256 - 1 : s2);
        f32x4 yv[4], hv[4]; float ss = 0.f;
#pragma unroll
        for (int j = 0; j < 4; ++j) { const u32x2 w = *(const u32x2*)((const unsigned char*)F.out + row * 4096 + 512 * j + 8 * F.lane); hv[j] = (f32x4){bflo(w.x), bfhi(w.x), bflo(w.y), bfhi(w.y)}; }
#pragma unroll
        for (int j = 0; j < 4; ++j) { const u32x2 wa = *(const u32x2*)(ys + (size_t)s1 * DM + 256 * j + 4 * F.lane), wb = *(const u32x2*)(ys + (size_t)s2 * DM + 256 * j + 4 * F.lane);
            yv[j] = (f32x4){p1 * bflo(wa.x) + p2 * bflo(wb.x), p1 * bfhi(wa.x) + p2 * bfhi(wb.x), p1 * bflo(wa.y) + p2 * bflo(wb.y), p1 * bfhi(wa.y) + p2 * bfhi(wb.y)};
            ss += (yv[j].x * yv[j].x + yv[j].y * yv[j].y) + (yv[j].z * yv[j].z + yv[j].w * yv[j].w); }
        const float rstd = 1.f / sqrtf(wave_sum(ss) * (1.f / DM) + NORM_EPS);
        VM_WAIT();
#pragma unroll
        for (int j = 0; j < 4; ++j) { float* op = F.out + row * DM + 256 * j + 4 * F.lane; *(f32x4*)op = hv[j] + Gv[j] * (yv[j] * rstd); }
    }
}

constexpr int NPHASES = 21;
__global__ void __launch_bounds__(NWAVES * 64, 2) trunk_fwd(Args args) {
    extern __shared__ __attribute__((aligned(16))) unsigned char lds_raw[];
    Frame F;
    F.lds = (LAS unsigned char*)lds_raw;
    volatile LAS unsigned* MISC = (volatile LAS unsigned*)(F.lds + MISC_OFF);
    F.tid = threadIdx.x; F.lane = F.tid & 63; F.wave = __builtin_amdgcn_readfirstlane(F.tid >> 6);
    F.G = gridDim.x; { const int bx = blockIdx.x; F.vcu = (F.G % 8 == 0) ? (bx % 8) * (F.G / 8) + bx / 8 : bx; }
    F.x = args.in[0]; F.c = args.in[1]; F.mod_w = args.in[2]; F.mod_b = args.in[3]; F.norm_g = args.in[4]; F.w_in0 = args.in[5]; F.fox_bias = args.in[6]; F.w_out0 = args.in[7];
    F.w_in1 = args.in[8]; F.w_out1 = args.in[9]; F.relb = args.in[10]; F.ffn_g = args.in[11]; F.ffn_u = args.in[12]; F.ffn_d = args.in[13]; F.router_w = args.in[14];
    F.ex_g = args.in[15]; F.ex_u = args.in[16]; F.ex_d = args.in[17]; F.out = args.out; F.ws = args.ws;
    for (int u = F.tid; u < (LDS_BYTES - RING_BYTES) / 4; u += NWAVES * 64) ((LAS unsigned*)(F.lds + RING_BYTES))[u] = 0u;
    __syncthreads();
    const int lo = args.ph_lo, hi = args.ph_hi;
    XcdBarrier bar; bar.bar = (unsigned*)(F.ws + WS_CTL) + CW_BAR; bar.x = 0; bar.st = nullptr;
    if (hi - lo > 1) bar = xcd_barrier_post((unsigned*)(F.ws + WS_CTL) + CW_BAR, MISC + 8);
#define IN(k) (lo <= (k) && (k) < hi)
#define SEAM(k) do { if (IN(k) && IN((k) + 1)) xcd_barrier(bar); } while (0)
    const float* mods = (const float*)(F.ws + WS_MODS);
    const float* mods0 = mods, * mods1 = mods + (size_t)NB * 6144;
    const float* ng0 = F.norm_g, * ng1 = F.norm_g + 4 * DM;
    bf16* RA = (bf16*)(F.ws + WS_RA); bf16* RB = (bf16*)(F.ws + WS_RB); bf16* RC = (bf16*)(F.ws + WS_RC); bf16* RD = (bf16*)(F.ws + WS_RD);
    const bf16* wo = (const bf16*)(F.ws + WS_WOTHER);

    if (IN(0)) { phase_prologue(F); } SEAM(0);
    if (IN(1)) { thin_phase<false, 1>(F, F.x, nullptr, nullptr, nullptr, ng0, mods0 + 0, mods0 + 1024, RA); __syncthreads(); weight_copies(F); } SEAM(1);
    if (IN(2)) { pg8::Gemm g{RA, wo + WO_IN0 / 2, NTOK, 3072, DM}; pg8::StaticOrder S; S.init(NTOK, 3072, F.G, (int)blockIdx.x);
        pg8::EpiHeadMajor E{RB, NTOK, 0xFFull | (0xFFull << 24), att::C2, (unsigned*)(F.ws + WS_CTL) + CW_QKN, (float*)(F.ws + WS_KMEAN)};
        pg8::gemm_phase<pg8::EpiHeadMajor, pg8::StaticOrder>(F.lds, g, S, E); } SEAM(2);
    if (IN(4)) {
        const int b = F.vcu >> 5, j = F.vcu & 31, a = j & 15;
        const float* cum = (const float*)(F.ws + WS_CUM); const float* km = (const float*)(F.ws + WS_KMEAN); const unsigned* qkn = (const unsigned*)(F.ws + WS_CTL) + CW_QKN;
        for (int r = 0; r < (MK_DUP == 41 ? 8 : 4); ++r) { const int r4 = r & 3; const int a8 = (a + 8) & 15; const int qt = (r4 == 0) ? a : (r4 == 1) ? 15 - a : (r4 == 2) ? a8 : 15 - a8;
            att::attn_unit_v2<1>(F.lds, RB, b, 8 + 2 * r4 + (j >> 4), qt, nullptr, km, F.relb, RA, qkn); }
        { const int hf = j >> 2, qq = j & 3;
          fox_cumsum(F, b * 8 + hf);
          for (int i = 0; i < (MK_DUP == 40 ? 8 : 4); ++i) { const int i4 = i & 3; const int qt = (i4 == 0) ? 15 - qq : (i4 == 1) ? 8 + qq : (i4 == 2) ? 7 - qq : qq;
            att::attn_unit_v2<0>(F.lds, RB, b, hf, qt, cum, nullptr, nullptr, RA, qkn); } }
    } SEAM(4);
    if (IN(5)) { pg8::Gemm g{RA, wo + WO_OUT0 / 2, NTOK, DM, DM}; pg8::StaticOrder S; S.init(NTOK, DM, F.G, (int)blockIdx.x); pg8::EpiBf16 E{RC, DM};
        pg8::gemm_phase<pg8::EpiBf16, pg8::StaticOrder>(F.lds, g, S, E); } SEAM(5);
    if (IN(6)) { thin_phase<true, 0, true>(F, F.x, RC, ng0 + 1 * DM, mods0 + 2048, ng0 + 2 * DM, mods0 + 3072, mods0 + 4096, RA);
#if MK_DUP == 6
        xcd_barrier(bar); thin_phase<true, 0, true>(F, F.x, RC, ng0 + 1 * DM, mods0 + 2048, ng0 + 2 * DM, mods0 + 3072, mods0 + 4096, RA);
#endif
    } SEAM(6);
    if (IN(7)) { { pg8::Gemm g{RA, wo + WO_FGU / 2, NTOK, 2 * DFF, DM / 2}; pg8::StaticOrder S; S.init(NTOK, 2 * DFF, F.G, (int)blockIdx.x); pg8::EpiSwigluFp8 E{(unsigned char*)RB, DFF, 1.f / (FP8_SU * FP8_SW), FP8_SH};
        pg8::gemm_phase<pg8::EpiSwigluFp8, pg8::StaticOrder, true, true, DM / 2>(F.lds, g, S, E); }
#if MK_DUP == 7
        xcd_barrier(bar); { pg8::Gemm g{RA, wo + WO_FGU / 2, NTOK, 2 * DFF, DM / 2}; pg8::StaticOrder S; S.init(NTOK, 2 * DFF, F.G, (int)blockIdx.x); pg8::EpiSwigluFp8 E{(unsigned char*)RB, DFF, 1.f / (FP8_SU * FP8_SW), FP8_SH};
        pg8::gemm_phase<pg8::EpiSwigluFp8, pg8::StaticOrder, true, true, DM / 2>(F.lds, g, S, E); }
#endif
    } SEAM(7);
    if (IN(8)) { pg8::Gemm g{RB, wo + WO_FDN / 2, NTOK, DM, DFF / 2}; pg8::StaticOrder S; S.init(NTOK, DM, F.G, (int)blockIdx.x); pg8::EpiBf16Scaled E{RC, DM, 1.f / (FP8_SH * FP8_SW)};
        pg8::gemm_phase<pg8::EpiBf16Scaled, pg8::StaticOrder, true, true, DFF / 2>(F.lds, g, S, E); } SEAM(8);
    if (IN(9)) { thin_phase<true, 0, false, true>(F, F.out, RC, ng0 + 3 * DM, mods0 + 5120, ng1 + 0, mods1 + 0, mods1 + 1024, RA); } SEAM(9);
    if (IN(10)) { pg8::Gemm g{RA, wo + WO_IN1 / 2, NTOK, 3072, DM}; pg8::StaticOrder S; S.init(NTOK, 3072, F.G, (int)blockIdx.x); pg8::EpiHeadMajor E{RB, NTOK, 0xFFFFull, att::C2, nullptr, nullptr};
        pg8::gemm_phase<pg8::EpiHeadMajor, pg8::StaticOrder>(F.lds, g, S, E); } SEAM(10);
    if (IN(11)) {
        float* ml = (float*)(F.ws + WS_ML);
        att::dilated_phase(F.lds, RB, F.vcu >> 5, F.vcu & 31, F.relb, RA, RC, RD, ml, (const unsigned*)(F.ws + WS_CTL) + CW_KN1);
    } SEAM(11);
    if (IN(12)) { phase_merge(F); } SEAM(12);
    if (IN(13)) { pg8::Gemm g{RA, wo + WO_OUT1 / 2, NTOK, DM, DM}; pg8::StaticOrder S; S.init(NTOK, DM, F.G, (int)blockIdx.x); pg8::EpiBf16 E{RC, DM};
        pg8::gemm_phase<pg8::EpiBf16, pg8::StaticOrder>(F.lds, g, S, E); } SEAM(13);
    if (IN(14)) { thin_phase<true, 2, true, true>(F, F.out, RC, ng1 + 1 * DM, mods1 + 2048, ng1 + 2 * DM, mods1 + 3072, mods1 + 4096, RA); expert_weight_copies(F); } SEAM(14);
    if (IN(15)) { phase_gather(F); } SEAM(15);
    { int t_ = F.tid; asm volatile("" : "+v"(t_)); F.tid = t_; F.lane = t_ & 63; }
    {
        const int* te = (const int*)(F.ws + WS_TILEE);
        const unsigned char* us = F.ws + WS_USORT; unsigned char* hid = F.ws + WS_HID; bf16* ysl = (bf16*)(F.ws + WS_YSLOT);
        const unsigned char* wexp = F.ws + WS_WEXP;
        if (IN(16) || IN(17)) {
            int n = __builtin_amdgcn_readfirstlane(te[MAXTILES]); if (n > MAXTILES) n = MAXTILES;
            if (IN(16) && n > 0) { pg8::Gemm g{(const bf16*)us, (const bf16*)wexp, n * 256, 2 * DFE, DM / 2}; pg8::MoeOrder S; S.so.init(n * 256, 2 * DFE, F.G, (int)blockIdx.x); S.so.wgm = 16; S.tile_e = te; S.estride = WEXP_STRIDE;
                pg8::EpiSwigluFp8 E{hid, DFE, 1.f / (FP8_SU * FP8_SW), FP8_SH}; pg8::gemm_phase<pg8::EpiSwigluFp8, pg8::MoeOrder, true, true, DM / 2>(F.lds, g, S, E); }
            SEAM(16);
            if (IN(17) && n > 0) { pg8::Gemm g{(const bf16*)hid, (const bf16*)(wexp + WEXP_DN_OFF), n * 256, DM, DFE / 2}; pg8::MoeOrder S; S.so.init(n * 256, DM, F.G, (int)blockIdx.x); S.tile_e = te; S.estride = WEXP_STRIDE;
                pg8::EpiBf16Scaled E{ysl, DM, 1.f / (FP8_SH * FP8_SW)}; pg8::gemm_phase<pg8::EpiBf16Scaled, pg8::MoeOrder, true, true, DFE / 2>(F.lds, g, S, E); }
            SEAM(17);
        }
    }
    { int t_ = F.tid; asm volatile("" : "+v"(t_)); F.tid = t_; F.lane = t_ & 63; }
    if (IN(20)) { phase_final(F, ng1 + 3 * DM, mods1 + 5120); }
#undef IN
#undef SEAM
}

extern "C" void kernel_launch(void* const* d_in, const int* in_sizes, int n_in, void* d_out, int out_size, void* d_ws, size_t ws_size, hipStream_t stream) {
    static int grid = 0;
    if (grid == 0) {
        if (n_in != 18 || in_sizes[0] != NTOK * DM || out_size != NTOK * DM || ws_size < WS_END) { fprintf(stderr, "kernel_launch: unexpected shapes / workspace (%d inputs, ws %zu, need %zu); nothing launched\n", n_in, ws_size, (size_t)WS_END); grid = -1; return; }
        int dev = 0, cus = 0, per_cu = 0;
        if (hipGetDevice(&dev) != hipSuccess || hipDeviceGetAttribute(&cus, hipDeviceAttributeMultiprocessorCount, dev) != hipSuccess) { grid = -1; return; }
        if (hipFuncSetAttribute((const void*)trunk_fwd, hipFuncAttributeMaxDynamicSharedMemorySize, LDS_BYTES) != hipSuccess) { fprintf(stderr, "kernel_launch: hipFuncSetAttribute failed\n"); grid = -1; return; }
        if (hipOccupancyMaxActiveBlocksPerMultiprocessor(&per_cu, (const void*)trunk_fwd, NWAVES * 64, LDS_BYTES) != hipSuccess || per_cu < 1) { fprintf(stderr, "kernel_launch: occupancy query reports %d\n", per_cu); }
        (void)hipGetLastError();
        grid = cus;
        if (grid != 256) { fprintf(stderr, "kernel_launch: built for 256 CUs, found %d; nothing launched\n", grid); grid = -1; return; }
    }
    if (grid < 0) return;
    if (hipMemsetAsync((char*)d_ws + WS_CTL, 0, CTL_ZERO_BYTES, stream) != hipSuccess) return;
    Args a{};
    for (int i = 0; i < 18; ++i) a.in[i] = (const float*)d_in[i];
    a.out = (float*)d_out; a.ws = (unsigned char*)d_ws;
#if MK_ONE_LAUNCH
    a.ph_lo = 0; a.ph_hi = MK_LAST_PHASE;
    hipLaunchKernelGGL(trunk_fwd, dim3(grid), dim3(NWAVES * 64), LDS_BYTES, stream, a);
#else
    for (int p = 0; p < MK_LAST_PHASE; ++p) { a.ph_lo = p; a.ph_hi = p + 1; hipLaunchKernelGGL(trunk_fwd, dim3(grid), dim3(NWAVES * 64), LDS_BYTES, stream, a); }
#endif
}
```

```cpp
#include <hip/hip_runtime.h>
#include <cstdio>
#include <cstdint>

#ifndef MK_ONE_LAUNCH
#define MK_ONE_LAUNCH 1
#endif
#ifndef MK_DUP
#define MK_DUP 0
#endif
#ifndef MK_LAST_PHASE
#define MK_LAST_PHASE 21
#endif

#define GAS __attribute__((address_space(1)))
#define LAS __attribute__((address_space(3)))
typedef unsigned short bf16;
typedef unsigned u32x4 __attribute__((ext_vector_type(4)));
typedef unsigned u32x2 __attribute__((ext_vector_type(2)));
typedef float f32x4 __attribute__((ext_vector_type(4)));
typedef float f32x2 __attribute__((ext_vector_type(2)));
typedef float f32x16 __attribute__((ext_vector_type(16)));
typedef short bf16x8 __attribute__((ext_vector_type(8)));
typedef short s16x4 __attribute__((ext_vector_type(4)));
typedef GAS unsigned gu32;

constexpr int NB = 8, SEQ = 4096, DM = 1024, NTOK = NB * SEQ, NH = 16, HD = 64;
constexpr int DFF = 2816, NEXP = 8, DFE = 3584;
constexpr int QKVP = 3072;
constexpr int DIN0 = 3080;
constexpr float NORM_EPS = 1e-6f;
constexpr float LOG2E = 1.4426950408889634f;
constexpr int NWAVES = 8;
constexpr int MAXTILES = 264;
constexpr int PASS0_TILES = 128, PASS1_MAXTILES = MAXTILES - PASS0_TILES;

constexpr size_t MiB = 1u << 20;
constexpr size_t WS_CTL = 0, CTL_ZERO_BYTES = 1 * MiB;
constexpr size_t WS_MODS = 1 * MiB;
constexpr size_t WS_LOGF = 2 * MiB;
constexpr size_t WS_CUM = 3 * MiB;
constexpr size_t WS_KMEAN = 512 * 1024;
constexpr size_t WS_TOKE = 5 * MiB;
constexpr size_t WS_TOKP = WS_TOKE + 256 * 1024;
constexpr size_t WS_TOKR = WS_TOKP + 256 * 1024;
constexpr size_t WS_TOKS = WS_TOKR + 256 * 1024;
constexpr size_t WS_TILEE = 6 * MiB;
constexpr size_t WS_ML = 8 * MiB;
constexpr size_t WS_RA = 24 * MiB;
constexpr size_t WS_RC = 88 * MiB;
constexpr size_t WS_WOTHER = 152 * MiB;
constexpr size_t WS_RB = 185 * MiB;
constexpr size_t WS_RD = 377 * MiB;
constexpr size_t WS_HID = 24 * MiB;
constexpr size_t WS_USORT = 262 * MiB;
constexpr size_t WS_YSLOT = 328 * MiB;
constexpr size_t WS_WEXP = 460 * MiB;
constexpr size_t WS_END = 544 * MiB;
constexpr size_t WEXP_STRIDE = 10 * MiB + 512 * 1024, WEXP_DN_OFF = 7 * MiB;
constexpr float FP8_SW = 64.f, FP8_SU = 4.f, FP8_SH = 8.f;
constexpr size_t WO_IN0 = 0, WO_OUT0 = 6 * MiB, WO_IN1 = 8 * MiB, WO_OUT1 = 14 * MiB, WO_FGU = 16 * MiB, WO_FDN = 27 * MiB;
static_assert(WS_RB + (size_t)NTOK * QKVP * 2 <= WS_RD && WS_HID + (size_t)MAXTILES * 256 * DFE <= WS_USORT && WS_USORT + (size_t)MAXTILES * 256 * DM <= WS_YSLOT && WS_YSLOT + (size_t)MAXTILES * 256 * DM * 2 <= WS_WEXP && WS_WEXP + 8 * WEXP_STRIDE <= WS_END, "d_ws map");
constexpr int CW_GCNT = 1024;
constexpr int CW_QKN = 2048;
constexpr int CW_KN1 = 3072;
constexpr int CW_BAR = 4096;
constexpr int CW_RDONE = 8192;

constexpr int RING_BYTES = 131072;
constexpr int MISC_OFF = RING_BYTES + 320;
constexpr int LDS_BYTES = 147456;

__device__ __forceinline__ unsigned f2bf(float f) { unsigned u = __builtin_bit_cast(unsigned, f); return (u + 0x7fffu + ((u >> 16) & 1u)) >> 16; }
__device__ __forceinline__ unsigned pk2(float lo, float hi) { return f2bf(lo) | (f2bf(hi) << 16); }
__device__ __forceinline__ float bf2f(unsigned short b) { return __builtin_bit_cast(float, (unsigned)b << 16); }
__device__ __forceinline__ float bflo(unsigned w) { return __builtin_bit_cast(float, w << 16); }
__device__ __forceinline__ float bfhi(unsigned w) { return __builtin_bit_cast(float, w & 0xffff0000u); }
__device__ __forceinline__ float wave_sum(float v) {
#pragma unroll
    for (int o = 1; o < 64; o <<= 1) v += __shfl_xor(v, o);
    return v;
}
__device__ __forceinline__ unsigned pk4_fp8(float a, float b, float c, float d) { unsigned w = __builtin_amdgcn_cvt_pk_fp8_f32(a, b, 0u, false); return __builtin_amdgcn_cvt_pk_fp8_f32(c, d, w, true); }
__device__ __forceinline__ float clamp448(float v) { return __builtin_amdgcn_fmed3f(v, -448.f, 448.f); }
#define LDS_WAIT() asm volatile("s_waitcnt lgkmcnt(0)" ::: "memory")
#define VM_WAIT() asm volatile("s_waitcnt vmcnt(0)" ::: "memory")

namespace pg8 {
typedef unsigned short bf16_t;
typedef int v8i_t __attribute__((ext_vector_type(8)));
constexpr int BM = 256, BK = 64, HALF = 128, HTB = HALF * BK * 2, STAGE_BYTES = 8 * HTB, NXCD = 8, WGM = 8;
__host__ __device__ __forceinline__ int lds_byte(int r, int c) { const int st = (r >> 4) * 2 + (c >> 5), rr = r & 15, cc = c & 31, ob = rr * 64 + cc * 2; return st * 1024 + (ob ^ (((ob >> 9) & 1) << 5)); }
__host__ __device__ __forceinline__ void stage_rc(int b, int& R, int& C) { const int st = b / 1024, sb = b % 1024, swz = sb ^ (((sb >> 9) & 1) << 5); R = (st >> 1) * 16 + swz / 64; C = (st & 1) * 32 + (swz % 64) / 2; }
__host__ __device__ __forceinline__ int perm32(int rho) { const int n = rho >> 4, i = rho & 15; return 8 * (i >> 2) + 4 * n + (i & 3); }

struct Unit { int pm, pn, kq; };
struct Gemm { const bf16_t* A; const bf16_t* Bt; int M, N, K; };

struct StaticOrder {
    int nM, nN, nwg, G, c, wgm = WGM;
    __device__ void init(int M, int N, int G_, int c_) { nM = M / BM; nN = N / BM; nwg = nM * nN; G = G_; c = c_; }
    __device__ bool next(int i, Unit& u) const {
        const long L = (long)i * G + c; if (L >= nwg) return false;
        int wgid = (int)L; { const int q = nwg / NXCD, r = nwg % NXCD, xcd = wgid % NXCD, off = wgid / NXCD; wgid = (xcd < r ? xcd * (q + 1) : r * (q + 1) + (xcd - r) * q) + off; }
        const int nig = wgm * nN, gid = wgid / nig, fm = gid * wgm, gsz = (nM - fm) < wgm ? (nM - fm) : wgm;
        u.pm = fm + ((wgid % nig) % gsz); u.pn = (wgid % nig) / gsz; u.kq = -1; return true;
    }
    __device__ __forceinline__ int ntu(const Unit&, int nt_full) const { return nt_full; }
    __device__ __forceinline__ const char* abase(const Gemm& g, const Unit& u) const { return (const char*)g.A + (size_t)u.pm * ((size_t)BM * g.K * 2); }
    __device__ __forceinline__ const char* bbase(const Gemm& g, const Unit& u) const { return (const char*)g.Bt + (size_t)u.pn * ((size_t)BM * g.K * 2); }
};
struct MoeOrder {
    StaticOrder so; const int* tile_e; size_t estride;
    int tail = 0, ntiles = 0;
    static constexpr int TSPLIT = 7, TSLICE_KT = 4;
    __device__ bool next(int i, Unit& u) const {
        if (!tail) return so.next(i, u);
        if (i < 4) return so.next(i, u);
        if (i > 4) return false;
        const int c = so.c, nq = (ntiles - 256) * 4 * TSPLIT; if (c >= nq) return false;
        u.pm = 256 + c / (4 * TSPLIT); u.pn = (c / TSPLIT) & 3; u.kq = c % TSPLIT; return true;
    }
    __device__ __forceinline__ int ntu(const Unit& u, int nt_full) const { return u.kq < 0 ? nt_full : TSLICE_KT; }
    __device__ __forceinline__ const char* abase(const Gemm& g, const Unit& u) const { return (const char*)g.A + (size_t)u.pm * ((size_t)BM * g.K * 2) + (u.kq > 0 ? u.kq * (TSLICE_KT * BK * 2) : 0); }
    __device__ __forceinline__ const char* bbase(const Gemm& g, const Unit& u) const { const int e = __builtin_amdgcn_readfirstlane(tile_e[u.pm]);
        return (const char*)g.Bt + (size_t)e * estride + (size_t)u.pn * ((size_t)BM * g.K * 2) + (u.kq > 0 ? u.kq * (TSLICE_KT * BK * 2) : 0); }
};

typedef float f32x2_t __attribute__((ext_vector_type(2))); typedef __bf16 bf16x2_t __attribute__((ext_vector_type(2)));
__device__ __forceinline__ unsigned cvt_pk_bf16(float lo, float hi) { f32x2_t v = {lo, hi}; bf16x2_t b = __builtin_convertvector(v, bf16x2_t); return __builtin_bit_cast(unsigned, b); }

struct EpiBf16 {
    static constexpr bool PERM = true;
    bf16_t* O; int ldc;
    __device__ __forceinline__ void operator()(const f32x4 (&acc)[2][2][4][2], const Unit& u, int wr, int wc, int fr, int fq) const {
        const int row0 = u.pm * BM + wr * 64 + fr; const int col0 = u.pn * BM + wc * 32 + 8 * fq;
#pragma unroll
        for (int ai = 0; ai < 2; ++ai)
#pragma unroll
            for (int m = 0; m < 4; ++m) { bf16_t* rowp = O + (size_t)(row0 + ai * HALF + m * 16) * ldc + col0;
#pragma unroll
                for (int bj = 0; bj < 2; ++bj) { const f32x4 v0 = acc[ai][bj][m][0], v1 = acc[ai][bj][m][1];
                    u32x4 w; w.x = cvt_pk_bf16(v0[0], v0[1]); w.y = cvt_pk_bf16(v0[2], v0[3]); w.z = cvt_pk_bf16(v1[0], v1[1]); w.w = cvt_pk_bf16(v1[2], v1[3]);
                    *(u32x4*)(rowp + bj * HALF) = w; } }
    }
};
struct EpiHeadMajor {
    static constexpr bool PERM = true;
    bf16_t* O; int M; unsigned long long qmask; float qscale;
    unsigned* nrm; float* kmean;
    __device__ __forceinline__ void operator()(const f32x4 (&acc)[2][2][4][2], const Unit& u, int wr, int wc, int fr, int fq) const {
        const int row0 = u.pm * BM + wr * 64 + fr; const int col0 = u.pn * BM + wc * 32 + 8 * fq;
        const bool donorm = nrm != nullptr && u.pn < 4, dokm = kmean != nullptr && (u.pn == 8 || u.pn == 9);
        float mx[2] = {0.f, 0.f}; float cs[2][8];
#pragma unroll
        for (int bj = 0; bj < 2; ++bj)
#pragma unroll
            for (int q = 0; q < 8; ++q) cs[bj][q] = 0.f;
#pragma unroll
        for (int ai = 0; ai < 2; ++ai)
#pragma unroll
            for (int m = 0; m < 4; ++m) { const int row = row0 + ai * HALF + m * 16;
#pragma unroll
                for (int bj = 0; bj < 2; ++bj) { const int col = col0 + bj * HALF; const float sc = ((qmask >> (col >> 6)) & 1ull) ? qscale : 1.f; const f32x4 v0 = acc[ai][bj][m][0] * sc, v1 = acc[ai][bj][m][1] * sc;
                    u32x4 w; w.x = cvt_pk_bf16(v0[0], v0[1]); w.y = cvt_pk_bf16(v0[2], v0[3]); w.z = cvt_pk_bf16(v1[0], v1[1]); w.w = cvt_pk_bf16(v1[2], v1[3]);
                    *(u32x4*)(O + ((size_t)(col >> 6) * M + row) * 64 + (col & 63)) = w;
                    if (donorm || dokm) {
                        float x[8];
#pragma unroll
                        for (int e = 0; e < 4; ++e) { x[2 * e] = __builtin_bit_cast(float, w[e] << 16); x[2 * e + 1] = __builtin_bit_cast(float, w[e] & 0xffff0000u); }
                        if (donorm) { float s2 = ((x[0] * x[0] + x[1] * x[1]) + (x[2] * x[2] + x[3] * x[3])) + ((x[4] * x[4] + x[5] * x[5]) + (x[6] * x[6] + x[7] * x[7]));
                            s2 += __shfl_xor(s2, 16); s2 += __shfl_xor(s2, 32); mx[bj] = fmaxf(mx[bj], s2); }
                        if (dokm) {
#pragma unroll
                            for (int q = 0; q < 8; ++q) cs[bj][q] += x[q]; }
                    } } }
        if (donorm) {
#pragma unroll
            for (int bj = 0; bj < 2; ++bj) { float v = mx[bj];
#pragma unroll
                for (int o = 1; o < 16; o <<= 1) v = fmaxf(v, __shfl_xor(v, o));
                const int col = u.pn * BM + bj * HALF + wc * 32, slot = col >> 6, half = (col >> 5) & 1, b = u.pm >> 4;
                if ((fr | fq) == 0) __hip_atomic_fetch_max(nrm + ((b * 16 + (slot & 7)) * 2 + (slot >> 3)) * 2 + half, __builtin_bit_cast(unsigned, v), __ATOMIC_RELAXED, __HIP_MEMORY_SCOPE_AGENT); }
        }
        if (dokm) {
#pragma unroll
            for (int bj = 0; bj < 2; ++bj) {
#pragma unroll
                for (int q = 0; q < 8; ++q) { float v = cs[bj][q];
#pragma unroll
                    for (int o = 1; o < 16; o <<= 1) v += __shfl_xor(v, o);
                    cs[bj][q] = v; }
                const int col = col0 + bj * HALF, hh = (col >> 6) - 32, b = u.pm >> 4, blk = u.pm & 15;
                { float v = cs[bj][0];
#pragma unroll
                  for (int q = 1; q < 8; ++q) v = (fr == q) ? cs[bj][q] : v;
                  if (fr < 8) __hip_atomic_fetch_add(kmean + ((size_t)(b * 8 + hh) * 16 + blk) * 64 + (col & 63) + fr, v * (1.f / 256.f), __ATOMIC_RELAXED, __HIP_MEMORY_SCOPE_AGENT); }
            }
        }
    }
};
__device__ __forceinline__ float silu_mul(float g, float u) { return g * u * __builtin_amdgcn_rcpf(1.f + __builtin_amdgcn_exp2f(-g * LOG2E)); }
struct EpiBf16Scaled {
    static constexpr bool PERM = true;
    bf16_t* O; int ldc; float scale; bf16_t* Otail;
    __device__ __forceinline__ void operator()(const f32x4 (&acc)[2][2][4][2], const Unit& u, int wr, int wc, int fr, int fq) const {
        bf16_t* Ob = u.kq < 0 ? O : Otail + (size_t)u.kq * ((size_t)2048 * ldc); const int pmr = u.kq < 0 ? u.pm : u.pm - 256;
        const int row0 = pmr * BM + wr * 64 + fr; const int col0 = u.pn * BM + wc * 32 + 8 * fq;
#pragma unroll
        for (int ai = 0; ai < 2; ++ai)
#pragma unroll
            for (int m = 0; m < 4; ++m) { bf16_t* rowp = Ob + (size_t)(row0 + ai * HALF + m * 16) * ldc + col0;
#pragma unroll
                for (int bj = 0; bj < 2; ++bj) { const f32x4 v0 = acc[ai][bj][m][0] * scale, v1 = acc[ai][bj][m][1] * scale;
                    u32x4 w; w.x = cvt_pk_bf16(v0[0], v0[1]); w.y = cvt_pk_bf16(v0[2], v0[3]); w.z = cvt_pk_bf16(v1[0], v1[1]); w.w = cvt_pk_bf16(v1[2], v1[3]);
                    *(u32x4*)(rowp + bj * HALF) = w; } }
    }
};
struct EpiSwigluFp8 {
    static constexpr bool PERM = true;
    unsigned char* O; int ldc; float sin, sout;
    __device__ __forceinline__ void operator()(const f32x4 (&acc)[2][2][4][2], const Unit& u, int wr, int wc, int fr, int fq) const {
        const int row0 = u.pm * BM + wr * 64 + fr; const int col0 = u.pn * HALF + wc * 32 + 8 * fq;
#pragma unroll
        for (int ai = 0; ai < 2; ++ai)
#pragma unroll
            for (int m = 0; m < 4; ++m) { unsigned char* rowp = O + (size_t)(row0 + ai * HALF + m * 16) * ldc + col0;
                const f32x4 ag0 = acc[ai][0][m][0], ag1 = acc[ai][0][m][1];
                const f32x4 t0 = ag0 * (-sin * LOG2E), t1 = ag1 * (-sin * LOG2E);
                f32x4 d0, d1;
#pragma unroll
                for (int e = 0; e < 4; ++e) { d0[e] = __builtin_amdgcn_exp2f(t0[e]); d1[e] = __builtin_amdgcn_exp2f(t1[e]); }
                d0 = d0 + 1.f; d1 = d1 + 1.f;
                f32x4 r0, r1;
#pragma unroll
                for (int e = 0; e < 4; ++e) { r0[e] = __builtin_amdgcn_rcpf(d0[e]); r1[e] = __builtin_amdgcn_rcpf(d1[e]); }
                const f32x4 v0 = (ag0 * acc[ai][1][m][0]) * (sin * sin * sout) * r0, v1 = (ag1 * acc[ai][1][m][1]) * (sin * sin * sout) * r1;
                u32x2 w; w.x = pk4_fp8(clamp448(v0[0]), clamp448(v0[1]), clamp448(v0[2]), clamp448(v0[3]));
                w.y = pk4_fp8(clamp448(v1[0]), clamp448(v1[1]), clamp448(v1[2]), clamp448(v1[3]));
                *(u32x2*)rowp = w; __builtin_amdgcn_sched_barrier(0); }
    }
};
struct EpiSwiglu {
    static constexpr bool PERM = true;
    bf16_t* O; int ldc;
    __device__ __forceinline__ void operator()(const f32x4 (&acc)[2][2][4][2], const Unit& u, int wr, int wc, int fr, int fq) const {
        const int row0 = u.pm * BM + wr * 64 + fr; const int col0 = u.pn * HALF + wc * 32 + 8 * fq;
#pragma unroll
        for (int ai = 0; ai < 2; ++ai)
#pragma unroll
            for (int m = 0; m < 4; ++m) { bf16_t* rowp = O + (size_t)(row0 + ai * HALF + m * 16) * ldc + col0;
                const f32x4 g0 = acc[ai][0][m][0], g1 = acc[ai][0][m][1], u0 = acc[ai][1][m][0], u1 = acc[ai][1][m][1];
                u32x4 w; w.x = cvt_pk_bf16(silu_mul(g0[0], u0[0]), silu_mul(g0[1], u0[1])); w.y = cvt_pk_bf16(silu_mul(g0[2], u0[2]), silu_mul(g0[3], u0[3]));
                w.z = cvt_pk_bf16(silu_mul(g1[0], u1[0]), silu_mul(g1[1], u1[1])); w.w = cvt_pk_bf16(silu_mul(g1[2], u1[2]), silu_mul(g1[3], u1[3]));
                *(u32x4*)rowp = w; }
    }
};

__device__ __forceinline__ void glds16s(const void* sbase, unsigned voff, unsigned lds_dst) { unsigned keep;
    asm volatile("s_mov_b32 %0, m0\n\ts_mov_b32 m0, %3\n\ts_nop 0\n\tglobal_load_lds_dwordx4 %2, %1\n\ts_mov_b32 m0, %0" : "=&s"(keep) : "s"(sbase), "v"(voff), "s"(lds_dst) : "memory"); }
template <class Epi, class Sched, bool ALIGN_EPI = true, bool FP8 = false, int KC = 0>
__device__ __forceinline__ void gemm_phase(LAS unsigned char* lds, const Gemm g, const Sched& S, const Epi& E) {
    const int tid = threadIdx.x, wid = __builtin_amdgcn_readfirstlane(tid >> 6), lane = tid & 63, wr = wid >> 2, wc = wid & 3, fr = lane & 15, fq = lane >> 4;
    const int K = KC > 0 ? KC : g.K;
    unsigned voffA[2], voffB[2];
#pragma unroll
    for (int i = 0; i < 2; ++i) { int R, C; stage_rc(tid * 16 + i * 8192, R, C); const int Rb = Epi::PERM ? ((R & ~31) + perm32(R & 31)) : R;
        voffA[i] = (unsigned)(R * K + C) * 2u; voffB[i] = (unsigned)(Rb * K + C) * 2u; }
    const size_t kstep = (size_t)(BK * 2);
    const size_t hstep = (size_t)HALF * K * 2;
    const unsigned ldsw = (unsigned)wid * 1024u;
    const unsigned lds_u32 = (unsigned)(unsigned long long)lds;
    const int aoff = lds_byte(wr * 64 + fr, fq * 8), boff = lds_byte(wc * 32 + fr, fq * 8);
    const int aoff8 = lds_byte(wr * 64 + fr, (fq & 1) * 16) + (fq >> 1) * 1024, boff8 = lds_byte(wc * 32 + fr, (fq & 1) * 16) + (fq >> 1) * 1024;
#define PG8_SA(b, h) (((b) * 2 + (h)) * HTB)
#define PG8_SB(b, h) ((4 + (b) * 2 + (h)) * HTB)
#define PG8_STAGE(bufoff, gbase, voff) do { _Pragma("unroll") for (int _i = 0; _i < 2; ++_i) \
        glds16s((const void*)(gbase), (voff)[_i], lds_u32 + (unsigned)(bufoff) + ldsw + (unsigned)(_i * 8192)); } while (0)
#define PG8_LD8(p_) (*(const LAS v8i_t*)(p_))
#define PG8_LDA(dst, b, h) do { if constexpr (FP8) { _Pragma("unroll") for (int m = 0; m < 4; ++m) dst##8[m] = PG8_LD8(lds + PG8_SA(b, h) + aoff8 + m * 2048); } \
        else { _Pragma("unroll") for (int m = 0; m < 4; ++m) _Pragma("unroll") for (int k = 0; k < 2; ++k) dst[m][k] = *(const LAS bf16x8*)(lds + PG8_SA(b, h) + aoff + m * 2048 + k * 1024); } } while (0)
#define PG8_LDB(dst, b, h) do { if constexpr (FP8) { _Pragma("unroll") for (int n = 0; n < 2; ++n) dst##8[n] = PG8_LD8(lds + PG8_SB(b, h) + boff8 + n * 2048); } \
        else { _Pragma("unroll") for (int n = 0; n < 2; ++n) _Pragma("unroll") for (int k = 0; k < 2; ++k) dst[n][k] = *(const LAS bf16x8*)(lds + PG8_SB(b, h) + boff + n * 2048 + k * 1024); } } while (0)
#define PG8_MMA(ai, bj, At, Bt) do { __builtin_amdgcn_s_setprio(1); if constexpr (FP8) { _Pragma("unroll") for (int m = 0; m < 4; ++m) _Pragma("unroll") for (int n = 0; n < 2; ++n) \
            asm volatile("v_mfma_f32_16x16x128_f8f6f4 %0, %1, %2, %0" : "+v"(acc[ai][bj][m][n]) : "v"(Bt##8[n]), "v"(At##8[m])); } \
        else { _Pragma("unroll") for (int m = 0; m < 4; ++m) _Pragma("unroll") for (int n = 0; n < 2; ++n) _Pragma("unroll") for (int k = 0; k < 2; ++k) \
        acc[ai][bj][m][n] = __builtin_amdgcn_mfma_f32_16x16x32_bf16(Bt[n][k], At[m][k], acc[ai][bj][m][n], 0, 0, 0); } __builtin_amdgcn_s_setprio(0); } while (0)
#define PG8_WAIT_V(n) asm volatile("s_waitcnt vmcnt(" #n ")" ::: "memory")
#define PG8_WAIT_L(n) asm volatile("s_waitcnt lgkmcnt(" #n ")" ::: "memory")
#define PG8_BAR __builtin_amdgcn_s_barrier()
#define PG8_SCHED __builtin_amdgcn_sched_barrier(0)
    Unit cur, nxt; int ui = 0;
    if (!S.next(0, cur)) return;
    f32x4 acc[2][2][4][2];
#pragma unroll
    for (int a = 0; a < 2; ++a)
#pragma unroll
        for (int b = 0; b < 2; ++b)
#pragma unroll
            for (int m = 0; m < 4; ++m)
#pragma unroll
                for (int n = 0; n < 2; ++n) acc[a][b][m][n] = (f32x4){0.f, 0.f, 0.f, 0.f};
    bf16x8 At[4][2], B0[2][2], B1[2][2]; v8i_t At8[4], B08[2], B18[2];
    const char* cA = S.abase(g, cur); const char* cB = S.bbase(g, cur); int nt = S.ntu(cur, K / BK);
    PG8_STAGE(PG8_SB(0, 0), cB, voffB); PG8_STAGE(PG8_SB(0, 1), cB + hstep, voffB); PG8_STAGE(PG8_SA(0, 0), cA, voffA); PG8_STAGE(PG8_SA(0, 1), cA + hstep, voffA);
    if (wr == 1) PG8_BAR;
    PG8_WAIT_V(2); PG8_BAR;
    PG8_STAGE(PG8_SB(1, 0), cB + kstep, voffB); PG8_STAGE(PG8_SA(1, 0), cA + kstep, voffA); PG8_STAGE(PG8_SB(1, 1), cB + hstep + kstep, voffB);
    PG8_WAIT_V(6); PG8_BAR;
    for (;;) {
        const bool has_next = S.next(ui + 1, nxt);
        const char* nA = cA; const char* nB = cB;
        if (has_next) { nA = S.abase(g, nxt); nB = S.bbase(g, nxt); }
        for (int t = 0; t < nt; t += 2) {
            const bool last = (t == nt - 2);
            const char* a1 = cA + (size_t)(t + 1) * kstep;
            const char* a2 = last ? nA : cA + (size_t)(t + 2) * kstep; const char* b2 = last ? nB : cB + (size_t)(t + 2) * kstep;
            const char* a3 = a2 + kstep; const char* b3 = b2 + kstep;
            PG8_LDB(B0, 0, 0); PG8_LDB(B1, 0, 1); PG8_SCHED; PG8_LDA(At, 0, 0); PG8_STAGE(PG8_SA(1, 1), a1 + hstep, voffA);
            PG8_WAIT_V(8); PG8_WAIT_L(0); PG8_BAR; PG8_MMA(0, 0, At, B0); PG8_MMA(0, 1, At, B1); PG8_BAR; PG8_SCHED;
            PG8_LDA(At, 0, 1); PG8_STAGE(PG8_SB(0, 0), b2, voffB); PG8_STAGE(PG8_SB(0, 1), b2 + hstep, voffB); PG8_STAGE(PG8_SA(0, 0), a2, voffA);
            PG8_WAIT_V(8); PG8_WAIT_L(0); PG8_BAR; PG8_MMA(1, 0, At, B0); PG8_MMA(1, 1, At, B1); PG8_BAR; PG8_SCHED;
            PG8_LDB(B0, 1, 0); PG8_LDB(B1, 1, 1); PG8_SCHED; PG8_LDA(At, 1, 0); PG8_STAGE(PG8_SA(0, 1), a2 + hstep, voffA);
            PG8_WAIT_V(8); PG8_WAIT_L(0); PG8_BAR; PG8_MMA(0, 0, At, B0); PG8_MMA(0, 1, At, B1); PG8_BAR; PG8_SCHED;
            PG8_LDA(At, 1, 1); PG8_STAGE(PG8_SB(1, 0), b3, voffB); PG8_STAGE(PG8_SB(1, 1), b3 + hstep, voffB); PG8_STAGE(PG8_SA(1, 0), a3, voffA);
            PG8_WAIT_V(8); PG8_WAIT_L(0); PG8_BAR; PG8_MMA(1, 0, At, B0); PG8_MMA(1, 1, At, B1); PG8_BAR; PG8_SCHED;
        }
        if constexpr (ALIGN_EPI) { if (wr == 0) PG8_BAR; }
        if constexpr (FP8) asm volatile("s_nop 15\n\ts_nop 15" ::: "memory");
        E(acc, cur, wr, wc, fr, fq);
#if MK_DUP == 116
        if constexpr (FP8) { asm volatile("" ::: "memory"); E(acc, cur, wr, wc, fr, fq); }
#endif
        if (!has_next) break;
#pragma unroll
        for (int a = 0; a < 2; ++a)
#pragma unroll
            for (int b = 0; b < 2; ++b)
#pragma unroll
                for (int m = 0; m < 4; ++m)
#pragma unroll
                    for (int n = 0; n < 2; ++n) acc[a][b][m][n] = (f32x4){0.f, 0.f, 0.f, 0.f};
        cur = nxt; cA = nA; cB = nB; ++ui; nt = S.ntu(cur, K / BK);
        if constexpr (ALIGN_EPI) { if (wr == 1) PG8_BAR; }
    }
    PG8_WAIT_V(0);
    if constexpr (!ALIGN_EPI) { if (wr == 0) PG8_BAR; }
    PG8_BAR;
#undef PG8_SA
#undef PG8_SB
#undef PG8_STAGE
#undef PG8_LDA
#undef PG8_LDB
#undef PG8_MMA
#undef PG8_WAIT_V
#undef PG8_WAIT_L
#undef PG8_BAR
#undef PG8_SCHED
}
}

namespace att {
constexpr int KS = 0, VS = 16384, TAB = 32768, KM = TAB + 4224 * 4, LDS_END = KM + 4096;
constexpr float C2 = 0.125f * LOG2E;
constexpr float NEG = -1e30f;
__device__ __forceinline__ int crow(int r, int hi) { return (r & 3) + 8 * (r >> 2) + 4 * hi; }
__device__ __forceinline__ int t5_bucket(int d) {
    if (d < 16) return d < 0 ? 0 : d;
    int b = 16;
    b += (d >= 22); b += (d >= 30); b += (d >= 40); b += (d >= 54); b += (d >= 73); b += (d >= 99); b += (d >= 134); b += (d >= 182);
    b += (d >= 246); b += (d >= 332); b += (d >= 450); b += (d >= 609); b += (d >= 825); b += (d >= 1117); b += (d >= 1513);
    return b;
}
__device__ __forceinline__ float swapmax(float m) { return fmaxf(m, __shfl_xor(m, 32)); }
__device__ __forceinline__ float swapsum(float m) { return m + __shfl_xor(m, 32); }
typedef short v4i16_t __attribute__((ext_vector_type(4)));
__device__ __forceinline__ s16x4 vtr(const LAS unsigned char* p) { return __builtin_bit_cast(s16x4, __builtin_amdgcn_ds_read_tr16_b64_v4i16((LAS v4i16_t*)p)); }

constexpr int R_K = 0, R_V = 32768, R_TAB = 65536, R_KM = R_TAB + 4288 * 4, R_TS = R_KM + 4096, R_END = R_TS + 64, R_OSTG = 87040;
#define ATT_WAITBAR(N) asm volatile("s_waitcnt vmcnt(" #N ") lgkmcnt(0)\n\ts_barrier" ::: "memory")
__device__ __forceinline__ bf16x8 scale_q(bf16x8 q) { bf16x8 r;
#pragma unroll
    for (int e = 0; e < 8; ++e) r[e] = (short)f2bf(bf2f((unsigned short)q[e]) * C2);
    return r; }

#define ATT_QK(Ks) do { _Pragma("unroll") for (int d0 = 0; d0 < 4; ++d0) { const bf16x8 k0_ = *(const LAS bf16x8*)((Ks) + koff[d0]), k1_ = *(const LAS bf16x8*)((Ks) + koff[d0] + 4096); \
        p0 = __builtin_amdgcn_mfma_f32_32x32x16_bf16(k0_, qr[d0], p0, 0, 0, 0); p1 = __builtin_amdgcn_mfma_f32_32x32x16_bf16(k1_, qr[d0], p1, 0, 0, 0); } } while (0)
#define ATT_SOFTMAX_PV(vp) do { \
        float mx_ = fmaxf(p0[0], p1[0]); \
        _Pragma("unroll") for (int r = 1; r < 16; ++r) mx_ = fmaxf(mx_, fmaxf(p0[r], p1[r])); \
        mx_ = swapmax(mx_); \
        const float mn_ = fmaxf(m, mx_); \
        if (__any(mn_ > m)) { const float alpha_ = __builtin_amdgcn_exp2f(m - mn_); l *= alpha_; \
            _Pragma("unroll") for (int r = 0; r < 16; ++r) { o0[r] *= alpha_; o1[r] *= alpha_; } } \
        m = mn_; float rs_ = 0.f; \
        _Pragma("unroll") for (int r = 0; r < 16; ++r) { p0[r] = __builtin_amdgcn_exp2f(p0[r] - mn_); p1[r] = __builtin_amdgcn_exp2f(p1[r] - mn_); rs_ += p0[r] + p1[r]; } \
        l += rs_; \
        bf16x8 pa_[4]; \
        _Pragma("unroll") for (int ks = 0; ks < 4; ++ks) { u32x4 w_; \
            _Pragma("unroll") for (int e = 0; e < 4; ++e) { const int r = 8 * (ks & 1) + 2 * e; w_[e] = (ks < 2) ? pg8::cvt_pk_bf16(p0[r], p0[r + 1]) : pg8::cvt_pk_bf16(p1[r], p1[r + 1]); } \
            pa_[ks] = __builtin_bit_cast(bf16x8, w_); } \
        _Pragma("unroll") for (int ks = 0; ks < 4; ++ks) { \
            const s16x4 a0_ = vtr((vp) + ks * 1024), a1_ = vtr((vp) + ks * 1024 + 512), b0_ = vtr((vp) + 4096 + ks * 1024), b1_ = vtr((vp) + 4096 + ks * 1024 + 512); \
            const bf16x8 va_ = (bf16x8){a0_[0], a0_[1], a0_[2], a0_[3], a1_[0], a1_[1], a1_[2], a1_[3]}, vb_ = (bf16x8){b0_[0], b0_[1], b0_[2], b0_[3], b1_[0], b1_[1], b1_[2], b1_[3]}; \
            o0 = __builtin_amdgcn_mfma_f32_32x32x16_bf16(va_, pa_[ks], o0, 0, 0, 0); o1 = __builtin_amdgcn_mfma_f32_32x32x16_bf16(vb_, pa_[ks], o1, 0, 0, 0); } \
    } while (0)
#define ATT_FAST_PV(vp) do { \
        _Pragma("unroll") for (int r = 0; r < 16; ++r) { p0[r] = __builtin_amdgcn_exp2f(p0[r]); p1[r] = __builtin_amdgcn_exp2f(p1[r]); } \
        bf16x8 pa_[4]; \
        _Pragma("unroll") for (int ks = 0; ks < 4; ++ks) { u32x4 w_; \
            _Pragma("unroll") for (int e = 0; e < 4; ++e) { const int r = 8 * (ks & 1) + 2 * e; w_[e] = (ks < 2) ? pg8::cvt_pk_bf16(p0[r], p0[r + 1]) : pg8::cvt_pk_bf16(p1[r], p1[r + 1]); } \
            pa_[ks] = __builtin_bit_cast(bf16x8, w_); } \
        _Pragma("unroll") for (int ks = 0; ks < 4; ++ks) { \
            const s16x4 a0_ = vtr((vp) + ks * 1024), a1_ = vtr((vp) + ks * 1024 + 512), b0_ = vtr((vp) + 4096 + ks * 1024), b1_ = vtr((vp) + 4096 + ks * 1024 + 512); \
            const bf16x8 va_ = (bf16x8){a0_[0], a0_[1], a0_[2], a0_[3], a1_[0], a1_[1], a1_[2], a1_[3]}, vb_ = (bf16x8){b0_[0], b0_[1], b0_[2], b0_[3], b1_[0], b1_[1], b1_[2], b1_[3]}; \
            o0 = __builtin_amdgcn_mfma_f32_32x32x16_bf16(va_, pa_[ks], o0, 0, 0, 0); o1 = __builtin_amdgcn_mfma_f32_32x32x16_bf16(vb_, pa_[ks], o1, 0, 0, 0); \
            o2 = __builtin_amdgcn_mfma_f32_32x32x16_bf16(ones8, pa_[ks], o2, 0, 0, 0); } \
    } while (0)
#define FT_SB __builtin_amdgcn_sched_barrier(0)
#define FT_EX(P, r) P[r] = __builtin_amdgcn_exp2f(P[r])
#define FT_PIN(x) asm volatile("" : "+v"(x))
#define FT_PACK(dst, P, base) do { u32x4 w_; w_[0] = pg8::cvt_pk_bf16(P[(base)], P[(base) + 1]); w_[1] = pg8::cvt_pk_bf16(P[(base) + 2], P[(base) + 3]); \
        w_[2] = pg8::cvt_pk_bf16(P[(base) + 4], P[(base) + 5]); w_[3] = pg8::cvt_pk_bf16(P[(base) + 6], P[(base) + 7]); FT_PIN(w_); dst = __builtin_bit_cast(bf16x8, w_); } while (0)
#define FT_VLOAD(va, vb, ks) do { const s16x4 a0_ = vtr((vp) + (ks) * 1024), a1_ = vtr((vp) + (ks) * 1024 + 512), b0_ = vtr((vp) + 4096 + (ks) * 1024), b1_ = vtr((vp) + 4096 + (ks) * 1024 + 512); \
        va = (bf16x8){a0_[0], a0_[1], a0_[2], a0_[3], a1_[0], a1_[1], a1_[2], a1_[3]}; vb = (bf16x8){b0_[0], b0_[1], b0_[2], b0_[3], b1_[0], b1_[1], b1_[2], b1_[3]}; } while (0)
__device__ __forceinline__ void fast_tile(const LAS unsigned char* Ks, const LAS unsigned char* vp, const int (&koff)[4], const bf16x8 (&qr)[4], const bf16x8 ones8,
                                          f32x16& p0, f32x16& p1, f32x16& o0, f32x16& o1, f32x16& o2) {
    bf16x8 ka[4], kb[4], va0, vb0, va1, vb1, va2, vb2, va3, vb3, pa0, pa1, pa2, pa3;
#pragma unroll
    for (int d0 = 0; d0 < 4; ++d0) ka[d0] = *(const LAS bf16x8*)(Ks + koff[d0]);
#pragma unroll
    for (int d0 = 0; d0 < 4; ++d0) kb[d0] = *(const LAS bf16x8*)(Ks + koff[d0] + 4096);
    FT_SB;
    p0 = __builtin_amdgcn_mfma_f32_32x32x16_bf16(ka[0], qr[0], p0, 0, 0, 0); FT_VLOAD(va0, vb0, 0); FT_SB;
    p0 = __builtin_amdgcn_mfma_f32_32x32x16_bf16(ka[1], qr[1], p0, 0, 0, 0); FT_VLOAD(va1, vb1, 1); FT_SB;
    p0 = __builtin_amdgcn_mfma_f32_32x32x16_bf16(ka[2], qr[2], p0, 0, 0, 0); FT_SB;
    p0 = __builtin_amdgcn_mfma_f32_32x32x16_bf16(ka[3], qr[3], p0, 0, 0, 0); FT_SB;
    p1 = __builtin_amdgcn_mfma_f32_32x32x16_bf16(kb[0], qr[0], p1, 0, 0, 0); FT_EX(p0, 0); FT_EX(p0, 1); FT_EX(p0, 2); FT_PIN(p0); FT_SB;
    p1 = __builtin_amdgcn_mfma_f32_32x32x16_bf16(kb[1], qr[1], p1, 0, 0, 0); FT_EX(p0, 3); FT_EX(p0, 4); FT_EX(p0, 5); FT_PIN(p0); FT_SB;
    p1 = __builtin_amdgcn_mfma_f32_32x32x16_bf16(kb[2], qr[2], p1, 0, 0, 0); FT_EX(p0, 6); FT_EX(p0, 7); FT_EX(p0, 8); FT_PIN(p0); FT_SB;
    p1 = __builtin_amdgcn_mfma_f32_32x32x16_bf16(kb[3], qr[3], p1, 0, 0, 0); FT_PACK(pa0, p0, 0); FT_EX(p0, 9); FT_PIN(p0); FT_SB;
    o0 = __builtin_amdgcn_mfma_f32_32x32x16_bf16(va0, pa0, o0, 0, 0, 0); FT_EX(p0, 10); FT_EX(p0, 11); FT_EX(p0, 12); FT_PIN(p0); FT_VLOAD(va2, vb2, 2); FT_SB;
    o1 = __builtin_amdgcn_mfma_f32_32x32x16_bf16(vb0, pa0, o1, 0, 0, 0); FT_EX(p0, 13); FT_EX(p0, 14); FT_EX(p0, 15); FT_PIN(p0); FT_SB;
    o2 = __builtin_amdgcn_mfma_f32_32x32x16_bf16(ones8, pa0, o2, 0, 0, 0); FT_PACK(pa1, p0, 8); FT_EX(p1, 0); FT_PIN(p1); FT_SB;
    o0 = __builtin_amdgcn_mfma_f32_32x32x16_bf16(va1, pa1, o0, 0, 0, 0); FT_EX(p1, 1); FT_EX(p1, 2); FT_EX(p1, 3); FT_PIN(p1); FT_VLOAD(va3, vb3, 3); FT_SB;
    o1 = __builtin_amdgcn_mfma_f32_32x32x16_bf16(vb1, pa1, o1, 0, 0, 0); FT_EX(p1, 4); FT_EX(p1, 5); FT_EX(p1, 6); FT_PIN(p1); FT_SB;
    o2 = __builtin_amdgcn_mfma_f32_32x32x16_bf16(ones8, pa1, o2, 0, 0, 0); FT_EX(p1, 7); FT_PIN(p1); FT_PACK(pa2, p1, 0); FT_SB;
    o0 = __builtin_amdgcn_mfma_f32_32x32x16_bf16(va2, pa2, o0, 0, 0, 0); FT_EX(p1, 8); FT_EX(p1, 9); FT_EX(p1, 10); FT_PIN(p1); FT_SB;
    o1 = __builtin_amdgcn_mfma_f32_32x32x16_bf16(vb2, pa2, o1, 0, 0, 0); FT_EX(p1, 11); FT_EX(p1, 12); FT_EX(p1, 13); FT_PIN(p1); FT_SB;
    o2 = __builtin_amdgcn_mfma_f32_32x32x16_bf16(ones8, pa2, o2, 0, 0, 0); FT_EX(p1, 14); FT_EX(p1, 15); FT_PIN(p1); FT_PACK(pa3, p1, 8); FT_SB;
    o0 = __builtin_amdgcn_mfma_f32_32x32x16_bf16(va3, pa3, o0, 0, 0, 0);
    o1 = __builtin_amdgcn_mfma_f32_32x32x16_bf16(vb3, pa3, o1, 0, 0, 0);
    o2 = __builtin_amdgcn_mfma_f32_32x32x16_bf16(ones8, pa3, o2, 0, 0, 0); FT_SB;
}
#define ATT_STORE_O(orow, inv) do { _Pragma("unroll") for (int a = 0; a < 4; ++a) { \
        u32x2 w0_, w1_; w0_.x = pg8::cvt_pk_bf16(o0[4 * a] * (inv), o0[4 * a + 1] * (inv)); w0_.y = pg8::cvt_pk_bf16(o0[4 * a + 2] * (inv), o0[4 * a + 3] * (inv)); \
        w1_.x = pg8::cvt_pk_bf16(o1[4 * a] * (inv), o1[4 * a + 1] * (inv)); w1_.y = pg8::cvt_pk_bf16(o1[4 * a + 2] * (inv), o1[4 * a + 3] * (inv)); \
        *(u32x2*)((orow) + 8 * a) = w0_; *(u32x2*)((orow) + 32 + 8 * a) = w1_; } } while (0)

constexpr int OSTG_PITCH = 80, OSTG_WAVE = 32 * OSTG_PITCH;
constexpr int R_BK = 107520, R_RBL = 112640;
template <class RowFn> __device__ __forceinline__ void store_o_staged(LAS unsigned char* stg, const f32x16& o0, const f32x16& o1, float inv, int lane, RowFn rowp) {
    const int q = lane & 31, hi = lane >> 5;
#pragma unroll
    for (int half = 0; half < 2; ++half) {
#pragma unroll
        for (int a = 0; a < 4; ++a) { u32x2 w;
            if (half == 0) { w.x = pg8::cvt_pk_bf16(o0[4 * a] * inv, o0[4 * a + 1] * inv); w.y = pg8::cvt_pk_bf16(o0[4 * a + 2] * inv, o0[4 * a + 3] * inv); }
            else { w.x = pg8::cvt_pk_bf16(o1[4 * a] * inv, o1[4 * a + 1] * inv); w.y = pg8::cvt_pk_bf16(o1[4 * a + 2] * inv, o1[4 * a + 3] * inv); }
            *(LAS u32x2*)(stg + q * OSTG_PITCH + 16 * a + 8 * hi) = w; }
        asm volatile("s_waitcnt lgkmcnt(0)" ::: "memory");
#pragma unroll
        for (int p = 0; p < 2; ++p) { const int ql = (lane >> 2) + 16 * p, c = lane & 3;
            const u32x4 v = *(const LAS u32x4*)(stg + ql * OSTG_PITCH + 16 * c);
            *(u32x4*)(rowp(ql) + half * 32 + 8 * c) = v; }
        asm volatile("s_waitcnt lgkmcnt(0)" ::: "memory");
    }
}

template <int MODE>
__device__ __forceinline__ void attn_unit_v2(LAS unsigned char* lds, const bf16* __restrict__ qkv, int b, int h, int qt,
                                             const float* __restrict__ cum, const float* __restrict__ kmean, const float* __restrict__ relb,
                                             bf16* __restrict__ O, const unsigned* __restrict__ qkn) {
    const int tid = threadIdx.x, lane = tid & 63, r32 = lane & 31, hi = lane >> 5; const int wid = __builtin_amdgcn_readfirstlane(tid >> 6);
    const int qs = (MODE == 0) ? h : 24 + (h - 8), ks = qs + 8, vs = qs + 16;
    const bf16* qb = qkv + ((size_t)qs * NTOK + (size_t)b * SEQ) * 64; const bf16* kb = qkv + ((size_t)ks * NTOK + (size_t)b * SEQ) * 64; const bf16* vb = qkv + ((size_t)vs * NTOK + (size_t)b * SEQ) * 64;
    const int pw = 256 * qt + 32 * wid, myq = pw + r32;
    bf16x8 qr[4];
    { const bf16* qrow = qb + (size_t)myq * 64 + hi * 8;
#pragma unroll
      for (int d0 = 0; d0 < 4; ++d0) qr[d0] = *(const bf16x8*)(qrow + d0 * 16); }
    LAS float* tab = (LAS float*)(lds + R_TAB); LAS float* kml = (LAS float*)(lds + R_KM); LAS int* tsl = (LAS int*)(lds + R_TS);
    const int thi = 4 * qt + 3; int tlo = 0; float fox_b2 = 0.f;
    if (MODE == 0) {
        const unsigned* nq = qkn + (b * 16 + h) * 4;
        const float qn_ = sqrtf(__builtin_bit_cast(float, nq[0]) + __builtin_bit_cast(float, nq[1])), kn_ = sqrtf(__builtin_bit_cast(float, nq[2]) + __builtin_bit_cast(float, nq[3]));
        fox_b2 = 2.f * qn_ * kn_;
        const float* cp = cum + (size_t)(b * 8 + h) * SEQ; const int nk = 256 * (qt + 1);
        for (int s = tid; s < nk; s += 512) tab[s] = -cp[s] * LOG2E;
        if (tid == 0) tsl[0] = 4 * qt;
        __syncthreads();
        if (tid < 4 * qt) {
            const float bound = fox_b2 + (cp[256 * qt] - cp[64 * tid + 63]) * LOG2E;
            if (bound >= -64.f) __hip_atomic_fetch_min(&tsl[0], tid, __ATOMIC_RELAXED, __HIP_MEMORY_SCOPE_WORKGROUP); }
        __syncthreads();
        tlo = __builtin_amdgcn_readfirstlane(tsl[0]);
    } else {
        { const LAS unsigned char* bk = lds + R_BK; const LAS float* rbl = (const LAS float*)(lds + R_RBL);
          for (int j = tid; j < 4288; j += 512) tab[j] = j < 4096 ? rbl[bk[j] * 16 + h] : NEG; }
        const float* kp = kmean + (size_t)(b * 8 + (h - 8)) * 16 * 64;
        for (int j = tid; j < qt * 64; j += 512) kml[j] = kp[j];
        __syncthreads();
    }
    unsigned sel = 0u;
    if (MODE == 1) {
        float v1 = -INFINITY, v2 = -INFINITY, v3 = -INFINITY; int i1 = -1, i2 = -1, i3 = -1;
        for (int n = 0; n < qt; ++n) {
            float part = 0.f;
#pragma unroll
            for (int d0 = 0; d0 < 4; ++d0) { const f32x4 ka = *(const LAS f32x4*)(kml + n * 64 + d0 * 16 + hi * 8), kb = *(const LAS f32x4*)(kml + n * 64 + d0 * 16 + hi * 8 + 4);
                part += bf2f((unsigned short)qr[d0][0]) * ka[0] + bf2f((unsigned short)qr[d0][1]) * ka[1] + bf2f((unsigned short)qr[d0][2]) * ka[2] + bf2f((unsigned short)qr[d0][3]) * ka[3];
                part += bf2f((unsigned short)qr[d0][4]) * kb[0] + bf2f((unsigned short)qr[d0][5]) * kb[1] + bf2f((unsigned short)qr[d0][6]) * kb[2] + bf2f((unsigned short)qr[d0][7]) * kb[3]; }
            const float gt = swapsum(part);
            if (gt > v1) { v3 = v2; i3 = i2; v2 = v1; i2 = i1; v1 = gt; i1 = n; }
            else if (gt > v2) { v3 = v2; i3 = i2; v2 = gt; i2 = n; }
            else if (gt > v3) { v3 = gt; i3 = n; }
        }
        if (i1 >= 0) sel |= 1u << i1; if (i2 >= 0) sel |= 1u << i2; if (i3 >= 0) sel |= 1u << i3;
    }
    bool fast = false; f32x16 o2 = {}; bf16x8 ones8;
#pragma unroll
    for (int e = 0; e < 8; ++e) ones8[e] = (short)0x3F80;
    if (MODE == 1) fast = true;
    const int vrow = 16 * (wid & 3) + (lane >> 2);
    const int krow = 8 * wid + (lane >> 3);
    const bf16* ksrc0 = kb + (size_t)krow * 64 + (((lane & 7) ^ ((krow >> 1) & 7)) * 8);
    const bf16* vsrc0 = vb + (size_t)vrow * 64 + (wid >> 2) * 32 + (lane & 3) * 8;
    int koff[4];
#pragma unroll
    for (int d0 = 0; d0 < 4; ++d0) koff[d0] = r32 * 128 + (((2 * d0 + hi) ^ ((r32 >> 1) & 7)) << 4);
#define ATT_DMA(t) do { const unsigned so_ = (unsigned)((((t) & 3) * 8192) + wid * 1024); \
        __builtin_amdgcn_global_load_lds((const unsigned*)(ksrc0 + (size_t)(t) * 4096), (LAS unsigned*)(lds + R_K + so_), 16, 0, 0); \
        __builtin_amdgcn_global_load_lds((const unsigned*)(vsrc0 + (size_t)(t) * 4096), (LAS unsigned*)(lds + R_V + so_), 16, 0, 0); } while (0)
    const LAS unsigned char* vp0 = lds + R_V + ((lane >> 4) & 1) * 32 + (lane & 3) * 8 + (4 * hi + ((lane & 15) >> 2)) * 64;
    float m = NEG, l = 0.f; f32x16 o0 = {}, o1 = {};
#pragma unroll 1
  for (int attempt = 0; attempt < (MODE == 1 ? 2 : 1); ++attempt) {
    if (attempt == 1) { fast = false; m = NEG; l = 0.f; o0 = f32x16{}; o1 = f32x16{}; }
    asm volatile("s_waitcnt vmcnt(0)" ::: "memory");
    ATT_DMA(tlo); ATT_DMA(tlo + 1); ATT_DMA(tlo + 2);
    ATT_WAITBAR(4);
    for (int t = tlo; t <= thi; ++t) {
        if (t + 3 <= thi) ATT_DMA(t + 3);
        bool active = (64 * t <= pw + 31);
        if (MODE == 1) { if (t < 4 * qt) active = (__ballot((sel >> (t >> 2)) & 1u) != 0ull); }
        if (MODE == 0) { if (64 * t + 63 < pw) active = active && !((fox_b2 + tab[64 * t + 63] - tab[pw]) < -64.f); }
        if (active) {
            const LAS unsigned char* Ks = lds + R_K + (t & 3) * 8192;
            f32x16 p0, p1;
            if (MODE == 0) {
                const LAS float* cn = tab + 64 * t + 4 * hi;
#pragma unroll
                for (int a = 0; a < 4; ++a) { const f32x4 c0 = *(const LAS f32x4*)(cn + 8 * a), c1 = *(const LAS f32x4*)(cn + 32 + 8 * a);
#pragma unroll
                    for (int e = 0; e < 4; ++e) { p0[4 * a + e] = c0[e]; p1[4 * a + e] = c1[e]; } }
            } else {
                const int relbase = myq - 64 * t - 4 * hi;
                const LAS float* tj = tab + (4095 - relbase);
                if (t < 4 * qt) { if (!((sel >> (t >> 2)) & 1u)) tj = tab + 4224; }
#pragma unroll
                for (int r = 0; r < 16; ++r) { const int cr = (r & 3) + 8 * (r >> 2); p0[r] = tj[cr]; p1[r] = tj[cr + 32]; }
            }
            if (!(MODE == 1 && fast)) ATT_QK(Ks);
            if (MODE == 0) { if (t >= 4 * qt) {
#pragma unroll
                    for (int r = 0; r < 16; ++r) { const int kp = 64 * t + crow(r, hi); if (kp > myq) p0[r] = NEG; if (kp + 32 > myq) p1[r] = NEG; } } }
            const LAS unsigned char* vp = vp0 + (t & 3) * 8192;
            if (MODE == 1 && fast) { fast_tile(Ks, vp, koff, qr, ones8, p0, p1, o0, o1, o2); } else { ATT_SOFTMAX_PV(vp); }
        }
        if (t + 3 <= thi) ATT_WAITBAR(4); else if (t + 2 <= thi) ATT_WAITBAR(2); else ATT_WAITBAR(0);
    }
    if (MODE == 1 && attempt == 0) {
        const float l0 = o2[0]; const bool bad = __any(!(l0 > 7.9e-31f && l0 < 1.3e36f));
        if (tid == 0) tsl[1] = 0;
        __syncthreads();
        if (bad && lane == 0) tsl[1] = 1;
        __syncthreads();
        const int redo = __builtin_amdgcn_readfirstlane(tsl[1]);
        __syncthreads();
        if (!redo) break;
    }
  }
#undef ATT_DMA
    const float lt = (MODE == 1 && fast) ? o2[0] : swapsum(l), inv = 1.f / lt;
    store_o_staged(lds + R_OSTG + wid * OSTG_WAVE, o0, o1, inv, lane, [&](int ql) { return O + ((size_t)b * SEQ + pw + ql) * DM + h * 64; });
}

constexpr int DL_K = 0, DL_V = 49152, DL_TAB = 98304, DL_END = DL_TAB + 1536 + 128 + 2048, DL_OSTG = 102400;
__device__ __forceinline__ void dil_params(int i, int j, int& h, int& gp, int& dil, int& cls, int& qt) { const int hp = i / 3, idx = j + 32 * (i % 3), h2 = idx / 48, rem = idx % 48, x = rem & 15;
    h = 2 * hp + h2; gp = rem >> 4; dil = gp == 0 ? 1 : (gp == 1 ? 4 : 16); qt = gp == 0 ? x : (gp == 1 ? (x >> 2) : 0); cls = gp == 0 ? 0 : (gp == 1 ? (x & 3) : x); }
__device__ __forceinline__ void dilated_phase(LAS unsigned char* lds, const bf16* __restrict__ qkv, int b, int j, const float* __restrict__ relb,
                                              bf16* O0, bf16* O1, bf16* O2, float* __restrict__ ml, const unsigned* __restrict__ knw  ) {
    const int tid = threadIdx.x, lane = tid & 63, r32 = lane & 31, hi = lane >> 5; const int wid = __builtin_amdgcn_readfirstlane(tid >> 6);
    const int vrow = 16 * (wid & 3) + (lane >> 2), krow = 8 * wid + (lane >> 3);
    int koff[4];
#pragma unroll
    for (int d0 = 0; d0 < 4; ++d0) koff[d0] = r32 * 128 + (((2 * d0 + hi) ^ ((r32 >> 1) & 7)) << 4);
    LAS float* tab = (LAS float*)(lds + DL_TAB);
    LAS float* rbl = (LAS float*)(lds + DL_TAB + 1536 + 128);
    if (tid < 512) rbl[tid] = relb[tid] * LOG2E;
    __syncthreads();
    u32x4 kv[12]; bf16x8 qn[4], qn2[4];
#define DIL_PREFETCH(h_, qt_, dil_, cls_) do { const int T0_ = 4 * (qt_) - 2; \
        const bf16* ksrc0 = qkv + ((size_t)(16 + (h_)) * NTOK + (size_t)b * SEQ) * 64 + (((lane & 7) ^ ((krow >> 1) & 7)) * 8); \
        const bf16* vsrc0 = qkv + ((size_t)(32 + (h_)) * NTOK + (size_t)b * SEQ) * 64 + (wid >> 2) * 32 + (lane & 3) * 8; \
        _Pragma("unroll") for (int s_ = 0; s_ < 6; ++s_) { int kp_ = 64 * (T0_ + s_) + krow, vq_ = 64 * (T0_ + s_) + vrow; kp_ = kp_ < 0 ? 0 : kp_; vq_ = vq_ < 0 ? 0 : vq_; \
            kv[2 * s_] = *(const u32x4*)(ksrc0 + (size_t)(kp_ * (dil_) + (cls_)) * 64); kv[2 * s_ + 1] = *(const u32x4*)(vsrc0 + (size_t)(vq_ * (dil_) + (cls_)) * 64); } \
        } while (0)
#define DIL_PREFETCH_Q2(h_, qt_, dil_, cls_) do { const bf16* qrow_ = qkv + ((size_t)(h_) * NTOK + (size_t)b * SEQ) * 64 + (size_t)((256 * (qt_) + 32 * wid + r32) * (dil_) + (cls_)) * 64 + hi * 8; \
          _Pragma("unroll") for (int d0 = 0; d0 < 4; ++d0) qn2[d0] = *(const bf16x8*)(qrow_ + d0 * 16); } while (0)
#define DIL_PREFETCH_Q(h_, qt_, dil_, cls_) do { const bf16* qrow_ = qkv + ((size_t)(h_) * NTOK + (size_t)b * SEQ) * 64 + (size_t)((256 * (qt_) + 32 * wid + r32) * (dil_) + (cls_)) * 64 + hi * 8; \
          _Pragma("unroll") for (int d0 = 0; d0 < 4; ++d0) qn[d0] = *(const bf16x8*)(qrow_ + d0 * 16); } while (0)
    bf16x8 ones8;
#pragma unroll
    for (int e = 0; e < 8; ++e) ones8[e] = (short)0x3F80;
    int h, gp, dil, cls, qt;
    const LAS unsigned char* vp0 = lds + DL_V + ((lane >> 4) & 1) * 32 + (lane & 3) * 8 + (4 * hi + ((lane & 15) >> 2)) * 64;
    dil_params(0, j, h, gp, dil, cls, qt);
    DIL_PREFETCH(h, qt, dil, cls); DIL_PREFETCH_Q(h, qt, dil, cls);
    asm volatile("s_waitcnt vmcnt(0)" ::: "memory");
#pragma unroll
    for (int k_ = 0; k_ < 12; ++k_) asm volatile("" : "+v"(kv[k_]));
    constexpr int NIT = (MK_DUP == 113) ? 48 : 24;
#pragma unroll 1
    for (int i = 0; i < NIT; ++i) {
        dil_params(i % 24, j, h, gp, dil, cls, qt);
#pragma unroll
        for (int s_ = 0; s_ < 6; ++s_) { *(LAS u32x4*)(lds + DL_K + s_ * 8192 + wid * 1024 + lane * 16) = kv[2 * s_]; *(LAS u32x4*)(lds + DL_V + s_ * 8192 + wid * 1024 + lane * 16) = kv[2 * s_ + 1]; }
        { for (int j = tid; j < 384; j += 512) { const int rel = 255 - j; tab[j] = (rel >= 0 && rel <= 128) ? rbl[t5_bucket(rel * dil) * 16 + h] : NEG; } }
        __syncthreads();
        if (i + 1 < NIT) { int h2_, g2_, d2, c2, q2; dil_params((i + 1) % 24, j, h2_, g2_, d2, c2, q2); DIL_PREFETCH(h2_, q2, d2, c2); DIL_PREFETCH_Q2(h2_, q2, d2, c2); }
        f32x16 o0 = {}, o1 = {}, o2 = {};
        float cshift = 0.f;
#pragma unroll 1
        for (int attempt = 0; attempt < 2; ++attempt) {
            if (attempt == 1) { float mx = NEG; o0 = f32x16{}; o1 = f32x16{}; o2 = f32x16{};
#pragma unroll
                for (int jj = 0; jj < 3; ++jj) { const int slot = (wid >> 1) + jj;
                    if (4 * qt - 2 + slot >= 0) { const int relbase = 32 * (wid & 1) + r32 + 128 - 64 * jj - 4 * hi; const LAS float* tj = tab + (255 - relbase);
                        f32x16 p0, p1;
#pragma unroll
                        for (int r = 0; r < 16; ++r) { const int cr = (r & 3) + 8 * (r >> 2); p0[r] = tj[cr]; p1[r] = tj[cr + 32]; }
                        const LAS unsigned char* Ks = lds + DL_K + slot * 8192;
                        { bf16x8 (&qr)[4] = qn; ATT_QK(Ks); }
#pragma unroll
                        for (int r = 0; r < 16; ++r) mx = fmaxf(mx, fmaxf(p0[r], p1[r])); } }
                cshift = swapmax(mx); }
#pragma unroll
            for (int jj = 0; jj < 3; ++jj) { const int slot = (wid >> 1) + jj;
                if (4 * qt - 2 + slot >= 0) { const int relbase = 32 * (wid & 1) + r32 + 128 - 64 * jj - 4 * hi; const LAS float* tj = tab + (255 - relbase);
                    f32x16 p0, p1;
                    if (attempt == 0) {
#pragma unroll
                        for (int r = 0; r < 16; ++r) { const int cr = (r & 3) + 8 * (r >> 2); p0[r] = tj[cr]; p1[r] = tj[cr + 32]; } }
                    else {
#pragma unroll
                        for (int r = 0; r < 16; ++r) { const int cr = (r & 3) + 8 * (r >> 2); p0[r] = tj[cr] - cshift; p1[r] = tj[cr + 32] - cshift; } }
                    const LAS unsigned char* Ks = lds + DL_K + slot * 8192;
                    const LAS unsigned char* vp = vp0 + slot * 8192;
                    fast_tile(Ks, vp, koff, qn, ones8, p0, p1, o0, o1, o2); } }
            if (attempt == 0) { const float l0 = o2[0]; if (!__any(!(l0 > 7.9e-31f && l0 < 1.3e36f))) break; }
        }
        const float m = cshift;
        const float lt = o2[0], inv = 1.f / lt;
        asm volatile("s_waitcnt vmcnt(0)" ::: "memory");
#pragma unroll
        for (int k_ = 0; k_ < 12; ++k_) asm volatile("" : "+v"(kv[k_]));
        if (i + 1 < NIT) {
#pragma unroll
            for (int d0 = 0; d0 < 4; ++d0) qn[d0] = qn2[d0]; }
        bf16* Op = gp == 0 ? O0 : (gp == 1 ? O1 : O2);
        const int mytok = (256 * qt + 32 * wid + r32) * dil + cls;
        store_o_staged(lds + DL_OSTG + wid * OSTG_WAVE, o0, o1, inv, lane, [&](int ql) { return Op + ((size_t)b * SEQ + (256 * qt + 32 * wid + ql) * dil + cls) * DM + h * 64; });
        { f32x2 v; v.x = m; v.y = lt; *(f32x2*)(ml + (size_t)gp * NTOK * NH * 2 + (((size_t)b * SEQ + mytok) * NH + h) * 2) = v; }
        __syncthreads();
    }
#undef DIL_PREFETCH
#undef DIL_PREFETCH_Q
}
}

#define XB_TMO      128
#define XB_XCNT(j)  (256  + 64 * (j))
#define XB_XSUB(j)  (1280 + 64 * (j))
#define XB_XGEN(j)  (2304 + 64 * (j))
#define XB_TOP      3328
#define XB_TOPGEN   3392
#define XCD_BAR_WORDS 3456
#define XB_SPIN_CAP (1u << 18)
__device__ __forceinline__ unsigned xb_ld(unsigned* p)              { return __hip_atomic_load(p, __ATOMIC_RELAXED, __HIP_MEMORY_SCOPE_AGENT); }
__device__ __forceinline__ unsigned xb_add(unsigned* p, unsigned v) { return __hip_atomic_fetch_add(p, v, __ATOMIC_RELAXED, __HIP_MEMORY_SCOPE_AGENT); }
__device__ __forceinline__ unsigned xb_xcc_id() { return (unsigned)__builtin_amdgcn_s_getreg((3 << 11) | 20) & 0xFu; }
#define XB_SPIN(cond, bar) do { unsigned _sp = 0; while (cond) { __builtin_amdgcn_s_sleep(1); \
    if ((++_sp & 255u) == 0u) { if (xb_ld(&(bar)[XB_TMO])) break; if (_sp > XB_SPIN_CAP) { atomicAdd(&(bar)[XB_TMO], 1u); break; } } } } while (0)
struct XcdBarrier { unsigned* bar; unsigned x; volatile LAS unsigned* st; };
__device__ __forceinline__ XcdBarrier xcd_barrier_post(unsigned* bar, volatile LAS unsigned* st) {
    XcdBarrier b; b.bar = bar; b.x = xb_xcc_id(); b.st = st;
    if (threadIdx.x == 0) (void)xb_add(&bar[XB_XCNT(b.x)], 1u);
    return b;
}
__device__ __forceinline__ void xcd_barrier_complete(unsigned* bar, unsigned x, unsigned& nloc, unsigned& nx) {
    const unsigned G = gridDim.x * gridDim.y * gridDim.z;
    unsigned sum, cnt, mine, sp = 0u;
    for (;;) {
        sum = 0u; cnt = 0u; mine = 0u;
#pragma unroll
        for (unsigned j = 0; j < 16; ++j) { const unsigned c = xb_ld(&bar[XB_XCNT(j)]); sum += c; cnt += (c > 0u) ? 1u : 0u; mine = (j == x) ? c : mine; }
        if (sum == G) break;
        __builtin_amdgcn_s_sleep(1);
        if ((++sp & 255u) == 0u) { if (xb_ld(&bar[XB_TMO])) break; if (sp > XB_SPIN_CAP) { atomicAdd(&bar[XB_TMO], 1u); break; } }
    }
    nloc = mine > 0u ? mine : 1u; nx = cnt > 0u ? cnt : 1u;
}
__device__ __forceinline__ void xcd_barrier(const XcdBarrier& b) {
    asm volatile("s_waitcnt vmcnt(0)" ::: "memory");
    __syncthreads();
    if (threadIdx.x == 0) {
        unsigned* bar = b.bar;
        __builtin_amdgcn_s_waitcnt(0);
        unsigned nloc = b.st[0], nx = b.st[1];
        if (nloc == 0u) { xcd_barrier_complete(bar, b.x, nloc, nx); b.st[0] = nloc; b.st[1] = nx; }
        const unsigned old = xb_add(&bar[XB_XSUB(b.x)], 1u);
        const unsigned gen = old / nloc;
        if (old + 1u == (gen + 1u) * nloc) {
            __builtin_amdgcn_fence(__ATOMIC_RELEASE, "agent");
            asm volatile("s_waitcnt vmcnt(0)" ::: "memory");
            const unsigned og = xb_add(&bar[XB_TOP], 1u);
            const unsigned tg = og / nx;
            if (og + 1u == (tg + 1u) * nx) xb_add(&bar[XB_TOPGEN], 1u);
            else XB_SPIN(xb_ld(&bar[XB_TOPGEN]) == tg, bar);
            __builtin_amdgcn_fence(__ATOMIC_ACQUIRE, "agent");
            xb_add(&bar[XB_XGEN(b.x)], 1u);
            asm volatile("s_waitcnt vmcnt(0)" ::: "memory");
        } else {
            XB_SPIN(xb_ld(&bar[XB_XGEN(b.x)]) == gen, bar);
            __builtin_amdgcn_fence(__ATOMIC_ACQUIRE, "agent");
            asm volatile("s_waitcnt vmcnt(0)" ::: "memory");
        }
    }
    __syncthreads();
}

struct Args { const float* in[18]; float* out; unsigned char* ws; int ph_lo, ph_hi; };
struct Frame {
    LAS unsigned char* lds; int tid, lane, wave, vcu, G;
    const float *x, *c, *mod_w, *mod_b, *norm_g, *w_in0, *fox_bias, *w_out0, *w_in1, *w_out1, *relb, *ffn_g, *ffn_u, *ffn_d, *router_w, *ex_g, *ex_u, *ex_d;
    float* out; unsigned char* ws;
};

struct TMat { const float* W; unsigned char* WT; int K, N, row_off, mode, fp8; };
__device__ __forceinline__ int t_dest_row(int mode, int n) {
    if (mode == 0) return n;
    if (mode == 1) return ((n >> 7) << 8) + (n & 127);
    return n < 1536 ? n : (n >= 1544 ? n - 8 : -1);
}
__device__ __forceinline__ void t_load(const TMat& m, int item, int lane, f32x4 (&r)[8], int& k0, int& n0) {
    const int kblocks = m.K >> 5, nb = item / kblocks, kb = item - nb * kblocks; k0 = kb * 32; n0 = nb * 64;
    const int n = n0 + 4 * (lane & 15); const bool ok = n < m.N;
    const float* p = m.W + (size_t)(k0 + 8 * (lane >> 4)) * m.N + n;
#pragma unroll
    for (int i = 0; i < 8; ++i) r[i] = ok ? __builtin_nontemporal_load((const f32x4*)(p + (size_t)i * m.N)) : (f32x4){0.f, 0.f, 0.f, 0.f};
}
__device__ __forceinline__ void t_pack(int fp8, const f32x4 (&r)[8], LAS unsigned char* stage, int lane, int k0) {
    const int kr = lane >> 4, n4 = 4 * (lane & 15);
    if (fp8) {
#pragma unroll
        for (int e = 0; e < 4; ++e) { u32x2 w; w.x = pk4_fp8(r[0][e] * FP8_SW, r[1][e] * FP8_SW, r[2][e] * FP8_SW, r[3][e] * FP8_SW); w.y = pk4_fp8(r[4][e] * FP8_SW, r[5][e] * FP8_SW, r[6][e] * FP8_SW, r[7][e] * FP8_SW);
            *(LAS u32x2*)(stage + (n4 + e) * 144 + (k0 & 127) + 8 * kr) = w; }
    } else {
#pragma unroll
        for (int e = 0; e < 4; ++e) { u32x4 w; w.x = pg8::cvt_pk_bf16(r[0][e], r[1][e]); w.y = pg8::cvt_pk_bf16(r[2][e], r[3][e]); w.z = pg8::cvt_pk_bf16(r[4][e], r[5][e]); w.w = pg8::cvt_pk_bf16(r[6][e], r[7][e]);
            *(LAS u32x4*)(stage + (n4 + e) * 144 + (k0 & 63) * 2 + 16 * kr) = w; }
    }
}
__device__ __forceinline__ void t_flush(const TMat& m, int n0, int gk, int cfirst, int clast, const LAS unsigned char* stage, int lane) {
    const int c = lane & 7; const bool okc = c >= cfirst && c <= clast;
#pragma unroll
    for (int j = 0; j < 8; ++j) { const int nl = (lane >> 3) + 8 * j, n = n0 + nl, dr = t_dest_row(m.mode, n);
        const u32x4 w = *(const LAS u32x4*)(stage + nl * 144 + 16 * c);
        if (okc && n < m.N && dr >= 0) *(u32x4*)(m.WT + ((size_t)(m.row_off + dr) * m.K + gk) * (m.fp8 ? 1 : 2) + 16 * c) = w; }
}
template <class Dec> __device__ __forceinline__ void t_run(int i0, int i1, int lane, LAS unsigned char* stage, const Dec& dec) {
    if (i0 >= i1) return;
    f32x4 r[8]; int k0, n0, loc; TMat m;
    dec(i0, m, loc); t_load(m, loc, lane, r, k0, n0);
    int cfirst = -1;
    for (int it = i0; it < i1; ++it) {
        const TMat mc = m; const int k0c = k0, n0c = n0;
        const int gk = mc.fp8 ? (k0c & ~127) : (k0c & ~63);
        const int cs = mc.fp8 ? ((k0c & 127) >> 4) : ((k0c & 63) >> 3), ce = cs + (mc.fp8 ? 1 : 3);
        t_pack(mc.fp8, r, stage, lane, k0c);
        asm volatile("" ::: "memory");
        if (cfirst < 0) cfirst = cs;
        bool flush = true;
        if (it + 1 < i1) { dec(it + 1, m, loc); t_load(m, loc, lane, r, k0, n0);
            const int gkn = m.fp8 ? (k0 & ~127) : (k0 & ~63);
            flush = !(m.W == mc.W && n0 == n0c && gkn == gk); }
        asm volatile("" ::: "memory");
        if (flush) { LDS_WAIT(); t_flush(mc, n0c, gk, cfirst, ce, stage, lane); cfirst = -1; LDS_WAIT(); asm volatile("" ::: "memory"); }
    }
}
__device__ __forceinline__ void t_split(int nitems, int gw, int ngw, int& i0, int& i1) { const int q = nitems / ngw, rem = nitems % ngw; i0 = gw * q + (gw < rem ? gw : rem); i1 = i0 + q + (gw < rem ? 1 : 0); }

__device__ __forceinline__ void weight_copies(Frame& F) {
    LAS unsigned char* scr = F.lds + F.wave * 16384;
    const int gw = F.vcu * NWAVES + F.wave, NGW = F.G * NWAVES;
    unsigned char* wo = F.ws + WS_WOTHER;
    constexpr int I_IN0 = 32 * 49, I_OUT = 32 * 16, I_IN1 = 32 * 48, I_FG = 32 * 44, I_FD = 88 * 16;
    constexpr int NITEMS = I_IN0 + I_OUT + I_IN1 + I_OUT + 2 * I_FG + I_FD;
    auto dec = [&](int it, TMat& m, int& loc) { int r = it;
        if (r < I_IN0) { m = TMat{F.w_in0, wo + WO_IN0, DM, DIN0, 0, 2, 0}; loc = r; return; } r -= I_IN0;
        if (r < I_OUT) { m = TMat{F.w_out0, wo + WO_OUT0, DM, DM, 0, 0, 0}; loc = r; return; } r -= I_OUT;
        if (r < I_IN1) { m = TMat{F.w_in1, wo + WO_IN1, DM, 3 * DM, 0, 0, 0}; loc = r; return; } r -= I_IN1;
        if (r < I_OUT) { m = TMat{F.w_out1, wo + WO_OUT1, DM, DM, 0, 0, 0}; loc = r; return; } r -= I_OUT;
        if (r < I_FG) { m = TMat{F.ffn_g, wo + WO_FGU, DM, DFF, 0, 1, 1}; loc = r; return; } r -= I_FG;
        if (r < I_FG) { m = TMat{F.ffn_u, wo + WO_FGU, DM, DFF, 128, 1, 1}; loc = r; return; } r -= I_FG;
        m = TMat{F.ffn_d, wo + WO_FDN, DFF, DM, 0, 0, 1}; loc = r; };
    int i0, i1; t_split(NITEMS, gw, NGW, i0, i1);
    t_run(i0, i1, F.lane, scr, dec);
    __syncthreads();
}

__device__ __forceinline__ void phase_prologue(Frame& F) {
    if (F.vcu < 192) {
        LAS float* sc = (LAS float*)F.lds;
        LAS float* red = (LAS float*)(F.lds + 32768);
        for (int i = F.tid; i < NB * DM; i += 512) { const float v = F.c[i]; sc[i] = v / (1.f + expf(-v)); }
        __syncthreads();
        const int l = F.vcu / 96, e0 = (F.vcu % 96) * 64, col = F.lane, kq = F.wave;
        float acc[8];
#pragma unroll
        for (int b = 0; b < 8; ++b) acc[b] = 0.f;
        const float* wp = F.mod_w + ((size_t)l * DM + kq * 128) * 6144 + e0 + col;
#pragma unroll 32
        for (int k = 0; k < 128; ++k) { const float w = __builtin_nontemporal_load(wp + (size_t)k * 6144);
#pragma unroll
            for (int b = 0; b < 8; ++b) acc[b] += sc[b * DM + kq * 128 + k] * w; }
#pragma unroll
        for (int b = 0; b < 8; ++b) red[(kq * 8 + b) * 64 + col] = acc[b];
        __syncthreads();
        { const int b = F.tid >> 6; float s = 0.f;
#pragma unroll
          for (int q = 0; q < 8; ++q) s += red[(q * 8 + b) * 64 + col];
          ((float*)(F.ws + WS_MODS))[((size_t)l * NB + b) * 6144 + e0 + col] = s + F.mod_b[l * 6144 + e0 + col]; }
        __syncthreads();
    }
}

__device__ __forceinline__ void expert_weight_copies(Frame& F) {
    LAS unsigned char* scr = F.lds + F.wave * 16384;
    const int gw = F.vcu * NWAVES + F.wave, NGW = F.G * NWAVES;
    constexpr int I_GU = 32 * 56, I_DN = 112 * 16, PER_E = 2 * I_GU + I_DN;
    auto dec = [&](int it, TMat& m, int& loc) { const int e = it / PER_E; int r = it - e * PER_E;
        unsigned char* we = F.ws + WS_WEXP + (size_t)e * WEXP_STRIDE;
        if (r < I_GU) { m = TMat{F.ex_g + (size_t)e * DM * DFE, we, DM, DFE, 0, 1, 1}; loc = r; return; } r -= I_GU;
        if (r < I_GU) { m = TMat{F.ex_u + (size_t)e * DM * DFE, we, DM, DFE, 128, 1, 1}; loc = r; return; } r -= I_GU;
        m = TMat{F.ex_d + (size_t)e * DFE * DM, we + WEXP_DN_OFF, DFE, DM, 0, 0, 1}; loc = r; };
    int i0, i1; t_split(NEXP * PER_E, gw, NGW, i0, i1);
    t_run(i0, i1, F.lane, scr, dec);
}

template <bool RES, int EXTRA, bool U8 = false, bool HB = false>
__device__ __forceinline__ void thin_phase(Frame& F, const float* hin, const bf16* y, const float* gy, const float* gatev  ,
                                           const float* gu, const float* shv, const float* scv, bf16* uout) {
    const int gw = F.vcu * NWAVES + F.wave;
    const int row0 = gw * 16, b = row0 >> 12;
    LAS float* w8 = (LAS float*)F.lds;
    LAS int* lcnt = (LAS int*)(F.lds + 32768);
    if (EXTRA == 1) { for (int i = F.tid; i < 8 * DM; i += 512) { const int k = i >> 3, j = i & 7; w8[j * DM + k] = F.w_in0[(size_t)k * DIN0 + 1536 + j]; } }
    if (EXTRA == 2) { for (int i = F.tid; i < 8 * DM; i += 512) { const int k = i >> 3, j = i & 7; w8[j * DM + k] = F.router_w[(size_t)k * NEXP + j]; }
        if (F.tid < 16) lcnt[F.tid] = 0; }
    if (EXTRA != 0) __syncthreads();
    f32x4 Gv[4], Av[4], Bv[4];
#pragma unroll
    for (int j = 0; j < 4; ++j) { const int c = 256 * j + 4 * F.lane;
        const f32x4 g = *(const f32x4*)(gu + c), s1 = *(const f32x4*)(scv + (size_t)b * 6144 + c); Av[j] = g * (s1 + 1.f); Bv[j] = *(const f32x4*)(shv + (size_t)b * 6144 + c);
        if (RES) Gv[j] = *(const f32x4*)(gatev + (size_t)b * 6144 + c) * *(const f32x4*)(gy + c); }
    for (int i = 0; i < 16; ++i) {
        const int row = row0 + i;
        f32x4 hv[4];
#pragma unroll
        for (int j = 0; j < 4; ++j) { if constexpr (HB) { const u32x2 w = __builtin_nontemporal_load((const u32x2*)((const unsigned char*)hin + (size_t)row * 4096 + 512 * j + 8 * F.lane)); hv[j] = (f32x4){bflo(w.x), bfhi(w.x), bflo(w.y), bfhi(w.y)}; }
            else hv[j] = __builtin_nontemporal_load((const f32x4*)(hin + (size_t)row * DM + 256 * j + 4 * F.lane)); }
        if (RES) {
            f32x4 yv[4]; float ss = 0.f;
#pragma unroll
            for (int j = 0; j < 4; ++j) { const u32x2 w = __builtin_nontemporal_load((const u32x2*)(y + (size_t)row * DM + 256 * j + 4 * F.lane)); yv[j] = (f32x4){bflo(w.x), bfhi(w.x), bflo(w.y), bfhi(w.y)};
#ifdef DBG_SANITIZE
                for (int e_ = 0; e_ < 4; ++e_) if (!(fabsf(yv[j][e_]) < 1e30f)) yv[j][e_] = 0.f;
#endif
                ss += (yv[j].x * yv[j].x + yv[j].y * yv[j].y) + (yv[j].z * yv[j].z + yv[j].w * yv[j].w); }
            const float rstd = 1.f / sqrtf(wave_sum(ss) * (1.f / DM) + NORM_EPS);
#pragma unroll
            for (int j = 0; j < 4; ++j) { hv[j] = hv[j] + Gv[j] * (yv[j] * rstd); u32x2 w; w.x = pg8::cvt_pk_bf16(hv[j].x, hv[j].y); w.y = pg8::cvt_pk_bf16(hv[j].z, hv[j].w);
                __builtin_nontemporal_store(w, (u32x2*)((unsigned char*)F.out + (size_t)row * 4096 + 512 * j + 8 * F.lane)); }
        }
        float s2 = 0.f;
#pragma unroll
        for (int j = 0; j < 4; ++j) s2 += (hv[j].x * hv[j].x + hv[j].y * hv[j].y) + (hv[j].z * hv[j].z + hv[j].w * hv[j].w);
        const float rs = 1.f / sqrtf(wave_sum(s2) * (1.f / DM) + NORM_EPS);
        f32x4 uv[4];
#pragma unroll
        for (int j = 0; j < 4; ++j) { uv[j] = hv[j] * rs * Av[j] + Bv[j];
            if constexpr (U8) { *(unsigned*)((unsigned char*)uout + (size_t)row * DM + 256 * j + 4 * F.lane) = pk4_fp8(clamp448(uv[j].x * FP8_SU), clamp448(uv[j].y * FP8_SU), clamp448(uv[j].z * FP8_SU), clamp448(uv[j].w * FP8_SU)); }
            else { u32x2 w; w.x = pk2(uv[j].x, uv[j].y); w.y = pk2(uv[j].z, uv[j].w); *(u32x2*)(uout + (size_t)row * DM + 256 * j + 4 * F.lane) = w; } }
        if (EXTRA != 0) {
            float d[8];
#pragma unroll
            for (int q = 0; q < 8; ++q) { float s = 0.f;
#pragma unroll
                for (int j = 0; j < 4; ++j) { const f32x4 w = *(const LAS f32x4*)(w8 + q * DM + 256 * j + 4 * F.lane); s += (uv[j].x * w.x + uv[j].y * w.y) + (uv[j].z * w.z + uv[j].w * w.w); }
                d[q] = wave_sum(s); }
            if (EXTRA == 1) {
                float z = d[0];
#pragma unroll
                for (int q = 1; q < 8; ++q) z = (F.lane == q) ? d[q] : z;
                if (F.lane < 8) { z += F.fox_bias[F.lane]; const float ls = fminf(z, 0.f) - log1pf(expf(-fabsf(z)));
                    ((float*)(F.ws + WS_LOGF))[((size_t)b * 8 + F.lane) * SEQ + (row & (SEQ - 1))] = ls; }
            } else {
                int i1 = 0; float v1 = d[0];
#pragma unroll
                for (int q = 1; q < 8; ++q) if (d[q] > v1) { v1 = d[q]; i1 = q; }
                int i2 = -1; float v2 = -INFINITY;
#pragma unroll
                for (int q = 0; q < 8; ++q) if (q != i1 && d[q] > v2) { v2 = d[q]; i2 = q; }
                if (i2 < 0) { i2 = (i1 + 1) & 7; v2 = v1; }
                const float p1 = 1.f / (1.f + expf(v2 - v1)), p2 = 1.f - p1;
                if (F.lane == 0) {
                    const int rl = row - F.vcu * 128;
                    const int k1 = __hip_atomic_fetch_add(&lcnt[i1], 1, __ATOMIC_RELAXED, __HIP_MEMORY_SCOPE_WORKGROUP);
                    const int k2 = __hip_atomic_fetch_add(&lcnt[i2], 1, __ATOMIC_RELAXED, __HIP_MEMORY_SCOPE_WORKGROUP);
                    lcnt[16 + rl * 2] = i1; lcnt[16 + rl * 2 + 1] = i2; lcnt[16 + 256 + rl * 2] = k1; lcnt[16 + 256 + rl * 2 + 1] = k2;
                    f32x2 pv; pv.x = p1; pv.y = p2; *(f32x2*)((float*)(F.ws + WS_TOKP) + (size_t)row * 2) = pv;
                }
            }
        }
    }
    if (EXTRA == 2) {
        __syncthreads();
        if (F.tid < 8) lcnt[8 + F.tid] = (int)__hip_atomic_fetch_add((unsigned*)(F.ws + WS_CTL) + CW_GCNT + 64 * F.tid, (unsigned)lcnt[F.tid], __ATOMIC_RELAXED, __HIP_MEMORY_SCOPE_AGENT);
        __syncthreads();
        if (F.tid < 256) { const int rl = F.tid >> 1, k = F.tid & 1, e = lcnt[16 + F.tid], rk = lcnt[16 + 256 + F.tid]; const size_t row = (size_t)F.vcu * 128 + rl;
            ((int*)(F.ws + WS_TOKE))[row * 2 + k] = e; ((int*)(F.ws + WS_TOKR))[row * 2 + k] = lcnt[8 + e] + rk; }
        __syncthreads();
    }
}

__device__ __forceinline__ void fox_cumsum(Frame& F, int bh) {
    const float* lf = (const float*)(F.ws + WS_LOGF) + (size_t)bh * SEQ; float* cu = (float*)(F.ws + WS_CUM) + (size_t)bh * SEQ;
    LAS float* wt = (LAS float*)(F.lds + RING_BYTES);
    __syncthreads();
    f32x4 a = *(const f32x4*)(lf + F.tid * 8), c = *(const f32x4*)(lf + F.tid * 8 + 4);
    float v[8] = {a.x, a.y, a.z, a.w, c.x, c.y, c.z, c.w};
#pragma unroll
    for (int i = 1; i < 8; ++i) v[i] += v[i - 1];
    float run = v[7];
#pragma unroll
    for (int o = 1; o < 64; o <<= 1) { const float t = __shfl_up(run, o); if (F.lane >= o) run += t; }
    if (F.lane == 63) wt[F.wave] = run;
    __syncthreads();
    float off = run - v[7];
    for (int w = 0; w < F.wave; ++w) off += wt[w];
    f32x4 o0 = {v[0] + off, v[1] + off, v[2] + off, v[3] + off}, o1 = {v[4] + off, v[5] + off, v[6] + off, v[7] + off};
    *(f32x4*)(cu + F.tid * 8) = o0; *(f32x4*)(cu + F.tid * 8 + 4) = o1;
    VM_WAIT();
    __syncthreads();
}

__device__ __forceinline__ void phase_merge(Frame& F) {
    const int gw = F.vcu * NWAVES + F.wave;
    bf16* p0 = (bf16*)(F.ws + WS_RA); const bf16* p1 = (const bf16*)(F.ws + WS_RC); const bf16* p2 = (const bf16*)(F.ws + WS_RD);
    const float* ml = (const float*)(F.ws + WS_ML);
    for (int i0 = 0; i0 < 16; i0 += 2) {
        u32x4 xa[2][2], xb[2][2], xc[2][2]; f32x2 ma[2][2], mb[2][2], mc[2][2];
#pragma unroll
        for (int r = 0; r < 2; ++r) { const size_t row = (size_t)gw * 16 + i0 + r;
#pragma unroll
            for (int c = 0; c < 2; ++c) { const int head = 8 * c + (F.lane >> 3); const size_t mi = (row * NH + head) * 2; const size_t off = row * DM + 512 * c + 8 * F.lane;
                ma[r][c] = *(const f32x2*)(ml + mi); mb[r][c] = *(const f32x2*)(ml + (size_t)NTOK * NH * 2 + mi); mc[r][c] = *(const f32x2*)(ml + (size_t)2 * NTOK * NH * 2 + mi);
                xa[r][c] = __builtin_nontemporal_load((const u32x4*)(p0 + off)); xb[r][c] = __builtin_nontemporal_load((const u32x4*)(p1 + off)); xc[r][c] = __builtin_nontemporal_load((const u32x4*)(p2 + off)); } }
#pragma unroll
        for (int r = 0; r < 2; ++r) { const size_t row = (size_t)gw * 16 + i0 + r;
#pragma unroll
            for (int c = 0; c < 2; ++c) { const f32x2 a = ma[r][c], b = mb[r][c], cc = mc[r][c];
                const float M = fmaxf(a.x, fmaxf(b.x, cc.x));
                float wa = a.y * __builtin_amdgcn_exp2f(a.x - M), wb = b.y * __builtin_amdgcn_exp2f(b.x - M), wc = cc.y * __builtin_amdgcn_exp2f(cc.x - M);
                const float inv = 1.f / (wa + wb + wc); wa *= inv; wb *= inv; wc *= inv;
                u32x4 w;
#pragma unroll
                for (int e = 0; e < 4; ++e) w[e] = pk2(wa * bflo(xa[r][c][e]) + wb * bflo(xb[r][c][e]) + wc * bflo(xc[r][c][e]), wa * bfhi(xa[r][c][e]) + wb * bfhi(xb[r][c][e]) + wc * bfhi(xc[r][c][e]));
                *(u32x4*)(p0 + row * DM + 512 * c + 8 * F.lane) = w; } }
    }
}

__device__ __forceinline__ void phase_gather(Frame& F) {
    LAS int* so = (LAS int*)F.lds;
    if (F.tid == 0) { int acc = 0; for (int e = 0; e < 8; ++e) { so[e] = acc; const int c = (int)__hip_atomic_load((unsigned*)(F.ws + WS_CTL) + CW_GCNT + 64 * e, __ATOMIC_RELAXED, __HIP_MEMORY_SCOPE_AGENT); acc += (c + 255) & ~255; } so[8] = acc; }
    __syncthreads();
    if (F.vcu == 0) { int* te = (int*)(F.ws + WS_TILEE); const int nt = so[8] >> 8;
        for (int t = F.tid; t < MAXTILES; t += 512) { int e = 0; for (int q = 1; q < 8; ++q) if (t * 256 >= so[q]) e = q; te[t] = e; }
        if (F.tid == 0) te[MAXTILES] = nt < MAXTILES ? nt : MAXTILES; }
    const int gw = F.vcu * NWAVES + F.wave;
    const bf16* u = (const bf16*)(F.ws + WS_RA); unsigned char* us = F.ws + WS_USORT;
    const int* te = (const int*)(F.ws + WS_TOKE); const int* tr = (const int*)(F.ws + WS_TOKR); int* ts = (int*)(F.ws + WS_TOKS);
    int d_l = 0;
    if (F.lane < 32) { const int e = te[gw * 32 + F.lane] & 7; d_l = so[e] + tr[gw * 32 + F.lane]; d_l = d_l < 0 ? 0 : (d_l >= MAXTILES * 256 ? MAXTILES * 256 - 1 : d_l); ts[gw * 32 + F.lane] = d_l; }
    const unsigned char* u8 = (const unsigned char*)u;
#pragma unroll 1
    for (int i0 = 0; i0 < 16; i0 += 8) {
        u32x4 a[8];
#pragma unroll
        for (int r = 0; r < 8; ++r) { const size_t row = (size_t)gw * 16 + i0 + r; a[r] = __builtin_nontemporal_load((const u32x4*)(u8 + row * DM + F.lane * 16)); }
#pragma unroll
        for (int r = 0; r < 8; ++r) {
#pragma unroll
            for (int k = 0; k < 2; ++k) { const int dst = __builtin_amdgcn_readlane(d_l, 2 * (i0 + r) + k); *(u32x4*)(us + (size_t)dst * DM + F.lane * 16) = a[r]; } }
    }
}

__device__ __forceinline__ void phase_final(Frame& F, const float* __restrict__ gy, const float* __restrict__ gatev) {
    const int gw = F.vcu * NWAVES + F.wave; const int row0 = gw * 16, b = row0 >> 12;
    const bf16* ys = (const bf16*)(F.ws + WS_YSLOT); const int* ts = (const int*)(F.ws + WS_TOKS); const float* tp = (const float*)(F.ws + WS_TOKP);
    const bf16* yt = (const bf16*)(F.ws + WS_USORT); const bool split = F.G == 256 && __builtin_amdgcn_readfirstlane(((const int*)(F.ws + WS_TILEE))[MAXTILES]) > 256;
    f32x4 Gv[4];
#pragma unroll
    for (int k = 0; k < 4; ++k) { const int c = 512 * (k >> 1) + 8 * F.lane + 4 * (k & 1); Gv[k] = *(const f32x4*)(gatev + (size_t)b * 6144 + c) * *(const f32x4*)(gy + c); }
#define PF_UNPACK(dst, V_, c_) do { dst[2 * (c_)] = (f32x4){bflo(V_[0]), bfhi(V_[0]), bflo(V_[1]), bfhi(V_[1])}; dst[2 * (c_) + 1] = (f32x4){bflo(V_[2]), bfhi(V_[2]), bflo(V_[3]), bfhi(V_[3])}; } while (0)
    for (int i = 0; i < 16; ++i) { const size_t row = (size_t)row0 + i;
        int s1 = ts[row * 2], s2 = ts[row * 2 + 1]; const float p1 = tp[row * 2], p2 = tp[row * 2 + 1];
        s1 = s1 < 0 ? 0 : (s1 >= MAXTILES * 256 ? MAXTILES * 256 - 1 : s1); s2 = s2 < 0 ? 0 : (s2 >= MAXTILES * 256 ? MAXTILES * 256 - 1 : s2);
        f32x4 yv[4], hv[4], ya[4], yb[4]; float ss = 0.f;
#pragma unroll
        for (int c = 0; c < 2; ++c) { const u32x4 w = __builtin_nontemporal_load((const u32x4*)((const unsigned char*)F.out + row * 4096 + 1024 * c + 16 * F.lane)); PF_UNPACK(hv, w, c); }
#pragma unroll
        for (int c = 0; c < 2; ++c) { const u32x4 wa = __builtin_nontemporal_load((const u32x4*)(ys + (size_t)s1 * DM + 512 * c + 8 * F.lane)), wb = __builtin_nontemporal_load((const u32x4*)(ys + (size_t)s2 * DM + 512 * c + 8 * F.lane));
            PF_UNPACK(ya, wa, c); PF_UNPACK(yb, wb, c); }
        if (split && s1 >= 65536) {
#pragma unroll
            for (int k = 0; k < 4; ++k) ya[k] = (f32x4){0.f, 0.f, 0.f, 0.f};
            for (int q = 0; q < pg8::MoeOrder::TSPLIT; ++q) {
#pragma unroll
                for (int c = 0; c < 2; ++c) { const u32x4 w = *(const u32x4*)(yt + ((size_t)q * 2048 + (s1 - 65536)) * DM + 512 * c + 8 * F.lane); f32x4 t_[4]; PF_UNPACK(t_, w, c); ya[2 * c] += t_[2 * c]; ya[2 * c + 1] += t_[2 * c + 1]; } } }
        if (split && s2 >= 65536) {
#pragma unroll
            for (int k = 0; k < 4; ++k) yb[k] = (f32x4){0.f, 0.f, 0.f, 0.f};
            for (int q = 0; q < pg8::MoeOrder::TSPLIT; ++q) {
#pragma unroll
                for (int c = 0; c < 2; ++c) { const u32x4 w = *(const u32x4*)(yt + ((size_t)q * 2048 + (s2 - 65536)) * DM + 512 * c + 8 * F.lane); f32x4 t_[4]; PF_UNPACK(t_, w, c); yb[2 * c] += t_[2 * c]; yb[2 * c + 1] += t_[2 * c + 1]; } } }
#pragma unroll
        for (int k = 0; k < 4; ++k) { yv[k] = p1 * ya[k] + p2 * yb[k];
            ss += (yv[k].x * yv[k].x + yv[k].y * yv[k].y) + (yv[k].z * yv[k].z + yv[k].w * yv[k].w); }
        const float rstd = 1.f / sqrtf(wave_sum(ss) * (1.f / DM) + NORM_EPS);
        VM_WAIT();
#pragma unroll
        for (int k = 0; k < 4; ++k) { float* op = F.out + row * DM + 512 * (k >> 1) + 8 * F.lane + 4 * (k & 1); __builtin_nontemporal_store(hv[k] + Gv[k] * (yv[k] * rstd), (f32x4*)op); }
    }
#undef PF_UNPACK
}

constexpr int NPHASES = 21;
__global__ void __launch_bounds__(NWAVES * 64, 2) trunk_fwd(Args args) {
    extern __shared__ __attribute__((aligned(16))) unsigned char lds_raw[];
    Frame F;
    F.lds = (LAS unsigned char*)lds_raw;
    volatile LAS unsigned* MISC = (volatile LAS unsigned*)(F.lds + MISC_OFF);
    F.tid = threadIdx.x; F.lane = F.tid & 63; F.wave = __builtin_amdgcn_readfirstlane(F.tid >> 6);
    F.G = gridDim.x; { const int bx = blockIdx.x; F.vcu = (F.G % 8 == 0) ? (bx % 8) * (F.G / 8) + bx / 8 : bx; }
    F.x = args.in[0]; F.c = args.in[1]; F.mod_w = args.in[2]; F.mod_b = args.in[3]; F.norm_g = args.in[4]; F.w_in0 = args.in[5]; F.fox_bias = args.in[6]; F.w_out0 = args.in[7];
    F.w_in1 = args.in[8]; F.w_out1 = args.in[9]; F.relb = args.in[10]; F.ffn_g = args.in[11]; F.ffn_u = args.in[12]; F.ffn_d = args.in[13]; F.router_w = args.in[14];
    F.ex_g = args.in[15]; F.ex_u = args.in[16]; F.ex_d = args.in[17]; F.out = args.out; F.ws = args.ws;
    for (int u = F.tid; u < (LDS_BYTES - RING_BYTES) / 4; u += NWAVES * 64) ((LAS unsigned*)(F.lds + RING_BYTES))[u] = 0u;
    __syncthreads();
    const int lo = args.ph_lo, hi = args.ph_hi;
    XcdBarrier bar; bar.bar = (unsigned*)(F.ws + WS_CTL) + CW_BAR; bar.x = 0; bar.st = nullptr;
    if (hi - lo > 1) bar = xcd_barrier_post((unsigned*)(F.ws + WS_CTL) + CW_BAR, MISC + 8);
#define IN(k) (lo <= (k) && (k) < hi)
#define SEAM(k) do { if (IN(k) && IN((k) + 1)) xcd_barrier(bar); } while (0)
    const float* mods = (const float*)(F.ws + WS_MODS);
    const float* mods0 = mods, * mods1 = mods + (size_t)NB * 6144;
    const float* ng0 = F.norm_g, * ng1 = F.norm_g + 4 * DM;
    bf16* RA = (bf16*)(F.ws + WS_RA); bf16* RB = (bf16*)(F.ws + WS_RB); bf16* RC = (bf16*)(F.ws + WS_RC); bf16* RD = (bf16*)(F.ws + WS_RD);
    const bf16* wo = (const bf16*)(F.ws + WS_WOTHER);

    if (IN(0)) { phase_prologue(F); } SEAM(0);
    if (IN(1)) { thin_phase<false, 1>(F, F.x, nullptr, nullptr, nullptr, ng0, mods0 + 0, mods0 + 1024, RA); __syncthreads(); weight_copies(F); } SEAM(1);
    if (IN(2)) { pg8::Gemm g{RA, wo + WO_IN0 / 2, NTOK, 3072, DM}; pg8::StaticOrder S; S.init(NTOK, 3072, F.G, (int)blockIdx.x);
        pg8::EpiHeadMajor E{RB, NTOK, 0xFFull | (0xFFull << 24), att::C2, (unsigned*)(F.ws + WS_CTL) + CW_QKN, (float*)(F.ws + WS_KMEAN)};
        pg8::gemm_phase<pg8::EpiHeadMajor, pg8::StaticOrder>(F.lds, g, S, E); } SEAM(2);
    if (IN(4)) {
        const int b = F.vcu >> 5, j = F.vcu & 31, a = j & 15;
        const float* cum = (const float*)(F.ws + WS_CUM); const float* km = (const float*)(F.ws + WS_KMEAN); const unsigned* qkn = (const unsigned*)(F.ws + WS_CTL) + CW_QKN;
        { LAS unsigned char* bk = F.lds + att::R_BK; LAS float* rbl = (LAS float*)(F.lds + att::R_RBL);
          for (int j2 = F.tid; j2 < 4096; j2 += 512) bk[j2] = (unsigned char)att::t5_bucket(4095 - j2);
          rbl[F.tid] = F.relb[F.tid] * LOG2E;
          __syncthreads(); }
        for (int r = 0; r < (MK_DUP == 41 ? 8 : 4); ++r) { const int r4 = r & 3; const int a8 = (a + 8) & 15; const int qt = (r4 == 0) ? a : (r4 == 1) ? 15 - a : (r4 == 2) ? a8 : 15 - a8;
            att::attn_unit_v2<1>(F.lds, RB, b, 8 + 2 * r4 + (j >> 4), qt, nullptr, km, F.relb, RA, qkn); }
        { const int hf = j >> 2, qq = j & 3;
          fox_cumsum(F, b * 8 + hf);
          for (int i = 0; i < (MK_DUP == 40 ? 8 : 4); ++i) { const int i4 = i & 3; const int qt = (i4 == 0) ? 15 - qq : (i4 == 1) ? 8 + qq : (i4 == 2) ? 7 - qq : qq;
            att::attn_unit_v2<0>(F.lds, RB, b, hf, qt, cum, nullptr, nullptr, RA, qkn); } }
    } SEAM(4);
    if (IN(5)) { pg8::Gemm g{RA, wo + WO_OUT0 / 2, NTOK, DM, DM}; pg8::StaticOrder S; S.init(NTOK, DM, F.G, (int)blockIdx.x); pg8::EpiBf16 E{RC, DM};
        pg8::gemm_phase<pg8::EpiBf16, pg8::StaticOrder>(F.lds, g, S, E); } SEAM(5);
    if (IN(6)) { thin_phase<true, 0, true>(F, F.x, RC, ng0 + 1 * DM, mods0 + 2048, ng0 + 2 * DM, mods0 + 3072, mods0 + 4096, RA);
#if MK_DUP == 6
        xcd_barrier(bar); thin_phase<true, 0, true>(F, F.x, RC, ng0 + 1 * DM, mods0 + 2048, ng0 + 2 * DM, mods0 + 3072, mods0 + 4096, RA);
#endif
    } SEAM(6);
    if (IN(7)) { { pg8::Gemm g{RA, wo + WO_FGU / 2, NTOK, 2 * DFF, DM / 2}; pg8::StaticOrder S; S.init(NTOK, 2 * DFF, F.G, (int)blockIdx.x); pg8::EpiSwigluFp8 E{(unsigned char*)RB, DFF, 1.f / (FP8_SU * FP8_SW), FP8_SH};
        pg8::gemm_phase<pg8::EpiSwigluFp8, pg8::StaticOrder, true, true, DM / 2>(F.lds, g, S, E); }
#if MK_DUP == 7
        xcd_barrier(bar); { pg8::Gemm g{RA, wo + WO_FGU / 2, NTOK, 2 * DFF, DM / 2}; pg8::StaticOrder S; S.init(NTOK, 2 * DFF, F.G, (int)blockIdx.x); pg8::EpiSwigluFp8 E{(unsigned char*)RB, DFF, 1.f / (FP8_SU * FP8_SW), FP8_SH};
        pg8::gemm_phase<pg8::EpiSwigluFp8, pg8::StaticOrder, true, true, DM / 2>(F.lds, g, S, E); }
#endif
    } SEAM(7);
    if (IN(8)) { pg8::Gemm g{RB, wo + WO_FDN / 2, NTOK, DM, DFF / 2}; pg8::StaticOrder S; S.init(NTOK, DM, F.G, (int)blockIdx.x); pg8::EpiBf16Scaled E{RC, DM, 1.f / (FP8_SH * FP8_SW), nullptr};
        pg8::gemm_phase<pg8::EpiBf16Scaled, pg8::StaticOrder, true, true, DFF / 2>(F.lds, g, S, E); } SEAM(8);
    if (IN(9)) { thin_phase<true, 0, false, true>(F, F.out, RC, ng0 + 3 * DM, mods0 + 5120, ng1 + 0, mods1 + 0, mods1 + 1024, RA); } SEAM(9);
    if (IN(10)) { pg8::Gemm g{RA, wo + WO_IN1 / 2, NTOK, 3072, DM}; pg8::StaticOrder S; S.init(NTOK, 3072, F.G, (int)blockIdx.x); pg8::EpiHeadMajor E{RB, NTOK, 0xFFFFull, att::C2, nullptr, nullptr};
        pg8::gemm_phase<pg8::EpiHeadMajor, pg8::StaticOrder>(F.lds, g, S, E); } SEAM(10);
    if (IN(11)) {
        float* ml = (float*)(F.ws + WS_ML);
        att::dilated_phase(F.lds, RB, F.vcu >> 5, F.vcu & 31, F.relb, RA, RC, RD, ml, (const unsigned*)(F.ws + WS_CTL) + CW_KN1);
    } SEAM(11);
    if (IN(12)) { phase_merge(F); } SEAM(12);
    if (IN(13)) { pg8::Gemm g{RA, wo + WO_OUT1 / 2, NTOK, DM, DM}; pg8::StaticOrder S; S.init(NTOK, DM, F.G, (int)blockIdx.x); pg8::EpiBf16 E{RC, DM};
        pg8::gemm_phase<pg8::EpiBf16, pg8::StaticOrder>(F.lds, g, S, E); } SEAM(13);
    if (IN(14)) { thin_phase<true, 2, true, true>(F, F.out, RC, ng1 + 1 * DM, mods1 + 2048, ng1 + 2 * DM, mods1 + 3072, mods1 + 4096, RA);
        unsigned* rdone = (unsigned*)(F.ws + WS_CTL) + CW_RDONE;
        if (F.tid == 0) __hip_atomic_fetch_add(rdone, 1u, __ATOMIC_RELAXED, __HIP_MEMORY_SCOPE_AGENT);
        expert_weight_copies(F);
        __syncthreads();
        if (F.tid < 64) { unsigned spins = 0;
            while ((unsigned)__builtin_amdgcn_readfirstlane(__hip_atomic_load(rdone, __ATOMIC_RELAXED, __HIP_MEMORY_SCOPE_AGENT)) < (unsigned)F.G) { __builtin_amdgcn_s_sleep(1); if (++spins > (1u << 22)) break; }
            __builtin_amdgcn_fence(__ATOMIC_ACQUIRE, "agent"); }
        __syncthreads();
        phase_gather(F); } SEAM(14);
    { int t_ = F.tid; asm volatile("" : "+v"(t_)); F.tid = t_; F.lane = t_ & 63; }
    {
        const int* te = (const int*)(F.ws + WS_TILEE);
        const unsigned char* us = F.ws + WS_USORT; unsigned char* hid = F.ws + WS_HID; bf16* ysl = (bf16*)(F.ws + WS_YSLOT);
        const unsigned char* wexp = F.ws + WS_WEXP;
        if (IN(16) || IN(17)) {
            int n = __builtin_amdgcn_readfirstlane(te[MAXTILES]); if (n > MAXTILES) n = MAXTILES;
            if (IN(16) && n > 0) { pg8::Gemm g{(const bf16*)us, (const bf16*)wexp, n * 256, 2 * DFE, DM / 2}; pg8::MoeOrder S; S.so.init(n * 256, 2 * DFE, F.G, (int)blockIdx.x); S.so.wgm = 16; S.tile_e = te; S.estride = WEXP_STRIDE;
                pg8::EpiSwigluFp8 E{hid, DFE, 1.f / (FP8_SU * FP8_SW), FP8_SH}; pg8::gemm_phase<pg8::EpiSwigluFp8, pg8::MoeOrder, true, true, DM / 2>(F.lds, g, S, E); }
            SEAM(16);
            if (IN(17) && n > 0) { pg8::Gemm g{(const bf16*)hid, (const bf16*)(wexp + WEXP_DN_OFF), n * 256, DM, DFE / 2}; pg8::MoeOrder S; S.tile_e = te; S.estride = WEXP_STRIDE;
                if (n > 256 && F.G == 256) { S.so.init(256 * 256, DM, F.G, (int)blockIdx.x); S.tail = 1; S.ntiles = n; } else S.so.init(n * 256, DM, F.G, (int)blockIdx.x);
                pg8::EpiBf16Scaled E{ysl, DM, 1.f / (FP8_SH * FP8_SW), (bf16*)(F.ws + WS_USORT)  }; pg8::gemm_phase<pg8::EpiBf16Scaled, pg8::MoeOrder, true, true, DFE / 2>(F.lds, g, S, E); }
            SEAM(17);
        }
    }
    { int t_ = F.tid; asm volatile("" : "+v"(t_)); F.tid = t_; F.lane = t_ & 63; }
    if (IN(20)) { phase_final(F, ng1 + 3 * DM, mods1 + 5120); }
#undef IN
#undef SEAM
}

extern "C" void kernel_launch(void* const* d_in, const int* in_sizes, int n_in, void* d_out, int out_size, void* d_ws, size_t ws_size, hipStream_t stream) {
    static int grid = 0;
    if (grid == 0) {
        if (n_in != 18 || in_sizes[0] != NTOK * DM || out_size != NTOK * DM || ws_size < WS_END) { fprintf(stderr, "kernel_launch: unexpected shapes / workspace (%d inputs, ws %zu, need %zu); nothing launched\n", n_in, ws_size, (size_t)WS_END); grid = -1; return; }
        int dev = 0, cus = 0, per_cu = 0;
        if (hipGetDevice(&dev) != hipSuccess || hipDeviceGetAttribute(&cus, hipDeviceAttributeMultiprocessorCount, dev) != hipSuccess) { grid = -1; return; }
        if (hipFuncSetAttribute((const void*)trunk_fwd, hipFuncAttributeMaxDynamicSharedMemorySize, LDS_BYTES) != hipSuccess) { fprintf(stderr, "kernel_launch: hipFuncSetAttribute failed\n"); grid = -1; return; }
        if (hipOccupancyMaxActiveBlocksPerMultiprocessor(&per_cu, (const void*)trunk_fwd, NWAVES * 64, LDS_BYTES) != hipSuccess || per_cu < 1) { fprintf(stderr, "kernel_launch: occupancy query reports %d\n", per_cu); }
        (void)hipGetLastError();
        grid = cus;
        if (grid != 256) { fprintf(stderr, "kernel_launch: built for 256 CUs, found %d; nothing launched\n", grid); grid = -1; return; }
    }
    if (grid < 0) return;
    if (hipMemsetAsync((char*)d_ws + WS_CTL, 0, CTL_ZERO_BYTES, stream) != hipSuccess) return;
    Args a{};
    for (int i = 0; i < 18; ++i) a.in[i] = (const float*)d_in[i];
    a.out = (float*)d_out; a.ws = (unsigned char*)d_ws;
#if MK_ONE_LAUNCH
    a.ph_lo = 0; a.ph_hi = MK_LAST_PHASE;
    hipLaunchKernelGGL(trunk_fwd, dim3(grid), dim3(NWAVES * 64), LDS_BYTES, stream, a);
#else
    for (int p = 0; p < MK_LAST_PHASE; ++p) { a.ph_lo = p; a.ph_hi = p + 1; hipLaunchKernelGGL(trunk_fwd, dim3(grid), dim3(NWAVES * 64), LDS_BYTES, stream, a); }
#endif
}
```
